# Optimizing an MI355X kernel written in HIP

```python
import math
import jax, jax.numpy as jnp
from jax import lax
import numpy as np

D_MODEL = 1024
BATCH = 1
SEQ = 16384
DEPTH = 4

N_MIXERS = 3
RMS_EPS = 1e-6
CONV_W = 4
RG_WIDTH = 1280
RG_BLOCKS = 10
RG_BLOCK_DIM = RG_WIDTH // RG_BLOCKS
RG_C = 8.0
ML_INNER = 2 * D_MODEL
ML_HEADS = 4
ML_HEAD_DIM = ML_INNER // ML_HEADS
ML_QKV_BLOCK = 4
ML_QKV_BLOCKS = ML_INNER // ML_QKV_BLOCK
ML_CHUNK = 128
S5_GROUP = 16
S5_GROUPS = D_MODEL // S5_GROUP
S5_STATE = 64
D_FF = 2816
N_EXPERTS = 8
TOP_K = 2
N_RGLRU = (DEPTH + 2) // 3
N_MLSTM = (DEPTH + 1) // 3
N_S5 = DEPTH // 3
N_DENSE = (DEPTH + 1) // 2
N_MOE = DEPTH // 2

kernel_name = 'hybrid_rglru_mlstm_s5_moe_trunk'


def rms_norm(x, g):
    xf = x.astype(jnp.float32)
    y = xf * lax.rsqrt(jnp.mean(xf * xf, axis=-1, keepdims=True) + RMS_EPS)
    return (y * g.astype(jnp.float32)).astype(x.dtype)


def causal_conv(x, w, b):
    s = x.shape[1]
    xp = jnp.pad(x, ((0, 0), (CONV_W - 1, 0), (0, 0)))
    out = b + w[0] * xp[:, 0:s]
    for k in range(1, CONV_W):
        out = out + w[k] * xp[:, k:k + s]
    return out


def _lin_combine(c1, c2):
    a1, b1 = c1
    a2, b2 = c2
    return a1 * a2, a2 * b1 + b2


def linear_scan(a, b):
    _, h = lax.associative_scan(_lin_combine, (a, b), axis=1)
    return h


def swiglu(h, w1, w3, w2):
    return (jax.nn.silu(h @ w1) * (h @ w3)) @ w2


def rglru_mixer(h, w_in, conv_w, conv_b, w_r, b_r, w_i, b_i, lam, w_out):
    bsz, s, _ = h.shape
    gx, xr = jnp.split(h @ w_in, 2, axis=-1)
    xr = causal_conv(xr, conv_w, conv_b)
    xb = xr.reshape(bsz, s, RG_BLOCKS, RG_BLOCK_DIM)
    r = jax.nn.sigmoid(jnp.einsum('bsni,nij->bsnj', xb, w_r).reshape(bsz, s, RG_WIDTH) + b_r)
    ig = jax.nn.sigmoid(jnp.einsum('bsni,nij->bsnj', xb, w_i).reshape(bsz, s, RG_WIDTH) + b_i)
    log_a = (-RG_C * r * jax.nn.softplus(-lam)).astype(jnp.float32)
    a = jnp.exp(log_a)
    b = jnp.sqrt(-jnp.expm1(2.0 * log_a)) * (ig * xr).astype(jnp.float32)
    hs = linear_scan(a, b).astype(h.dtype)
    return (jax.nn.gelu(gx) * hs) @ w_out


def mlstm_chunkwise(q, k, v, ig, lf):
    q, k, v, ig, lf = (t.astype(jnp.float32) for t in (q, k, v, ig, lf))
    bsz, s = q.shape[:2]
    nc = s // ML_CHUNK

    def to_chunks(t):
        return t.reshape(bsz, nc, ML_CHUNK, ML_HEADS, ML_HEAD_DIM).transpose(1, 0, 3, 2, 4)

    def gate_chunks(t):
        return t.reshape(bsz, nc, ML_CHUNK, ML_HEADS).transpose(1, 0, 3, 2)

    mask = jnp.tril(jnp.ones((ML_CHUNK, ML_CHUNK), dtype=bool))

    def step(carry, inp):
        c_st, n_st, m_st = carry
        qc, kc, vc, ic, fc = inp
        bcum = jnp.cumsum(fc, axis=-1)
        dm = bcum[..., :, None] - bcum[..., None, :] + ic[..., None, :]
        dm = jnp.where(mask, dm, -jnp.inf)
        inter = bcum + m_st[..., None]
        m_t = jnp.maximum(inter, jnp.max(dm, axis=-1))
        dexp = jnp.exp(dm - m_t[..., None])
        sc = jnp.exp(inter - m_t)
        sco = jnp.einsum('bhtd,bhsd->bhts', qc, kc) * dexp
        num = jnp.einsum('bhts,bhse->bhte', sco, vc) + sc[..., None] * jnp.einsum('bhtd,bhde->bhte', qc, c_st)
        den = jnp.sum(sco, axis=-1) + sc * jnp.einsum('bhtd,bhd->bht', qc, n_st)
        hc = num / jnp.maximum(jnp.abs(den), jnp.exp(-m_t))[..., None]
        m_new = m_t[..., -1]
        w = jnp.exp(bcum[..., -1:] - bcum + ic - m_new[..., None])
        decay = jnp.exp(bcum[..., -1] + m_st - m_new)
        c_new = decay[..., None, None] * c_st + jnp.einsum('bhs,bhsd,bhse->bhde', w, kc, vc)
        n_new = decay[..., None] * n_st + jnp.einsum('bhs,bhsd->bhd', w, kc)
        return (c_new, n_new, m_new), hc

    init = (jnp.zeros((bsz, ML_HEADS, ML_HEAD_DIM, ML_HEAD_DIM), jnp.float32),
            jnp.zeros((bsz, ML_HEADS, ML_HEAD_DIM), jnp.float32),
            jnp.zeros((bsz, ML_HEADS), jnp.float32))
    _, hs = lax.scan(step, init, (to_chunks(q), to_chunks(k), to_chunks(v), gate_chunks(ig), gate_chunks(lf)))
    return hs.transpose(1, 0, 3, 2, 4).reshape(bsz, s, ML_HEADS, ML_HEAD_DIM)


def mlstm_mixer(h, w_in, conv_w, conv_b, w_q, w_k, w_v, w_gate, b_gate, norm_g, skip, w_out):
    bsz, s, _ = h.shape
    xm, z = jnp.split(h @ w_in, 2, axis=-1)
    xc = jax.nn.silu(causal_conv(xm, conv_w, conv_b))

    def headwise(t, w):
        tb = t.reshape(bsz, s, ML_QKV_BLOCKS, ML_QKV_BLOCK)
        return jnp.einsum('bsni,nij->bsnj', tb, w).reshape(bsz, s, ML_INNER)

    q = headwise(xc, w_q)
    k = headwise(xc, w_k)
    v = headwise(xm, w_v)
    gates = (jnp.concatenate([q, k, v], axis=-1) @ w_gate + b_gate).astype(jnp.float32)
    ig, fg = jnp.split(gates, 2, axis=-1)
    lf = jax.nn.log_sigmoid(fg)

    def heads(t):
        return t.reshape(bsz, s, ML_HEADS, ML_HEAD_DIM)

    hc = mlstm_chunkwise(heads(q), heads(k) * (ML_HEAD_DIM ** -0.5), heads(v), ig, lf)
    hn = hc * lax.rsqrt(jnp.mean(hc * hc, axis=-1, keepdims=True) + RMS_EPS)
    hn = (hn.reshape(bsz, s, ML_INNER) * norm_g.astype(jnp.float32)).astype(h.dtype)
    y = jax.nn.sigmoid(z) * (hn + skip * xc)
    return y @ w_out


def s5_mixer(h, a_re, a_im, log_step, b_re, b_im, c_re, c_im, d_skip, w_glu, b_glu):
    bsz, s, _ = h.shape
    f32 = jnp.float32
    u = h.astype(f32).reshape(bsz, s, S5_GROUPS, S5_GROUP)
    lam = lax.complex(a_re.astype(f32), a_im.astype(f32))
    step = jnp.exp(log_step.astype(f32))[:, None]
    lam_bar = jnp.exp(lam * step)
    b_bar = ((lam_bar - 1.0) / lam)[..., None] * lax.complex(b_re.astype(f32), b_im.astype(f32))
    bu = jnp.einsum('bsgi,gpi->bsgp', u.astype(jnp.complex64), b_bar)
    states = linear_scan(jnp.broadcast_to(lam_bar, bu.shape), bu)
    c_mat = lax.complex(c_re.astype(f32), c_im.astype(f32))
    y = jnp.einsum('bsgp,gip->bsgi', states, c_mat).real + d_skip.astype(f32).reshape(S5_GROUPS, S5_GROUP) * u
    y = jax.nn.gelu(y.reshape(bsz, s, D_MODEL)).astype(h.dtype)
    return y * jax.nn.sigmoid(y @ w_glu + b_glu)


def moe_swiglu(h, router, router_b, w1, w3, w2):
    logits = (h @ router).astype(jnp.float32) + router_b.astype(jnp.float32)
    top_v, top_i = lax.top_k(logits, TOP_K)
    top_w = jax.nn.softmax(top_v, axis=-1)
    gates = jnp.sum(jax.nn.one_hot(top_i, N_EXPERTS, dtype=jnp.float32) * top_w[..., None], axis=-2)
    gates = gates.astype(h.dtype)
    out = jnp.zeros_like(h)
    for e in range(N_EXPERTS):
        out = out + gates[..., e:e + 1] * swiglu(h, w1[e], w3[e], w2[e])
    return out


def setup_inputs(seed: int = 0) -> dict:
    key = jax.random.key(seed)
    ks = iter(jax.random.split(key, 64))
    f32 = jnp.float32

    def nrm(shape, scale):
        return scale * jax.random.normal(next(ks), shape, f32)

    def gain(shape):
        return 1.0 + nrm(shape, 0.02)

    x = nrm((BATCH, SEQ, D_MODEL), 1.0)
    norm_mix = gain((DEPTH, D_MODEL))
    norm_ffn = gain((DEPTH, D_MODEL))
    norm_final = gain((D_MODEL,))
    a_w_in = nrm((N_RGLRU, D_MODEL, 2 * RG_WIDTH), D_MODEL ** -0.5)
    a_conv_w = nrm((N_RGLRU, CONV_W, RG_WIDTH), CONV_W ** -0.5)
    a_conv_b = nrm((N_RGLRU, RG_WIDTH), 0.02)
    a_w_r = nrm((N_RGLRU, RG_BLOCKS, RG_BLOCK_DIM, RG_BLOCK_DIM), RG_BLOCK_DIM ** -0.5)
    a_b_r = nrm((N_RGLRU, RG_WIDTH), 0.1)
    a_w_i = nrm((N_RGLRU, RG_BLOCKS, RG_BLOCK_DIM, RG_BLOCK_DIM), RG_BLOCK_DIM ** -0.5)
    a_b_i = nrm((N_RGLRU, RG_WIDTH), 0.1)
    a0 = jax.random.uniform(next(ks), (N_RGLRU, RG_WIDTH), f32, 0.9, 0.999)
    a_lam = jnp.log(a0) - jnp.log1p(-a0)
    a_w_out = nrm((N_RGLRU, RG_WIDTH, D_MODEL), RG_WIDTH ** -0.5)
    b_w_in = nrm((N_MLSTM, D_MODEL, 2 * ML_INNER), D_MODEL ** -0.5)
    b_conv_w = nrm((N_MLSTM, CONV_W, ML_INNER), CONV_W ** -0.5)
    b_conv_b = nrm((N_MLSTM, ML_INNER), 0.02)
    b_w_q = nrm((N_MLSTM, ML_QKV_BLOCKS, ML_QKV_BLOCK, ML_QKV_BLOCK), ML_QKV_BLOCK ** -0.5)
    b_w_k = nrm((N_MLSTM, ML_QKV_BLOCKS, ML_QKV_BLOCK, ML_QKV_BLOCK), ML_QKV_BLOCK ** -0.5)
    b_w_v = nrm((N_MLSTM, ML_QKV_BLOCKS, ML_QKV_BLOCK, ML_QKV_BLOCK), ML_QKV_BLOCK ** -0.5)
    b_w_gate = nrm((N_MLSTM, 3 * ML_INNER, 2 * ML_HEADS), (3 * ML_INNER) ** -0.5)
    f_bias = jnp.broadcast_to(jnp.linspace(3.0, 6.0, ML_HEADS, dtype=f32), (N_MLSTM, ML_HEADS))
    b_b_gate = jnp.concatenate([nrm((N_MLSTM, ML_HEADS), 0.1), f_bias + nrm((N_MLSTM, ML_HEADS), 0.1)], axis=-1)
    b_norm = gain((N_MLSTM, ML_INNER))
    b_skip = gain((N_MLSTM, ML_INNER))
    b_w_out = nrm((N_MLSTM, ML_INNER, D_MODEL), ML_INNER ** -0.5)
    c_a_re = -0.5 + nrm((N_S5, S5_GROUPS, S5_STATE), 0.01)
    c_a_im = math.pi * jnp.arange(S5_STATE, dtype=f32) + nrm((N_S5, S5_GROUPS, S5_STATE), 0.01)
    c_log_step = jax.random.uniform(next(ks), (N_S5, S5_GROUPS), f32, math.log(1e-3), math.log(1e-1))
    c_b_re = nrm((N_S5, S5_GROUPS, S5_STATE, S5_GROUP), (2 * S5_GROUP) ** -0.5)
    c_b_im = nrm((N_S5, S5_GROUPS, S5_STATE, S5_GROUP), (2 * S5_GROUP) ** -0.5)
    c_c_re = nrm((N_S5, S5_GROUPS, S5_GROUP, S5_STATE), S5_STATE ** -0.5)
    c_c_im = nrm((N_S5, S5_GROUPS, S5_GROUP, S5_STATE), S5_STATE ** -0.5)
    c_d = nrm((N_S5, D_MODEL), 1.0)
    c_w_glu = nrm((N_S5, D_MODEL, D_MODEL), D_MODEL ** -0.5)
    c_b_glu = nrm((N_S5, D_MODEL), 0.02)
    f_w1 = nrm((N_DENSE, D_MODEL, D_FF), D_MODEL ** -0.5)
    f_w3 = nrm((N_DENSE, D_MODEL, D_FF), D_MODEL ** -0.5)
    f_w2 = nrm((N_DENSE, D_FF, D_MODEL), D_FF ** -0.5)
    e_router = nrm((N_MOE, D_MODEL, N_EXPERTS), D_MODEL ** -0.5)
    e_router_b = nrm((N_MOE, N_EXPERTS), 0.01)
    e_w1 = nrm((N_MOE, N_EXPERTS, D_MODEL, D_FF), D_MODEL ** -0.5)
    e_w3 = nrm((N_MOE, N_EXPERTS, D_MODEL, D_FF), D_MODEL ** -0.5)
    e_w2 = nrm((N_MOE, N_EXPERTS, D_FF, D_MODEL), D_FF ** -0.5)
    return {'x': x, 'norm_mix': norm_mix, 'norm_ffn': norm_ffn, 'norm_final': norm_final,
            'a_w_in': a_w_in, 'a_conv_w': a_conv_w, 'a_conv_b': a_conv_b, 'a_w_r': a_w_r, 'a_b_r': a_b_r,
            'a_w_i': a_w_i, 'a_b_i': a_b_i, 'a_lam': a_lam, 'a_w_out': a_w_out,
            'b_w_in': b_w_in, 'b_conv_w': b_conv_w, 'b_conv_b': b_conv_b, 'b_w_q': b_w_q, 'b_w_k': b_w_k,
            'b_w_v': b_w_v, 'b_w_gate': b_w_gate, 'b_b_gate': b_b_gate, 'b_norm': b_norm, 'b_skip': b_skip,
            'b_w_out': b_w_out,
            'c_a_re': c_a_re, 'c_a_im': c_a_im, 'c_log_step': c_log_step, 'c_b_re': c_b_re, 'c_b_im': c_b_im,
            'c_c_re': c_c_re, 'c_c_im': c_c_im, 'c_d': c_d, 'c_w_glu': c_w_glu, 'c_b_glu': c_b_glu,
            'f_w1': f_w1, 'f_w3': f_w3, 'f_w2': f_w2,
            'e_router': e_router, 'e_router_b': e_router_b, 'e_w1': e_w1, 'e_w3': e_w3, 'e_w2': e_w2}


def reference(x, norm_mix, norm_ffn, norm_final,
              a_w_in, a_conv_w, a_conv_b, a_w_r, a_b_r, a_w_i, a_b_i, a_lam, a_w_out,
              b_w_in, b_conv_w, b_conv_b, b_w_q, b_w_k, b_w_v, b_w_gate, b_b_gate, b_norm, b_skip, b_w_out,
              c_a_re, c_a_im, c_log_step, c_b_re, c_b_im, c_c_re, c_c_im, c_d, c_w_glu, c_b_glu,
              f_w1, f_w3, f_w2,
              e_router, e_router_b, e_w1, e_w3, e_w2):
    for i in range(DEPTH):
        hn = rms_norm(x, norm_mix[i])
        kind = i % N_MIXERS
        j = i // N_MIXERS
        if kind == 0:
            mix = rglru_mixer(hn, a_w_in[j], a_conv_w[j], a_conv_b[j], a_w_r[j], a_b_r[j],
                              a_w_i[j], a_b_i[j], a_lam[j], a_w_out[j])
        elif kind == 1:
            mix = mlstm_mixer(hn, b_w_in[j], b_conv_w[j], b_conv_b[j], b_w_q[j], b_w_k[j], b_w_v[j],
                              b_w_gate[j], b_b_gate[j], b_norm[j], b_skip[j], b_w_out[j])
        else:
            mix = s5_mixer(hn, c_a_re[j], c_a_im[j], c_log_step[j], c_b_re[j], c_b_im[j],
                           c_c_re[j], c_c_im[j], c_d[j], c_w_glu[j], c_b_glu[j])
        x = x + mix
        hn = rms_norm(x, norm_ffn[i])
        f = i // 2
        if i % 2 == 0:
            x = x + swiglu(hn, f_w1[f], f_w3[f], f_w2[f])
        else:
            x = x + moe_swiglu(hn, e_router[f], e_router_b[f], e_w1[f], e_w3[f], e_w2[f])
    return rms_norm(x, norm_final)
```

```cpp
#include <hip/hip_runtime.h>
#include <cstdio>
#include <cstdint>

#define LAS __attribute__((address_space(3)))
#define GAS __attribute__((address_space(1)))
typedef unsigned short bf16;
typedef short bf16x8 __attribute__((ext_vector_type(8)));
typedef float f32x4 __attribute__((ext_vector_type(4)));
typedef float f32x2 __attribute__((ext_vector_type(2)));
typedef unsigned u32x4 __attribute__((ext_vector_type(4)));
typedef unsigned u32x2 __attribute__((ext_vector_type(2)));

__device__ __forceinline__ unsigned cvt_pk_bf16(float lo, float hi) { unsigned r; asm volatile("v_cvt_pk_bf16_f32 %0, %1, %2" : "=v"(r) : "v"(lo), "v"(hi)); return r; }
__device__ __forceinline__ float bflo(unsigned u) { return __uint_as_float(u << 16); }
__device__ __forceinline__ float bfhi(unsigned u) { return __uint_as_float(u & 0xffff0000u); }
__device__ __forceinline__ float bf2f(bf16 b) { return __uint_as_float(((unsigned)b) << 16); }
__device__ __forceinline__ bf16 f2bf(float f) { return (bf16)(cvt_pk_bf16(f, 0.f) & 0xffffu); }
__device__ __forceinline__ unsigned cvt4_fp8(float a, float b, float c, float d) { int p = 0; p = __builtin_amdgcn_cvt_pk_fp8_f32(a, b, p, false); p = __builtin_amdgcn_cvt_pk_fp8_f32(c, d, p, true); return (unsigned)p; }
__device__ __forceinline__ float sigm(float x) { return __builtin_amdgcn_rcpf(1.0f + __expf(-x)); }
__device__ __forceinline__ float silu_f(float x) { return x * sigm(x); }
__device__ __forceinline__ float gelu_tanh(float x) { return x * sigm(1.5957691216057308f * (x + 0.044715f * x * x * x)); }
__device__ __forceinline__ float softplus_f(float x) { return x > 20.f ? x : log1pf(__expf(x)); }

__device__ __forceinline__ int otid() { int t = threadIdx.x; asm volatile("" : "+v"(t)); return t; }
__device__ __forceinline__ void glds16(const char* sbase, unsigned voff, unsigned lds_dst) {
    unsigned keep;
    asm volatile("s_mov_b32 %0, m0\n\ts_mov_b32 m0, %3\n\ts_nop 0\n\tglobal_load_lds_dwordx4 %1, %2\n\ts_mov_b32 m0, %0" : "=&s"(keep) : "v"(voff), "s"(sbase), "s"(lds_dst) : "memory");
}
namespace pg8 {
constexpr int BM = 256, BK = 64, HALF = 128, HTB = HALF * BK * 2, STAGE_BYTES = 8 * HTB;
__host__ __device__ __forceinline__ int lds_byte(int r, int c) { const int st = (r >> 4) * 2 + (c >> 5), rr = r & 15, cc = c & 31, ob = rr * 64 + cc * 2; return st * 1024 + (ob ^ (((ob >> 9) & 1) << 5)); }
__host__ __device__ __forceinline__ void stage_rc(int b, int& R, int& C) { const int st = b / 1024, sb = b % 1024, swz = sb ^ (((sb >> 9) & 1) << 5); R = (st >> 1) * 16 + swz / 64; C = (st & 1) * 32 + (swz % 64) / 2; }
__host__ __device__ __forceinline__ int perm32(int rho) { const int n = rho >> 4, i = rho & 15; return 8 * (i >> 2) + 4 * n + (i & 3); }

struct Unit { int pm, pn, aux; const char *A1, *B1, *A2, *B2; };
struct Shape { int nt1, nt2; unsigned lda1, ldb1, lda2, ldb2; };

typedef int pg8_v8i __attribute__((ext_vector_type(8))); typedef int pg8_v4i __attribute__((ext_vector_type(4)));
__device__ __forceinline__ pg8_v8i pg8_cat(bf16x8 lo, bf16x8 hi) { const pg8_v4i a = __builtin_bit_cast(pg8_v4i, lo), b = __builtin_bit_cast(pg8_v4i, hi); return __builtin_shufflevector(a, b, 0, 1, 2, 3, 4, 5, 6, 7); }
template <class Epi, class Sched, bool TWO, bool GATHER = false, bool FP8 = false>
__device__ __forceinline__ void gemm_phase(LAS unsigned char* lds, const Shape sh, const Sched& S, const Epi& E) {
    const int tid = otid(), wid = __builtin_amdgcn_readfirstlane(tid >> 6), lane = tid & 63, wr = wid >> 2, wc = wid & 3, fr = lane & 15, fq = lane >> 4;
    const int nt1 = sh.nt1, nt = sh.nt1 + (TWO ? sh.nt2 : 0);
    unsigned vA1[2], vB1[2], vA2[2], vB2[2]; unsigned vGc[2][2], vGn[2][2];
#pragma unroll
    for (int i = 0; i < 2; ++i) { int R, C; stage_rc(tid * 16 + i * 8192, R, C); const int Rb = Epi::PERM ? ((R & ~31) + perm32(R & 31)) : R;
        vA1[i] = (unsigned)(R * sh.lda1 + C) * 2u; vB1[i] = (unsigned)(Rb * sh.ldb1 + C) * 2u;
        vA2[i] = TWO ? (unsigned)(R * sh.lda2 + C) * 2u : 0u; vB2[i] = TWO ? (unsigned)(Rb * sh.ldb2 + C) * 2u : 0u; }
    const unsigned hA1 = 256u * sh.lda1, hB1 = 256u * sh.ldb1, hA2 = TWO ? 256u * sh.lda2 : 0u, hB2 = TWO ? 256u * sh.ldb2 : 0u;
    const unsigned ldsw = (unsigned)wid * 1024u, ldsbase = (unsigned)(unsigned long long)lds;
    const int aoff = lds_byte(wr * 64 + fr, fq * 8), boff = lds_byte(wc * 32 + fr, fq * 8);
#define PG8_SA(b, h) (((b) * 2 + (h)) * HTB)
#define PG8_SB(b, h) ((4 + (b) * 2 + (h)) * HTB)
#define PG8_LOADG(ui_, dst) do { if constexpr (GATHER) { const int tg_ = otid(); _Pragma("unroll") for (int i_ = 0; i_ < 2; ++i_) { int R_, C_; stage_rc(tg_ * 16 + i_ * 8192, R_, C_);     \
        _Pragma("unroll") for (int h_ = 0; h_ < 2; ++h_) dst[h_][i_] = (unsigned)S.gt[(ui_) * 256 + h_ * 128 + R_] * (sh.lda1 * 2u) + (unsigned)C_ * 2u; } } } while (0)
#define PG8_STG_AG(bufoff, U, tt, h, usen) do { if constexpr (GATHER) { const char* gp_ = (U).A1 + (size_t)(tt) * 128; \
        const unsigned v0_ = (usen) ? vGn[h][0] : vGc[h][0], v1_ = (usen) ? vGn[h][1] : vGc[h][1]; \
        glds16(gp_, v0_, ldsbase + (unsigned)(bufoff) + ldsw); glds16(gp_, v1_, ldsbase + (unsigned)(bufoff) + ldsw + 8192u); } else { PG8_STG_A(bufoff, U, tt, h); } } while (0)
#define PG8_STG_A(bufoff, U, tt, h) do { const bool s2_ = TWO && ((tt) >= nt1); \
        const char* gp_ = (s2_ ? (U).A2 + (size_t)((tt) - nt1) * 128 + (size_t)(h) * hA2 : (U).A1 + (size_t)(tt) * 128 + (size_t)(h) * hA1); \
        const unsigned v0_ = s2_ ? vA2[0] : vA1[0], v1_ = s2_ ? vA2[1] : vA1[1]; \
        glds16(gp_, v0_, ldsbase + (unsigned)(bufoff) + ldsw); glds16(gp_, v1_, ldsbase + (unsigned)(bufoff) + ldsw + 8192u); } while (0)
#define PG8_STG_B(bufoff, U, tt, h) do { const bool s2_ = TWO && ((tt) >= nt1); \
        const char* gp_ = (s2_ ? (U).B2 + (size_t)((tt) - nt1) * 128 + (size_t)(h) * hB2 : (U).B1 + (size_t)(tt) * 128 + (size_t)(h) * hB1); \
        const unsigned v0_ = s2_ ? vB2[0] : vB1[0], v1_ = s2_ ? vB2[1] : vB1[1]; \
        glds16(gp_, v0_, ldsbase + (unsigned)(bufoff) + ldsw); glds16(gp_, v1_, ldsbase + (unsigned)(bufoff) + ldsw + 8192u); } while (0)
#define PG8_LDA(dst, b, h) do { if constexpr (FP8) { _Pragma("unroll") for (int m = 0; m < 4; ++m) dst##8[m] = pg8_cat(*(const LAS bf16x8*)(lds + PG8_SA(b, h) + aoff + m * 2048), *(const LAS bf16x8*)(lds + PG8_SA(b, h) + aoff + m * 2048 + 1024)); } \
        else { _Pragma("unroll") for (int m = 0; m < 4; ++m) _Pragma("unroll") for (int k = 0; k < 2; ++k) dst[m][k] = *(const LAS bf16x8*)(lds + PG8_SA(b, h) + aoff + m * 2048 + k * 1024); } } while (0)
#define PG8_LDB(dst, b, h) do { if constexpr (FP8) { _Pragma("unroll") for (int n = 0; n < 2; ++n) dst##8[n] = pg8_cat(*(const LAS bf16x8*)(lds + PG8_SB(b, h) + boff + n * 2048), *(const LAS bf16x8*)(lds + PG8_SB(b, h) + boff + n * 2048 + 1024)); } \
        else { _Pragma("unroll") for (int n = 0; n < 2; ++n) _Pragma("unroll") for (int k = 0; k < 2; ++k) dst[n][k] = *(const LAS bf16x8*)(lds + PG8_SB(b, h) + boff + n * 2048 + k * 1024); } } while (0)
#define PG8_MMA(ai, bj, At, Bt) do { __builtin_amdgcn_s_setprio(1); if constexpr (FP8) { _Pragma("unroll") for (int m = 0; m < 4; ++m) _Pragma("unroll") for (int n = 0; n < 2; ++n) \
        acc[ai][bj][m][n] = __builtin_amdgcn_mfma_scale_f32_16x16x128_f8f6f4(Bt##8[n], At##8[m], acc[ai][bj][m][n], 0, 0, 0, 0x7f7f7f7f, 0, 0x7f7f7f7f); } \
        else { _Pragma("unroll") for (int m = 0; m < 4; ++m) _Pragma("unroll") for (int n = 0; n < 2; ++n) _Pragma("unroll") for (int k = 0; k < 2; ++k) \
        acc[ai][bj][m][n] = __builtin_amdgcn_mfma_f32_16x16x32_bf16(Bt[n][k], At[m][k], acc[ai][bj][m][n], 0, 0, 0); } __builtin_amdgcn_s_setprio(0); } while (0)
#define PG8_WAIT_V(n) asm volatile("s_waitcnt vmcnt(" #n ")" ::: "memory")
#define PG8_WAIT_L(n) asm volatile("s_waitcnt lgkmcnt(" #n ")" ::: "memory")
#define PG8_BAR __builtin_amdgcn_s_barrier()
#define PG8_SCHED __builtin_amdgcn_sched_barrier(0)
    Unit cur, nxt;
    if (!S.next(0, cur)) return;
    f32x4 acc[2][2][4][2];
#pragma unroll
    for (int a = 0; a < 2; ++a)
#pragma unroll
        for (int b = 0; b < 2; ++b)
#pragma unroll
            for (int m = 0; m < 4; ++m)
#pragma unroll
                for (int n = 0; n < 2; ++n) acc[a][b][m][n] = (f32x4){0.f, 0.f, 0.f, 0.f};
    bf16x8 At[4][2], B0[2][2], B1[2][2]; pg8_v8i At8[4], B08[2], B18[2];
    PG8_LOADG(0, vGc);
    PG8_STG_B(PG8_SB(0, 0), cur, 0, 0); PG8_STG_B(PG8_SB(0, 1), cur, 0, 1); PG8_STG_AG(PG8_SA(0, 0), cur, 0, 0, false); PG8_STG_AG(PG8_SA(0, 1), cur, 0, 1, false);
    if (wr == 1) PG8_BAR;
    PG8_WAIT_V(2); PG8_BAR;
    PG8_STG_B(PG8_SB(1, 0), cur, 1, 0); PG8_STG_AG(PG8_SA(1, 0), cur, 1, 0, false); PG8_STG_B(PG8_SB(1, 1), cur, 1, 1);
    PG8_WAIT_V(6); PG8_BAR;
    for (int ui = 0;; ++ui) {
        const bool has_next = S.next(ui + 1, nxt);
        if (!has_next) nxt = cur;
        if constexpr (GATHER) { if (has_next) PG8_LOADG(ui + 1, vGn); else {
#pragma unroll
            for (int h_ = 0; h_ < 2; ++h_) { vGn[h_][0] = vGc[h_][0]; vGn[h_][1] = vGc[h_][1]; } } }
#pragma unroll 1
        for (int t = 0; t < nt; t += 2) {
            const bool last = (t == nt - 2);
            const char* uA1 = last ? nxt.A1 : cur.A1; const char* uB1 = last ? nxt.B1 : cur.B1; const char* uA2 = last ? nxt.A2 : cur.A2; const char* uB2 = last ? nxt.B2 : cur.B2;
            Unit U2; U2.A1 = uA1; U2.B1 = uB1; U2.A2 = uA2; U2.B2 = uB2;
            const int t2 = last ? 0 : t + 2, t3 = t2 + 1;
            PG8_LDB(B0, 0, 0); PG8_LDB(B1, 0, 1); PG8_SCHED; PG8_LDA(At, 0, 0); PG8_STG_AG(PG8_SA(1, 1), cur, t + 1, 1, false);
            PG8_WAIT_V(8); PG8_WAIT_L(0); PG8_BAR; PG8_MMA(0, 0, At, B0); PG8_MMA(0, 1, At, B1); PG8_BAR; PG8_SCHED;
            PG8_LDA(At, 0, 1); PG8_STG_B(PG8_SB(0, 0), U2, t2, 0); PG8_STG_B(PG8_SB(0, 1), U2, t2, 1); PG8_STG_AG(PG8_SA(0, 0), U2, t2, 0, last);
            PG8_WAIT_V(8); PG8_WAIT_L(0); PG8_BAR; PG8_MMA(1, 0, At, B0); PG8_MMA(1, 1, At, B1); PG8_BAR; PG8_SCHED;
            PG8_LDB(B0, 1, 0); PG8_LDB(B1, 1, 1); PG8_SCHED; PG8_LDA(At, 1, 0); PG8_STG_AG(PG8_SA(0, 1), U2, t2, 1, last);
            PG8_WAIT_V(8); PG8_WAIT_L(0); PG8_BAR; PG8_MMA(0, 0, At, B0); PG8_MMA(0, 1, At, B1); PG8_BAR; PG8_SCHED;
            PG8_LDA(At, 1, 1); PG8_STG_B(PG8_SB(1, 0), U2, t3, 0); PG8_STG_B(PG8_SB(1, 1), U2, t3, 1); PG8_STG_AG(PG8_SA(1, 0), U2, t3, 0, last);
            PG8_WAIT_V(8); PG8_WAIT_L(0); PG8_BAR; PG8_MMA(1, 0, At, B0); PG8_MMA(1, 1, At, B1); PG8_BAR; PG8_SCHED;
        }
        if (wr == 0) PG8_BAR;
        { const int l2_ = otid() & 63; E(acc, cur, wr, wc, l2_ & 15, l2_ >> 4); }
        if (!has_next) break;
#pragma unroll
        for (int a = 0; a < 2; ++a)
#pragma unroll
            for (int b = 0; b < 2; ++b)
#pragma unroll
                for (int m = 0; m < 4; ++m)
#pragma unroll
                    for (int n = 0; n < 2; ++n) acc[a][b][m][n] = (f32x4){0.f, 0.f, 0.f, 0.f};
        cur = nxt;
        if constexpr (GATHER) {
#pragma unroll
            for (int h_ = 0; h_ < 2; ++h_) { vGc[h_][0] = vGn[h_][0]; vGc[h_][1] = vGn[h_][1]; } }
        if (wr == 1) PG8_BAR;
    }
    PG8_WAIT_V(0);
    PG8_BAR;
#undef PG8_SA
#undef PG8_SB
#undef PG8_STG_A
#undef PG8_STG_AG
#undef PG8_LOADG
#undef PG8_STG_B
#undef PG8_LDA
#undef PG8_LDB
#undef PG8_MMA
#undef PG8_WAIT_V
#undef PG8_WAIT_L
#undef PG8_BAR
#undef PG8_SCHED
}
}

#define XB_TMO      128
#define XB_XCNT(j)  (256  + 64 * (j))
#define XB_XSUB(j)  (1280 + 64 * (j))
#define XB_XGEN(j)  (2304 + 64 * (j))
#define XB_TOP      3328
#define XB_TOPGEN   3392
#define XCD_BAR_WORDS 3456
#define XB_SPIN_CAP (1u << 18)

__device__ __forceinline__ unsigned xb_ld(unsigned* p)              { return __hip_atomic_load(p, __ATOMIC_RELAXED, __HIP_MEMORY_SCOPE_AGENT); }
__device__ __forceinline__ unsigned xb_add(unsigned* p, unsigned v) { return __hip_atomic_fetch_add(p, v, __ATOMIC_RELAXED, __HIP_MEMORY_SCOPE_AGENT); }
__device__ __forceinline__ unsigned xb_xcc_id() { return (unsigned)__builtin_amdgcn_s_getreg((3 << 11) | 20) & 0xFu; }
#define XB_SPIN(cond, bar) do { unsigned _sp = 0; while (cond) { __builtin_amdgcn_s_sleep(1); \
    if ((++_sp & 255u) == 0u) { if (xb_ld(&(bar)[XB_TMO])) break; if (_sp > XB_SPIN_CAP) { atomicAdd(&(bar)[XB_TMO], 1u); break; } } } } while (0)

struct XcdBarrier {
    unsigned* bar; unsigned x;
    volatile LAS unsigned* st;
};

__device__ __forceinline__ XcdBarrier xcd_barrier_post(unsigned* bar, volatile LAS unsigned* st) {
    XcdBarrier b; b.bar = bar; b.x = xb_xcc_id(); b.st = st;
    if (threadIdx.x == 0) (void)xb_add(&bar[XB_XCNT(b.x)], 1u);
    return b;
}
__device__ __forceinline__ void xcd_barrier_complete(unsigned* bar, unsigned x, unsigned& nloc, unsigned& nx) {
    const unsigned G = gridDim.x * gridDim.y * gridDim.z;
    unsigned sum, cnt, mine, sp = 0u;
    for (;;) {
        sum = 0u; cnt = 0u; mine = 0u;
#pragma unroll
        for (unsigned j = 0; j < 16; ++j) { const unsigned c = xb_ld(&bar[XB_XCNT(j)]); sum += c; cnt += (c > 0u) ? 1u : 0u; mine = (j == x) ? c : mine; }
        if (sum == G) break;
        __builtin_amdgcn_s_sleep(1);
        if ((++sp & 255u) == 0u) { if (xb_ld(&bar[XB_TMO])) break; if (sp > XB_SPIN_CAP) { atomicAdd(&bar[XB_TMO], 1u); break; } }
    }
    nloc = mine > 0u ? mine : 1u; nx = cnt > 0u ? cnt : 1u;
}

__device__ __forceinline__ void xcd_barrier(const XcdBarrier& b) {
    asm volatile("s_waitcnt vmcnt(0)" ::: "memory");
    __syncthreads();
    if (threadIdx.x == 0) {
        unsigned* bar = b.bar;
        __builtin_amdgcn_s_waitcnt(0);
        unsigned nloc = b.st[0], nx = b.st[1];
        if (nloc == 0u) { xcd_barrier_complete(bar, b.x, nloc, nx); b.st[0] = nloc; b.st[1] = nx; }
        const unsigned old = xb_add(&bar[XB_XSUB(b.x)], 1u);
        const unsigned gen = old / nloc;
        if (old + 1u == (gen + 1u) * nloc) {
            __builtin_amdgcn_fence(__ATOMIC_RELEASE, "agent");
            asm volatile("s_waitcnt vmcnt(0)" ::: "memory");
            const unsigned og = xb_add(&bar[XB_TOP], 1u);
            const unsigned tg = og / nx;
            if (og + 1u == (tg + 1u) * nx) xb_add(&bar[XB_TOPGEN], 1u);
            else XB_SPIN(xb_ld(&bar[XB_TOPGEN]) == tg, bar);
            __builtin_amdgcn_fence(__ATOMIC_ACQUIRE, "agent");
            xb_add(&bar[XB_XGEN(b.x)], 1u);
            asm volatile("s_waitcnt vmcnt(0)" ::: "memory");
        } else {
            XB_SPIN(xb_ld(&bar[XB_XGEN(b.x)]) == gen, bar);
            __builtin_amdgcn_fence(__ATOMIC_ACQUIRE, "agent");
            asm volatile("s_waitcnt vmcnt(0)" ::: "memory");
        }
    }
    __syncthreads();
}

constexpr int T = 16384, D = 1024;
constexpr int RW = 1280, RNB = 10, RBD = 128, RCH = 64, RNC = T / RCH;
constexpr int MI = 2048, MH = 4, HD = 512, MCH = 256, MNC = T / MCH;
constexpr int LDT = T + 64;
constexpr int NG = 64, SL = 16, SNC = T / SL, SK = 384;
constexpr int FF = 2816, NE = 8, MOE_ROWS = 2 * T + NE * 256;
#ifndef MOE_F8_MASK
#define MOE_F8_MASK 3
#endif
#define MOE_F8(f) (((MOE_F8_MASK) >> (f)) & 1)
#ifndef DENSE_F8_MASK
#define DENSE_F8_MASK 2
#endif
#define DENSE_F8(f) (((DENSE_F8_MASK) >> (f)) & 1)
#ifndef RG_F8_MASK
#define RG_F8_MASK 2
#endif
#define RG_F8(j) (((RG_F8_MASK) >> (j)) & 1)
#ifndef DEFER_NORM
#define DEFER_NORM 1
#endif
constexpr float EPS = 1e-6f;
constexpr int NTHR = 512, NWAVES = 8;

enum { I_X = 0, I_NORM_MIX, I_NORM_FFN, I_NORM_FINAL, I_A_W_IN, I_A_CONV_W, I_A_CONV_B, I_A_W_R, I_A_B_R, I_A_W_I, I_A_B_I, I_A_LAM, I_A_W_OUT,
       I_B_W_IN, I_B_CONV_W, I_B_CONV_B, I_B_W_Q, I_B_W_K, I_B_W_V, I_B_W_GATE, I_B_B_GATE, I_B_NORM, I_B_SKIP, I_B_W_OUT,
       I_C_A_RE, I_C_A_IM, I_C_LOG_STEP, I_C_B_RE, I_C_B_IM, I_C_C_RE, I_C_C_IM, I_C_D, I_C_W_GLU, I_C_B_GLU,
       I_F_W1, I_F_W3, I_F_W2, I_E_ROUTER, I_E_ROUTER_B, I_E_W1, I_E_W3, I_E_W2, N_IN };

constexpr size_t MiB = 1u << 20;
constexpr size_t WS_CTL = 0, CTL_ZERO_BYTES = 1 * MiB;
constexpr size_t WS_WA_IN = 2 * MiB, WS_WA_OUT = 12 * MiB, WS_WA_G = 17 * MiB, WS_WB_IN = 19 * MiB, WS_WB_OUT = 27 * MiB, WS_WC_GLU = 31 * MiB, WS_S5_BE = 33 * MiB, WS_S5_KC = 41 * MiB;
constexpr size_t WS_RSS = 53 * MiB;
constexpr size_t SCR = 56 * MiB;
constexpr size_t WS_HN = SCR + 0 * MiB;
constexpr size_t WS_GX = SCR + 32 * MiB, WS_XR = SCR + 72 * MiB, WS_HL = SCR + 112 * MiB, WS_AC = SCR + 152 * MiB, WS_CSA = SCR + 192 * MiB, WS_CSH = SCR + 194 * MiB, WS_CIN = SCR + 196 * MiB;
constexpr size_t WS_XM = SCR + 32 * MiB, WS_Z = SCR + 96 * MiB, WS_Q = SCR + 160 * MiB, WS_K = SCR + 224 * MiB, WS_KT = SCR + 288 * MiB, WS_VT = SCR + 353 * MiB, WS_XC = SCR + 418 * MiB,
                 WS_SM = SCR + 482 * MiB, WS_CT = SCR + 514 * MiB, WS_MLS = SCR + 642 * MiB;
static_assert((size_t)MI * LDT * 2 <= 65 * MiB && WS_MLS + 4 * MiB <= SCR + 656 * MiB, "mLSTM scratch");
constexpr size_t WS_NUM = WS_XM, WS_Y = WS_XC;
constexpr size_t WS_GI = WS_MLS, WS_GF = WS_MLS + 256 * 1024, WS_GS = WS_MLS + 512 * 1024, WS_RMT = WS_MLS + 768 * 1024, WS_EF = WS_MLS + 1024 * 1024, WS_MC = WS_MLS + 1280 * 1024,
                 WS_DENP = WS_MLS + 2 * MiB, WS_NS = WS_MLS + 3 * MiB;
constexpr size_t WS_UP = SCR + 32 * MiB, WS_EB = SCR + 80 * MiB, WS_YA = SCR + 112 * MiB;
constexpr size_t WS_WFFN = SCR + 200 * MiB, WS_AG = SCR + 332 * MiB, WS_H = SCR + 400 * MiB, WS_OUT = SCR + 587 * MiB, WS_META = SCR + 655 * MiB, WS_END = SCR + 656 * MiB;
constexpr size_t WS_TOPI = WS_META, WS_TOPW = WS_META + 128 * 1024, WS_LISTE = WS_META + 384 * 1024;
constexpr size_t W13_BYTES = (size_t)2 * FF * D * 2, W2_BYTES = (size_t)D * FF * 2;
constexpr size_t WS_W13 = WS_WFFN, WS_W2T = WS_WFFN + NE * W13_BYTES;
constexpr size_t WS_WD1_13 = SCR + 144 * MiB, WS_WD1_2 = SCR + 155 * MiB;
constexpr size_t WS_W2T8 = WS_WFFN + NE * (W13_BYTES / 2);
constexpr size_t WS_AGX = WS_WFFN + NE * (W13_BYTES / 2) + NE * (W2_BYTES / 2);
static_assert(WS_AGX + (size_t)NE * T * D <= WS_H, "fp8 MoE rows");
static_assert(WS_WD1_13 + W13_BYTES <= WS_WD1_2 && WS_WD1_2 + W2_BYTES <= SCR + 161 * MiB, "dense-1 weights");
static_assert(WS_W2T + NE * W2_BYTES <= WS_AG, "ffn weights");
static_assert(WS_CIN + (size_t)RNC * RW * 4 <= WS_WFFN, "rg scratch vs dense weights");
static_assert(WS_H + (size_t)MOE_ROWS * FF * 2 <= WS_OUT && WS_OUT + (size_t)MOE_ROWS * D * 2 <= WS_META, "moe buffers");
constexpr int CW_BAR = 4096, CW_MOE = 204800, CW_DQ = 208896;

constexpr int RING_BYTES = 131072, EXTRA_OFF = RING_BYTES, EXTRA_BYTES = 24576, LDS_BYTES = RING_BYTES + EXTRA_BYTES;
constexpr int MISC_OFF = LDS_BYTES - 64;

struct Args { const float* in[N_IN]; float* out; unsigned char* ws; int ph_lo, ph_hi, li, pad; };

__device__ __forceinline__ float wave_sum(float v) {
#pragma unroll
    for (int o = 1; o < 64; o <<= 1) v += __shfl_xor(v, o);
    return v;
}
__device__ __forceinline__ float wave_max(float v) {
#pragma unroll
    for (int o = 1; o < 64; o <<= 1) v = fmaxf(v, __shfl_xor(v, o));
    return v;
}
__device__ __forceinline__ u32x4 ldg16(const void* p) { return *(const GAS u32x4*)p; }
__device__ __forceinline__ u32x2 ldg8(const void* p) { return *(const GAS u32x2*)p; }
__device__ __forceinline__ f32x4 ldgf4(const void* p) { return *(const GAS f32x4*)p; }
__device__ __forceinline__ float ldgf(const void* p) { return *(const GAS float*)p; }
__device__ __forceinline__ int ldgi(const void* p) { return *(const GAS int*)p; }
#ifndef STORE_SC1
#define STORE_SC1 0
#endif
#if STORE_SC1
__device__ __forceinline__ void stg16(void* p, u32x4 v) { asm volatile("global_store_dwordx4 %0, %1, off sc1\n\ts_nop 1" :: "v"((GAS u32x4*)p), "v"(v) : "memory"); }
__device__ __forceinline__ void stg8(void* p, u32x2 v) { asm volatile("global_store_dwordx2 %0, %1, off sc1\n\ts_nop 1" :: "v"((GAS u32x2*)p), "v"(v) : "memory"); }
__device__ __forceinline__ void stgf4(void* p, f32x4 v) { asm volatile("global_store_dwordx4 %0, %1, off sc1\n\ts_nop 1" :: "v"((GAS f32x4*)p), "v"(v) : "memory"); }
__device__ __forceinline__ void stgf(void* p, float v) { asm volatile("global_store_dword %0, %1, off sc1\n\ts_nop 1" :: "v"((GAS float*)p), "v"(v) : "memory"); }
__device__ __forceinline__ void stgi(void* p, int v) { asm volatile("global_store_dword %0, %1, off sc1\n\ts_nop 1" :: "v"((GAS int*)p), "v"(v) : "memory"); }
__device__ __forceinline__ void stgh(void* p, bf16 v) { asm volatile("global_store_short %0, %1, off sc1\n\ts_nop 1" :: "v"((GAS bf16*)p), "v"((unsigned)v) : "memory"); }
#else
__device__ __forceinline__ void stg16(void* p, u32x4 v) { *(GAS u32x4*)p = v; }
__device__ __forceinline__ void stg8(void* p, u32x2 v) { *(GAS u32x2*)p = v; }
__device__ __forceinline__ void stgf4(void* p, f32x4 v) { *(GAS f32x4*)p = v; }
__device__ __forceinline__ void stgf(void* p, float v) { *(GAS float*)p = v; }
__device__ __forceinline__ void stgi(void* p, int v) { *(GAS int*)p = v; }
__device__ __forceinline__ void stgh(void* p, bf16 v) { *(GAS bf16*)p = v; }
#endif
#define LDS_WAIT() asm volatile("s_waitcnt lgkmcnt(0)" ::: "memory")

#ifndef WGM_
#define WGM_ 8
#endif
__device__ __forceinline__ void tile_of(int L, int nM, int nN, int& pm, int& pn) {
    const int nwg = nM * nN; int wgid = L;
    { const int q = nwg / 8, r = nwg % 8, xcd = wgid % 8, off = wgid / 8; wgid = (xcd < r ? xcd * (q + 1) : r * (q + 1) + (xcd - r) * q) + off; }
    const int nig = WGM_ * nN, gid = wgid / nig, fm = gid * WGM_, gsz = (nM - fm) < WGM_ ? (nM - fm) : WGM_;
    pm = fm + ((wgid % nig) % gsz); pn = (wgid % nig) / gsz;
}
using pg8::Unit;
__device__ __forceinline__ const char* uptr(const char* p) { const unsigned long long v = (unsigned long long)p; unsigned lo = __builtin_amdgcn_readfirstlane((unsigned)v), hi = __builtin_amdgcn_readfirstlane((unsigned)(v >> 32));
    asm volatile("s_nop 4" : "+s"(lo), "+s"(hi)); return (const char*)(((unsigned long long)hi << 32) | lo); }
struct Sched2D {
    const char* A; const char* B; unsigned lda, ldb; int nM, nN, G, c;
    __device__ __forceinline__ bool next(int i, Unit& u) const {
        const int L = i * G + c; if (L >= nM * nN) return false;
        tile_of(L, nM, nN, u.pm, u.pn); u.aux = 0;
        u.A1 = uptr(A + (size_t)u.pm * 512 * lda); u.B1 = uptr(B + (size_t)u.pn * 512 * ldb); u.A2 = u.A1; u.B2 = u.B1; return true;
    }
};
struct SchedMoe {
    LAS const int* gt; int gather;
    const char* A; const char* B; unsigned lda, ldb; size_t bstride; int P, nN, G, c; int ps[NE];
    int erows = 0;
    int ksplit; unsigned khbytes;
    __device__ __forceinline__ bool next(int i, Unit& u) const {
        const int L = i * G + c, nu = P * nN; if (L >= nu * ksplit) return false;
        const int kh = L / nu;
        tile_of(L - kh * nu, P, nN, u.pm, u.pn);
        int e = 0;
#pragma unroll
        for (int j = 1; j < NE; ++j) e += (u.pm >= ps[j]) ? 1 : 0;
        u.aux = (ksplit > 1) ? kh : e;
        int arow = u.pm * 256;
        if (erows) { int pse = 0;
#pragma unroll
            for (int j = 1; j < NE; ++j) pse = (u.pm >= ps[j]) ? ps[j] : pse;
            arow = e * erows + (u.pm - pse) * 256; }
        u.A1 = gather ? A : uptr(A + (size_t)arow * 2 * lda + (size_t)kh * khbytes); u.B1 = uptr(B + (size_t)e * bstride + (size_t)u.pn * 512 * ldb + (size_t)kh * khbytes); u.A2 = u.A1; u.B2 = u.B1; return true;
    }
};
struct SchedBatch {
    const char* A; const char* B; unsigned lda, ldb; size_t astride, bstride; int nMb, nB, G, c;
    __device__ __forceinline__ bool next(int i, Unit& u) const {
        const int L = i * G + c; if (L >= nMb * nB) return false;
        u.aux = L / nMb; u.pm = L % nMb; u.pn = 0;
        u.A1 = uptr(A + (size_t)u.aux * astride + (size_t)u.pm * 512 * lda); u.B1 = uptr(B + (size_t)u.aux * bstride); u.A2 = u.A1; u.B2 = u.B1; return true;
    }
};
struct SchedSbuild {
    const char* Q; const char* K; int G, c;
    __device__ __forceinline__ bool next(int i, Unit& u) const {
        const int L = i * G + c; if (L >= MNC * MH) return false;
        const int ch = L / MH, h = L % MH; u.aux = L; u.pm = ch; u.pn = h;
        u.A1 = uptr(Q + ((size_t)ch * MCH * MI + (size_t)h * HD) * 2); u.B1 = uptr(K + ((size_t)ch * MCH * MI + (size_t)h * HD) * 2); u.A2 = u.A1; u.B2 = u.B1; return true;
    }
};
struct SchedPass2 {
    const char* SMp; const char* Q; const char* VT; const char* CT; int G, c;
    __device__ __forceinline__ bool next(int i, Unit& u) const {
        const int pr_ = (i >> 1) * G + c; if (pr_ >= MNC * MH) return false;
        const int L = pr_ * 2 + (i & 1);
        const int eh = L & 1, ch_h = L >> 1, ch = ch_h / MH, h = ch_h % MH; u.aux = ch_h; u.pm = ch; u.pn = h * 2 + eh;
        u.A1 = uptr(SMp + (size_t)ch_h * MCH * MCH * 2); u.A2 = uptr(Q + ((size_t)ch * MCH * MI + (size_t)h * HD) * 2);
        u.B1 = uptr(VT + ((size_t)(h * HD + eh * 256) * LDT + (size_t)ch * MCH) * 2); u.B2 = uptr(CT + ((size_t)ch_h * HD * HD + (size_t)eh * 256 * HD) * 2); return true;
    }
};

struct SchedState {
    const char* VT; const char* KT; int G, c;
    __device__ __forceinline__ bool next(int i, Unit& u) const {
        const int pq_ = (i >> 2) * G + c; if (pq_ >= MNC * MH) return false;
        const int L = pq_ * 4 + (i & 3);
        const int ch_h = L >> 2, ch = ch_h / MH, h = ch_h % MH; u.aux = ch_h; u.pm = (L >> 1) & 1; u.pn = L & 1;
        u.A1 = uptr(VT + ((size_t)(h * HD + u.pm * 256) * LDT + (size_t)ch * MCH) * 2); u.B1 = uptr(KT + ((size_t)(h * HD + u.pn * 256) * LDT + (size_t)ch * MCH) * 2); u.A2 = u.A1; u.B2 = u.B1; return true;
    }
};

__device__ __forceinline__ float rss_rstd(const float* rss, int row) { const f32x4 p = ldgf4(rss + (size_t)row * 4); return __builtin_amdgcn_rsqf(((p[0] + p[1]) + (p[2] + p[3])) * (1.0f / D) + EPS); }
template <int EMIT> __device__ __forceinline__ float emit_x(unsigned char* hn, size_t eoff, const f32x4& x) {
    if (EMIT == 1) { u32x2 w; w.x = cvt_pk_bf16(x[0], x[1]); w.y = cvt_pk_bf16(x[2], x[3]); stg8(hn + eoff * 2, w); }
    else stgi(hn + eoff, (int)cvt4_fp8(__builtin_amdgcn_fmed3f(x[0], -448.0f, 448.0f), __builtin_amdgcn_fmed3f(x[1], -448.0f, 448.0f), __builtin_amdgcn_fmed3f(x[2], -448.0f, 448.0f), __builtin_amdgcn_fmed3f(x[3], -448.0f, 448.0f)));
    return (x[0] * x[0] + x[1] * x[1]) + (x[2] * x[2] + x[3] * x[3]);
}
__device__ __forceinline__ void emit_rss(LAS float* P, float* rss, const pg8::Unit& u) {
    LDS_WAIT(); __builtin_amdgcn_s_barrier(); asm volatile("" ::: "memory");
    const int t = otid(); if (t < 256) { const f32x4 p = *(const LAS f32x4*)(P + t * 4); stgf(rss + ((size_t)u.pm * 256 + t) * 4 + u.pn, (p[0] + p[1]) + (p[2] + p[3])); }
}

template <bool RS> struct EpiBf16T {
    static constexpr bool PERM = true;
    bf16* O; int ldc; int split_cols; size_t split_stride; size_t aux_stride;
    float scale = 1.0f; const float* rss = nullptr;
    __device__ __forceinline__ void operator()(const f32x4 (&acc)[2][2][4][2], const Unit& u, int wr, int wc, int fr, int fq) const {
        const int row0 = u.pm * 256 + wr * 64 + fr; int colt = u.pn * 256; bf16* base = O + (size_t)u.aux * aux_stride;
        if (split_cols) { const int t = colt / split_cols; base += (size_t)t * split_stride; colt -= t * split_cols; }
        const int col0 = colt + wc * 32 + 8 * fq;
#pragma unroll
        for (int ai = 0; ai < 2; ++ai)
#pragma unroll
            for (int m = 0; m < 4; ++m) { bf16* rowp = base + (size_t)(row0 + ai * 128 + m * 16) * ldc + col0; const float sc_ = RS ? scale * rss_rstd(rss, row0 + ai * 128 + m * 16) : scale;
#pragma unroll
                for (int bj = 0; bj < 2; ++bj) { const f32x4 v0 = acc[ai][bj][m][0] * sc_, v1 = acc[ai][bj][m][1] * sc_;
                    u32x4 w; w.x = cvt_pk_bf16(v0[0], v0[1]); w.y = cvt_pk_bf16(v0[2], v0[3]); w.z = cvt_pk_bf16(v1[0], v1[1]); w.w = cvt_pk_bf16(v1[2], v1[3]);
                    stg16(rowp + bj * 128, w); }
                asm volatile("" ::: "memory"); }
    }
};
using EpiBf16 = EpiBf16T<false>;
template <int EMIT> struct EpiResidT {
    static constexpr bool PERM = false;
    const float* base; float* out; unsigned char* hn; float* rss; LAS float* P; float scale;
    __device__ __forceinline__ void operator()(const f32x4 (&acc)[2][2][4][2], const Unit& u, int wr, int wc, int fr, int fq) const {
        const int row0 = u.pm * 256 + wr * 64 + fr, col0 = u.pn * 256 + wc * 32 + 4 * fq;
#pragma unroll
        for (int ai = 0; ai < 2; ++ai) { f32x4 bs[4][2][2];
#pragma unroll
            for (int m = 0; m < 4; ++m) { const size_t off = (size_t)(row0 + ai * 128 + m * 16) * D + col0;
#pragma unroll
                for (int bj = 0; bj < 2; ++bj)
#pragma unroll
                    for (int n = 0; n < 2; ++n) bs[m][bj][n] = ldgf4(base + off + bj * 128 + n * 16); }
#pragma unroll
            for (int m = 0; m < 4; ++m) { const size_t off = (size_t)(row0 + ai * 128 + m * 16) * D + col0; float ss = 0.f;
#pragma unroll
                for (int bj = 0; bj < 2; ++bj)
#pragma unroll
                    for (int n = 0; n < 2; ++n) { const f32x4 x = bs[m][bj][n] + acc[ai][bj][m][n] * scale; stgf4(out + off + bj * 128 + n * 16, x);
                        if (EMIT) ss += emit_x<EMIT>(hn, off + bj * 128 + n * 16, x); }
                if (EMIT) { ss += __shfl_xor(ss, 16); ss += __shfl_xor(ss, 32); if (fq == 0) P[(ai * 128 + wr * 64 + m * 16 + fr) * 4 + wc] = ss; } }
            asm volatile("" ::: "memory"); }
        if (EMIT) emit_rss(P, rss, u);
    }
};
using EpiResid = EpiResidT<0>;
template <bool RS> struct EpiSwigluT {
    static constexpr bool PERM = true;
    bf16* Hh; const float* rss = nullptr;
    __device__ __forceinline__ void operator()(const f32x4 (&acc)[2][2][4][2], const Unit& u, int wr, int wc, int fr, int fq) const {
        const int row0 = u.pm * 256 + wr * 64 + fr, col0 = u.pn * 128 + wc * 32 + 8 * fq;
#pragma unroll
        for (int ai = 0; ai < 2; ++ai)
#pragma unroll
            for (int m = 0; m < 4; ++m) { bf16* rowp = Hh + (size_t)(row0 + ai * 128 + m * 16) * FF + col0; const float rs_ = RS ? rss_rstd(rss, row0 + ai * 128 + m * 16) : 1.0f;
                f32x2 o[4];
#pragma unroll
                for (int n = 0; n < 2; ++n)
#pragma unroll
                    for (int hh = 0; hh < 2; ++hh) { const f32x4 a4 = acc[ai][0][m][n], b4 = acc[ai][1][m][n];
                        f32x2 a = hh ? (f32x2){a4[2], a4[3]} : (f32x2){a4[0], a4[1]}, b = hh ? (f32x2){b4[2], b4[3]} : (f32x2){b4[0], b4[1]}; if (RS) { a = a * rs_; b = b * rs_; }
                        f32x2 e; e[0] = __builtin_amdgcn_exp2f(-a[0]); e[1] = __builtin_amdgcn_exp2f(-a[1]);
                        const f32x2 d = e + 1.0f; f32x2 r; r[0] = __builtin_amdgcn_rcpf(d[0]); r[1] = __builtin_amdgcn_rcpf(d[1]);
                        o[n * 2 + hh] = (a * b) * r; }
                u32x4 w; w.x = cvt_pk_bf16(o[0][0], o[0][1]); w.y = cvt_pk_bf16(o[1][0], o[1][1]); w.z = cvt_pk_bf16(o[2][0], o[2][1]); w.w = cvt_pk_bf16(o[3][0], o[3][1]);
                stg16(rowp, w); asm volatile("" ::: "memory"); }
    }
};
using EpiSwiglu = EpiSwigluT<false>;
template <bool RS> struct EpiSwiglu8T {
    static constexpr bool PERM = true;
    unsigned char* H8; const float* rss = nullptr;
    __device__ __forceinline__ void operator()(const f32x4 (&acc)[2][2][4][2], const Unit& u, int wr, int wc, int fr, int fq) const {
        const int row0 = u.pm * 256 + wr * 64 + fr, col0 = u.pn * 128 + wc * 32 + 8 * fq;
#pragma unroll
        for (int ai = 0; ai < 2; ++ai)
#pragma unroll
            for (int m = 0; m < 4; ++m) { unsigned char* rowp = H8 + (size_t)(row0 + ai * 128 + m * 16) * FF + col0; const float rs_ = RS ? 0.03125f * rss_rstd(rss, row0 + ai * 128 + m * 16) : 0.03125f;
                f32x2 o[4];
#pragma unroll
                for (int n = 0; n < 2; ++n)
#pragma unroll
                    for (int hh = 0; hh < 2; ++hh) { const f32x4 a4 = acc[ai][0][m][n], b4 = acc[ai][1][m][n];
                        const f32x2 a = (hh ? (f32x2){a4[2], a4[3]} : (f32x2){a4[0], a4[1]}) * rs_, b = hh ? (f32x2){b4[2], b4[3]} : (f32x2){b4[0], b4[1]};
                        f32x2 e; e[0] = __builtin_amdgcn_exp2f(-a[0]); e[1] = __builtin_amdgcn_exp2f(-a[1]);
                        const f32x2 d = e + 1.0f; f32x2 r; r[0] = __builtin_amdgcn_rcpf(d[0]); r[1] = __builtin_amdgcn_rcpf(d[1]);
                        o[n * 2 + hh] = (a * (b * rs_)) * r; }
                u32x2 w; w.x = cvt4_fp8(o[0][0], o[0][1], o[1][0], o[1][1]); w.y = cvt4_fp8(o[2][0], o[2][1], o[3][0], o[3][1]);
                stg8(rowp, w); asm volatile("" ::: "memory"); }
    }
};
using EpiSwiglu8 = EpiSwiglu8T<false>;
template <int EMIT> struct EpiGluT {
    static constexpr bool PERM = false;
    const bf16* YA; const float* bglu; float* xf; unsigned char* hn = nullptr; float* rss = nullptr; LAS float* P = nullptr;
    __device__ __forceinline__ void operator()(const f32x4 (&acc)[2][2][4][2], const Unit& u, int wr, int wc, int fr, int fq) const {
        const int row0 = u.pm * 256 + wr * 64 + fr, col0 = u.pn * 256 + wc * 32 + 4 * fq;
        f32x4 bv[2][2];
#pragma unroll
        for (int bj = 0; bj < 2; ++bj)
#pragma unroll
            for (int n = 0; n < 2; ++n) bv[bj][n] = ldgf4(bglu + col0 + bj * 128 + n * 16);
#pragma unroll
        for (int ai = 0; ai < 2; ++ai)
#pragma unroll
            for (int mp = 0; mp < 2; ++mp) { f32x4 xs[2][2][2]; u32x2 yv[2][2][2];
#pragma unroll
                for (int mm = 0; mm < 2; ++mm) { const size_t off = (size_t)(row0 + ai * 128 + (2 * mp + mm) * 16) * D + col0;
#pragma unroll
                    for (int bj = 0; bj < 2; ++bj)
#pragma unroll
                        for (int n = 0; n < 2; ++n) { const size_t o2 = off + bj * 128 + n * 16; xs[mm][bj][n] = ldgf4(xf + o2); yv[mm][bj][n] = ldg8(YA + o2); } }
#pragma unroll
                for (int mm = 0; mm < 2; ++mm) { const int m = 2 * mp + mm; const size_t off = (size_t)(row0 + ai * 128 + m * 16) * D + col0; float ss = 0.f;
#pragma unroll
                    for (int bj = 0; bj < 2; ++bj)
#pragma unroll
                        for (int n = 0; n < 2; ++n) { const size_t o2 = off + bj * 128 + n * 16; const f32x4 x_ = xs[mm][bj][n]; const u32x2 y_ = yv[mm][bj][n];
                            const f32x4 z = acc[ai][bj][m][n] + bv[bj][n]; f32x4 r;
                            r[0] = x_[0] + bflo(y_.x) * sigm(z[0]); r[1] = x_[1] + bfhi(y_.x) * sigm(z[1]); r[2] = x_[2] + bflo(y_.y) * sigm(z[2]); r[3] = x_[3] + bfhi(y_.y) * sigm(z[3]);
                            stgf4(xf + o2, r); if (EMIT) ss += emit_x<EMIT>(hn, o2, r); }
                    if (EMIT) { ss += __shfl_xor(ss, 16); ss += __shfl_xor(ss, 32); if (fq == 0) P[(ai * 128 + wr * 64 + m * 16 + fr) * 4 + wc] = ss; } }
                asm volatile("" ::: "memory"); }
        if (EMIT) emit_rss(P, rss, u);
    }
};
using EpiGlu = EpiGluT<0>;
struct EpiS5e {
    static constexpr bool PERM = false;
    float* EB;
    __device__ __forceinline__ void operator()(const f32x4 (&acc)[2][2][4][2], const Unit& u, int wr, int wc, int fr, int fq) const {
        const int row0 = u.aux * SNC + u.pm * 256 + wr * 64 + fr, col0 = wc * 32 + 4 * fq;
#pragma unroll
        for (int ai = 0; ai < 2; ++ai)
#pragma unroll
            for (int m = 0; m < 4; ++m) { float* rowp = EB + (size_t)(row0 + ai * 128 + m * 16) * 128 + col0;
#pragma unroll
                for (int n = 0; n < 2; ++n) stgf4(rowp + n * 16, acc[ai][0][m][n]); }
    }
};
struct EpiS5y {
    static constexpr bool PERM = true;
    const bf16* UP; const float* dsk; bf16* YA;
    __device__ __forceinline__ void operator()(const f32x4 (&acc)[2][2][4][2], const Unit& u, int wr, int wc, int fr, int fq) const {
        const int g = u.aux, row0 = u.pm * 256 + wr * 64 + fr;
#pragma unroll
        for (int bj = 0; bj < 2; ++bj) { const int cc = bj * 128 + wc * 32 + 8 * fq, tt = cc >> 4, i0 = cc & 15;
            const f32x4 d0 = ldgf4(dsk + g * 16 + i0), d1 = ldgf4(dsk + g * 16 + i0 + 4);
#pragma unroll
            for (int ai = 0; ai < 2; ++ai) { u32x4 uvv[4];
#pragma unroll
                for (int m = 0; m < 4; ++m) uvv[m] = ldg16(UP + ((size_t)g * SNC + (row0 + ai * 128 + m * 16)) * SK + cc);
#pragma unroll
                for (int m = 0; m < 4; ++m) { const int chunk = row0 + ai * 128 + m * 16;
                    const u32x4 uv = uvv[m];
                    const f32x4 v0 = acc[ai][bj][m][0], v1 = acc[ai][bj][m][1]; float o[8];
                    o[0] = gelu_tanh(v0[0] + d0[0] * bflo(uv.x)); o[1] = gelu_tanh(v0[1] + d0[1] * bfhi(uv.x)); o[2] = gelu_tanh(v0[2] + d0[2] * bflo(uv.y)); o[3] = gelu_tanh(v0[3] + d0[3] * bfhi(uv.y));
                    o[4] = gelu_tanh(v1[0] + d1[0] * bflo(uv.z)); o[5] = gelu_tanh(v1[1] + d1[1] * bfhi(uv.z)); o[6] = gelu_tanh(v1[2] + d1[2] * bflo(uv.w)); o[7] = gelu_tanh(v1[3] + d1[3] * bfhi(uv.w));
                    u32x4 w; w.x = cvt_pk_bf16(o[0], o[1]); w.y = cvt_pk_bf16(o[2], o[3]); w.z = cvt_pk_bf16(o[4], o[5]); w.w = cvt_pk_bf16(o[6], o[7]);
                    stg16(YA + (size_t)(chunk * SL + tt) * D + g * 16 + i0, w); }
                asm volatile("" ::: "memory"); } }
    }
};
struct EpiSbuild {
    static constexpr bool PERM = true;
    bf16* SMp; float* DENP; const float* GS; const float* MC;
    __device__ __forceinline__ void operator()(const f32x4 (&acc)[2][2][4][2], const Unit& u, int wr, int wc, int fr, int fq) const {
        const int ch = u.pm, h = u.pn, ch_h = u.aux; const float mc = ldgf(MC + h * 80 + ch);
        float rs[2][4];
#pragma unroll
        for (int ai = 0; ai < 2; ++ai)
#pragma unroll
            for (int m = 0; m < 4; ++m) rs[ai][m] = 0.f;
#pragma unroll
        for (int bj = 0; bj < 2; ++bj) { const int s0 = bj * 128 + wc * 32 + 8 * fq; float w[8];
            { const f32x4 g0 = ldgf4(GS + (size_t)h * T + ch * MCH + s0), g1 = ldgf4(GS + (size_t)h * T + ch * MCH + s0 + 4);
#pragma unroll
              for (int j = 0; j < 4; ++j) { w[j] = __expf(g0[j] - mc); w[4 + j] = __expf(g1[j] - mc); } }
#pragma unroll
            for (int ai = 0; ai < 2; ++ai)
#pragma unroll
                for (int m = 0; m < 4; ++m) { const int r = ai * 128 + wr * 64 + m * 16 + fr; float o[8];
#pragma unroll
                    for (int n = 0; n < 2; ++n)
#pragma unroll
                        for (int j = 0; j < 4; ++j) { const int s = s0 + n * 4 + j; o[n * 4 + j] = (s <= r) ? acc[ai][bj][m][n][j] * w[n * 4 + j] : 0.f; }
                    u32x4 pk; pk.x = cvt_pk_bf16(o[0], o[1]); pk.y = cvt_pk_bf16(o[2], o[3]); pk.z = cvt_pk_bf16(o[4], o[5]); pk.w = cvt_pk_bf16(o[6], o[7]);
                    rs[ai][m] += (bflo(pk.x) + bfhi(pk.x)) + (bflo(pk.y) + bfhi(pk.y)) + (bflo(pk.z) + bfhi(pk.z)) + (bflo(pk.w) + bfhi(pk.w));
                    stg16(SMp + ((size_t)ch_h * MCH + r) * MCH + s0, pk); asm volatile("" ::: "memory"); } }
#pragma unroll
        for (int ai = 0; ai < 2; ++ai)
#pragma unroll
            for (int m = 0; m < 4; ++m) { const int r = ai * 128 + wr * 64 + m * 16 + fr; float v = rs[ai][m]; v += __shfl_xor(v, 16); v += __shfl_xor(v, 32);
                if (fq == 0) stgf(DENP + ((size_t)ch_h * MCH + r) * 4 + wc, v); }
    }
};
struct EpiNum {
    static constexpr bool PERM = true;
    bf16* NUM; const float* RMT; const float* MC;
    __device__ __forceinline__ void operator()(const f32x4 (&acc)[2][2][4][2], const Unit& u, int wr, int wc, int fr, int fq) const {
        const int ch = u.pm, h = u.pn >> 1, eh = u.pn & 1; const float mc = ldgf(MC + h * 80 + ch);
        const int col0 = h * HD + eh * 256 + wc * 32 + 8 * fq;
        float rmv[2][4];
#pragma unroll
        for (int ai = 0; ai < 2; ++ai)
#pragma unroll
            for (int m = 0; m < 4; ++m) rmv[ai][m] = ldgf(RMT + (size_t)h * T + ch * MCH + ai * 128 + wr * 64 + m * 16 + fr);
#pragma unroll
        for (int ai = 0; ai < 2; ++ai)
#pragma unroll
            for (int m = 0; m < 4; ++m) { const int t = ch * MCH + ai * 128 + wr * 64 + m * 16 + fr; const float sc = __expf(mc - rmv[ai][m]);
                bf16* rowp = NUM + (size_t)t * MI + col0;
#pragma unroll
                for (int bj = 0; bj < 2; ++bj) { const f32x4 v0 = acc[ai][bj][m][0] * sc, v1 = acc[ai][bj][m][1] * sc;
                    u32x4 w; w.x = cvt_pk_bf16(v0[0], v0[1]); w.y = cvt_pk_bf16(v0[2], v0[3]); w.z = cvt_pk_bf16(v1[0], v1[1]); w.w = cvt_pk_bf16(v1[2], v1[3]);
                    stg16(rowp + bj * 128, w); }
                asm volatile("" ::: "memory"); }
    }
};
struct ConvItem { const float* W; bf16* WT; int ldw, ldt, k0, n0, drow0; float scale; int f8; const float* kg; };
__device__ __forceinline__ void tr_load(const ConvItem& d, f32x2 (&v)[33], int lane) {
    const int hrow = lane >> 5, cl = lane & 31; const unsigned voff = (unsigned)(hrow * d.ldw + 2 * cl) * 4u;
    const char* rb = (const char*)(d.W + (size_t)d.k0 * d.ldw + d.n0); const size_t rstep = (size_t)d.ldw * 8;
#pragma unroll
    for (int i = 0; i < 32; ++i) v[i] = *(const GAS f32x2*)(rb + (size_t)i * rstep + voff);
    v[32][0] = d.kg ? ldgf(d.kg + d.k0 + lane) : 1.0f; v[32][1] = 0.f;
}
__device__ __forceinline__ float tr_scale(const ConvItem& d, const f32x2 (&v)[33], int i, int hrow) {
    const int gi = __float_as_int(v[32][0]); const float g0 = __int_as_float(__builtin_amdgcn_readlane(gi, 2 * i)), g1 = __int_as_float(__builtin_amdgcn_readlane(gi, 2 * i + 1)); return d.scale * (hrow ? g1 : g0);
}
__device__ __forceinline__ void tr_store8(const ConvItem& d, const f32x2 (&v)[33], LAS float* scr, int lane) {
    LAS unsigned char* tile = (LAS unsigned char*)scr; constexpr int TS8 = 68;
    const int hrow = lane >> 5, cl = lane & 31;
#pragma unroll
    for (int i = 0; i < 32; ++i) { const float s_ = tr_scale(d, v, i, hrow); *(LAS unsigned short*)(tile + (2 * i + hrow) * TS8 + cl * 2) = (unsigned short)__builtin_amdgcn_cvt_pk_fp8_f32(v[i][0] * s_, v[i][1] * s_, 0, false); }
    LDS_WAIT(); asm volatile("" ::: "memory");
    const int c = lane & 7;
#pragma unroll
    for (int j = 0; j < 8; ++j) { const int n = (lane >> 3) + 8 * j; const LAS unsigned char* sp = tile + (8 * c) * TS8 + n;
        u32x2 o; o.x = (unsigned)sp[0 * TS8] | ((unsigned)sp[1 * TS8] << 8) | ((unsigned)sp[2 * TS8] << 16) | ((unsigned)sp[3 * TS8] << 24);
        o.y = (unsigned)sp[4 * TS8] | ((unsigned)sp[5 * TS8] << 8) | ((unsigned)sp[6 * TS8] << 16) | ((unsigned)sp[7 * TS8] << 24);
        stg8((unsigned char*)d.WT + (size_t)(d.drow0 + n) * d.ldt + d.k0 + 8 * c, o); }
    LDS_WAIT(); asm volatile("" ::: "memory");
}
__device__ __forceinline__ void tr_store(const ConvItem& d, const f32x2 (&v)[33], LAS float* scr, int lane) {
    if (d.f8) { tr_store8(d, v, scr, lane); return; }
    LAS unsigned char* tile = (LAS unsigned char*)scr; constexpr int TS = 132;
    const int hrow = lane >> 5, cl = lane & 31;
#pragma unroll
    for (int i = 0; i < 32; ++i) { const float s_ = tr_scale(d, v, i, hrow); *(LAS unsigned*)(tile + (2 * i + hrow) * TS + cl * 4) = cvt_pk_bf16(v[i][0] * s_, v[i][1] * s_); }
    LDS_WAIT(); asm volatile("" ::: "memory");
    const int c = lane & 7;
#pragma unroll
    for (int j = 0; j < 8; ++j) { const int n = (lane >> 3) + 8 * j; const LAS bf16* sp = (const LAS bf16*)(tile + (8 * c) * TS) + n;
        u32x4 o; o.x = (unsigned)sp[0 * (TS / 2)] | ((unsigned)sp[1 * (TS / 2)] << 16); o.y = (unsigned)sp[2 * (TS / 2)] | ((unsigned)sp[3 * (TS / 2)] << 16);
        o.z = (unsigned)sp[4 * (TS / 2)] | ((unsigned)sp[5 * (TS / 2)] << 16); o.w = (unsigned)sp[6 * (TS / 2)] | ((unsigned)sp[7 * (TS / 2)] << 16);
        stg16(d.WT + (size_t)(d.drow0 + n) * d.ldt + d.k0 + 8 * c, o); }
    LDS_WAIT(); asm volatile("" ::: "memory");
}
__device__ __forceinline__ ConvItem conv_desc(const float* W, int K, int N, bf16* WT, int ldt, int mode, int it) {
    const int nblk = N / 64, kb = it / nblk, nb_ = it % nblk, n0 = nb_ * 64;
    ConvItem d; d.W = W; d.WT = WT; d.ldw = N; d.ldt = ldt; d.k0 = kb * 64; d.n0 = n0; d.drow0 = (mode == 0 || mode == 3) ? n0 : ((n0 >> 7) * 256 + (n0 & 127) + (mode == 2 ? 128 : 0));
    d.scale = (mode == 1 || mode == 3) ? 1.4426950408889634f : (mode == 2) ? 0.6931471805599453f : 1.0f;
    d.f8 = 0; d.kg = nullptr; return d;
}
__device__ __forceinline__ ConvItem conv_desc8(const float* W, int K, int N, unsigned char* WT, int mode, int it) {
    ConvItem d = conv_desc(W, K, N, (bf16*)WT, K, mode, it); d.f8 = 1;
    d.scale = (mode == 1) ? 32.0f * 1.4426950408889634f : (mode == 2) ? 32.0f * 0.6931471805599453f : 64.0f; return d;
}
__device__ __forceinline__ void conv_item(const float* W, int K, int N, bf16* WT, int ldt, int mode, int it, LAS float* scr, int lane) {
    const ConvItem d = conv_desc(W, K, N, WT, ldt, mode, it); f32x2 v[33]; tr_load(d, v, lane); tr_store(d, v, scr, lane);
}
__device__ __forceinline__ void conv_mat(const float* W, int K, int N, bf16* WT, int ldt, int mode, int gw, int NGW, LAS float* scr, int lane) {
    const int items = (K / 64) * (N / 64);
    int it = gw; if (it >= items) return;
    f32x2 va[33], vb[33]; ConvItem da = conv_desc(W, K, N, WT, ldt, mode, it), db = da; tr_load(da, va, lane);
    for (;;) {
        const int i1 = it + NGW; if (i1 < items) { db = conv_desc(W, K, N, WT, ldt, mode, i1); tr_load(db, vb, lane); }
        tr_store(da, va, scr, lane); if (i1 >= items) break;
        const int i2 = i1 + NGW; if (i2 < items) { da = conv_desc(W, K, N, WT, ldt, mode, i2); tr_load(da, va, lane); }
        tr_store(db, vb, scr, lane); if (i2 >= items) break;
        it = i2;
    }
}
__device__ __forceinline__ void conv_dense(const Args& a, int f, int gw, int NGW, LAS float* scr, int lane) {
    bf16* W13 = (bf16*)(a.ws + (f ? WS_WD1_13 : WS_W13)); bf16* W2T = (bf16*)(a.ws + (f ? WS_WD1_2 : WS_W2T));
    conv_mat(a.in[I_F_W1] + (size_t)f * D * FF, D, FF, W13, D, 1, gw, NGW, scr, lane);
    conv_mat(a.in[I_F_W3] + (size_t)f * D * FF, D, FF, W13, D, 2, gw, NGW, scr, lane);
    conv_mat(a.in[I_F_W2] + (size_t)f * D * FF, FF, D, W2T, FF, 0, gw, NGW, scr, lane);
}
__device__ __forceinline__ ConvItem moe_desc(const Args& a, int f, int idx) {
    constexpr int I1 = (D / 64) * (FF / 64), I2 = (FF / 64) * (D / 64), PER = 2 * I1 + I2;
    const int e = idx / PER, r = idx % PER; const size_t wo = ((size_t)f * NE + e) * D * FF;
    if (MOE_F8(f)) {
        unsigned char* W13 = a.ws + WS_W13 + (size_t)e * (W13_BYTES / 2); unsigned char* W2T = a.ws + WS_W2T8 + (size_t)e * (W2_BYTES / 2);
        if (r < I1) return conv_desc8(a.in[I_E_W1] + wo, D, FF, W13, 1, r);
        if (r < 2 * I1) return conv_desc8(a.in[I_E_W3] + wo, D, FF, W13, 2, r - I1);
        return conv_desc8(a.in[I_E_W2] + wo, FF, D, W2T, 0, r - 2 * I1); }
    bf16* W13 = (bf16*)(a.ws + WS_W13 + (size_t)e * W13_BYTES); bf16* W2T = (bf16*)(a.ws + WS_W2T + (size_t)e * W2_BYTES);
    if (r < I1) return conv_desc(a.in[I_E_W1] + wo, D, FF, W13, D, 1, r);
    if (r < 2 * I1) return conv_desc(a.in[I_E_W3] + wo, D, FF, W13, D, 2, r - I1);
    return conv_desc(a.in[I_E_W2] + wo, FF, D, W2T, FF, 0, r - 2 * I1);
}
__device__ __forceinline__ void conv_moe(const Args& a, int f, int gw, int NGW, LAS float* scr, int lane) {
    constexpr int I1 = (D / 64) * (FF / 64), I2 = (FF / 64) * (D / 64), PER = 2 * I1 + I2, items = NE * PER;
    int it = gw; if (it >= items) return;
    f32x2 va[33], vb[33]; ConvItem da = moe_desc(a, f, it), db = da; tr_load(da, va, lane);
    for (;;) {
        const int i1 = it + NGW; if (i1 < items) { db = moe_desc(a, f, i1); tr_load(db, vb, lane); }
        tr_store(da, va, scr, lane); if (i1 >= items) break;
        const int i2 = i1 + NGW; if (i2 < items) { da = moe_desc(a, f, i2); tr_load(da, va, lane); }
        tr_store(db, vb, scr, lane); if (i2 >= items) break;
        it = i2;
    }
}
enum { DQ_DENSE0 = 0, DQ_B, DQ_C, DQ_DENSE1, DQ_A1, DQ_MOE1, DQ_NG };
constexpr int DQ_I = (D / 64) * (FF / 64);
__device__ __forceinline__ int dq_size(int g) { return g == DQ_DENSE0 || g == DQ_DENSE1 ? 3 * DQ_I : g == DQ_B ? 1024 + 512 : g == DQ_C ? 256 : g == DQ_A1 ? 640 + 320 + 80 : NE * 3 * DQ_I; }
__device__ __forceinline__ ConvItem dq_desc0(const Args& a, int g, int idx) {
    if (g == DQ_DENSE0 || g == DQ_DENSE1) { const int f = (g == DQ_DENSE1) ? 1 : 0, m = idx / DQ_I, it = idx % DQ_I;
        if (DENSE_F8(f)) { unsigned char* W13 = a.ws + (f ? WS_WD1_13 : WS_W13); unsigned char* W2T = a.ws + (f ? WS_WD1_2 : WS_W2T);
            if (m == 0) return conv_desc8(a.in[I_F_W1] + (size_t)f * D * FF, D, FF, W13, 1, it);
            if (m == 1) return conv_desc8(a.in[I_F_W3] + (size_t)f * D * FF, D, FF, W13, 2, it);
            return conv_desc8(a.in[I_F_W2] + (size_t)f * D * FF, FF, D, W2T, 0, it); }
        bf16* W13 = (bf16*)(a.ws + (f ? WS_WD1_13 : WS_W13)); bf16* W2T = (bf16*)(a.ws + (f ? WS_WD1_2 : WS_W2T));
        if (m == 0) return conv_desc(a.in[I_F_W1] + (size_t)f * D * FF, D, FF, W13, D, 1, it);
        if (m == 1) return conv_desc(a.in[I_F_W3] + (size_t)f * D * FF, D, FF, W13, D, 2, it);
        return conv_desc(a.in[I_F_W2] + (size_t)f * D * FF, FF, D, W2T, FF, 0, it); }
    if (g == DQ_B) { if (idx < 1024) return conv_desc(a.in[I_B_W_IN], D, 2 * MI, (bf16*)(a.ws + WS_WB_IN), D, 0, idx);
        return conv_desc(a.in[I_B_W_OUT], MI, D, (bf16*)(a.ws + WS_WB_OUT), MI, 0, idx - 1024); }
    if (g == DQ_C) return conv_desc(a.in[I_C_W_GLU], D, D, (bf16*)(a.ws + WS_WC_GLU), D, 0, idx);
    if (g == DQ_A1) { if (idx < 640) { if (RG_F8(1)) return conv_desc8(a.in[I_A_W_IN] + (size_t)D * 2 * RW, D, 2 * RW, a.ws + WS_WA_IN + (size_t)2 * RW * D * 2, 0, idx);
            return conv_desc(a.in[I_A_W_IN] + (size_t)D * 2 * RW, D, 2 * RW, (bf16*)(a.ws + WS_WA_IN) + (size_t)2 * RW * D, D, 0, idx); }
        if (idx < 960) return conv_desc(a.in[I_A_W_OUT] + (size_t)RW * D, RW, D, (bf16*)(a.ws + WS_WA_OUT) + (size_t)D * RW, RW, 0, idx - 640);
        const int it = idx - 960, n = it / 8, r = it % 8, which = r / 4, q = r % 4;
        return conv_desc(a.in[which ? I_A_W_I : I_A_W_R] + ((size_t)RNB + n) * RBD * RBD, RBD, RBD, (bf16*)(a.ws + WS_WA_G) + ((size_t)RNB + n) * 256 * RBD + (size_t)which * 128 * RBD, RBD, 3, q); }
    return moe_desc(a, 1, idx);
}
__device__ __forceinline__ ConvItem dq_desc(const Args& a, int g, int idx) {
    ConvItem d = dq_desc0(a, g, idx);
#if DEFER_NORM
    if ((g == DQ_DENSE0 || g == DQ_DENSE1) && idx < 2 * DQ_I) d.kg = a.in[I_NORM_FFN] + (g == DQ_DENSE1 ? 2 : 0) * D;
    if (g == DQ_B && idx < 1024) d.kg = a.in[I_NORM_MIX] + 1 * D;
    if (g == DQ_A1 && idx < 640) d.kg = a.in[I_NORM_MIX] + 3 * D;
#endif
    return d;
}
__device__ __forceinline__ unsigned* dq_cursor(const Args& a, int g) { return (unsigned*)(a.ws + WS_CTL) + CW_DQ + 64 * g; }
__device__ __forceinline__ int dq_left(const Args& a, int g) { const int c = (int)__hip_atomic_load(dq_cursor(a, g), __ATOMIC_RELAXED, __HIP_MEMORY_SCOPE_AGENT), s = dq_size(g); return c >= s ? 0 : s - c; }
__device__ __forceinline__ void dq_work(const Args& a, int g_lo, int g_hi, int quota, LAS unsigned char* lds, LAS float* scr) {
    const int tid = otid(), lane = tid & 63, wave = tid >> 6; volatile LAS int* slot = (volatile LAS int*)(lds + MISC_OFF + 16);
    int done = 0;
    if (quota == -2) {
        __syncthreads(); if (tid == 0) *slot = (dq_left(a, g_lo) + 16 * (int)gridDim.x - 1) / (16 * (int)gridDim.x); __syncthreads(); quota = *slot; }
    for (int g = g_lo; g <= g_hi; ++g) {
        const int size = dq_size(g);
        for (;;) {
            if (quota >= 0 && done >= quota) return;
            __syncthreads();
            if (tid == 0) { int base = size; if (dq_left(a, g) > 0) base = (int)__hip_atomic_fetch_add(dq_cursor(a, g), 16u, __ATOMIC_RELAXED, __HIP_MEMORY_SCOPE_AGENT); *slot = base; }
            __syncthreads();
            const int base = *slot; if (base >= size) break;
            const int i0 = base + wave * 2, i1 = i0 + 1; ++done;
            if (i0 < size) { f32x2 va[33], vb[33]; const ConvItem da = dq_desc(a, g, i0); tr_load(da, va, lane);
                if (i1 < size) { const ConvItem db = dq_desc(a, g, i1); tr_load(db, vb, lane); tr_store(da, va, scr, lane); tr_store(db, vb, scr, lane); }
                else tr_store(da, va, scr, lane); }
        }
    }
}
__device__ __forceinline__ void conv_a(const Args& a, int j, int gw, int NGW, LAS float* scr, int lane) {
    conv_mat(a.in[I_A_W_IN] + (size_t)j * D * 2 * RW, D, 2 * RW, (bf16*)(a.ws + WS_WA_IN) + (size_t)j * 2 * RW * D, D, 0, gw, NGW, scr, lane);
    conv_mat(a.in[I_A_W_OUT] + (size_t)j * RW * D, RW, D, (bf16*)(a.ws + WS_WA_OUT) + (size_t)j * D * RW, RW, 0, gw, NGW, scr, lane);
    for (int it = gw; it < RNB * 2 * 4; it += NGW) { const int n = it / 8, r = it % 8, which = r / 4, q = r % 4;
        const float* W = a.in[which ? I_A_W_I : I_A_W_R] + ((size_t)j * RNB + n) * RBD * RBD;
        bf16* WT = (bf16*)(a.ws + WS_WA_G) + ((size_t)j * RNB + n) * 256 * RBD + (size_t)which * 128 * RBD;
        conv_item(W, RBD, RBD, WT, RBD, 3, q, scr, lane); }
}
__device__ __forceinline__ void conv_perm(const Args& a, int gw, int NGW, LAS float* scr, int lane) {
    for (int j = 0; j < 2; ++j) {
        conv_mat(a.in[I_A_W_IN] + (size_t)j * D * 2 * RW, D, 2 * RW, (bf16*)(a.ws + WS_WA_IN) + (size_t)j * 2 * RW * D, D, 0, gw, NGW, scr, lane);
        conv_mat(a.in[I_A_W_OUT] + (size_t)j * RW * D, RW, D, (bf16*)(a.ws + WS_WA_OUT) + (size_t)j * D * RW, RW, 0, gw, NGW, scr, lane);
        for (int it = gw; it < RNB * 2 * 4; it += NGW) { const int n = it / 8, r = it % 8, which = r / 4, q = r % 4;
            const float* W = a.in[which ? I_A_W_I : I_A_W_R] + ((size_t)j * RNB + n) * RBD * RBD;
            bf16* WT = (bf16*)(a.ws + WS_WA_G) + ((size_t)j * RNB + n) * 256 * RBD + (size_t)which * 128 * RBD;
            conv_item(W, RBD, RBD, WT, RBD, 3, q, scr, lane); }
    }
    conv_mat(a.in[I_B_W_IN], D, 2 * MI, (bf16*)(a.ws + WS_WB_IN), D, 0, gw, NGW, scr, lane);
    conv_mat(a.in[I_B_W_OUT], MI, D, (bf16*)(a.ws + WS_WB_OUT), MI, 0, gw, NGW, scr, lane);
    conv_mat(a.in[I_C_W_GLU], D, D, (bf16*)(a.ws + WS_WC_GLU), D, 0, gw, NGW, scr, lane);
}
__device__ __forceinline__ void s5_mats(const Args& a, LAS unsigned char* lds, int bid, int nb) {
    LAS float* lre = (LAS float*)lds; LAS float* lim = lre + 17 * 64; LAS float* bre = lim + 17 * 64; LAS float* bim = bre + 1024; LAS float* cre = bim + 1024; LAS float* cim = cre + 1024; LAS float* Kt = cim + 1024;
    const int tid = otid();
    for (int gq = bid; gq < NG * 4; gq += nb) {
        const int g = gq >> 2, q4 = gq & 3;
        __syncthreads();
        if (tid < 64) { const int p = tid; const float are = ldgf(a.in[I_C_A_RE] + g * 64 + p), aim = ldgf(a.in[I_C_A_IM] + g * 64 + p), dl = __expf(ldgf(a.in[I_C_LOG_STEP] + g));
            for (int tau = 0; tau <= 16; ++tau) { const float mag = __expf((float)tau * dl * are); float sn, cs; sincosf((float)tau * dl * aim, &sn, &cs); lre[tau * 64 + p] = mag * cs; lim[tau * 64 + p] = mag * sn; }
            const float mag = __expf(dl * are); float sn, cs; sincosf(dl * aim, &sn, &cs);
            const float nr = mag * cs - 1.0f, ni = mag * sn, den = are * are + aim * aim, fr_ = (nr * are + ni * aim) / den, fi_ = (ni * are - nr * aim) / den;
            for (int j = 0; j < 16; ++j) { const float br = ldgf(a.in[I_C_B_RE] + ((size_t)g * 64 + p) * 16 + j), bi = ldgf(a.in[I_C_B_IM] + ((size_t)g * 64 + p) * 16 + j);
                bre[p * 16 + j] = fr_ * br - fi_ * bi; bim[p * 16 + j] = fr_ * bi + fi_ * br; } }
        for (int i = tid; i < 1024; i += NTHR) { cre[i] = ldgf(a.in[I_C_C_RE] + (size_t)g * 1024 + i); cim[i] = ldgf(a.in[I_C_C_IM] + (size_t)g * 1024 + i); }
        __syncthreads();
        for (int o = tid; o < 4096; o += NTHR) { const int tau = o >> 8, i = (o >> 4) & 15, j = o & 15; float s = 0.f;
            for (int p = 0; p < 64; ++p) { const float cr = cre[i * 64 + p], ci = cim[i * 64 + p], lr = lre[tau * 64 + p], li = lim[tau * 64 + p], xr = cr * lr - ci * li, xi = cr * li + ci * lr;
                s += xr * bre[p * 16 + j] - xi * bim[p * 16 + j]; }
            Kt[o] = s; }
        __syncthreads();
        bf16* KC = (bf16*)(a.ws + WS_S5_KC) + (size_t)g * 256 * SK; bf16* BE = (bf16*)(a.ws + WS_S5_BE) + (size_t)g * 256 * 256;
        for (int o = tid; o < 64 * (SK / 8); o += NTHR) { const int n = q4 * 64 + o / (SK / 8), k0 = (o % (SK / 8)) * 8, tt = n >> 4, i = n & 15; float v[8];
#pragma unroll
            for (int q = 0; q < 8; ++q) { const int k = k0 + q;
                if (k < 256) { const int s = k >> 4, j = k & 15; v[q] = (s <= tt) ? Kt[((tt - s) << 8) + (i << 4) + j] : 0.f; }
                else { const int p = (k - 256) & 63, im = (k - 256) >> 6; const float cr = cre[i * 64 + p], ci = cim[i * 64 + p], lr = lre[(tt + 1) * 64 + p], li = lim[(tt + 1) * 64 + p];
                    v[q] = im ? -(cr * li + ci * lr) : (cr * lr - ci * li); } }
            u32x4 w; w.x = cvt_pk_bf16(v[0], v[1]); w.y = cvt_pk_bf16(v[2], v[3]); w.z = cvt_pk_bf16(v[4], v[5]); w.w = cvt_pk_bf16(v[6], v[7]);
            stg16(KC + (size_t)n * SK + k0, w); }
        for (int o = tid; o < 64 * 32; o += NTHR) { const int n = q4 * 64 + (o >> 5), k0 = (o & 31) * 8; float v[8];
#pragma unroll
            for (int q = 0; q < 8; ++q) { const int k = k0 + q, s = k >> 4, j = k & 15;
                if (n < 128) { const int p = n & 63, im = n >> 6; const float lr = lre[(15 - s) * 64 + p], li = lim[(15 - s) * 64 + p], br = bre[p * 16 + j], bi = bim[p * 16 + j];
                    v[q] = im ? (lr * bi + li * br) : (lr * br - li * bi); } else v[q] = 0.f; }
            u32x4 w; w.x = cvt_pk_bf16(v[0], v[1]); w.y = cvt_pk_bf16(v[2], v[3]); w.z = cvt_pk_bf16(v[4], v[5]); w.w = cvt_pk_bf16(v[6], v[7]);
            stg16(BE + (size_t)n * 256 + k0, w); }
    }
    __syncthreads();
}

__device__ __forceinline__ void moe_prefix(const Args& a, int f, int (&ps)[NE], int& P, int (&cnt)[NE]) {
    const unsigned* gc = (const unsigned*)(a.ws + WS_CTL) + CW_MOE + f * 1024; int acc = 0;
#pragma unroll
    for (int e = 0; e < NE; ++e) { ps[e] = acc; const int c = __builtin_amdgcn_readfirstlane((int)__hip_atomic_load(gc + e * 64, __ATOMIC_RELAXED, __HIP_MEMORY_SCOPE_AGENT)); cnt[e] = c; acc += (c + 255) >> 8; }
    P = acc;
}
template <bool COMBINE, bool ROUTER, int OUTMODE>
__device__ __forceinline__ void ph_norm(const Args& a, LAS unsigned char* lds, int bid, int nb, const float* xsrc, float* xf, const float* gain, int f) {
    const int tid = otid(), lane = tid & 63, wave = tid >> 6;
    const int RPB = T / nb;
    LAS float* rt = (LAS float*)lds; LAS int* sel = (LAS int*)(lds + 32768); LAS int* rnk = (LAS int*)(lds + 32768 + 1024); LAS int* bases = (LAS int*)(lds + 32768 + 2048); LAS int* dstl = (LAS int*)(lds + 32768 + 3072); LAS unsigned char* rows8 = lds + 36864;
    if (ROUTER) {
        const float* router = a.in[I_E_ROUTER] + (size_t)f * D * NE;
        for (int i = tid; i < D * NE; i += NTHR) rt[(i & 7) * D + (i >> 3)] = ldgf(router + i);
        __syncthreads();
    }
    f32x4 gv[4];
#pragma unroll
    for (int j = 0; j < 4; ++j) gv[j] = ldgf4(gain + 4 * lane + 256 * j);
    bf16* HN = (bf16*)(a.ws + WS_HN); bf16* UP = (bf16*)(a.ws + WS_UP);
    const bf16* OUTB = (const bf16*)(a.ws + WS_OUT); const bf16* OUTA = (const bf16*)(a.ws + WS_AG); float* TOPW = (float*)(a.ws + WS_TOPW); int* TOPI = (int*)(a.ws + WS_TOPI);
    int cps[NE], cP = 0, ccnt[NE];
    if (COMBINE) moe_prefix(a, f, cps, cP, ccnt);
    for (int lr0 = wave; lr0 < RPB; lr0 += NWAVES * 4) {
      f32x4 vv[4][4];
#pragma unroll
      for (int k_ = 0; k_ < 4; ++k_) { const int lrk = (lr0 + k_ * NWAVES < RPB) ? lr0 + k_ * NWAVES : lr0;
#pragma unroll
        for (int j = 0; j < 4; ++j) vv[k_][j] = ldgf4(xsrc + (size_t)(bid * RPB + lrk) * D + 4 * lane + 256 * j); }
#pragma unroll
      for (int k_ = 0; k_ < 4; ++k_) { const int lr = lr0 + k_ * NWAVES; if (lr < RPB) {
        const int row = bid * RPB + lr;
        f32x4 (&v)[4] = vv[k_];
        if (COMBINE) {
            const int t1 = ldgi(TOPI + row * 2), t2 = ldgi(TOPI + row * 2 + 1); const int e1 = t1 >> 16, e2 = t2 >> 16; int s1 = 0, s2 = 0;
#pragma unroll
            for (int e = 0; e < NE; ++e) { s1 = (e1 == e) ? cps[e] : s1; s2 = (e2 == e) ? cps[e] : s2; }
            const int r1 = s1 * 256 + (t1 & 0xffff), r2 = s2 * 256 + (t2 & 0xffff); const float p1 = ldgf(TOPW + row * 2), p2 = ldgf(TOPW + row * 2 + 1);
#pragma unroll
            for (int j = 0; j < 4; ++j) { const bool one_buf = MOE_F8(f) != 0;
                const u32x2 o1 = ldg8(OUTA + (size_t)r1 * D + 4 * lane + 256 * j), o2 = ldg8(OUTA + (size_t)r2 * D + 4 * lane + 256 * j);
                u32x2 q1 = (u32x2){0u, 0u}, q2 = (u32x2){0u, 0u};
                if (!one_buf) { q1 = ldg8(OUTB + (size_t)r1 * D + 4 * lane + 256 * j); q2 = ldg8(OUTB + (size_t)r2 * D + 4 * lane + 256 * j); }
                v[j][0] += p1 * (bflo(o1.x) + bflo(q1.x)) + p2 * (bflo(o2.x) + bflo(q2.x)); v[j][1] += p1 * (bfhi(o1.x) + bfhi(q1.x)) + p2 * (bfhi(o2.x) + bfhi(q2.x));
                v[j][2] += p1 * (bflo(o1.y) + bflo(q1.y)) + p2 * (bflo(o2.y) + bflo(q2.y)); v[j][3] += p1 * (bfhi(o1.y) + bfhi(q1.y)) + p2 * (bfhi(o2.y) + bfhi(q2.y));
                if (OUTMODE != 2) stgf4(xf + (size_t)row * D + 4 * lane + 256 * j, v[j]); }
        }
        float s2 = 0.f;
#pragma unroll
        for (int j = 0; j < 4; ++j) s2 += (v[j][0] * v[j][0] + v[j][1] * v[j][1]) + (v[j][2] * v[j][2] + v[j][3] * v[j][3]);
        const float rstd = __builtin_amdgcn_rsqf(wave_sum(s2) * (1.0f / D) + EPS);
#pragma unroll
        for (int j = 0; j < 4; ++j) v[j] = v[j] * rstd * gv[j];
        if (OUTMODE == 0) {
#pragma unroll
            for (int j = 0; j < 4; ++j) { u32x2 w; w.x = cvt_pk_bf16(v[j][0], v[j][1]); w.y = cvt_pk_bf16(v[j][2], v[j][3]); stg8(HN + (size_t)row * D + 4 * lane + 256 * j, w); }
        } else if (OUTMODE == 3) {
            if (ROUTER) {
#pragma unroll
                for (int j = 0; j < 4; ++j) *(LAS int*)(rows8 + lr * D + 4 * lane + 256 * j) = (int)cvt4_fp8(v[j][0], v[j][1], v[j][2], v[j][3]);
            } else {
#pragma unroll
                for (int j = 0; j < 4; ++j) stgi((unsigned char*)HN + (size_t)row * D + 4 * lane + 256 * j, (int)cvt4_fp8(v[j][0], v[j][1], v[j][2], v[j][3]));
            }
        } else if (OUTMODE == 1) {
            const int chunk = row >> 4, s = row & 15;
#pragma unroll
            for (int j = 0; j < 4; ++j) { const int g = (lane >> 2) + 16 * j, i0 = 4 * (lane & 3); u32x2 w; w.x = cvt_pk_bf16(v[j][0], v[j][1]); w.y = cvt_pk_bf16(v[j][2], v[j][3]);
                stg8(UP + ((size_t)g * SNC + chunk) * SK + s * 16 + i0, w); }
        } else {
#pragma unroll
            for (int j = 0; j < 4; ++j) stgf4(a.out + (size_t)row * D + 4 * lane + 256 * j, v[j]);
        }
        if (ROUTER) {
            float lg[NE];
#pragma unroll
            for (int e = 0; e < NE; ++e) { float s = 0.f;
#pragma unroll
                for (int j = 0; j < 4; ++j) { const f32x4 r = *(const LAS f32x4*)(rt + e * D + 4 * lane + 256 * j); s += (v[j][0] * r[0] + v[j][1] * r[1]) + (v[j][2] * r[2] + v[j][3] * r[3]); }
                lg[e] = wave_sum(s) + ldgf(a.in[I_E_ROUTER_B] + f * NE + e); }
            int e1 = 0; float v1 = lg[0];
#pragma unroll
            for (int e = 1; e < NE; ++e) if (lg[e] > v1) { v1 = lg[e]; e1 = e; }
            int e2 = -1; float v2 = -3.0e38f;
#pragma unroll
            for (int e = 0; e < NE; ++e) if (e != e1 && lg[e] > v2) { v2 = lg[e]; e2 = e; }
            const float p1 = 1.0f / (1.0f + __expf(v2 - v1)), p2 = 1.0f - p1;
            if (lane == 0) { sel[lr * 2] = e1; sel[lr * 2 + 1] = e2; stgf(TOPW + row * 2, p1); stgf(TOPW + row * 2 + 1, p2); }
        }
      } }
    }
    if (ROUTER) {
        __syncthreads();
        if (tid < NE) { int cnt = 0;
            for (int i = 0; i < RPB * 2; ++i) if (sel[i] == tid) rnk[i] = cnt++;
            unsigned* gc = (unsigned*)(a.ws + WS_CTL) + CW_MOE + f * 1024 + tid * 64;
            bases[tid] = (int)__hip_atomic_fetch_add(gc, (unsigned)cnt, __ATOMIC_RELAXED, __HIP_MEMORY_SCOPE_AGENT); }
        __syncthreads();
        if (tid < RPB * 2) { const int e = sel[tid], pos = bases[e] + rnk[tid]; stgi(TOPI + (size_t)bid * RPB * 2 + tid, (e << 16) | pos);
            stgi((int*)(a.ws + WS_LISTE) + e * T + pos, bid * RPB + (tid >> 1));
            if (OUTMODE == 3) dstl[tid] = e * T + pos; }
        __syncthreads();
        if (OUTMODE == 3) {
            unsigned char* AGX = a.ws + WS_AGX;
            for (int p = wave; p < RPB * 2; p += NWAVES) { const u32x4 x = *(const LAS u32x4*)(rows8 + (p >> 1) * D + lane * 16); stg16(AGX + (size_t)dstl[p] * D + lane * 16, x); }
            __syncthreads(); }
    }
}
__device__ __forceinline__ void ph_rg_gates(const Args& a, LAS unsigned char* lds, int bid, int nb, int jl) {
    const int tid = otid(), lane = tid & 63, wave = tid >> 6, fr = lane & 15, fq = lane >> 4;
    constexpr int AS_OFF = 0, BS_OFF = 17408, LA_OFF = 87040, BB_OFF = 87040 + 16384, XS_OFF = 87040 + 32768, RS = 272;
    const bf16* XR = (const bf16*)(a.ws + WS_XR); bf16* HL = (bf16*)(a.ws + WS_HL); bf16* AC = (bf16*)(a.ws + WS_AC);
    float* CSA = (float*)(a.ws + WS_CSA); float* CSH = (float*)(a.ws + WS_CSH);
    const int n = bid % RNB, rnk = bid / RNB, cnt = (nb - 1 - n) / RNB + 1;
    { const bf16* WG = (const bf16*)(a.ws + WS_WA_G) + ((size_t)jl * RNB + n) * 256 * RBD;
#pragma unroll
        for (int i = 0; i < 8; ++i) { const int idx = tid + NTHR * i, row = idx >> 4, c16 = idx & 15; *(LAS u32x4*)(lds + BS_OFF + row * RS + c16 * 16) = ldg16(WG + row * RBD + c16 * 8); } }
    const int r2 = tid >> 4, cg = tid & 15, ch0 = n * RBD + cg * 8;
    f32x2 cwv[4][4], cbv[4];
    { const float* cw = a.in[I_A_CONV_W] + (size_t)jl * 4 * RW; const float* cb = a.in[I_A_CONV_B] + (size_t)jl * RW;
#pragma unroll
      for (int k = 0; k < 4; ++k) { const f32x4 w0 = ldgf4(cw + (size_t)k * RW + ch0), w1 = ldgf4(cw + (size_t)k * RW + ch0 + 4); cwv[k][0] = (f32x2){w0[0], w0[1]}; cwv[k][1] = (f32x2){w0[2], w0[3]}; cwv[k][2] = (f32x2){w1[0], w1[1]}; cwv[k][3] = (f32x2){w1[2], w1[3]}; }
      const f32x4 b0 = ldgf4(cb + ch0), b1 = ldgf4(cb + ch0 + 4); cbv[0] = (f32x2){b0[0], b0[1]}; cbv[1] = (f32x2){b0[2], b0[3]}; cbv[2] = (f32x2){b1[0], b1[1]}; cbv[3] = (f32x2){b1[2], b1[3]}; }
    const int tg = wave & 3, half = wave >> 2;
    float brq[4], biq[4], spq[4];
#pragma unroll
    for (int q = 0; q < 4; ++q) { const int ch = n * RBD + 64 * half + 16 * q + fr; const float L2E = 1.4426950408889634f;
        brq[q] = L2E * ldgf(a.in[I_A_B_R] + (size_t)jl * RW + ch); biq[q] = L2E * ldgf(a.in[I_A_B_I] + (size_t)jl * RW + ch); spq[q] = 8.0f * L2E * softplus_f(-ldgf(a.in[I_A_LAM] + (size_t)jl * RW + ch)); }
    u32x4 xr_[5];
    int c = rnk;
#define RG_LOADX(cc) do { _Pragma("unroll") for (int k = 0; k < 5; ++k) { const int tk = (cc) * RCH + 2 * r2 - 3 + k; xr_[k] = (tk >= 0) ? ldg16(XR + (size_t)tk * RW + ch0) : (u32x4){0u, 0u, 0u, 0u}; } } while (0)
    if (c < RNC) RG_LOADX(c);
    for (; c < RNC; c += cnt) {
        __syncthreads();
        {
#pragma unroll
            for (int rr = 0; rr < 2; ++rr) { f32x2 acc[4];
#pragma unroll
                for (int j = 0; j < 4; ++j) acc[j] = cbv[j];
#pragma unroll
                for (int k = 0; k < 4; ++k) { const u32x4 x = xr_[rr + k];
                    acc[0] += cwv[k][0] * (f32x2){bflo(x.x), bfhi(x.x)}; acc[1] += cwv[k][1] * (f32x2){bflo(x.y), bfhi(x.y)};
                    acc[2] += cwv[k][2] * (f32x2){bflo(x.z), bfhi(x.z)}; acc[3] += cwv[k][3] * (f32x2){bflo(x.w), bfhi(x.w)}; }
                u32x4 w0; w0.x = cvt_pk_bf16(acc[0][0], acc[0][1]); w0.y = cvt_pk_bf16(acc[1][0], acc[1][1]); w0.z = cvt_pk_bf16(acc[2][0], acc[2][1]); w0.w = cvt_pk_bf16(acc[3][0], acc[3][1]);
                *(LAS u32x4*)(lds + AS_OFF + (2 * r2 + rr) * RS + cg * 16) = w0; }
        }
        { const int cn = c + cnt; if (cn < RNC) RG_LOADX(cn); }
        __syncthreads();
        f32x4 accr[4], acci[4];
#pragma unroll
        for (int q = 0; q < 4; ++q) { accr[q] = (f32x4){0.f, 0.f, 0.f, 0.f}; acci[q] = (f32x4){0.f, 0.f, 0.f, 0.f}; }
#pragma unroll
        for (int kk = 0; kk < 4; ++kk) { const bf16x8 af = *(const LAS bf16x8*)(lds + AS_OFF + (16 * tg + fr) * RS + (kk * 32 + 8 * fq) * 2);
#pragma unroll
            for (int q = 0; q < 4; ++q) { const bf16x8 br = *(const LAS bf16x8*)(lds + BS_OFF + (64 * half + 16 * q + fr) * RS + (kk * 32 + 8 * fq) * 2);
                const bf16x8 bi = *(const LAS bf16x8*)(lds + BS_OFF + (128 + 64 * half + 16 * q + fr) * RS + (kk * 32 + 8 * fq) * 2);
                accr[q] = __builtin_amdgcn_mfma_f32_16x16x32_bf16(af, br, accr[q], 0, 0, 0); acci[q] = __builtin_amdgcn_mfma_f32_16x16x32_bf16(af, bi, acci[q], 0, 0, 0); } }
#pragma unroll
        for (int q = 0; q < 4; ++q) { const int chl = 64 * half + 16 * q + fr;
#pragma unroll
            for (int pr_ = 0; pr_ < 2; ++pr_) { const int row = 16 * tg + 4 * fq + 2 * pr_;
                const f32x2 R2 = (f32x2){accr[q][2 * pr_], accr[q][2 * pr_ + 1]} + brq[q], I2 = (f32x2){acci[q][2 * pr_], acci[q][2 * pr_ + 1]} + biq[q];
                f32x2 eR, eI; eR[0] = __builtin_amdgcn_exp2f(-R2[0]); eR[1] = __builtin_amdgcn_exp2f(-R2[1]); eI[0] = __builtin_amdgcn_exp2f(-I2[0]); eI[1] = __builtin_amdgcn_exp2f(-I2[1]);
                const f32x2 dR = eR + 1.0f, dI = eI + 1.0f; f32x2 rr, ii; rr[0] = __builtin_amdgcn_rcpf(dR[0]); rr[1] = __builtin_amdgcn_rcpf(dR[1]); ii[0] = __builtin_amdgcn_rcpf(dI[0]); ii[1] = __builtin_amdgcn_rcpf(dI[1]);
                const f32x2 la = rr * spq[q]; f32x2 a_; a_[0] = __builtin_amdgcn_exp2f(-la[0]); a_[1] = __builtin_amdgcn_exp2f(-la[1]);
                f32x2 om = 1.0f - a_; om[0] = fmaxf(om[0], 0.f); om[1] = fmaxf(om[1], 0.f);
                const f32x2 t2 = om * (a_ + 1.0f); f32x2 sq; sq[0] = __builtin_amdgcn_sqrtf(t2[0]); sq[1] = __builtin_amdgcn_sqrtf(t2[1]);
                const f32x2 xr = (f32x2){bf2f(*(const LAS bf16*)(lds + AS_OFF + row * RS + chl * 2)), bf2f(*(const LAS bf16*)(lds + AS_OFF + (row + 1) * RS + chl * 2))};
                const f32x2 bb = (sq * ii) * xr;
                *(LAS bf16*)(lds + LA_OFF + (row * 128 + chl) * 2) = f2bf(om[0]); *(LAS bf16*)(lds + LA_OFF + ((row + 1) * 128 + chl) * 2) = f2bf(om[1]);
                *(LAS bf16*)(lds + BB_OFF + (row * 128 + chl) * 2) = f2bf(bb[0]); *(LAS bf16*)(lds + BB_OFF + ((row + 1) * 128 + chl) * 2) = f2bf(bb[1]); } }
        __syncthreads();
        { const int j = tid & 127, seg = tid >> 7, ch = n * RBD + j; float hl[16], pa[16]; float h = 0.f, pr = 1.f;
#pragma unroll
            for (int i = 0; i < 16; ++i) { const float om = bf2f(*(const LAS bf16*)(lds + LA_OFF + ((16 * seg + i) * 128 + j) * 2)), bb = bf2f(*(const LAS bf16*)(lds + BB_OFF + ((16 * seg + i) * 128 + j) * 2));
                const float ai = 1.0f - om; h = ai * h + bb; pr *= ai; hl[i] = h; pa[i] = pr; }
            LAS float* xs = (LAS float*)(lds + XS_OFF); xs[(seg * 128 + j) * 2] = pr; xs[(seg * 128 + j) * 2 + 1] = h;
            __syncthreads();
            float cin_h = 0.f, cin_a = 1.f;
#pragma unroll
            for (int s = 0; s < 3; ++s) if (s < seg) { const float sa = xs[(s * 128 + j) * 2], sh = xs[(s * 128 + j) * 2 + 1]; cin_h = sa * cin_h + sh; cin_a *= sa; }
#pragma unroll
            for (int i = 0; i < 16; ++i) { const float hf = hl[i] + pa[i] * cin_h, af = pa[i] * cin_a;
                *(LAS bf16*)(lds + LA_OFF + ((16 * seg + i) * 128 + j) * 2) = f2bf(hf); *(LAS bf16*)(lds + BB_OFF + ((16 * seg + i) * 128 + j) * 2) = f2bf(af);
                if (i == 15 && seg == 3) { stgf(CSA + (size_t)c * RW + ch, af); stgf(CSH + (size_t)c * RW + ch, hf); } } }
        __syncthreads();
#pragma unroll
        for (int i = 0; i < 2; ++i) { const int idx = tid + NTHR * i, row = idx >> 4, c16 = idx & 15; const size_t o = (size_t)(c * RCH + row) * RW + n * RBD + c16 * 8;
            stg16(HL + o, *(const LAS u32x4*)(lds + LA_OFF + row * 256 + c16 * 16)); stg16(AC + o, *(const LAS u32x4*)(lds + BB_OFF + row * 256 + c16 * 16)); }
    }
#undef RG_LOADX
    __syncthreads();
}
__device__ __forceinline__ void ph_rg_carry(const Args& a, int bid, int nb) {
    const int tid = otid(), lane = tid & 63, gw = bid * NWAVES + (tid >> 6), NGW = nb * NWAVES;
    const float* CSA = (const float*)(a.ws + WS_CSA); const float* CSH = (const float*)(a.ws + WS_CSH); float* CIN = (float*)(a.ws + WS_CIN);
    for (int ch = gw; ch < RW; ch += NGW) {
        float Ak[4], Hk[4]; float A = 1.f, H = 0.f;
#pragma unroll
        for (int k = 0; k < 4; ++k) { Ak[k] = ldgf(CSA + (size_t)(4 * lane + k) * RW + ch); Hk[k] = ldgf(CSH + (size_t)(4 * lane + k) * RW + ch); H = Ak[k] * H + Hk[k]; A = Ak[k] * A; }
#pragma unroll
        for (int off = 1; off < 64; off <<= 1) { const float Ay = __shfl_up(A, off), Hy = __shfl_up(H, off); if (lane >= off) { H = A * Hy + H; A = A * Ay; } }
        float h = __shfl_up(H, 1); if (lane == 0) h = 0.f;
#pragma unroll
        for (int k = 0; k < 4; ++k) { stgf(CIN + (size_t)(4 * lane + k) * RW + ch, h); h = Ak[k] * h + Hk[k]; }
    }
}
__device__ __forceinline__ void ph_rg_fix(const Args& a, int bid, int nb) {
    const int tid = otid(); bf16* GX = (bf16*)(a.ws + WS_GX); const bf16* HL = (const bf16*)(a.ws + WS_HL); const bf16* AC = (const bf16*)(a.ws + WS_AC); const float* CIN = (const float*)(a.ws + WS_CIN);
    const int total = T * (RW / 8);
    for (int it = bid * NTHR + tid; it < total; it += nb * NTHR) {
        const int t = it / (RW / 8), ch = (it % (RW / 8)) * 8, c = t / RCH; const size_t o = (size_t)t * RW + ch;
        const u32x4 g = ldg16(GX + o), hl = ldg16(HL + o), ac = ldg16(AC + o); const f32x4 c0 = ldgf4(CIN + (size_t)c * RW + ch), c1 = ldgf4(CIN + (size_t)c * RW + ch + 4);
        float y[8];
        y[0] = gelu_tanh(bflo(g.x)) * (bflo(hl.x) + bflo(ac.x) * c0[0]); y[1] = gelu_tanh(bfhi(g.x)) * (bfhi(hl.x) + bfhi(ac.x) * c0[1]);
        y[2] = gelu_tanh(bflo(g.y)) * (bflo(hl.y) + bflo(ac.y) * c0[2]); y[3] = gelu_tanh(bfhi(g.y)) * (bfhi(hl.y) + bfhi(ac.y) * c0[3]);
        y[4] = gelu_tanh(bflo(g.z)) * (bflo(hl.z) + bflo(ac.z) * c1[0]); y[5] = gelu_tanh(bfhi(g.z)) * (bfhi(hl.z) + bfhi(ac.z) * c1[1]);
        y[6] = gelu_tanh(bflo(g.w)) * (bflo(hl.w) + bflo(ac.w) * c1[2]); y[7] = gelu_tanh(bfhi(g.w)) * (bfhi(hl.w) + bfhi(ac.w) * c1[3]);
        u32x4 w; w.x = cvt_pk_bf16(y[0], y[1]); w.y = cvt_pk_bf16(y[2], y[3]); w.z = cvt_pk_bf16(y[4], y[5]); w.w = cvt_pk_bf16(y[6], y[7]);
        stg16(GX + o, w);
    }
}

__device__ __forceinline__ void ph_ml_prep(const Args& a, LAS unsigned char* lds, int bid, int nb) {
    const bf16* XM = (const bf16*)(a.ws + WS_XM); bf16* Q = (bf16*)(a.ws + WS_Q); bf16* Kb = (bf16*)(a.ws + WS_K); bf16* XC = (bf16*)(a.ws + WS_XC);
    float* GI = (float*)(a.ws + WS_GI); float* GF = (float*)(a.ws + WS_GF);
    LAS float* red = (LAS float*)(lds + EXTRA_OFF);
    const float kscale = 0.044194173824159216f;
    for (int tb = bid; tb < T / 64; tb += nb) {
        const int t0 = tb * 64;
        {
            const int tid = otid(), lane = tid & 63, wave = tid >> 6, n4 = tid * 4;
            f32x2 cw[4][2], cb[2], wq[4][2], wk[4][2], wv[4][2], gqk[4][4], gv[4][4];
#pragma unroll
            for (int k = 0; k < 4; ++k) { const f32x4 v = ldgf4(a.in[I_B_CONV_W] + k * MI + n4); cw[k][0] = (f32x2){v[0], v[1]}; cw[k][1] = (f32x2){v[2], v[3]}; }
            { const f32x4 v = ldgf4(a.in[I_B_CONV_B] + n4); cb[0] = (f32x2){v[0], v[1]}; cb[1] = (f32x2){v[2], v[3]}; }
#pragma unroll
            for (int i = 0; i < 4; ++i) { const f32x4 q_ = ldgf4(a.in[I_B_W_Q] + tid * 16 + i * 4), k_ = ldgf4(a.in[I_B_W_K] + tid * 16 + i * 4), v_ = ldgf4(a.in[I_B_W_V] + tid * 16 + i * 4);
                wq[i][0] = (f32x2){q_[0], q_[1]}; wq[i][1] = (f32x2){q_[2], q_[3]}; wk[i][0] = (f32x2){k_[0], k_[1]}; wk[i][1] = (f32x2){k_[2], k_[3]}; wv[i][0] = (f32x2){v_[0], v_[1]}; wv[i][1] = (f32x2){v_[2], v_[3]}; }
#pragma unroll
            for (int i = 0; i < 4; ++i)
#pragma unroll
                for (int e = 0; e < 4; ++e) { gqk[i][e] = (f32x2){0.f, 0.f}; gv[i][e] = (f32x2){0.f, 0.f}; }
#pragma unroll
            for (int j = 0; j < 4; ++j) { const float* pwg = a.in[I_B_W_GATE];
                const f32x4 a0 = ldgf4(pwg + (size_t)(0 * MI + n4 + j) * 8), a1 = ldgf4(pwg + (size_t)(0 * MI + n4 + j) * 8 + 4);
                const f32x4 b0 = ldgf4(pwg + (size_t)(1 * MI + n4 + j) * 8), b1 = ldgf4(pwg + (size_t)(1 * MI + n4 + j) * 8 + 4);
                const f32x4 c0 = ldgf4(pwg + (size_t)(2 * MI + n4 + j) * 8), c1 = ldgf4(pwg + (size_t)(2 * MI + n4 + j) * 8 + 4);
                const f32x2 ga[4] = {(f32x2){a0[0], a0[1]}, (f32x2){a0[2], a0[3]}, (f32x2){a1[0], a1[1]}, (f32x2){a1[2], a1[3]}};
                const f32x2 gb[4] = {(f32x2){b0[0], b0[1]}, (f32x2){b0[2], b0[3]}, (f32x2){b1[0], b1[1]}, (f32x2){b1[2], b1[3]}};
                const f32x2 gc[4] = {(f32x2){c0[0], c0[1]}, (f32x2){c0[2], c0[3]}, (f32x2){c1[0], c1[1]}, (f32x2){c1[2], c1[3]}};
#pragma unroll
                for (int i = 0; i < 4; ++i) { const float wq_ = wq[i][j >> 1][j & 1], wk_ = wk[i][j >> 1][j & 1], wv_ = wv[i][j >> 1][j & 1];
#pragma unroll
                    for (int e = 0; e < 4; ++e) { gqk[i][e] += ga[e] * wq_ + gb[e] * wk_; gv[i][e] += gc[e] * wv_; } } }
            f32x2 x0[2], x1[2], x2[2], x3[2];
#pragma unroll
            for (int p = 0; p < 2; ++p) { x0[p] = (f32x2){0.f, 0.f}; x1[p] = x0[p]; x2[p] = x0[p]; }
            if (t0 > 0) { const u32x2 p0 = ldg8(XM + (size_t)(t0 - 3) * MI + n4), p1 = ldg8(XM + (size_t)(t0 - 2) * MI + n4), p2 = ldg8(XM + (size_t)(t0 - 1) * MI + n4);
                x0[0] = (f32x2){bflo(p0.x), bfhi(p0.x)}; x0[1] = (f32x2){bflo(p0.y), bfhi(p0.y)}; x1[0] = (f32x2){bflo(p1.x), bfhi(p1.x)}; x1[1] = (f32x2){bflo(p1.y), bfhi(p1.y)};
                x2[0] = (f32x2){bflo(p2.x), bfhi(p2.x)}; x2[1] = (f32x2){bflo(p2.y), bfhi(p2.y)}; }
            u32x2 xs[8], xn[8];
#pragma unroll
            for (int b = 0; b < 8; ++b) xs[b] = ldg8(XM + (size_t)(t0 + b) * MI + n4);
#pragma unroll 1
            for (int tl0 = 0; tl0 < 64; tl0 += 8) {
              { const int tn = (tl0 + 8 < 64) ? tl0 + 8 : tl0;
#pragma unroll
                for (int b = 0; b < 8; ++b) xn[b] = ldg8(XM + (size_t)(t0 + tn + b) * MI + n4); }
#pragma unroll 1
              for (int b = 0; b < 8; ++b) {
                const int tl = tl0 + b, t = t0 + tl;
                { const u32x2 p3 = xs[0];
#pragma unroll
                  for (int q = 0; q < 7; ++q) xs[q] = xs[q + 1];
                  x3[0] = (f32x2){bflo(p3.x), bfhi(p3.x)}; x3[1] = (f32x2){bflo(p3.y), bfhi(p3.y)}; }
                float xc[4]; f32x2 q2[2], k2[2], v2[2];
#pragma unroll
                for (int p = 0; p < 2; ++p) { const f32x2 cv = cb[p] + cw[0][p] * x0[p] + cw[1][p] * x1[p] + cw[2][p] * x2[p] + cw[3][p] * x3[p]; xc[2 * p] = silu_f(cv[0]); xc[2 * p + 1] = silu_f(cv[1]); }
                const float xm[4] = {x3[0][0], x3[0][1], x3[1][0], x3[1][1]};
#pragma unroll
                for (int p = 0; p < 2; ++p) { q2[p] = wq[0][p] * xc[0] + wq[1][p] * xc[1] + wq[2][p] * xc[2] + wq[3][p] * xc[3]; k2[p] = wk[0][p] * xc[0] + wk[1][p] * xc[1] + wk[2][p] * xc[2] + wk[3][p] * xc[3];
                    v2[p] = wv[0][p] * xm[0] + wv[1][p] * xm[1] + wv[2][p] * xm[2] + wv[3][p] * xm[3]; }
                { u32x2 w; w.x = cvt_pk_bf16(q2[0][0], q2[0][1]); w.y = cvt_pk_bf16(q2[1][0], q2[1][1]); stg8(Q + (size_t)t * MI + n4, w);
                  w.x = cvt_pk_bf16(k2[0][0] * kscale, k2[0][1] * kscale); w.y = cvt_pk_bf16(k2[1][0] * kscale, k2[1][1] * kscale); stg8(Kb + (size_t)t * MI + n4, w);
                  w.x = cvt_pk_bf16(xc[0], xc[1]); w.y = cvt_pk_bf16(xc[2], xc[3]); stg8(XC + (size_t)t * MI + n4, w);
                  (void)v2; }
                f32x2 g2[4];
#pragma unroll
                for (int e = 0; e < 4; ++e) g2[e] = gqk[0][e] * xc[0] + gqk[1][e] * xc[1] + gqk[2][e] * xc[2] + gqk[3][e] * xc[3] + gv[0][e] * xm[0] + gv[1][e] * xm[1] + gv[2][e] * xm[2] + gv[3][e] * xm[3];
                const float g[8] = {g2[0][0], g2[0][1], g2[1][0], g2[1][1], g2[2][0], g2[2][1], g2[3][0], g2[3][1]};
                { const bool h5 = (lane & 32) != 0; float k4[4];
#pragma unroll
                  for (int e = 0; e < 4; ++e) { const float snd = h5 ? g[e] : g[4 + e], kp = h5 ? g[4 + e] : g[e]; k4[e] = kp + __shfl_xor(snd, 32); }
                  const bool h4 = (lane & 16) != 0; float k2_[2];
#pragma unroll
                  for (int e = 0; e < 2; ++e) { const float snd = h4 ? k4[e] : k4[2 + e], kp = h4 ? k4[2 + e] : k4[e]; k2_[e] = kp + __shfl_xor(snd, 16); }
                  const bool h3 = (lane & 8) != 0; const float snd = h3 ? k2_[0] : k2_[1], kp = h3 ? k2_[1] : k2_[0]; float k1 = kp + __shfl_xor(snd, 8);
                  k1 += __shfl_xor(k1, 4); k1 += __shfl_xor(k1, 2); k1 += __shfl_xor(k1, 1);
                  if ((lane & 7) == 0) red[(tl * 8 + wave) * 8 + (lane >> 3)] = k1; }
#pragma unroll
                for (int p = 0; p < 2; ++p) { x0[p] = x1[p]; x1[p] = x2[p]; x2[p] = x3[p]; }
              }
#pragma unroll
              for (int b = 0; b < 8; ++b) xs[b] = xn[b];
            }
        }
        __syncthreads();
        { const int tid = otid(), tok = tid >> 3, e = tid & 7; float s = ldgf(a.in[I_B_B_GATE] + e);
#pragma unroll
            for (int w = 0; w < 8; ++w) s += red[(tok * 8 + w) * 8 + e];
            if (e < 4) stgf(GI + (size_t)e * T + t0 + tok, s); else stgf(GF + (size_t)(e - 4) * T + t0 + tok, -softplus_f(-s)); }
        __syncthreads();
    }
}
__device__ __forceinline__ void ph_ml_gscan(const Args& a, LAS unsigned char* lds, int bid, int nb) {
    const int tid = otid(), lane = tid & 63, wave = tid >> 6;
    const float* GI = (const float*)(a.ws + WS_GI); const float* GF = (const float*)(a.ws + WS_GF);
    float* GS = (float*)(a.ws + WS_GS); float* RMT = (float*)(a.ws + WS_RMT); float* EF = (float*)(a.ws + WS_EF); float* MC = (float*)(a.ws + WS_MC);
    LAS float* wt = (LAS float*)lds;
    for (int h = bid; h < MH; h += nb) {
        __syncthreads();
        float lf[32], ig[32]; float s = 0.f;
#pragma unroll
        for (int q = 0; q < 8; ++q) { const f32x4 v = ldgf4(GF + (size_t)h * T + tid * 32 + 4 * q), w = ldgf4(GI + (size_t)h * T + tid * 32 + 4 * q);
            lf[4 * q] = v[0]; lf[4 * q + 1] = v[1]; lf[4 * q + 2] = v[2]; lf[4 * q + 3] = v[3]; ig[4 * q] = w[0]; ig[4 * q + 1] = w[1]; ig[4 * q + 2] = w[2]; ig[4 * q + 3] = w[3]; }
#pragma unroll
        for (int i = 0; i < 32; ++i) s += lf[i];
        float inc = s;
#pragma unroll
        for (int off = 1; off < 64; off <<= 1) { const float y = __shfl_up(inc, off); if (lane >= off) inc += y; }
        if (lane == 63) wt[wave] = inc;
        __syncthreads();
        float base = inc - s;
#pragma unroll
        for (int w = 0; w < 8; ++w) if (w < wave) base += wt[w];
        float F = base, lmax = -3.0e38f;
#pragma unroll
        for (int i = 0; i < 32; ++i) { F += lf[i]; lf[i] = F; ig[i] = ig[i] - F; lmax = fmaxf(lmax, ig[i]); }
        float minc = lmax;
#pragma unroll
        for (int off = 1; off < 64; off <<= 1) { const float y = __shfl_up(minc, off); if (lane >= off) minc = fmaxf(minc, y); }
        __syncthreads();
        if (lane == 63) wt[8 + wave] = minc;
        __syncthreads();
        float pm = __shfl_up(minc, 1); if (lane == 0) pm = -3.0e38f;
#pragma unroll
        for (int w = 0; w < 8; ++w) if (w < wave) pm = fmaxf(pm, wt[8 + w]);
        float rm = fmaxf(pm, 0.f);
#pragma unroll
        for (int i = 0; i < 32; ++i) { rm = fmaxf(rm, ig[i]); const size_t o = (size_t)h * T + tid * 32 + i; stgf(GS + o, ig[i]); stgf(RMT + o, rm); stgf(EF + o, __expf(-lf[i] - rm)); }
        if ((tid & 7) == 7) stgf(MC + h * 80 + (tid + 1) / 8, rm);
        if (tid == 0) stgf(MC + h * 80, 0.f);
    }
    __syncthreads();
}
__device__ __forceinline__ void ph_ml_ktw(const Args& a, LAS unsigned char* lds, int bid, int nb) {
    const bf16* Kn = (const bf16*)(a.ws + WS_K); const bf16* Xm = (const bf16*)(a.ws + WS_XM); bf16* KT = (bf16*)(a.ws + WS_KT); bf16* VT = (bf16*)(a.ws + WS_VT);
    const float* GS = (const float*)(a.ws + WS_GS); const float* MC = (const float*)(a.ws + WS_MC); float* NS = (float*)(a.ws + WS_NS);
    LAS float* w = (LAS float*)(lds + EXTRA_OFF); constexpr int TS = 144;
    for (int u = bid; u < MNC * MH; u += nb) { const int c = u / MH, h = u % MH; const int tid = otid(), lane = tid & 63, wave = tid >> 6;
        LAS unsigned char* tile = lds + wave * 16384;
        __syncthreads();
        if (tid < MCH) w[tid] = __expf(ldgf(GS + (size_t)h * T + c * MCH + tid) - ldgf(MC + h * 80 + c + 1));
        __syncthreads();
        const int ch0 = h * HD + wave * 64, rr = lane >> 3, c8 = lane & 7;
        f32x2 wvv[2][4][2];
#pragma unroll
        for (int bk = 0; bk < 2; ++bk)
#pragma unroll
            for (int i = 0; i < 4; ++i) { const f32x4 wr = ldgf4(a.in[I_B_W_V] + (size_t)((ch0 + c8 * 8) / 4 + bk) * 16 + i * 4); wvv[bk][i][0] = (f32x2){wr[0], wr[1]}; wvv[bk][i][1] = (f32x2){wr[2], wr[3]}; }
        float psum[8];
#pragma unroll
        for (int i = 0; i < 8; ++i) psum[i] = 0.f;
#pragma unroll 1
        for (int pass = 0; pass < 8; ++pass) { const int isv = pass >> 2, tg = pass & 3; const bf16* src = (isv ? Xm : Kn) + (size_t)(c * MCH + tg * 64) * MI + ch0; bf16* dst = (isv ? VT : KT) + (size_t)ch0 * LDT + c * MCH + tg * 64;
            u32x4 x[8];
#pragma unroll
            for (int i = 0; i < 8; ++i) x[i] = ldg16(src + (size_t)(rr + 8 * i) * MI + c8 * 8);
            if (isv) {
#pragma unroll
                for (int i = 0; i < 8; ++i) { const u32x4 xx = x[i]; const float xa[4] = {bflo(xx.x), bfhi(xx.x), bflo(xx.y), bfhi(xx.y)}, xb[4] = {bflo(xx.z), bfhi(xx.z), bflo(xx.w), bfhi(xx.w)};
                    const f32x2 va0 = wvv[0][0][0] * xa[0] + wvv[0][1][0] * xa[1] + wvv[0][2][0] * xa[2] + wvv[0][3][0] * xa[3], va1 = wvv[0][0][1] * xa[0] + wvv[0][1][1] * xa[1] + wvv[0][2][1] * xa[2] + wvv[0][3][1] * xa[3];
                    const f32x2 vb0 = wvv[1][0][0] * xb[0] + wvv[1][1][0] * xb[1] + wvv[1][2][0] * xb[2] + wvv[1][3][0] * xb[3], vb1 = wvv[1][0][1] * xb[0] + wvv[1][1][1] * xb[1] + wvv[1][2][1] * xb[2] + wvv[1][3][1] * xb[3];
                    u32x4 o; o.x = cvt_pk_bf16(va0[0], va0[1]); o.y = cvt_pk_bf16(va1[0], va1[1]); o.z = cvt_pk_bf16(vb0[0], vb0[1]); o.w = cvt_pk_bf16(vb1[0], vb1[1]); x[i] = o; } }
#pragma unroll
            for (int i = 0; i < 8; ++i) *(LAS u32x4*)(tile + (rr + 8 * i) * TS + c8 * 16) = x[i];
            LDS_WAIT(); asm volatile("" ::: "memory");
#pragma unroll
            for (int i = 0; i < 8; ++i) { const int d = rr + 8 * i; const LAS bf16* tp = (const LAS bf16*)(tile + (c8 * 8) * TS) + d; float v[8];
#pragma unroll
                for (int q = 0; q < 8; ++q) v[q] = bf2f(tp[q * (TS / 2)]);
                if (!isv) { const LAS float* wp = w + tg * 64 + c8 * 8;
#pragma unroll
                    for (int q = 0; q < 8; ++q) v[q] *= wp[q]; }
                u32x4 o; o.x = cvt_pk_bf16(v[0], v[1]); o.y = cvt_pk_bf16(v[2], v[3]); o.z = cvt_pk_bf16(v[4], v[5]); o.w = cvt_pk_bf16(v[6], v[7]);
                if (!isv) psum[i] += (bflo(o.x) + bfhi(o.x)) + (bflo(o.y) + bfhi(o.y)) + (bflo(o.z) + bfhi(o.z)) + (bflo(o.w) + bfhi(o.w));
                stg16(dst + (size_t)d * LDT + c8 * 8, o); }
            LDS_WAIT(); asm volatile("" ::: "memory");
        }
#pragma unroll
        for (int i = 0; i < 8; ++i) { float ps = psum[i]; ps += __shfl_xor(ps, 1); ps += __shfl_xor(ps, 2); ps += __shfl_xor(ps, 4); if (c8 == 0) stgf(NS + (size_t)u * HD + wave * 64 + rr + 8 * i, ps); }
    }
    asm volatile("s_waitcnt vmcnt(0)" ::: "memory");
    __syncthreads();
}
__device__ __forceinline__ void ph_ml_sscan(const Args& a, int bid, int nb) {
    bf16* CT = (bf16*)(a.ws + WS_CT); float* NS = (float*)(a.ws + WS_NS); const float* MC = (const float*)(a.ws + WS_MC);
    for (int it = bid * NTHR + otid(); it < MH * HD * (HD / 8); it += nb * NTHR) {
        const int h = it / (HD * (HD / 8)), rem = it % (HD * (HD / 8)); bf16* p = CT + (size_t)h * HD * HD + (size_t)rem * 8; const size_t cs = (size_t)MH * HD * HD;
        float run[8];
#pragma unroll
        for (int j = 0; j < 8; ++j) run[j] = 0.f;
        u32x4 sv[8], sn[8];
#pragma unroll
        for (int q = 0; q < 8; ++q) sv[q] = ldg16(p + (size_t)q * cs);
        for (int c0 = 0; c0 < MNC; c0 += 8) {
            float dec[8]; const int cn = (c0 + 8 < MNC) ? c0 + 8 : c0;
#pragma unroll
            for (int q = 0; q < 8; ++q) { sn[q] = ldg16(p + (size_t)(cn + q) * cs); dec[q] = __expf(ldgf(MC + h * 80 + c0 + q) - ldgf(MC + h * 80 + c0 + q + 1)); }
#pragma unroll
            for (int q = 0; q < 8; ++q) { u32x4 o; o.x = cvt_pk_bf16(run[0], run[1]); o.y = cvt_pk_bf16(run[2], run[3]); o.z = cvt_pk_bf16(run[4], run[5]); o.w = cvt_pk_bf16(run[6], run[7]);
                stg16(p + (size_t)(c0 + q) * cs, o);
                run[0] = dec[q] * run[0] + bflo(sv[q].x); run[1] = dec[q] * run[1] + bfhi(sv[q].x); run[2] = dec[q] * run[2] + bflo(sv[q].y); run[3] = dec[q] * run[3] + bfhi(sv[q].y);
                run[4] = dec[q] * run[4] + bflo(sv[q].z); run[5] = dec[q] * run[5] + bfhi(sv[q].z); run[6] = dec[q] * run[6] + bflo(sv[q].w); run[7] = dec[q] * run[7] + bfhi(sv[q].w); }
#pragma unroll
            for (int q = 0; q < 8; ++q) sv[q] = sn[q];
        }
    }
    for (int it = bid * NTHR + otid(); it < MH * HD; it += nb * NTHR) {
        const int h = it / HD, d = it % HD; float run = 0.f;
        for (int c = 0; c < MNC; ++c) { float* q = NS + ((size_t)c * MH + h) * HD + d; const float s = ldgf(q); stgf(q, run); run = __expf(ldgf(MC + h * 80 + c) - ldgf(MC + h * 80 + c + 1)) * run + s; }
    }
}
struct FinIn { u32x4 nu, qv, zv, xv; f32x4 n0, n1, dp, g0, g1, k0, k1; float mc, rmt, ef; };
__device__ __forceinline__ FinIn fin_load(const Args& a, int it, int e0) {
    const bf16* NUM = (const bf16*)(a.ws + WS_NUM); const bf16* Q = (const bf16*)(a.ws + WS_Q); const bf16* Z = (const bf16*)(a.ws + WS_Z); const bf16* XC = (const bf16*)(a.ws + WS_XC);
    const float* NS = (const float*)(a.ws + WS_NS); const float* DENP = (const float*)(a.ws + WS_DENP); const float* MC = (const float*)(a.ws + WS_MC); const float* RMT = (const float*)(a.ws + WS_RMT); const float* EF = (const float*)(a.ws + WS_EF);
    const int t = it >> 2, h = it & 3, c = t >> 8, r = t & 255; const size_t o = (size_t)t * MI + h * HD + e0, cth = (size_t)(c * MH + h);
    FinIn f; f.nu = ldg16(NUM + o); f.qv = ldg16(Q + o); f.zv = ldg16(Z + o); f.xv = ldg16(XC + o);
    f.n0 = ldgf4(NS + cth * HD + e0); f.n1 = ldgf4(NS + cth * HD + e0 + 4); f.dp = ldgf4(DENP + (cth * MCH + r) * 4);
    f.g0 = ldgf4(a.in[I_B_NORM] + h * HD + e0); f.g1 = ldgf4(a.in[I_B_NORM] + h * HD + e0 + 4); f.k0 = ldgf4(a.in[I_B_SKIP] + h * HD + e0); f.k1 = ldgf4(a.in[I_B_SKIP] + h * HD + e0 + 4);
    f.mc = ldgf(MC + h * 80 + c); f.rmt = ldgf(RMT + (size_t)h * T + t); f.ef = ldgf(EF + (size_t)h * T + t); return f;
}
__device__ __forceinline__ void fin_compute(const Args& a, int it, int e0, const FinIn& f) {
    bf16* Y = (bf16*)(a.ws + WS_Y); const int t = it >> 2, h = it & 3; const size_t o = (size_t)t * MI + h * HD + e0;
    const u32x4 nu = f.nu, qv = f.qv, zv = f.zv, xv = f.xv;
    const f32x2 num[4] = {(f32x2){bflo(nu.x), bfhi(nu.x)}, (f32x2){bflo(nu.y), bfhi(nu.y)}, (f32x2){bflo(nu.z), bfhi(nu.z)}, (f32x2){bflo(nu.w), bfhi(nu.w)}};
    const f32x2 qq[4] = {(f32x2){bflo(qv.x), bfhi(qv.x)}, (f32x2){bflo(qv.y), bfhi(qv.y)}, (f32x2){bflo(qv.z), bfhi(qv.z)}, (f32x2){bflo(qv.w), bfhi(qv.w)}};
    const f32x2 nn[4] = {(f32x2){f.n0[0], f.n0[1]}, (f32x2){f.n0[2], f.n0[3]}, (f32x2){f.n1[0], f.n1[1]}, (f32x2){f.n1[2], f.n1[3]}};
    const f32x2 qn2 = (qq[0] * nn[0] + qq[1] * nn[1]) + (qq[2] * nn[2] + qq[3] * nn[3]);
    const float qn = wave_sum(qn2[0] + qn2[1]);
    const float rs = __expf(f.mc - f.rmt), den = rs * ((f.dp[0] + f.dp[1]) + (f.dp[2] + f.dp[3]) + qn);
    const float inv = __builtin_amdgcn_rcpf(fmaxf(fabsf(den), f.ef));
    f32x2 hc[4], s2 = (f32x2){0.f, 0.f};
#pragma unroll
    for (int i = 0; i < 4; ++i) { hc[i] = num[i] * inv; s2 += hc[i] * hc[i]; }
    const float rstd = __builtin_amdgcn_rsqf(wave_sum(s2[0] + s2[1]) * (1.0f / HD) + EPS);
    const f32x2 gg[4] = {(f32x2){f.g0[0], f.g0[1]}, (f32x2){f.g0[2], f.g0[3]}, (f32x2){f.g1[0], f.g1[1]}, (f32x2){f.g1[2], f.g1[3]}};
    const f32x2 sk[4] = {(f32x2){f.k0[0], f.k0[1]}, (f32x2){f.k0[2], f.k0[3]}, (f32x2){f.k1[0], f.k1[1]}, (f32x2){f.k1[2], f.k1[3]}};
    const f32x2 zz[4] = {(f32x2){bflo(zv.x), bfhi(zv.x)}, (f32x2){bflo(zv.y), bfhi(zv.y)}, (f32x2){bflo(zv.z), bfhi(zv.z)}, (f32x2){bflo(zv.w), bfhi(zv.w)}};
    const f32x2 xx[4] = {(f32x2){bflo(xv.x), bfhi(xv.x)}, (f32x2){bflo(xv.y), bfhi(xv.y)}, (f32x2){bflo(xv.z), bfhi(xv.z)}, (f32x2){bflo(xv.w), bfhi(xv.w)}};
    f32x2 y[4];
#pragma unroll
    for (int i = 0; i < 4; ++i) { const f32x2 zl = zz[i] * -1.4426950408889634f; f32x2 e; e[0] = __builtin_amdgcn_exp2f(zl[0]); e[1] = __builtin_amdgcn_exp2f(zl[1]);
        const f32x2 d = e + 1.0f; f32x2 sg; sg[0] = __builtin_amdgcn_rcpf(d[0]); sg[1] = __builtin_amdgcn_rcpf(d[1]);
        y[i] = sg * ((hc[i] * rstd) * gg[i] + sk[i] * xx[i]); }
    u32x4 w; w.x = cvt_pk_bf16(y[0][0], y[0][1]); w.y = cvt_pk_bf16(y[1][0], y[1][1]); w.z = cvt_pk_bf16(y[2][0], y[2][1]); w.w = cvt_pk_bf16(y[3][0], y[3][1]);
    stg16(Y + o, w);
}
__device__ __forceinline__ void ph_ml_fin(const Args& a, int bid, int nb) {
    const int tid = otid(), lane = tid & 63, wave = tid >> 6, e0 = 8 * lane;
    asm volatile("s_waitcnt vmcnt(0)" ::: "memory"); __syncthreads();
    for (int p = bid; p < MNC * MH; p += nb) { const int ch = p / MH, h = p % MH;
        for (int r = wave; r < MCH; r += 4 * NWAVES) { const int i0 = ((ch * MCH + r) << 2) + h, st = NWAVES << 2;
            const FinIn f0 = fin_load(a, i0, e0), f1 = fin_load(a, i0 + st, e0), f2 = fin_load(a, i0 + 2 * st, e0), f3 = fin_load(a, i0 + 3 * st, e0);
            fin_compute(a, i0, e0, f0); fin_compute(a, i0 + st, e0, f1); fin_compute(a, i0 + 2 * st, e0, f2); fin_compute(a, i0 + 3 * st, e0, f3); } }
}

__device__ __forceinline__ void ph_s5_scan(const Args& a, LAS unsigned char* lds, int bid, int nb) {
    const int tid = otid(), pl = tid & 15, seg = tid >> 4;
    const float* EB = (const float*)(a.ws + WS_EB); bf16* UP = (bf16*)(a.ws + WS_UP); LAS float* tot = (LAS float*)lds;
    for (int u = bid; u < NG * 4; u += nb) {
        const int g = u >> 2, p = 16 * (u & 3) + pl;
        const float are = ldgf(a.in[I_C_A_RE] + g * 64 + p), aim = ldgf(a.in[I_C_A_IM] + g * 64 + p), dl = __expf(ldgf(a.in[I_C_LOG_STEP] + g));
        float lr, li; { const float mag = __expf(dl * are); float sn, cs; sincosf(dl * aim, &sn, &cs); lr = mag * cs; li = mag * sn; }
#pragma unroll
        for (int q = 0; q < 4; ++q) { const float nr = lr * lr - li * li, ni = 2.f * lr * li; lr = nr; li = ni; }
        float sr = lr, si = li;
#pragma unroll
        for (int q = 0; q < 5; ++q) { const float nr = sr * sr - si * si, ni = 2.f * sr * si; sr = nr; si = ni; }
        const float* eb = EB + ((size_t)g * SNC + seg * 32) * 128 + p;
        float str = 0.f, sti = 0.f;
#pragma unroll 8
        for (int c = 0; c < 32; ++c) { const float er = ldgf(eb + (size_t)c * 128), ei = ldgf(eb + (size_t)c * 128 + 64); const float nr = lr * str - li * sti + er, ni = lr * sti + li * str + ei; str = nr; sti = ni; }
        __syncthreads();
        tot[(seg * 16 + pl) * 2] = str; tot[(seg * 16 + pl) * 2 + 1] = sti;
        __syncthreads();
        float cr = 0.f, ci = 0.f;
        for (int s = 0; s < seg; ++s) { const float tr = tot[(s * 16 + pl) * 2], ti = tot[(s * 16 + pl) * 2 + 1]; const float nr = sr * cr - si * ci + tr, ni = sr * ci + si * cr + ti; cr = nr; ci = ni; }
        bf16* up = UP + ((size_t)g * SNC + seg * 32) * SK + 256 + p;
        str = cr; sti = ci;
#pragma unroll 8
        for (int c = 0; c < 32; ++c) { stgh(up + (size_t)c * SK, f2bf(str)); stgh(up + (size_t)c * SK + 64, f2bf(sti));
            const float er = ldgf(eb + (size_t)c * 128), ei = ldgf(eb + (size_t)c * 128 + 64); const float nr = lr * str - li * sti + er, ni = lr * sti + li * str + ei; str = nr; sti = ni; }
    }
    __syncthreads();
}
#ifndef MK_PER_PHASE
#define MK_PER_PHASE 0
#endif
constexpr int NPHASES = 38 - 4 * DEFER_NORM;
__global__ void __launch_bounds__(NTHR, 2) mega_fwd(Args args0) {
    extern __shared__ __attribute__((aligned(16))) unsigned char lds_raw[];
    LAS unsigned char* lds = (LAS unsigned char*)lds_raw;
    const int tid = threadIdx.x, bid0 = blockIdx.x, nb0 = gridDim.x;
    if (tid < 16) ((LAS unsigned*)(lds + MISC_OFF))[tid] = 0u;
    __syncthreads();
    XcdBarrier bar = xcd_barrier_post((unsigned*)(args0.ws + WS_CTL) + CW_BAR + args0.li * 4096, (volatile LAS unsigned*)(lds + MISC_OFF));
    int pc = 0; const int lo = args0.ph_lo, hi = args0.ph_hi;
#ifndef PH_REP
#define PH_REP 0ull
#endif
#ifndef PH_REPN
#define PH_REPN 1
#endif
#ifndef XBAR_EXTRA
#define XBAR_EXTRA 0
#endif
#ifndef PH_MASK
#define PH_MASK 0xFFFFFFFFull
#endif
#define PHASE(id, ...) do { if (((PH_MASK >> (id)) & 1ull) && pc >= lo && pc < hi) { { int bid = bid0, nb = nb0; unsigned char* ws = args0.ws; asm volatile("" : "+s"(bid), "+s"(nb), "+s"(ws)); Args args = args0; args.ws = ws; const int tidl = otid(), lane = tidl & 63, wave = tidl >> 6; const int gw = bid * NWAVES + wave, NGW = nb * NWAVES; bf16* HN = (bf16*)(ws + WS_HN); LAS float* scr = (LAS float*)(lds + wave * 16384); for (int rep_ = 0; rep_ < 1 + (int)((PH_REP >> (id)) & 1ull) * PH_REPN; ++rep_) { __VA_ARGS__; __syncthreads(); } } if (pc + 1 < hi) xcd_barrier(bar); } ++pc; } while (0)


#define XSRC(l) ((l) == 0 ? args.in[I_X] : (const float*)args.out)
#define GMIX(l) (args.in[I_NORM_MIX] + (l) * D)
#define GFFN(l) (args.in[I_NORM_FFN] + (l) * D)
#define DQ_TAIL(nun_, TL, TH, q_) do { if ((TL) >= 0) { const int nu__ = (nun_); const int mine_ = bid < nu__ ? (nu__ - 1 - bid) / nb + 1 : 0, mx_ = (nu__ - 1) / nb + 1; \
        if (mine_ < mx_) dq_work(args, (TL), (TH), (q_) * (mx_ - mine_), lds, scr); } } while (0)
#define DQ_DRAIN(G) do { if ((G) >= 0) { dq_work(args, (G), (G), -1, lds, scr); __syncthreads(); } } while (0)
#define RG_MIXER(l, jl, CONVF, TL, TH, RSI, EM, DR)   \
    PHASE(3, { if (RG_F8(jl)) { Sched2D S{(const char*)HN, (const char*)(ws + WS_WA_IN) + (size_t)(jl) * 2 * RW * D * 2, (unsigned)D / 2, (unsigned)D / 2, T / 256, 2 * RW / 256, nb, bid}; \
               pg8::Shape sh{D / 128, 0, (unsigned)D / 2, (unsigned)D / 2, 0u, 0u}; EpiBf16T<(RSI) != 0> E{(bf16*)(ws + WS_GX), RW, RW, (WS_XR - WS_GX) / 2, 0, 1.0f / 64.0f, (const float*)(ws + WS_RSS)}; \
               pg8::gemm_phase<EpiBf16T<(RSI) != 0>, Sched2D, false, false, true>(lds, sh, S, E); } \
               else { Sched2D S{(const char*)HN, (const char*)(ws + WS_WA_IN) + (size_t)(jl) * 2 * RW * D * 2, (unsigned)D, (unsigned)D, T / 256, 2 * RW / 256, nb, bid}; \
               pg8::Shape sh{D / 64, 0, (unsigned)D, (unsigned)D, 0u, 0u}; EpiBf16T<(RSI) != 0> E{(bf16*)(ws + WS_GX), RW, RW, (WS_XR - WS_GX) / 2, 0, 1.0f, (const float*)(ws + WS_RSS)}; \
               pg8::gemm_phase<EpiBf16T<(RSI) != 0>, Sched2D, false>(lds, sh, S, E); } DQ_TAIL((T / 256) * (2 * RW / 256), TL, TH, 2); } ); \
    PHASE(4, ph_rg_gates(args, lds, bid, nb, (jl)); ); \
    PHASE(5, ph_rg_carry(args, bid, nb); ); \
    PHASE(6, ph_rg_fix(args, bid, nb); ); \
    PHASE(7, { const bool early_ = ((bid >> 3) & 1) != 0;        \
               DQ_DRAIN(DR); \
               if ((CONVF) >= 0 && early_) { dq_work(args, DQ_MOE1, DQ_MOE1, -2, lds, scr); __syncthreads(); }     \
               { Sched2D S{(const char*)(ws + WS_GX), (const char*)(ws + WS_WA_OUT) + (size_t)(jl) * D * RW * 2, (unsigned)RW, (unsigned)RW, T / 256, D / 256, nb, bid}; \
               pg8::Shape sh{RW / 64, 0, (unsigned)RW, (unsigned)RW, 0u, 0u}; \
               if (EM) { EpiResidT<(EM) ? (EM) : 1> E{XSRC(l), args.out, ws + WS_HN, (float*)(ws + WS_RSS), (LAS float*)(lds + EXTRA_OFF), 1.0f}; pg8::gemm_phase<EpiResidT<(EM) ? (EM) : 1>, Sched2D, false>(lds, sh, S, E); } \
               else { EpiResid E{XSRC(l), args.out, nullptr, nullptr, nullptr, 1.0f}; pg8::gemm_phase<EpiResid, Sched2D, false>(lds, sh, S, E); } } \
               if ((CONVF) >= 0) { dq_work(args, DQ_MOE1, DQ_MOE1, -1, lds, scr); __syncthreads(); } } );
#define DENSE_FFN(l, W13O, W2O, GDR, TL, TH, F8, EM, DR)   \
    if (!DEFER_NORM) { PHASE(20, DQ_DRAIN(GDR); ph_norm<false, false, (F8) ? 3 : 0>(args, lds, bid, nb, args.out, args.out, GFFN(l), 0); ); } \
    PHASE(21, { if (F8) { Sched2D S{(const char*)HN, (const char*)(ws + (W13O)), (unsigned)D / 2, (unsigned)D / 2, T / 256, 2 * FF / 256, nb, bid}; \
                          pg8::Shape sh{D / 128, 0, (unsigned)D / 2, (unsigned)D / 2, 0u, 0u}; EpiSwiglu8T<DEFER_NORM != 0> E{ws + WS_H, (const float*)(ws + WS_RSS)}; \
                          pg8::gemm_phase<EpiSwiglu8T<DEFER_NORM != 0>, Sched2D, false, false, true>(lds, sh, S, E); } \
                else { Sched2D S{(const char*)HN, (const char*)(ws + (W13O)), (unsigned)D, (unsigned)D, T / 256, 2 * FF / 256, nb, bid}; \
                       pg8::Shape sh{D / 64, 0, (unsigned)D, (unsigned)D, 0u, 0u}; EpiSwigluT<DEFER_NORM != 0> E{(bf16*)(ws + WS_H), (const float*)(ws + WS_RSS)}; \
                       pg8::gemm_phase<EpiSwigluT<DEFER_NORM != 0>, Sched2D, false>(lds, sh, S, E); } \
                DQ_TAIL((T / 256) * (2 * FF / 256), TL, TH, 2); \
                if ((l) == 0 && bid >= nb / 2) s5_mats(args, lds, bid - nb / 2, nb / 2); } );     \
    PHASE(22, { if (DEFER_NORM) DQ_DRAIN(DR); \
                if (F8) { Sched2D S{(const char*)(ws + WS_H), (const char*)(ws + (W2O)), (unsigned)FF / 2, (unsigned)FF / 2, T / 256, D / 256, nb, bid}; \
                          pg8::Shape sh{FF / 128, 0, (unsigned)FF / 2, (unsigned)FF / 2, 0u, 0u}; EpiResidT<DEFER_NORM ? (EM) : 0> E{args.out, args.out, ws + WS_HN, (float*)(ws + WS_RSS), (LAS float*)(lds + EXTRA_OFF), 1.0f / 64.0f}; \
                          pg8::gemm_phase<EpiResidT<DEFER_NORM ? (EM) : 0>, Sched2D, false, false, true>(lds, sh, S, E); } \
                else { Sched2D S{(const char*)(ws + WS_H), (const char*)(ws + (W2O)), (unsigned)FF, (unsigned)FF, T / 256, D / 256, nb, bid}; \
                       pg8::Shape sh{FF / 64, 0, (unsigned)FF, (unsigned)FF, 0u, 0u}; EpiResidT<DEFER_NORM ? (EM) : 0> E{args.out, args.out, ws + WS_HN, (float*)(ws + WS_RSS), (LAS float*)(lds + EXTRA_OFF), 1.0f}; \
                       pg8::gemm_phase<EpiResidT<DEFER_NORM ? (EM) : 0>, Sched2D, false>(lds, sh, S, E); } } );
#define MOE_FFN(l, f, CONV, TL, TH, F8) \
    PHASE(23, if (CONV) { conv_moe(args, (f), gw, NGW, scr, lane); __syncthreads(); } ph_norm<false, true, (F8) ? 3 : 0>(args, lds, bid, nb, args.out, args.out, GFFN(l), (f)); ); \
    PHASE(25, { SchedMoe S; S.A = (const char*)HN; S.B = (const char*)(ws + WS_W13); S.lda = (F8) ? D / 2 : D; S.ldb = S.lda; S.bstride = (F8) ? W13_BYTES / 2 : W13_BYTES; S.nN = 2 * FF / 256; S.G = nb; S.c = bid; S.ksplit = 1; S.khbytes = 0; S.gather = 1; \
                int cnt_[NE]; moe_prefix(args, (f), S.ps, S.P, cnt_); LAS int* gt_ = (LAS int*)(lds + EXTRA_OFF); S.gt = gt_; \
                if (!(F8)) { const int* LISTE = (const int*)(ws + WS_LISTE); pg8::Unit u_; const int tid_ = otid(); \
                  _Pragma("unroll 1") for (int i_ = 0; S.next(i_, u_) && i_ < 23; ++i_) { const int e_ = u_.aux; int c_ = 0, p0_ = 0; \
                      _Pragma("unroll") for (int q_ = 0; q_ < NE; ++q_) { c_ = (e_ == q_) ? cnt_[q_] : c_; p0_ = (e_ == q_) ? S.ps[q_] : p0_; } \
                      const int r_ = (u_.pm - p0_) * 256 + tid_; if (tid_ < 256) gt_[i_ * 256 + tid_] = (r_ < c_) ? ldgi(LISTE + e_ * T + r_) : 0; } \
                  __syncthreads(); } \
                if (F8) { S.A = (const char*)(ws + WS_AGX); S.gather = 0; S.erows = T; pg8::Shape sh{D / 128, 0, (unsigned)D / 2, (unsigned)D / 2, 0u, 0u}; EpiSwiglu8 E{ws + WS_H};     \
                          pg8::gemm_phase<EpiSwiglu8, SchedMoe, false, false, true>(lds, sh, S, E); } \
                else { pg8::Shape sh{D / 64, 0, (unsigned)D, (unsigned)D, 0u, 0u}; EpiSwiglu E{(bf16*)(ws + WS_H)}; \
                       pg8::gemm_phase<EpiSwiglu, SchedMoe, false, true>(lds, sh, S, E); } \
                DQ_TAIL(S.P * S.nN, TL, TH, 2); } ); \
    PHASE(26, { SchedMoe S; S.A = (const char*)(ws + WS_H); S.B = (const char*)(ws + ((F8) ? WS_W2T8 : WS_W2T)); S.lda = (F8) ? FF / 2 : FF; S.ldb = S.lda; S.bstride = (F8) ? W2_BYTES / 2 : W2_BYTES; S.nN = D / 256; S.G = nb; S.c = bid; \
                S.ksplit = (F8) ? 1 : 2; S.khbytes = FF; S.gather = 0; S.gt = nullptr; int cnt_[NE]; moe_prefix(args, (f), S.ps, S.P, cnt_); \
                if (F8) { pg8::Shape sh{FF / 128, 0, (unsigned)FF / 2, (unsigned)FF / 2, 0u, 0u}; EpiBf16 E{(bf16*)(ws + WS_AG), D, 0, 0, 0, 1.0f / 64.0f}; \
                          pg8::gemm_phase<EpiBf16, SchedMoe, false, false, true>(lds, sh, S, E); } \
                else { pg8::Shape sh{FF / 128, 0, (unsigned)FF, (unsigned)FF, 0u, 0u}; EpiBf16 E{(bf16*)(ws + WS_AG), D, 0, 0, (WS_OUT - WS_AG) / 2}; \
                       pg8::gemm_phase<EpiBf16, SchedMoe, false>(lds, sh, S, E); } \
                DQ_TAIL(S.P * S.nN * S.ksplit, TL, TH, 3); } );

        PHASE(0, conv_a(args, 0, gw, NGW, scr, lane); __syncthreads(); ph_norm<false, false, 0>(args, lds, bid, nb, XSRC(0), args.out, GMIX(0), 0); );
    RG_MIXER(0, 0, -1, DQ_DENSE0, DQ_C, 0, DEFER_NORM ? (DENSE_F8(0) ? 2 : 1) : 0, DEFER_NORM ? DQ_DENSE0 : -1)
    DENSE_FFN(0, WS_W13, WS_W2T, DQ_DENSE0, DQ_B, DQ_C, DENSE_F8(0), 1, DQ_B)
    if (!DEFER_NORM) { PHASE(1, DQ_DRAIN(DQ_B); ph_norm<false, false, 0>(args, lds, bid, nb, XSRC(1), args.out, GMIX(1), 0); ); }
    PHASE(8, { Sched2D S{(const char*)HN, (const char*)(ws + WS_WB_IN), (unsigned)D, (unsigned)D, T / 256, 2 * MI / 256, nb, bid};
               pg8::Shape sh{D / 64, 0, (unsigned)D, (unsigned)D, 0u, 0u}; EpiBf16T<DEFER_NORM != 0> E{(bf16*)(ws + WS_XM), MI, MI, (WS_Z - WS_XM) / 2, 0, 1.0f, (const float*)(ws + WS_RSS)};
               pg8::gemm_phase<EpiBf16T<DEFER_NORM != 0>, Sched2D, false>(lds, sh, S, E); } );
    PHASE(9, ph_ml_prep(args, lds, bid, nb); );
    PHASE(10, ph_ml_gscan(args, lds, bid, nb); );
    PHASE(11, { SchedSbuild S{(const char*)(ws + WS_Q), (const char*)(ws + WS_K), nb, bid};
                pg8::Shape sh{HD / 64, 0, (unsigned)MI, (unsigned)MI, 0u, 0u}; EpiSbuild E{(bf16*)(ws + WS_SM), (float*)(ws + WS_DENP), (const float*)(ws + WS_GS), (const float*)(ws + WS_MC)};
                pg8::gemm_phase<EpiSbuild, SchedSbuild, false>(lds, sh, S, E); }
              ph_ml_ktw(args, lds, bid, nb);
              { SchedState S{(const char*)(ws + WS_VT), (const char*)(ws + WS_KT), nb, bid};
                pg8::Shape sh{MCH / 64, 0, (unsigned)LDT, (unsigned)LDT, 0u, 0u}; EpiBf16 E{(bf16*)(ws + WS_CT), HD, 0, 0, (size_t)HD * HD};
                pg8::gemm_phase<EpiBf16, SchedState, false>(lds, sh, S, E); } );
    PHASE(28, ph_ml_sscan(args, bid, nb); );
    PHASE(13, { SchedPass2 S{(const char*)(ws + WS_SM), (const char*)(ws + WS_Q), (const char*)(ws + WS_VT), (const char*)(ws + WS_CT), nb, bid};
                pg8::Shape sh{MCH / 64, HD / 64, (unsigned)MCH, (unsigned)LDT, (unsigned)MI, (unsigned)HD}; EpiNum E{(bf16*)(ws + WS_NUM), (const float*)(ws + WS_RMT), (const float*)(ws + WS_MC)};
                pg8::gemm_phase<EpiNum, SchedPass2, true>(lds, sh, S, E); }
              ph_ml_fin(args, bid, nb); );
#ifndef ML_OUT_STAGGER
#define ML_OUT_STAGGER 1
#endif
    PHASE(15, { const bool early_ = !ML_OUT_STAGGER || ((bid >> 3) & 1) != 0;
                if (early_) { conv_moe(args, 0, gw, NGW, scr, lane); __syncthreads(); }
                { Sched2D S{(const char*)(ws + WS_Y), (const char*)(ws + WS_WB_OUT), (unsigned)MI, (unsigned)MI, T / 256, D / 256, nb, bid};
                pg8::Shape sh{MI / 64, 0, (unsigned)MI, (unsigned)MI, 0u, 0u}; EpiResid E{args.out, args.out, nullptr, nullptr, nullptr, 1.0f};
                pg8::gemm_phase<EpiResid, Sched2D, false>(lds, sh, S, E); }
                if (!early_) { conv_moe(args, 0, gw, NGW, scr, lane); __syncthreads(); } } );
    MOE_FFN(1, 0, false, DQ_DENSE1, DQ_A1, MOE_F8(0))
    PHASE(2, DQ_DRAIN(DQ_C); ph_norm<true, false, 1>(args, lds, bid, nb, XSRC(2), args.out, GMIX(2), 0); );
    PHASE(16, { SchedBatch S{(const char*)(ws + WS_UP), (const char*)(ws + WS_S5_BE), (unsigned)SK, 256u, (size_t)SNC * SK * 2, (size_t)256 * 256 * 2, SNC / 256, NG, nb, bid};
                pg8::Shape sh{4, 0, (unsigned)SK, 256u, 0u, 0u}; EpiS5e E{(float*)(ws + WS_EB)};
                pg8::gemm_phase<EpiS5e, SchedBatch, false>(lds, sh, S, E); } );
    PHASE(17, ph_s5_scan(args, lds, bid, nb); );
    PHASE(18, { SchedBatch S{(const char*)(ws + WS_UP), (const char*)(ws + WS_S5_KC), (unsigned)SK, (unsigned)SK, (size_t)SNC * SK * 2, (size_t)256 * SK * 2, SNC / 256, NG, nb, bid};
                pg8::Shape sh{SK / 64, 0, (unsigned)SK, (unsigned)SK, 0u, 0u}; EpiS5y E{(const bf16*)(ws + WS_UP), args.in[I_C_D], (bf16*)(ws + WS_YA)};
                pg8::gemm_phase<EpiS5y, SchedBatch, false>(lds, sh, S, E); } );
    PHASE(19, { if (DEFER_NORM) DQ_DRAIN(DQ_DENSE1);
                Sched2D S{(const char*)(ws + WS_YA), (const char*)(ws + WS_WC_GLU), (unsigned)D, (unsigned)D, T / 256, D / 256, nb, bid};
                pg8::Shape sh{D / 64, 0, (unsigned)D, (unsigned)D, 0u, 0u}; constexpr int EM_ = DEFER_NORM ? (DENSE_F8(1) ? 2 : 1) : 0;
                EpiGluT<EM_> E{(const bf16*)(ws + WS_YA), args.in[I_C_B_GLU], args.out, ws + WS_HN, (float*)(ws + WS_RSS), (LAS float*)(lds + EXTRA_OFF)};
                pg8::gemm_phase<EpiGluT<EM_>, Sched2D, false>(lds, sh, S, E); } );
    DENSE_FFN(2, WS_WD1_13, WS_WD1_2, DQ_DENSE1, DQ_MOE1, DQ_MOE1, DENSE_F8(1), (RG_F8(1) ? 2 : 1), DQ_A1)
    if (!DEFER_NORM) PHASE(1, DQ_DRAIN(DQ_A1); if (RG_F8(1)) ph_norm<false, false, 3>(args, lds, bid, nb, XSRC(3), args.out, GMIX(3), 0); else ph_norm<false, false, 0>(args, lds, bid, nb, XSRC(3), args.out, GMIX(3), 0); );
    RG_MIXER(3, 1, 1, DQ_MOE1, DQ_MOE1, DEFER_NORM, 0, -1)
    MOE_FFN(3, 1, false, -1, -1, MOE_F8(1))
    PHASE(27, ph_norm<true, false, 2>(args, lds, bid, nb, args.out, args.out, args.in[I_NORM_FINAL], 1); );
    for (int xb_ = 0; xb_ < XBAR_EXTRA; ++xb_) xcd_barrier(bar);
#undef PHASE
}

extern "C" void kernel_launch(void* const* d_in, const int* in_sizes, int n_in, void* d_out, int out_size, void* d_ws, size_t ws_size, hipStream_t stream) {
    static int grid = 0;
    if (grid == 0) {
        if (n_in != N_IN || in_sizes[0] != T * D || out_size != T * D || ws_size < WS_END) {
            fprintf(stderr, "kernel_launch: unexpected problem (n_in %d, in0 %d, out %d, ws %zu, need %zu)\n", n_in, n_in > 0 ? in_sizes[0] : -1, out_size, ws_size, (size_t)WS_END); grid = -1; return; }
        int dev = 0, cus = 0, per_cu = 0;
        if (hipGetDevice(&dev) != hipSuccess || hipDeviceGetAttribute(&cus, hipDeviceAttributeMultiprocessorCount, dev) != hipSuccess) { fprintf(stderr, "kernel_launch: device query failed\n"); grid = -1; return; }
        if (hipFuncSetAttribute((const void*)mega_fwd, hipFuncAttributeMaxDynamicSharedMemorySize, LDS_BYTES) != hipSuccess) { fprintf(stderr, "kernel_launch: hipFuncSetAttribute failed\n"); grid = -1; return; }
        if (hipOccupancyMaxActiveBlocksPerMultiprocessor(&per_cu, (const void*)mega_fwd, NTHR, LDS_BYTES) != hipSuccess || per_cu < 1) fprintf(stderr, "kernel_launch: occupancy query reports %d blocks per CU\n", per_cu);
        (void)hipGetLastError();
        if (cus < 256) { fprintf(stderr, "kernel_launch: %d CUs < 256: the 256-workgroup grid would not be resident\n", cus); grid = -1; return; }
        grid = 256;
    }
    if (grid < 0) return;
    if (hipMemsetAsync((char*)d_ws + WS_CTL, 0, CTL_ZERO_BYTES, stream) != hipSuccess) { fprintf(stderr, "kernel_launch: memset failed\n"); return; }
    Args a{};
    for (int i = 0; i < N_IN; ++i) a.in[i] = (const float*)d_in[i];
    a.out = (float*)d_out; a.ws = (unsigned char*)d_ws; a.pad = 0;
#if MK_PER_PHASE
    for (int k = 0; k < NPHASES; ++k) { a.ph_lo = k; a.ph_hi = k + 1; a.li = k; hipLaunchKernelGGL(mega_fwd, dim3(grid), dim3(NTHR), LDS_BYTES, stream, a); }
#else
    a.ph_lo = 0; a.ph_hi = NPHASES; a.li = 0;
    hipLaunchKernelGGL(mega_fwd, dim3(grid), dim3(NTHR), LDS_BYTES, stream, a);
#endif
    const hipError_t le = hipPeekAtLastError();
    if (le != hipSuccess) fprintf(stderr, "kernel_launch: launch failed: %s\n", hipGetErrorName(le));
}
```

```cpp
#include <hip/hip_runtime.h>
#include <cstdio>
#include <cstdint>

#define LAS __attribute__((address_space(3)))
#define GAS __attribute__((address_space(1)))
typedef unsigned short bf16;
typedef short bf16x8 __attribute__((ext_vector_type(8)));
typedef float f32x4 __attribute__((ext_vector_type(4)));
typedef float f32x2 __attribute__((ext_vector_type(2)));
typedef unsigned u32x4 __attribute__((ext_vector_type(4)));
typedef unsigned u32x2 __attribute__((ext_vector_type(2)));

__device__ __forceinline__ unsigned cvt_pk_bf16(float lo, float hi) { unsigned r; asm volatile("v_cvt_pk_bf16_f32 %0, %1, %2" : "=v"(r) : "v"(lo), "v"(hi)); return r; }
__device__ __forceinline__ float bflo(unsigned u) { return __uint_as_float(u << 16); }
__device__ __forceinline__ float bfhi(unsigned u) { return __uint_as_float(u & 0xffff0000u); }
__device__ __forceinline__ float bf2f(bf16 b) { return __uint_as_float(((unsigned)b) << 16); }
__device__ __forceinline__ bf16 f2bf(float f) { return (bf16)(cvt_pk_bf16(f, 0.f) & 0xffffu); }
__device__ __forceinline__ unsigned cvt4_fp8(float a, float b, float c, float d) { int p = 0; p = __builtin_amdgcn_cvt_pk_fp8_f32(a, b, p, false); p = __builtin_amdgcn_cvt_pk_fp8_f32(c, d, p, true); return (unsigned)p; }
__device__ __forceinline__ float sigm(float x) { return __builtin_amdgcn_rcpf(1.0f + __expf(-x)); }
__device__ __forceinline__ float silu_f(float x) { return x * sigm(x); }
__device__ __forceinline__ float gelu_tanh(float x) { return x * sigm(1.5957691216057308f * (x + 0.044715f * x * x * x)); }
__device__ __forceinline__ float softplus_f(float x) { return x > 20.f ? x : log1pf(__expf(x)); }

__device__ __forceinline__ int otid() { int t = threadIdx.x; asm volatile("" : "+v"(t)); return t; }
__device__ __forceinline__ void glds16(const char* sbase, unsigned voff, unsigned lds_dst) {
    unsigned keep;
    asm volatile("s_mov_b32 %0, m0\n\ts_mov_b32 m0, %3\n\ts_nop 0\n\tglobal_load_lds_dwordx4 %1, %2\n\ts_mov_b32 m0, %0" : "=&s"(keep) : "v"(voff), "s"(sbase), "s"(lds_dst) : "memory");
}
namespace pg8 {
constexpr int BM = 256, BK = 64, HALF = 128, HTB = HALF * BK * 2, STAGE_BYTES = 8 * HTB;
__host__ __device__ __forceinline__ int lds_byte(int r, int c) { const int st = (r >> 4) * 2 + (c >> 5), rr = r & 15, cc = c & 31, ob = rr * 64 + cc * 2; return st * 1024 + (ob ^ (((ob >> 9) & 1) << 5)); }
__host__ __device__ __forceinline__ void stage_rc(int b, int& R, int& C) { const int st = b / 1024, sb = b % 1024, swz = sb ^ (((sb >> 9) & 1) << 5); R = (st >> 1) * 16 + swz / 64; C = (st & 1) * 32 + (swz % 64) / 2; }
__host__ __device__ __forceinline__ int perm32(int rho) { const int n = rho >> 4, i = rho & 15; return 8 * (i >> 2) + 4 * n + (i & 3); }

struct Unit { int pm, pn, aux; const char *A1, *B1, *A2, *B2; };
struct Shape { int nt1, nt2; unsigned lda1, ldb1, lda2, ldb2; };

typedef int pg8_v8i __attribute__((ext_vector_type(8))); typedef int pg8_v4i __attribute__((ext_vector_type(4)));
__device__ __forceinline__ pg8_v8i pg8_cat(bf16x8 lo, bf16x8 hi) { const pg8_v4i a = __builtin_bit_cast(pg8_v4i, lo), b = __builtin_bit_cast(pg8_v4i, hi); return __builtin_shufflevector(a, b, 0, 1, 2, 3, 4, 5, 6, 7); }
template <class Epi, class Sched, bool TWO, bool GATHER = false, bool FP8 = false>
__device__ __forceinline__ void gemm_phase(LAS unsigned char* lds, const Shape sh, const Sched& S, const Epi& E) {
    const int tid = otid(), wid = __builtin_amdgcn_readfirstlane(tid >> 6), lane = tid & 63, wr = wid >> 2, wc = wid & 3, fr = lane & 15, fq = lane >> 4;
    const int nt1 = sh.nt1, nt = sh.nt1 + (TWO ? sh.nt2 : 0);
    unsigned vA1[2], vB1[2], vA2[2], vB2[2]; unsigned vGc[2][2], vGn[2][2];
#pragma unroll
    for (int i = 0; i < 2; ++i) { int R, C; stage_rc(tid * 16 + i * 8192, R, C); const int Rb = Epi::PERM ? ((R & ~31) + perm32(R & 31)) : R;
        vA1[i] = (unsigned)(R * sh.lda1 + C) * 2u; vB1[i] = (unsigned)(Rb * sh.ldb1 + C) * 2u;
        vA2[i] = TWO ? (unsigned)(R * sh.lda2 + C) * 2u : 0u; vB2[i] = TWO ? (unsigned)(Rb * sh.ldb2 + C) * 2u : 0u; }
    const unsigned hA1 = 256u * sh.lda1, hB1 = 256u * sh.ldb1, hA2 = TWO ? 256u * sh.lda2 : 0u, hB2 = TWO ? 256u * sh.ldb2 : 0u;
    const unsigned ldsw = (unsigned)wid * 1024u, ldsbase = (unsigned)(unsigned long long)lds;
    const int aoff = lds_byte(wr * 64 + fr, fq * 8), boff = lds_byte(wc * 32 + fr, fq * 8);
#define PG8_SA(b, h) (((b) * 2 + (h)) * HTB)
#define PG8_SB(b, h) ((4 + (b) * 2 + (h)) * HTB)
#define PG8_LOADG(ui_, dst) do { if constexpr (GATHER) { const int tg_ = otid(); _Pragma("unroll") for (int i_ = 0; i_ < 2; ++i_) { int R_, C_; stage_rc(tg_ * 16 + i_ * 8192, R_, C_);     \
        _Pragma("unroll") for (int h_ = 0; h_ < 2; ++h_) dst[h_][i_] = (unsigned)S.gt[(ui_) * 256 + h_ * 128 + R_] * (sh.lda1 * 2u) + (unsigned)C_ * 2u; } } } while (0)
#define PG8_STG_AG(bufoff, U, tt, h, usen) do { if constexpr (GATHER) { const char* gp_ = (U).A1 + (size_t)(tt) * 128; \
        const unsigned v0_ = (usen) ? vGn[h][0] : vGc[h][0], v1_ = (usen) ? vGn[h][1] : vGc[h][1]; \
        glds16(gp_, v0_, ldsbase + (unsigned)(bufoff) + ldsw); glds16(gp_, v1_, ldsbase + (unsigned)(bufoff) + ldsw + 8192u); } else { PG8_STG_A(bufoff, U, tt, h); } } while (0)
#define PG8_STG_A(bufoff, U, tt, h) do { const bool s2_ = TWO && ((tt) >= nt1); \
        const char* gp_ = (s2_ ? (U).A2 + (size_t)((tt) - nt1) * 128 + (size_t)(h) * hA2 : (U).A1 + (size_t)(tt) * 128 + (size_t)(h) * hA1); \
        const unsigned v0_ = s2_ ? vA2[0] : vA1[0], v1_ = s2_ ? vA2[1] : vA1[1]; \
        glds16(gp_, v0_, ldsbase + (unsigned)(bufoff) + ldsw); glds16(gp_, v1_, ldsbase + (unsigned)(bufoff) + ldsw + 8192u); } while (0)
#define PG8_STG_B(bufoff, U, tt, h) do { const bool s2_ = TWO && ((tt) >= nt1); \
        const char* gp_ = (s2_ ? (U).B2 + (size_t)((tt) - nt1) * 128 + (size_t)(h) * hB2 : (U).B1 + (size_t)(tt) * 128 + (size_t)(h) * hB1); \
        const unsigned v0_ = s2_ ? vB2[0] : vB1[0], v1_ = s2_ ? vB2[1] : vB1[1]; \
        glds16(gp_, v0_, ldsbase + (unsigned)(bufoff) + ldsw); glds16(gp_, v1_, ldsbase + (unsigned)(bufoff) + ldsw + 8192u); } while (0)
#define PG8_LDA(dst, b, h) do { if constexpr (FP8) { _Pragma("unroll") for (int m = 0; m < 4; ++m) dst##8[m] = pg8_cat(*(const LAS bf16x8*)(lds + PG8_SA(b, h) + aoff + m * 2048), *(const LAS bf16x8*)(lds + PG8_SA(b, h) + aoff + m * 2048 + 1024)); } \
        else { _Pragma("unroll") for (int m = 0; m < 4; ++m) _Pragma("unroll") for (int k = 0; k < 2; ++k) dst[m][k] = *(const LAS bf16x8*)(lds + PG8_SA(b, h) + aoff + m * 2048 + k * 1024); } } while (0)
#define PG8_LDB(dst, b, h) do { if constexpr (FP8) { _Pragma("unroll") for (int n = 0; n < 2; ++n) dst##8[n] = pg8_cat(*(const LAS bf16x8*)(lds + PG8_SB(b, h) + boff + n * 2048), *(const LAS bf16x8*)(lds + PG8_SB(b, h) + boff + n * 2048 + 1024)); } \
        else { _Pragma("unroll") for (int n = 0; n < 2; ++n) _Pragma("unroll") for (int k = 0; k < 2; ++k) dst[n][k] = *(const LAS bf16x8*)(lds + PG8_SB(b, h) + boff + n * 2048 + k * 1024); } } while (0)
#define PG8_MMA(ai, bj, At, Bt) do { __builtin_amdgcn_s_setprio(1); if constexpr (FP8) { _Pragma("unroll") for (int m = 0; m < 4; ++m) _Pragma("unroll") for (int n = 0; n < 2; ++n) \
        acc[ai][bj][m][n] = __builtin_amdgcn_mfma_scale_f32_16x16x128_f8f6f4(Bt##8[n], At##8[m], acc[ai][bj][m][n], 0, 0, 0, 0x7f7f7f7f, 0, 0x7f7f7f7f); } \
        else { _Pragma("unroll") for (int m = 0; m < 4; ++m) _Pragma("unroll") for (int n = 0; n < 2; ++n) _Pragma("unroll") for (int k = 0; k < 2; ++k) \
        acc[ai][bj][m][n] = __builtin_amdgcn_mfma_f32_16x16x32_bf16(Bt[n][k], At[m][k], acc[ai][bj][m][n], 0, 0, 0); } __builtin_amdgcn_s_setprio(0); } while (0)
#define PG8_WAIT_V(n) asm volatile("s_waitcnt vmcnt(" #n ")" ::: "memory")
#define PG8_WAIT_L(n) asm volatile("s_waitcnt lgkmcnt(" #n ")" ::: "memory")
#define PG8_BAR __builtin_amdgcn_s_barrier()
#define PG8_SCHED __builtin_amdgcn_sched_barrier(0)
    Unit cur, nxt;
    if (!S.next(0, cur)) return;
    f32x4 acc[2][2][4][2];
#pragma unroll
    for (int a = 0; a < 2; ++a)
#pragma unroll
        for (int b = 0; b < 2; ++b)
#pragma unroll
            for (int m = 0; m < 4; ++m)
#pragma unroll
                for (int n = 0; n < 2; ++n) acc[a][b][m][n] = (f32x4){0.f, 0.f, 0.f, 0.f};
    bf16x8 At[4][2], B0[2][2], B1[2][2]; pg8_v8i At8[4], B08[2], B18[2];
    PG8_LOADG(0, vGc);
    PG8_STG_B(PG8_SB(0, 0), cur, 0, 0); PG8_STG_B(PG8_SB(0, 1), cur, 0, 1); PG8_STG_AG(PG8_SA(0, 0), cur, 0, 0, false); PG8_STG_AG(PG8_SA(0, 1), cur, 0, 1, false);
    if (wr == 1) PG8_BAR;
    PG8_WAIT_V(2); PG8_BAR;
    PG8_STG_B(PG8_SB(1, 0), cur, 1, 0); PG8_STG_AG(PG8_SA(1, 0), cur, 1, 0, false); PG8_STG_B(PG8_SB(1, 1), cur, 1, 1);
    PG8_WAIT_V(6); PG8_BAR;
    for (int ui = 0;; ++ui) {
        const bool has_next = S.next(ui + 1, nxt);
        if (!has_next) nxt = cur;
        if constexpr (GATHER) { if (has_next) PG8_LOADG(ui + 1, vGn); else {
#pragma unroll
            for (int h_ = 0; h_ < 2; ++h_) { vGn[h_][0] = vGc[h_][0]; vGn[h_][1] = vGc[h_][1]; } } }
#pragma unroll 1
        for (int t = 0; t < nt; t += 2) {
            const bool last = (t == nt - 2);
            const char* uA1 = last ? nxt.A1 : cur.A1; const char* uB1 = last ? nxt.B1 : cur.B1; const char* uA2 = last ? nxt.A2 : cur.A2; const char* uB2 = last ? nxt.B2 : cur.B2;
            Unit U2; U2.A1 = uA1; U2.B1 = uB1; U2.A2 = uA2; U2.B2 = uB2;
            const int t2 = last ? 0 : t + 2, t3 = t2 + 1;
            PG8_LDB(B0, 0, 0); PG8_LDB(B1, 0, 1); PG8_SCHED; PG8_LDA(At, 0, 0); PG8_STG_AG(PG8_SA(1, 1), cur, t + 1, 1, false);
            PG8_WAIT_V(8); PG8_WAIT_L(0); PG8_BAR; PG8_MMA(0, 0, At, B0); PG8_MMA(0, 1, At, B1); PG8_BAR; PG8_SCHED;
            PG8_LDA(At, 0, 1); PG8_STG_B(PG8_SB(0, 0), U2, t2, 0); PG8_STG_B(PG8_SB(0, 1), U2, t2, 1); PG8_STG_AG(PG8_SA(0, 0), U2, t2, 0, last);
            PG8_WAIT_V(8); PG8_WAIT_L(0); PG8_BAR; PG8_MMA(1, 0, At, B0); PG8_MMA(1, 1, At, B1); PG8_BAR; PG8_SCHED;
            PG8_LDB(B0, 1, 0); PG8_LDB(B1, 1, 1); PG8_SCHED; PG8_LDA(At, 1, 0); PG8_STG_AG(PG8_SA(0, 1), U2, t2, 1, last);
            PG8_WAIT_V(8); PG8_WAIT_L(0); PG8_BAR; PG8_MMA(0, 0, At, B0); PG8_MMA(0, 1, At, B1); PG8_BAR; PG8_SCHED;
            PG8_LDA(At, 1, 1); PG8_STG_B(PG8_SB(1, 0), U2, t3, 0); PG8_STG_B(PG8_SB(1, 1), U2, t3, 1); PG8_STG_AG(PG8_SA(1, 0), U2, t3, 0, last);
            PG8_WAIT_V(8); PG8_WAIT_L(0); PG8_BAR; PG8_MMA(1, 0, At, B0); PG8_MMA(1, 1, At, B1); PG8_BAR; PG8_SCHED;
        }
        if (wr == 0) PG8_BAR;
        { const int l2_ = otid() & 63; E(acc, cur, wr, wc, l2_ & 15, l2_ >> 4); }
        if (!has_next) break;
#pragma unroll
        for (int a = 0; a < 2; ++a)
#pragma unroll
            for (int b = 0; b < 2; ++b)
#pragma unroll
                for (int m = 0; m < 4; ++m)
#pragma unroll
                    for (int n = 0; n < 2; ++n) acc[a][b][m][n] = (f32x4){0.f, 0.f, 0.f, 0.f};
        cur = nxt;
        if constexpr (GATHER) {
#pragma unroll
            for (int h_ = 0; h_ < 2; ++h_) { vGc[h_][0] = vGn[h_][0]; vGc[h_][1] = vGn[h_][1]; } }
        if (wr == 1) PG8_BAR;
    }
    PG8_WAIT_V(0);
    PG8_BAR;
#undef PG8_SA
#undef PG8_SB
#undef PG8_STG_A
#undef PG8_STG_AG
#undef PG8_LOADG
#undef PG8_STG_B
#undef PG8_LDA
#undef PG8_LDB
#undef PG8_MMA
#undef PG8_WAIT_V
#undef PG8_WAIT_L
#undef PG8_BAR
#undef PG8_SCHED
}
}

#define XB_TMO      128
#define XB_XCNT(j)  (256  + 64 * (j))
#define XB_XSUB(j)  (1280 + 64 * (j))
#define XB_XGEN(j)  (2304 + 64 * (j))
#define XB_TOP      3328
#define XB_TOPGEN   3392
#define XCD_BAR_WORDS 3456
#define XB_SPIN_CAP (1u << 18)

__device__ __forceinline__ unsigned xb_ld(unsigned* p)              { return __hip_atomic_load(p, __ATOMIC_RELAXED, __HIP_MEMORY_SCOPE_AGENT); }
__device__ __forceinline__ unsigned xb_add(unsigned* p, unsigned v) { return __hip_atomic_fetch_add(p, v, __ATOMIC_RELAXED, __HIP_MEMORY_SCOPE_AGENT); }
__device__ __forceinline__ unsigned xb_xcc_id() { return (unsigned)__builtin_amdgcn_s_getreg((3 << 11) | 20) & 0xFu; }
#define XB_SPIN(cond, bar) do { unsigned _sp = 0; while (cond) { __builtin_amdgcn_s_sleep(1); \
    if ((++_sp & 255u) == 0u) { if (xb_ld(&(bar)[XB_TMO])) break; if (_sp > XB_SPIN_CAP) { atomicAdd(&(bar)[XB_TMO], 1u); break; } } } } while (0)

struct XcdBarrier {
    unsigned* bar; unsigned x;
    volatile LAS unsigned* st;
};

__device__ __forceinline__ XcdBarrier xcd_barrier_post(unsigned* bar, volatile LAS unsigned* st) {
    XcdBarrier b; b.bar = bar; b.x = xb_xcc_id(); b.st = st;
    if (threadIdx.x == 0) (void)xb_add(&bar[XB_XCNT(b.x)], 1u);
    return b;
}
__device__ __forceinline__ void xcd_barrier_complete(unsigned* bar, unsigned x, unsigned& nloc, unsigned& nx) {
    const unsigned G = gridDim.x * gridDim.y * gridDim.z;
    unsigned sum, cnt, mine, sp = 0u;
    for (;;) {
        sum = 0u; cnt = 0u; mine = 0u;
#pragma unroll
        for (unsigned j = 0; j < 16; ++j) { const unsigned c = xb_ld(&bar[XB_XCNT(j)]); sum += c; cnt += (c > 0u) ? 1u : 0u; mine = (j == x) ? c : mine; }
        if (sum == G) break;
        __builtin_amdgcn_s_sleep(1);
        if ((++sp & 255u) == 0u) { if (xb_ld(&bar[XB_TMO])) break; if (sp > XB_SPIN_CAP) { atomicAdd(&bar[XB_TMO], 1u); break; } }
    }
    nloc = mine > 0u ? mine : 1u; nx = cnt > 0u ? cnt : 1u;
}

__device__ __forceinline__ void xcd_barrier(const XcdBarrier& b) {
    asm volatile("s_waitcnt vmcnt(0)" ::: "memory");
    __syncthreads();
    if (threadIdx.x == 0) {
        unsigned* bar = b.bar;
        __builtin_amdgcn_s_waitcnt(0);
        unsigned nloc = b.st[0], nx = b.st[1];
        if (nloc == 0u) { xcd_barrier_complete(bar, b.x, nloc, nx); b.st[0] = nloc; b.st[1] = nx; }
        const unsigned old = xb_add(&bar[XB_XSUB(b.x)], 1u);
        const unsigned gen = old / nloc;
        if (old + 1u == (gen + 1u) * nloc) {
            __builtin_amdgcn_fence(__ATOMIC_RELEASE, "agent");
            asm volatile("s_waitcnt vmcnt(0)" ::: "memory");
            const unsigned og = xb_add(&bar[XB_TOP], 1u);
            const unsigned tg = og / nx;
            if (og + 1u == (tg + 1u) * nx) xb_add(&bar[XB_TOPGEN], 1u);
            else XB_SPIN(xb_ld(&bar[XB_TOPGEN]) == tg, bar);
            __builtin_amdgcn_fence(__ATOMIC_ACQUIRE, "agent");
            xb_add(&bar[XB_XGEN(b.x)], 1u);
            asm volatile("s_waitcnt vmcnt(0)" ::: "memory");
        } else {
            XB_SPIN(xb_ld(&bar[XB_XGEN(b.x)]) == gen, bar);
            __builtin_amdgcn_fence(__ATOMIC_ACQUIRE, "agent");
            asm volatile("s_waitcnt vmcnt(0)" ::: "memory");
        }
    }
    __syncthreads();
}

constexpr int T = 16384, D = 1024;
constexpr int RW = 1280, RNB = 10, RBD = 128, RCH = 64, RNC = T / RCH;
constexpr int MI = 2048, MH = 4, HD = 512, MCH = 256, MNC = T / MCH;
constexpr int LDT = T + 64;
constexpr int NG = 64, SL = 16, SNC = T / SL, SK = 384;
constexpr int FF = 2816, NE = 8, MOE_ROWS = 2 * T + NE * 256;
#ifndef MOE_F8_MASK
#define MOE_F8_MASK 3
#endif
#define MOE_F8(f) (((MOE_F8_MASK) >> (f)) & 1)
#ifndef DENSE_F8_MASK
#define DENSE_F8_MASK 2
#endif
#define DENSE_F8(f) (((DENSE_F8_MASK) >> (f)) & 1)
#ifndef RG_F8_MASK
#define RG_F8_MASK 2
#endif
#define RG_F8(j) (((RG_F8_MASK) >> (j)) & 1)
#ifndef DEFER_NORM
#define DEFER_NORM 1
#endif
constexpr float EPS = 1e-6f;
constexpr int NTHR = 512, NWAVES = 8;

enum { I_X = 0, I_NORM_MIX, I_NORM_FFN, I_NORM_FINAL, I_A_W_IN, I_A_CONV_W, I_A_CONV_B, I_A_W_R, I_A_B_R, I_A_W_I, I_A_B_I, I_A_LAM, I_A_W_OUT,
       I_B_W_IN, I_B_CONV_W, I_B_CONV_B, I_B_W_Q, I_B_W_K, I_B_W_V, I_B_W_GATE, I_B_B_GATE, I_B_NORM, I_B_SKIP, I_B_W_OUT,
       I_C_A_RE, I_C_A_IM, I_C_LOG_STEP, I_C_B_RE, I_C_B_IM, I_C_C_RE, I_C_C_IM, I_C_D, I_C_W_GLU, I_C_B_GLU,
       I_F_W1, I_F_W3, I_F_W2, I_E_ROUTER, I_E_ROUTER_B, I_E_W1, I_E_W3, I_E_W2, N_IN };

constexpr size_t MiB = 1u << 20;
constexpr size_t WS_CTL = 0, CTL_ZERO_BYTES = 1 * MiB;
constexpr size_t WS_WA_IN = 2 * MiB, WS_WA_OUT = 12 * MiB, WS_WA_G = 17 * MiB, WS_WB_IN = 19 * MiB, WS_WB_OUT = 27 * MiB, WS_WC_GLU = 31 * MiB, WS_S5_BE = 33 * MiB, WS_S5_KC = 41 * MiB;
constexpr size_t WS_RSS = 53 * MiB;
constexpr size_t SCR = 56 * MiB;
constexpr size_t WS_HN = SCR + 0 * MiB;
constexpr size_t WS_GX = SCR + 32 * MiB, WS_XR = SCR + 72 * MiB, WS_HL = SCR + 112 * MiB, WS_AC = SCR + 152 * MiB, WS_CSA = SCR + 192 * MiB, WS_CSH = SCR + 194 * MiB, WS_CIN = SCR + 196 * MiB;
constexpr size_t WS_XM = SCR + 32 * MiB, WS_Z = SCR + 96 * MiB, WS_Q = SCR + 160 * MiB, WS_K = SCR + 224 * MiB, WS_KT = SCR + 288 * MiB, WS_VT = SCR + 353 * MiB, WS_XC = SCR + 418 * MiB,
                 WS_SM = SCR + 482 * MiB, WS_CT = SCR + 514 * MiB, WS_MLS = SCR + 642 * MiB;
static_assert((size_t)MI * LDT * 2 <= 65 * MiB && WS_MLS + 4 * MiB <= SCR + 656 * MiB, "mLSTM scratch");
constexpr size_t WS_NUM = WS_XM, WS_Y = WS_XC;
constexpr size_t WS_GI = WS_MLS, WS_GF = WS_MLS + 256 * 1024, WS_GS = WS_MLS + 512 * 1024, WS_RMT = WS_MLS + 768 * 1024, WS_EF = WS_MLS + 1024 * 1024, WS_MC = WS_MLS + 1280 * 1024,
                 WS_DENP = WS_MLS + 2 * MiB, WS_NS = WS_MLS + 3 * MiB;
constexpr size_t WS_UP = SCR + 32 * MiB, WS_EB = SCR + 80 * MiB, WS_YA = SCR + 112 * MiB;
constexpr size_t WS_WFFN = SCR + 200 * MiB, WS_AG = SCR + 332 * MiB, WS_H = SCR + 400 * MiB, WS_OUT = SCR + 587 * MiB, WS_META = SCR + 655 * MiB, WS_END = SCR + 656 * MiB;
constexpr size_t WS_TOPI = WS_META, WS_TOPW = WS_META + 128 * 1024, WS_LISTE = WS_META + 384 * 1024;
constexpr size_t W13_BYTES = (size_t)2 * FF * D * 2, W2_BYTES = (size_t)D * FF * 2;
constexpr size_t WS_W13 = WS_WFFN, WS_W2T = WS_WFFN + NE * W13_BYTES;
constexpr size_t WS_WD1_13 = SCR + 144 * MiB, WS_WD1_2 = SCR + 155 * MiB;
constexpr size_t WS_W2T8 = WS_WFFN + NE * (W13_BYTES / 2);
constexpr size_t WS_AGX = WS_WFFN + NE * (W13_BYTES / 2) + NE * (W2_BYTES / 2);
static_assert(WS_AGX + (size_t)NE * T * D <= WS_H, "fp8 MoE rows");
static_assert(WS_WD1_13 + W13_BYTES <= WS_WD1_2 && WS_WD1_2 + W2_BYTES <= SCR + 161 * MiB, "dense-1 weights");
static_assert(WS_W2T + NE * W2_BYTES <= WS_AG, "ffn weights");
static_assert(WS_CIN + (size_t)RNC * RW * 4 <= WS_WFFN, "rg scratch vs dense weights");
static_assert(WS_H + (size_t)MOE_ROWS * FF * 2 <= WS_OUT && WS_OUT + (size_t)MOE_ROWS * D * 2 <= WS_META, "moe buffers");
constexpr int CW_BAR = 4096, CW_MOE = 204800, CW_DQ = 208896;

constexpr int RING_BYTES = 131072, EXTRA_OFF = RING_BYTES, EXTRA_BYTES = 24576, LDS_BYTES = RING_BYTES + EXTRA_BYTES;
constexpr int MISC_OFF = LDS_BYTES - 64;

struct Args { const float* in[N_IN]; float* out; unsigned char* ws; int ph_lo, ph_hi, li, pad; };

__device__ __forceinline__ float wave_sum(float v) {
#pragma unroll
    for (int o = 1; o < 64; o <<= 1) v += __shfl_xor(v, o);
    return v;
}
__device__ __forceinline__ float wave_max(float v) {
#pragma unroll
    for (int o = 1; o < 64; o <<= 1) v = fmaxf(v, __shfl_xor(v, o));
    return v;
}
__device__ __forceinline__ u32x4 ldg16(const void* p) { return *(const GAS u32x4*)p; }
__device__ __forceinline__ u32x2 ldg8(const void* p) { return *(const GAS u32x2*)p; }
__device__ __forceinline__ f32x4 ldgf4(const void* p) { return *(const GAS f32x4*)p; }
__device__ __forceinline__ float ldgf(const void* p) { return *(const GAS float*)p; }
__device__ __forceinline__ int ldgi(const void* p) { return *(const GAS int*)p; }
#ifndef STORE_SC1
#define STORE_SC1 0
#endif
#if STORE_SC1
__device__ __forceinline__ void stg16(void* p, u32x4 v) { asm volatile("global_store_dwordx4 %0, %1, off sc1\n\ts_nop 1" :: "v"((GAS u32x4*)p), "v"(v) : "memory"); }
__device__ __forceinline__ void stg8(void* p, u32x2 v) { asm volatile("global_store_dwordx2 %0, %1, off sc1\n\ts_nop 1" :: "v"((GAS u32x2*)p), "v"(v) : "memory"); }
__device__ __forceinline__ void stgf4(void* p, f32x4 v) { asm volatile("global_store_dwordx4 %0, %1, off sc1\n\ts_nop 1" :: "v"((GAS f32x4*)p), "v"(v) : "memory"); }
__device__ __forceinline__ void stgf(void* p, float v) { asm volatile("global_store_dword %0, %1, off sc1\n\ts_nop 1" :: "v"((GAS float*)p), "v"(v) : "memory"); }
__device__ __forceinline__ void stgi(void* p, int v) { asm volatile("global_store_dword %0, %1, off sc1\n\ts_nop 1" :: "v"((GAS int*)p), "v"(v) : "memory"); }
__device__ __forceinline__ void stgh(void* p, bf16 v) { asm volatile("global_store_short %0, %1, off sc1\n\ts_nop 1" :: "v"((GAS bf16*)p), "v"((unsigned)v) : "memory"); }
#else
__device__ __forceinline__ void stg16(void* p, u32x4 v) { *(GAS u32x4*)p = v; }
__device__ __forceinline__ void stg8(void* p, u32x2 v) { *(GAS u32x2*)p = v; }
__device__ __forceinline__ void stgf4(void* p, f32x4 v) { *(GAS f32x4*)p = v; }
__device__ __forceinline__ void stgf(void* p, float v) { *(GAS float*)p = v; }
__device__ __forceinline__ void stgi(void* p, int v) { *(GAS int*)p = v; }
__device__ __forceinline__ void stgh(void* p, bf16 v) { *(GAS bf16*)p = v; }
#endif
#define LDS_WAIT() asm volatile("s_waitcnt lgkmcnt(0)" ::: "memory")

#ifndef WGM_
#define WGM_ 8
#endif
__device__ __forceinline__ void tile_of(int L, int nM, int nN, int& pm, int& pn) {
    const int nwg = nM * nN; int wgid = L;
    { const int q = nwg / 8, r = nwg % 8, xcd = wgid % 8, off = wgid / 8; wgid = (xcd < r ? xcd * (q + 1) : r * (q + 1) + (xcd - r) * q) + off; }
    const int nig = WGM_ * nN, gid = wgid / nig, fm = gid * WGM_, gsz = (nM - fm) < WGM_ ? (nM - fm) : WGM_;
    pm = fm + ((wgid % nig) % gsz); pn = (wgid % nig) / gsz;
}
using pg8::Unit;
__device__ __forceinline__ const char* uptr(const char* p) { const unsigned long long v = (unsigned long long)p; unsigned lo = __builtin_amdgcn_readfirstlane((unsigned)v), hi = __builtin_amdgcn_readfirstlane((unsigned)(v >> 32));
    asm volatile("s_nop 4" : "+s"(lo), "+s"(hi)); return (const char*)(((unsigned long long)hi << 32) | lo); }
struct Sched2D {
    const char* A; const char* B; unsigned lda, ldb; int nM, nN, G, c;
    __device__ __forceinline__ bool next(int i, Unit& u) const {
        const int L = i * G + c; if (L >= nM * nN) return false;
        tile_of(L, nM, nN, u.pm, u.pn); u.aux = 0;
        u.A1 = uptr(A + (size_t)u.pm * 512 * lda); u.B1 = uptr(B + (size_t)u.pn * 512 * ldb); u.A2 = u.A1; u.B2 = u.B1; return true;
    }
};
struct SchedMoe {
    LAS const int* gt; int gather;
    const char* A; const char* B; unsigned lda, ldb; size_t bstride; int P, nN, G, c; int ps[NE];
    int erows = 0;
    int ksplit; unsigned khbytes;
    __device__ __forceinline__ bool next(int i, Unit& u) const {
        const int L = i * G + c, nu = P * nN; if (L >= nu * ksplit) return false;
        const int kh = L / nu;
        tile_of(L - kh * nu, P, nN, u.pm, u.pn);
        int e = 0;
#pragma unroll
        for (int j = 1; j < NE; ++j) e += (u.pm >= ps[j]) ? 1 : 0;
        u.aux = (ksplit > 1) ? kh : e;
        int arow = u.pm * 256;
        if (erows) { int pse = 0;
#pragma unroll
            for (int j = 1; j < NE; ++j) pse = (u.pm >= ps[j]) ? ps[j] : pse;
            arow = e * erows + (u.pm - pse) * 256; }
        u.A1 = gather ? A : uptr(A + (size_t)arow * 2 * lda + (size_t)kh * khbytes); u.B1 = uptr(B + (size_t)e * bstride + (size_t)u.pn * 512 * ldb + (size_t)kh * khbytes); u.A2 = u.A1; u.B2 = u.B1; return true;
    }
};
struct SchedBatch {
    const char* A; const char* B; unsigned lda, ldb; size_t astride, bstride; int nMb, nB, G, c;
    __device__ __forceinline__ bool next(int i, Unit& u) const {
        const int L = i * G + c; if (L >= nMb * nB) return false;
        u.aux = L / nMb; u.pm = L % nMb; u.pn = 0;
        u.A1 = uptr(A + (size_t)u.aux * astride + (size_t)u.pm * 512 * lda); u.B1 = uptr(B + (size_t)u.aux * bstride); u.A2 = u.A1; u.B2 = u.B1; return true;
    }
};
struct SchedSbuild {
    const char* Q; const char* K; int G, c;
    __device__ __forceinline__ bool next(int i, Unit& u) const {
        const int L = i * G + c; if (L >= MNC * MH) return false;
        const int ch = L / MH, h = L % MH; u.aux = L; u.pm = ch; u.pn = h;
        u.A1 = uptr(Q + ((size_t)ch * MCH * MI + (size_t)h * HD) * 2); u.B1 = uptr(K + ((size_t)ch * MCH * MI + (size_t)h * HD) * 2); u.A2 = u.A1; u.B2 = u.B1; return true;
    }
};
struct SchedPass2 {
    const char* SMp; const char* Q; const char* VT; const char* CT; int G, c;
    __device__ __forceinline__ bool next(int i, Unit& u) const {
        const int pr_ = (i >> 1) * G + c; if (pr_ >= MNC * MH) return false;
        const int L = pr_ * 2 + (i & 1);
        const int eh = L & 1, ch_h = L >> 1, ch = ch_h / MH, h = ch_h % MH; u.aux = ch_h; u.pm = ch; u.pn = h * 2 + eh;
        u.A1 = uptr(SMp + (size_t)ch_h * MCH * MCH * 2); u.A2 = uptr(Q + ((size_t)ch * MCH * MI + (size_t)h * HD) * 2);
        u.B1 = uptr(VT + ((size_t)(h * HD + eh * 256) * LDT + (size_t)ch * MCH) * 2); u.B2 = uptr(CT + ((size_t)ch_h * HD * HD + (size_t)eh * 256 * HD) * 2); return true;
    }
};

struct SchedState {
    const char* VT; const char* KT; int G, c;
    __device__ __forceinline__ bool next(int i, Unit& u) const {
        const int pq_ = (i >> 2) * G + c; if (pq_ >= MNC * MH) return false;
        const int L = pq_ * 4 + (i & 3);
        const int ch_h = L >> 2, ch = ch_h / MH, h = ch_h % MH; u.aux = ch_h; u.pm = (L >> 1) & 1; u.pn = L & 1;
        u.A1 = uptr(VT + ((size_t)(h * HD + u.pm * 256) * LDT + (size_t)ch * MCH) * 2); u.B1 = uptr(KT + ((size_t)(h * HD + u.pn * 256) * LDT + (size_t)ch * MCH) * 2); u.A2 = u.A1; u.B2 = u.B1; return true;
    }
};

__device__ __forceinline__ float rss_rstd(const float* rss, int row) { const f32x4 p = ldgf4(rss + (size_t)row * 4); return __builtin_amdgcn_rsqf(((p[0] + p[1]) + (p[2] + p[3])) * (1.0f / D) + EPS); }
template <int EMIT> __device__ __forceinline__ float emit_x(unsigned char* hn, size_t eoff, const f32x4& x) {
    if (EMIT == 1) { u32x2 w; w.x = cvt_pk_bf16(x[0], x[1]); w.y = cvt_pk_bf16(x[2], x[3]); stg8(hn + eoff * 2, w); }
    else stgi(hn + eoff, (int)cvt4_fp8(__builtin_amdgcn_fmed3f(x[0], -448.0f, 448.0f), __builtin_amdgcn_fmed3f(x[1], -448.0f, 448.0f), __builtin_amdgcn_fmed3f(x[2], -448.0f, 448.0f), __builtin_amdgcn_fmed3f(x[3], -448.0f, 448.0f)));
    return (x[0] * x[0] + x[1] * x[1]) + (x[2] * x[2] + x[3] * x[3]);
}
__device__ __forceinline__ void emit_rss(LAS float* P, float* rss, const pg8::Unit& u) {
    LDS_WAIT(); __builtin_amdgcn_s_barrier(); asm volatile("" ::: "memory");
    const int t = otid(); if (t < 256) { const f32x4 p = *(const LAS f32x4*)(P + t * 4); stgf(rss + ((size_t)u.pm * 256 + t) * 4 + u.pn, (p[0] + p[1]) + (p[2] + p[3])); }
}

template <bool RS> struct EpiBf16T {
    static constexpr bool PERM = true;
    bf16* O; int ldc; int split_cols; size_t split_stride; size_t aux_stride;
    float scale = 1.0f; const float* rss = nullptr;
    __device__ __forceinline__ void operator()(const f32x4 (&acc)[2][2][4][2], const Unit& u, int wr, int wc, int fr, int fq) const {
        const int row0 = u.pm * 256 + wr * 64 + fr; int colt = u.pn * 256; bf16* base = O + (size_t)u.aux * aux_stride;
        if (split_cols) { const int t = colt / split_cols; base += (size_t)t * split_stride; colt -= t * split_cols; }
        const int col0 = colt + wc * 32 + 8 * fq;
#pragma unroll
        for (int ai = 0; ai < 2; ++ai)
#pragma unroll
            for (int m = 0; m < 4; ++m) { bf16* rowp = base + (size_t)(row0 + ai * 128 + m * 16) * ldc + col0; const float sc_ = RS ? scale * rss_rstd(rss, row0 + ai * 128 + m * 16) : scale;
#pragma unroll
                for (int bj = 0; bj < 2; ++bj) { const f32x4 v0 = acc[ai][bj][m][0] * sc_, v1 = acc[ai][bj][m][1] * sc_;
                    u32x4 w; w.x = cvt_pk_bf16(v0[0], v0[1]); w.y = cvt_pk_bf16(v0[2], v0[3]); w.z = cvt_pk_bf16(v1[0], v1[1]); w.w = cvt_pk_bf16(v1[2], v1[3]);
                    stg16(rowp + bj * 128, w); }
                asm volatile("" ::: "memory"); }
    }
};
using EpiBf16 = EpiBf16T<false>;
template <int EMIT> struct EpiResidT {
    static constexpr bool PERM = false;
    const float* base; float* out; unsigned char* hn; float* rss; LAS float* P; float scale;
    __device__ __forceinline__ void operator()(const f32x4 (&acc)[2][2][4][2], const Unit& u, int wr, int wc, int fr, int fq) const {
        const int row0 = u.pm * 256 + wr * 64 + fr, col0 = u.pn * 256 + wc * 32 + 4 * fq;
#pragma unroll
        for (int ai = 0; ai < 2; ++ai) { f32x4 bs[4][2][2];
#pragma unroll
            for (int m = 0; m < 4; ++m) { const size_t off = (size_t)(row0 + ai * 128 + m * 16) * D + col0;
#pragma unroll
                for (int bj = 0; bj < 2; ++bj)
#pragma unroll
                    for (int n = 0; n < 2; ++n) bs[m][bj][n] = ldgf4(base + off + bj * 128 + n * 16); }
#pragma unroll
            for (int m = 0; m < 4; ++m) { const size_t off = (size_t)(row0 + ai * 128 + m * 16) * D + col0; float ss = 0.f;
#pragma unroll
                for (int bj = 0; bj < 2; ++bj)
#pragma unroll
                    for (int n = 0; n < 2; ++n) { const f32x4 x = bs[m][bj][n] + acc[ai][bj][m][n] * scale; stgf4(out + off + bj * 128 + n * 16, x);
                        if (EMIT) ss += emit_x<EMIT>(hn, off + bj * 128 + n * 16, x); }
                if (EMIT) { ss += __shfl_xor(ss, 16); ss += __shfl_xor(ss, 32); if (fq == 0) P[(ai * 128 + wr * 64 + m * 16 + fr) * 4 + wc] = ss; } }
            asm volatile("" ::: "memory"); }
        if (EMIT) emit_rss(P, rss, u);
    }
};
using EpiResid = EpiResidT<0>;
template <bool RS> struct EpiSwigluT {
    static constexpr bool PERM = true;
    bf16* Hh; const float* rss = nullptr;
    __device__ __forceinline__ void operator()(const f32x4 (&acc)[2][2][4][2], const Unit& u, int wr, int wc, int fr, int fq) const {
        const int row0 = u.pm * 256 + wr * 64 + fr, col0 = u.pn * 128 + wc * 32 + 8 * fq;
#pragma unroll
        for (int ai = 0; ai < 2; ++ai)
#pragma unroll
            for (int m = 0; m < 4; ++m) { bf16* rowp = Hh + (size_t)(row0 + ai * 128 + m * 16) * FF + col0; const float rs_ = RS ? rss_rstd(rss, row0 + ai * 128 + m * 16) : 1.0f;
                f32x2 o[4];
#pragma unroll
                for (int n = 0; n < 2; ++n)
#pragma unroll
                    for (int hh = 0; hh < 2; ++hh) { const f32x4 a4 = acc[ai][0][m][n], b4 = acc[ai][1][m][n];
                        f32x2 a = hh ? (f32x2){a4[2], a4[3]} : (f32x2){a4[0], a4[1]}, b = hh ? (f32x2){b4[2], b4[3]} : (f32x2){b4[0], b4[1]}; if (RS) { a = a * rs_; b = b * rs_; }
                        f32x2 e; e[0] = __builtin_amdgcn_exp2f(-a[0]); e[1] = __builtin_amdgcn_exp2f(-a[1]);
                        const f32x2 d = e + 1.0f; f32x2 r; r[0] = __builtin_amdgcn_rcpf(d[0]); r[1] = __builtin_amdgcn_rcpf(d[1]);
                        o[n * 2 + hh] = (a * b) * r; }
                u32x4 w; w.x = cvt_pk_bf16(o[0][0], o[0][1]); w.y = cvt_pk_bf16(o[1][0], o[1][1]); w.z = cvt_pk_bf16(o[2][0], o[2][1]); w.w = cvt_pk_bf16(o[3][0], o[3][1]);
                stg16(rowp, w); asm volatile("" ::: "memory"); }
    }
};
using EpiSwiglu = EpiSwigluT<false>;
template <bool RS> struct EpiSwiglu8T {
    static constexpr bool PERM = true;
    unsigned char* H8; const float* rss = nullptr;
    __device__ __forceinline__ void operator()(const f32x4 (&acc)[2][2][4][2], const Unit& u, int wr, int wc, int fr, int fq) const {
        const int row0 = u.pm * 256 + wr * 64 + fr, col0 = u.pn * 128 + wc * 32 + 8 * fq;
#pragma unroll
        for (int ai = 0; ai < 2; ++ai)
#pragma unroll
            for (int m = 0; m < 4; ++m) { unsigned char* rowp = H8 + (size_t)(row0 + ai * 128 + m * 16) * FF + col0; const float rs_ = RS ? 0.03125f * rss_rstd(rss, row0 + ai * 128 + m * 16) : 0.03125f;
                f32x2 o[4];
#pragma unroll
                for (int n = 0; n < 2; ++n)
#pragma unroll
                    for (int hh = 0; hh < 2; ++hh) { const f32x4 a4 = acc[ai][0][m][n], b4 = acc[ai][1][m][n];
                        const f32x2 a = (hh ? (f32x2){a4[2], a4[3]} : (f32x2){a4[0], a4[1]}) * rs_, b = hh ? (f32x2){b4[2], b4[3]} : (f32x2){b4[0], b4[1]};
                        f32x2 e; e[0] = __builtin_amdgcn_exp2f(-a[0]); e[1] = __builtin_amdgcn_exp2f(-a[1]);
                        const f32x2 d = e + 1.0f; f32x2 r; r[0] = __builtin_amdgcn_rcpf(d[0]); r[1] = __builtin_amdgcn_rcpf(d[1]);
                        o[n * 2 + hh] = (a * (b * rs_)) * r; }
                u32x2 w; w.x = cvt4_fp8(o[0][0], o[0][1], o[1][0], o[1][1]); w.y = cvt4_fp8(o[2][0], o[2][1], o[3][0], o[3][1]);
                stg8(rowp, w); asm volatile("" ::: "memory"); }
    }
};
using EpiSwiglu8 = EpiSwiglu8T<false>;
template <int EMIT> struct EpiGluT {
    static constexpr bool PERM = false;
    const bf16* YA; const float* bglu; float* xf; unsigned char* hn = nullptr; float* rss = nullptr; LAS float* P = nullptr;
    __device__ __forceinline__ void operator()(const f32x4 (&acc)[2][2][4][2], const Unit& u, int wr, int wc, int fr, int fq) const {
        const int row0 = u.pm * 256 + wr * 64 + fr, col0 = u.pn * 256 + wc * 32 + 4 * fq;
        f32x4 bv[2][2];
#pragma unroll
        for (int bj = 0; bj < 2; ++bj)
#pragma unroll
            for (int n = 0; n < 2; ++n) bv[bj][n] = ldgf4(bglu + col0 + bj * 128 + n * 16);
#pragma unroll
        for (int ai = 0; ai < 2; ++ai)
#pragma unroll
            for (int mp = 0; mp < 2; ++mp) { f32x4 xs[2][2][2]; u32x2 yv[2][2][2];
#pragma unroll
                for (int mm = 0; mm < 2; ++mm) { const size_t off = (size_t)(row0 + ai * 128 + (2 * mp + mm) * 16) * D + col0;
#pragma unroll
                    for (int bj = 0; bj < 2; ++bj)
#pragma unroll
                        for (int n = 0; n < 2; ++n) { const size_t o2 = off + bj * 128 + n * 16; xs[mm][bj][n] = ldgf4(xf + o2); yv[mm][bj][n] = ldg8(YA + o2); } }
#pragma unroll
                for (int mm = 0; mm < 2; ++mm) { const int m = 2 * mp + mm; const size_t off = (size_t)(row0 + ai * 128 + m * 16) * D + col0; float ss = 0.f;
#pragma unroll
                    for (int bj = 0; bj < 2; ++bj)
#pragma unroll
                        for (int n = 0; n < 2; ++n) { const size_t o2 = off + bj * 128 + n * 16; const f32x4 x_ = xs[mm][bj][n]; const u32x2 y_ = yv[mm][bj][n];
                            const f32x4 z = acc[ai][bj][m][n] + bv[bj][n]; f32x4 r;
                            r[0] = x_[0] + bflo(y_.x) * sigm(z[0]); r[1] = x_[1] + bfhi(y_.x) * sigm(z[1]); r[2] = x_[2] + bflo(y_.y) * sigm(z[2]); r[3] = x_[3] + bfhi(y_.y) * sigm(z[3]);
                            stgf4(xf + o2, r); if (EMIT) ss += emit_x<EMIT>(hn, o2, r); }
                    if (EMIT) { ss += __shfl_xor(ss, 16); ss += __shfl_xor(ss, 32); if (fq == 0) P[(ai * 128 + wr * 64 + m * 16 + fr) * 4 + wc] = ss; } }
                asm volatile("" ::: "memory"); }
        if (EMIT) emit_rss(P, rss, u);
    }
};
using EpiGlu = EpiGluT<0>;
struct EpiS5e {
    static constexpr bool PERM = false;
    float* EB;
    __device__ __forceinline__ void operator()(const f32x4 (&acc)[2][2][4][2], const Unit& u, int wr, int wc, int fr, int fq) const {
        const int row0 = u.aux * SNC + u.pm * 256 + wr * 64 + fr, col0 = wc * 32 + 4 * fq;
#pragma unroll
        for (int ai = 0; ai < 2; ++ai)
#pragma unroll
            for (int m = 0; m < 4; ++m) { float* rowp = EB + (size_t)(row0 + ai * 128 + m * 16) * 128 + col0;
#pragma unroll
                for (int n = 0; n < 2; ++n) stgf4(rowp + n * 16, acc[ai][0][m][n]); }
    }
};
struct EpiS5y {
    static constexpr bool PERM = true;
    const bf16* UP; const float* dsk; bf16* YA;
    __device__ __forceinline__ void operator()(const f32x4 (&acc)[2][2][4][2], const Unit& u, int wr, int wc, int fr, int fq) const {
        const int g = u.aux, row0 = u.pm * 256 + wr * 64 + fr;
#pragma unroll
        for (int bj = 0; bj < 2; ++bj) { const int cc = bj * 128 + wc * 32 + 8 * fq, tt = cc >> 4, i0 = cc & 15;
            const f32x4 d0 = ldgf4(dsk + g * 16 + i0), d1 = ldgf4(dsk + g * 16 + i0 + 4);
#pragma unroll
            for (int ai = 0; ai < 2; ++ai) { u32x4 uvv[4];
#pragma unroll
                for (int m = 0; m < 4; ++m) uvv[m] = ldg16(UP + ((size_t)g * SNC + (row0 + ai * 128 + m * 16)) * SK + cc);
#pragma unroll
                for (int m = 0; m < 4; ++m) { const int chunk = row0 + ai * 128 + m * 16;
                    const u32x4 uv = uvv[m];
                    const f32x4 v0 = acc[ai][bj][m][0], v1 = acc[ai][bj][m][1]; float o[8];
                    o[0] = gelu_tanh(v0[0] + d0[0] * bflo(uv.x)); o[1] = gelu_tanh(v0[1] + d0[1] * bfhi(uv.x)); o[2] = gelu_tanh(v0[2] + d0[2] * bflo(uv.y)); o[3] = gelu_tanh(v0[3] + d0[3] * bfhi(uv.y));
                    o[4] = gelu_tanh(v1[0] + d1[0] * bflo(uv.z)); o[5] = gelu_tanh(v1[1] + d1[1] * bfhi(uv.z)); o[6] = gelu_tanh(v1[2] + d1[2] * bflo(uv.w)); o[7] = gelu_tanh(v1[3] + d1[3] * bfhi(uv.w));
                    u32x4 w; w.x = cvt_pk_bf16(o[0], o[1]); w.y = cvt_pk_bf16(o[2], o[3]); w.z = cvt_pk_bf16(o[4], o[5]); w.w = cvt_pk_bf16(o[6], o[7]);
                    stg16(YA + (size_t)(chunk * SL + tt) * D + g * 16 + i0, w); }
                asm volatile("" ::: "memory"); } }
    }
};
struct EpiSbuild {
    static constexpr bool PERM = true;
    bf16* SMp; float* DENP; const float* GS; const float* MC;
    __device__ __forceinline__ void operator()(const f32x4 (&acc)[2][2][4][2], const Unit& u, int wr, int wc, int fr, int fq) const {
        const int ch = u.pm, h = u.pn, ch_h = u.aux; const float mc = ldgf(MC + h * 80 + ch);
        float rs[2][4];
#pragma unroll
        for (int ai = 0; ai < 2; ++ai)
#pragma unroll
            for (int m = 0; m < 4; ++m) rs[ai][m] = 0.f;
#pragma unroll
        for (int bj = 0; bj < 2; ++bj) { const int s0 = bj * 128 + wc * 32 + 8 * fq; float w[8];
            { const f32x4 g0 = ldgf4(GS + (size_t)h * T + ch * MCH + s0), g1 = ldgf4(GS + (size_t)h * T + ch * MCH + s0 + 4);
#pragma unroll
              for (int j = 0; j < 4; ++j) { w[j] = __expf(g0[j] - mc); w[4 + j] = __expf(g1[j] - mc); } }
#pragma unroll
            for (int ai = 0; ai < 2; ++ai)
#pragma unroll
                for (int m = 0; m < 4; ++m) { const int r = ai * 128 + wr * 64 + m * 16 + fr; float o[8];
#pragma unroll
                    for (int n = 0; n < 2; ++n)
#pragma unroll
                        for (int j = 0; j < 4; ++j) { const int s = s0 + n * 4 + j; o[n * 4 + j] = (s <= r) ? acc[ai][bj][m][n][j] * w[n * 4 + j] : 0.f; }
                    u32x4 pk; pk.x = cvt_pk_bf16(o[0], o[1]); pk.y = cvt_pk_bf16(o[2], o[3]); pk.z = cvt_pk_bf16(o[4], o[5]); pk.w = cvt_pk_bf16(o[6], o[7]);
                    rs[ai][m] += (bflo(pk.x) + bfhi(pk.x)) + (bflo(pk.y) + bfhi(pk.y)) + (bflo(pk.z) + bfhi(pk.z)) + (bflo(pk.w) + bfhi(pk.w));
                    stg16(SMp + ((size_t)ch_h * MCH + r) * MCH + s0, pk); asm volatile("" ::: "memory"); } }
#pragma unroll
        for (int ai = 0; ai < 2; ++ai)
#pragma unroll
            for (int m = 0; m < 4; ++m) { const int r = ai * 128 + wr * 64 + m * 16 + fr; float v = rs[ai][m]; v += __shfl_xor(v, 16); v += __shfl_xor(v, 32);
                if (fq == 0) stgf(DENP + ((size_t)ch_h * MCH + r) * 4 + wc, v); }
    }
};
struct EpiNum {
    static constexpr bool PERM = true;
    bf16* NUM; const float* RMT; const float* MC;
    __device__ __forceinline__ void operator()(const f32x4 (&acc)[2][2][4][2], const Unit& u, int wr, int wc, int fr, int fq) const {
        const int ch = u.pm, h = u.pn >> 1, eh = u.pn & 1; const float mc = ldgf(MC + h * 80 + ch);
        const int col0 = h * HD + eh * 256 + wc * 32 + 8 * fq;
        float rmv[2][4];
#pragma unroll
        for (int ai = 0; ai < 2; ++ai)
#pragma unroll
            for (int m = 0; m < 4; ++m) rmv[ai][m] = ldgf(RMT + (size_t)h * T + ch * MCH + ai * 128 + wr * 64 + m * 16 + fr);
#pragma unroll
        for (int ai = 0; ai < 2; ++ai)
#pragma unroll
            for (int m = 0; m < 4; ++m) { const int t = ch * MCH + ai * 128 + wr * 64 + m * 16 + fr; const float sc = __expf(mc - rmv[ai][m]);
                bf16* rowp = NUM + (size_t)t * MI + col0;
#pragma unroll
                for (int bj = 0; bj < 2; ++bj) { const f32x4 v0 = acc[ai][bj][m][0] * sc, v1 = acc[ai][bj][m][1] * sc;
                    u32x4 w; w.x = cvt_pk_bf16(v0[0], v0[1]); w.y = cvt_pk_bf16(v0[2], v0[3]); w.z = cvt_pk_bf16(v1[0], v1[1]); w.w = cvt_pk_bf16(v1[2], v1[3]);
                    stg16(rowp + bj * 128, w); }
                asm volatile("" ::: "memory"); }
    }
};
struct ConvItem { const float* W; bf16* WT; int ldw, ldt, k0, n0, drow0; float scale; int f8; const float* kg; };
__device__ __forceinline__ void tr_load(const ConvItem& d, f32x2 (&v)[33], int lane) {
    const int hrow = lane >> 5, cl = lane & 31; const unsigned voff = (unsigned)(hrow * d.ldw + 2 * cl) * 4u;
    const char* rb = (const char*)(d.W + (size_t)d.k0 * d.ldw + d.n0); const size_t rstep = (size_t)d.ldw * 8;
#pragma unroll
    for (int i = 0; i < 32; ++i) v[i] = *(const GAS f32x2*)(rb + (size_t)i * rstep + voff);
    v[32][0] = d.kg ? ldgf(d.kg + d.k0 + lane) : 1.0f; v[32][1] = 0.f;
}
__device__ __forceinline__ float tr_scale(const ConvItem& d, const f32x2 (&v)[33], int i, int hrow) {
    const int gi = __float_as_int(v[32][0]); const float g0 = __int_as_float(__builtin_amdgcn_readlane(gi, 2 * i)), g1 = __int_as_float(__builtin_amdgcn_readlane(gi, 2 * i + 1)); return d.scale * (hrow ? g1 : g0);
}
__device__ __forceinline__ void tr_store8(const ConvItem& d, const f32x2 (&v)[33], LAS float* scr, int lane) {
    LAS unsigned char* tile = (LAS unsigned char*)scr; constexpr int TS8 = 68;
    const int hrow = lane >> 5, cl = lane & 31;
#pragma unroll
    for (int i = 0; i < 32; ++i) { const float s_ = tr_scale(d, v, i, hrow); *(LAS unsigned short*)(tile + (2 * i + hrow) * TS8 + cl * 2) = (unsigned short)__builtin_amdgcn_cvt_pk_fp8_f32(v[i][0] * s_, v[i][1] * s_, 0, false); }
    LDS_WAIT(); asm volatile("" ::: "memory");
    const int c = lane & 7;
#pragma unroll
    for (int j = 0; j < 8; ++j) { const int n = (lane >> 3) + 8 * j; const LAS unsigned char* sp = tile + (8 * c) * TS8 + n;
        u32x2 o; o.x = (unsigned)sp[0 * TS8] | ((unsigned)sp[1 * TS8] << 8) | ((unsigned)sp[2 * TS8] << 16) | ((unsigned)sp[3 * TS8] << 24);
        o.y = (unsigned)sp[4 * TS8] | ((unsigned)sp[5 * TS8] << 8) | ((unsigned)sp[6 * TS8] << 16) | ((unsigned)sp[7 * TS8] << 24);
        stg8((unsigned char*)d.WT + (size_t)(d.drow0 + n) * d.ldt + d.k0 + 8 * c, o); }
    LDS_WAIT(); asm volatile("" ::: "memory");
}
__device__ __forceinline__ void tr_store(const ConvItem& d, const f32x2 (&v)[33], LAS float* scr, int lane) {
    if (d.f8) { tr_store8(d, v, scr, lane); return; }
    LAS unsigned char* tile = (LAS unsigned char*)scr; constexpr int TS = 132;
    const int hrow = lane >> 5, cl = lane & 31;
#pragma unroll
    for (int i = 0; i < 32; ++i) { const float s_ = tr_scale(d, v, i, hrow); *(LAS unsigned*)(tile + (2 * i + hrow) * TS + cl * 4) = cvt_pk_bf16(v[i][0] * s_, v[i][1] * s_); }
    LDS_WAIT(); asm volatile("" ::: "memory");
    const int c = lane & 7;
#pragma unroll
    for (int j = 0; j < 8; ++j) { const int n = (lane >> 3) + 8 * j; const LAS bf16* sp = (const LAS bf16*)(tile + (8 * c) * TS) + n;
        u32x4 o; o.x = (unsigned)sp[0 * (TS / 2)] | ((unsigned)sp[1 * (TS / 2)] << 16); o.y = (unsigned)sp[2 * (TS / 2)] | ((unsigned)sp[3 * (TS / 2)] << 16);
        o.z = (unsigned)sp[4 * (TS / 2)] | ((unsigned)sp[5 * (TS / 2)] << 16); o.w = (unsigned)sp[6 * (TS / 2)] | ((unsigned)sp[7 * (TS / 2)] << 16);
        stg16(d.WT + (size_t)(d.drow0 + n) * d.ldt + d.k0 + 8 * c, o); }
    LDS_WAIT(); asm volatile("" ::: "memory");
}
__device__ __forceinline__ ConvItem conv_desc(const float* W, int K, int N, bf16* WT, int ldt, int mode, int it) {
    const int nblk = N / 64, kb = it / nblk, nb_ = it % nblk, n0 = nb_ * 64;
    ConvItem d; d.W = W; d.WT = WT; d.ldw = N; d.ldt = ldt; d.k0 = kb * 64; d.n0 = n0; d.drow0 = (mode == 0 || mode == 3) ? n0 : ((n0 >> 7) * 256 + (n0 & 127) + (mode == 2 ? 128 : 0));
    d.scale = (mode == 1 || mode == 3) ? 1.4426950408889634f : (mode == 2) ? 0.6931471805599453f : 1.0f;
    d.f8 = 0; d.kg = nullptr; return d;
}
__device__ __forceinline__ ConvItem conv_desc8(const float* W, int K, int N, unsigned char* WT, int mode, int it) {
    ConvItem d = conv_desc(W, K, N, (bf16*)WT, K, mode, it); d.f8 = 1;
    d.scale = (mode == 1) ? 32.0f * 1.4426950408889634f : (mode == 2) ? 32.0f * 0.6931471805599453f : 64.0f; return d;
}
__device__ __forceinline__ void conv_item(const float* W, int K, int N, bf16* WT, int ldt, int mode, int it, LAS float* scr, int lane) {
    const ConvItem d = conv_desc(W, K, N, WT, ldt, mode, it); f32x2 v[33]; tr_load(d, v, lane); tr_store(d, v, scr, lane);
}
__device__ __forceinline__ void conv_mat(const float* W, int K, int N, bf16* WT, int ldt, int mode, int gw, int NGW, LAS float* scr, int lane) {
    const int items = (K / 64) * (N / 64);
    int it = gw; if (it >= items) return;
    f32x2 va[33], vb[33]; ConvItem da = conv_desc(W, K, N, WT, ldt, mode, it), db = da; tr_load(da, va, lane);
    for (;;) {
        const int i1 = it + NGW; if (i1 < items) { db = conv_desc(W, K, N, WT, ldt, mode, i1); tr_load(db, vb, lane); }
        tr_store(da, va, scr, lane); if (i1 >= items) break;
        const int i2 = i1 + NGW; if (i2 < items) { da = conv_desc(W, K, N, WT, ldt, mode, i2); tr_load(da, va, lane); }
        tr_store(db, vb, scr, lane); if (i2 >= items) break;
        it = i2;
    }
}
__device__ __forceinline__ void conv_dense(const Args& a, int f, int gw, int NGW, LAS float* scr, int lane) {
    bf16* W13 = (bf16*)(a.ws + (f ? WS_WD1_13 : WS_W13)); bf16* W2T = (bf16*)(a.ws + (f ? WS_WD1_2 : WS_W2T));
    conv_mat(a.in[I_F_W1] + (size_t)f * D * FF, D, FF, W13, D, 1, gw, NGW, scr, lane);
    conv_mat(a.in[I_F_W3] + (size_t)f * D * FF, D, FF, W13, D, 2, gw, NGW, scr, lane);
    conv_mat(a.in[I_F_W2] + (size_t)f * D * FF, FF, D, W2T, FF, 0, gw, NGW, scr, lane);
}
__device__ __forceinline__ ConvItem moe_desc(const Args& a, int f, int idx) {
    constexpr int I1 = (D / 64) * (FF / 64), I2 = (FF / 64) * (D / 64), PER = 2 * I1 + I2;
    const int e = idx / PER, r = idx % PER; const size_t wo = ((size_t)f * NE + e) * D * FF;
    if (MOE_F8(f)) {
        unsigned char* W13 = a.ws + WS_W13 + (size_t)e * (W13_BYTES / 2); unsigned char* W2T = a.ws + WS_W2T8 + (size_t)e * (W2_BYTES / 2);
        if (r < I1) return conv_desc8(a.in[I_E_W1] + wo, D, FF, W13, 1, r);
        if (r < 2 * I1) return conv_desc8(a.in[I_E_W3] + wo, D, FF, W13, 2, r - I1);
        return conv_desc8(a.in[I_E_W2] + wo, FF, D, W2T, 0, r - 2 * I1); }
    bf16* W13 = (bf16*)(a.ws + WS_W13 + (size_t)e * W13_BYTES); bf16* W2T = (bf16*)(a.ws + WS_W2T + (size_t)e * W2_BYTES);
    if (r < I1) return conv_desc(a.in[I_E_W1] + wo, D, FF, W13, D, 1, r);
    if (r < 2 * I1) return conv_desc(a.in[I_E_W3] + wo, D, FF, W13, D, 2, r - I1);
    return conv_desc(a.in[I_E_W2] + wo, FF, D, W2T, FF, 0, r - 2 * I1);
}
__device__ __forceinline__ void conv_moe(const Args& a, int f, int gw, int NGW, LAS float* scr, int lane) {
    constexpr int I1 = (D / 64) * (FF / 64), I2 = (FF / 64) * (D / 64), PER = 2 * I1 + I2, items = NE * PER;
    int it = gw; if (it >= items) return;
    f32x2 va[33], vb[33]; ConvItem da = moe_desc(a, f, it), db = da; tr_load(da, va, lane);
    for (;;) {
        const int i1 = it + NGW; if (i1 < items) { db = moe_desc(a, f, i1); tr_load(db, vb, lane); }
        tr_store(da, va, scr, lane); if (i1 >= items) break;
        const int i2 = i1 + NGW; if (i2 < items) { da = moe_desc(a, f, i2); tr_load(da, va, lane); }
        tr_store(db, vb, scr, lane); if (i2 >= items) break;
        it = i2;
    }
}
enum { DQ_DENSE0 = 0, DQ_B, DQ_C, DQ_DENSE1, DQ_A1, DQ_MOE1, DQ_NG };
constexpr int DQ_I = (D / 64) * (FF / 64);
__device__ __forceinline__ int dq_size(int g) { return g == DQ_DENSE0 || g == DQ_DENSE1 ? 3 * DQ_I : g == DQ_B ? 1024 + 512 : g == DQ_C ? 256 : g == DQ_A1 ? 640 + 320 + 80 : NE * 3 * DQ_I; }
__device__ __forceinline__ ConvItem dq_desc0(const Args& a, int g, int idx) {
    if (g == DQ_DENSE0 || g == DQ_DENSE1) { const int f = (g == DQ_DENSE1) ? 1 : 0, m = idx / DQ_I, it = idx % DQ_I;
        if (DENSE_F8(f)) { unsigned char* W13 = a.ws + (f ? WS_WD1_13 : WS_W13); unsigned char* W2T = a.ws + (f ? WS_WD1_2 : WS_W2T);
            if (m == 0) return conv_desc8(a.in[I_F_W1] + (size_t)f * D * FF, D, FF, W13, 1, it);
            if (m == 1) return conv_desc8(a.in[I_F_W3] + (size_t)f * D * FF, D, FF, W13, 2, it);
            return conv_desc8(a.in[I_F_W2] + (size_t)f * D * FF, FF, D, W2T, 0, it); }
        bf16* W13 = (bf16*)(a.ws + (f ? WS_WD1_13 : WS_W13)); bf16* W2T = (bf16*)(a.ws + (f ? WS_WD1_2 : WS_W2T));
        if (m == 0) return conv_desc(a.in[I_F_W1] + (size_t)f * D * FF, D, FF, W13, D, 1, it);
        if (m == 1) return conv_desc(a.in[I_F_W3] + (size_t)f * D * FF, D, FF, W13, D, 2, it);
        return conv_desc(a.in[I_F_W2] + (size_t)f * D * FF, FF, D, W2T, FF, 0, it); }
    if (g == DQ_B) { if (idx < 1024) return conv_desc(a.in[I_B_W_IN], D, 2 * MI, (bf16*)(a.ws + WS_WB_IN), D, 0, idx);
        return conv_desc(a.in[I_B_W_OUT], MI, D, (bf16*)(a.ws + WS_WB_OUT), MI, 0, idx - 1024); }
    if (g == DQ_C) return conv_desc(a.in[I_C_W_GLU], D, D, (bf16*)(a.ws + WS_WC_GLU), D, 0, idx);
    if (g == DQ_A1) { if (idx < 640) { if (RG_F8(1)) return conv_desc8(a.in[I_A_W_IN] + (size_t)D * 2 * RW, D, 2 * RW, a.ws + WS_WA_IN + (size_t)2 * RW * D * 2, 0, idx);
            return conv_desc(a.in[I_A_W_IN] + (size_t)D * 2 * RW, D, 2 * RW, (bf16*)(a.ws + WS_WA_IN) + (size_t)2 * RW * D, D, 0, idx); }
        if (idx < 960) return conv_desc(a.in[I_A_W_OUT] + (size_t)RW * D, RW, D, (bf16*)(a.ws + WS_WA_OUT) + (size_t)D * RW, RW, 0, idx - 640);
        const int it = idx - 960, n = it / 8, r = it % 8, which = r / 4, q = r % 4;
        return conv_desc(a.in[which ? I_A_W_I : I_A_W_R] + ((size_t)RNB + n) * RBD * RBD, RBD, RBD, (bf16*)(a.ws + WS_WA_G) + ((size_t)RNB + n) * 256 * RBD + (size_t)which * 128 * RBD, RBD, 3, q); }
    return moe_desc(a, 1, idx);
}
__device__ __forceinline__ ConvItem dq_desc(const Args& a, int g, int idx) {
    ConvItem d = dq_desc0(a, g, idx);
#if DEFER_NORM
    if ((g == DQ_DENSE0 || g == DQ_DENSE1) && idx < 2 * DQ_I) d.kg = a.in[I_NORM_FFN] + (g == DQ_DENSE1 ? 2 : 0) * D;
    if (g == DQ_B && idx < 1024) d.kg = a.in[I_NORM_MIX] + 1 * D;
    if (g == DQ_A1 && idx < 640) d.kg = a.in[I_NORM_MIX] + 3 * D;
#endif
    return d;
}
__device__ __forceinline__ unsigned* dq_cursor(const Args& a, int g) { return (unsigned*)(a.ws + WS_CTL) + CW_DQ + 64 * g; }
__device__ __forceinline__ int dq_left(const Args& a, int g) { const int c = (int)__hip_atomic_load(dq_cursor(a, g), __ATOMIC_RELAXED, __HIP_MEMORY_SCOPE_AGENT), s = dq_size(g); return c >= s ? 0 : s - c; }
__device__ __forceinline__ void dq_work(const Args& a, int g_lo, int g_hi, int quota, LAS unsigned char* lds, LAS float* scr) {
    const int tid = otid(), lane = tid & 63, wave = tid >> 6; volatile LAS int* slot = (volatile LAS int*)(lds + MISC_OFF + 16);
    int done = 0;
    if (quota == -2) {
        __syncthreads(); if (tid == 0) *slot = (dq_left(a, g_lo) + 16 * (int)gridDim.x - 1) / (16 * (int)gridDim.x); __syncthreads(); quota = *slot; }
    for (int g = g_lo; g <= g_hi; ++g) {
        const int size = dq_size(g);
        for (;;) {
            if (quota >= 0 && done >= quota) return;
            __syncthreads();
            if (tid == 0) { int base = size; if (dq_left(a, g) > 0) base = (int)__hip_atomic_fetch_add(dq_cursor(a, g), 16u, __ATOMIC_RELAXED, __HIP_MEMORY_SCOPE_AGENT); *slot = base; }
            __syncthreads();
            const int base = *slot; if (base >= size) break;
            const int i0 = base + wave * 2, i1 = i0 + 1; ++done;
            if (i0 < size) { f32x2 va[33], vb[33]; const ConvItem da = dq_desc(a, g, i0); tr_load(da, va, lane);
                if (i1 < size) { const ConvItem db = dq_desc(a, g, i1); tr_load(db, vb, lane); tr_store(da, va, scr, lane); tr_store(db, vb, scr, lane); }
                else tr_store(da, va, scr, lane); }
        }
    }
}
__device__ __forceinline__ void conv_a(const Args& a, int j, int gw, int NGW, LAS float* scr, int lane) {
    conv_mat(a.in[I_A_W_IN] + (size_t)j * D * 2 * RW, D, 2 * RW, (bf16*)(a.ws + WS_WA_IN) + (size_t)j * 2 * RW * D, D, 0, gw, NGW, scr, lane);
    conv_mat(a.in[I_A_W_OUT] + (size_t)j * RW * D, RW, D, (bf16*)(a.ws + WS_WA_OUT) + (size_t)j * D * RW, RW, 0, gw, NGW, scr, lane);
    for (int it = gw; it < RNB * 2 * 4; it += NGW) { const int n = it / 8, r = it % 8, which = r / 4, q = r % 4;
        const float* W = a.in[which ? I_A_W_I : I_A_W_R] + ((size_t)j * RNB + n) * RBD * RBD;
        bf16* WT = (bf16*)(a.ws + WS_WA_G) + ((size_t)j * RNB + n) * 256 * RBD + (size_t)which * 128 * RBD;
        conv_item(W, RBD, RBD, WT, RBD, 3, q, scr, lane); }
}
__device__ __forceinline__ void conv_perm(const Args& a, int gw, int NGW, LAS float* scr, int lane) {
    for (int j = 0; j < 2; ++j) {
        conv_mat(a.in[I_A_W_IN] + (size_t)j * D * 2 * RW, D, 2 * RW, (bf16*)(a.ws + WS_WA_IN) + (size_t)j * 2 * RW * D, D, 0, gw, NGW, scr, lane);
        conv_mat(a.in[I_A_W_OUT] + (size_t)j * RW * D, RW, D, (bf16*)(a.ws + WS_WA_OUT) + (size_t)j * D * RW, RW, 0, gw, NGW, scr, lane);
        for (int it = gw; it < RNB * 2 * 4; it += NGW) { const int n = it / 8, r = it % 8, which = r / 4, q = r % 4;
            const float* W = a.in[which ? I_A_W_I : I_A_W_R] + ((size_t)j * RNB + n) * RBD * RBD;
            bf16* WT = (bf16*)(a.ws + WS_WA_G) + ((size_t)j * RNB + n) * 256 * RBD + (size_t)which * 128 * RBD;
            conv_item(W, RBD, RBD, WT, RBD, 3, q, scr, lane); }
    }
    conv_mat(a.in[I_B_W_IN], D, 2 * MI, (bf16*)(a.ws + WS_WB_IN), D, 0, gw, NGW, scr, lane);
    conv_mat(a.in[I_B_W_OUT], MI, D, (bf16*)(a.ws + WS_WB_OUT), MI, 0, gw, NGW, scr, lane);
    conv_mat(a.in[I_C_W_GLU], D, D, (bf16*)(a.ws + WS_WC_GLU), D, 0, gw, NGW, scr, lane);
}
__device__ __forceinline__ void s5_mats(const Args& a, LAS unsigned char* lds, int bid, int nb) {
    LAS float* lre = (LAS float*)lds; LAS float* lim = lre + 17 * 64; LAS float* bre = lim + 17 * 64; LAS float* bim = bre + 1024; LAS float* cre = bim + 1024; LAS float* cim = cre + 1024; LAS float* Kt = cim + 1024;
    const int tid = otid();
    for (int gq = bid; gq < NG * 4; gq += nb) {
        const int g = gq >> 2, q4 = gq & 3;
        __syncthreads();
        if (tid < 64) { const int p = tid; const float are = ldgf(a.in[I_C_A_RE] + g * 64 + p), aim = ldgf(a.in[I_C_A_IM] + g * 64 + p), dl = __expf(ldgf(a.in[I_C_LOG_STEP] + g));
            for (int tau = 0; tau <= 16; ++tau) { const float mag = __expf((float)tau * dl * are); float sn, cs; sincosf((float)tau * dl * aim, &sn, &cs); lre[tau * 64 + p] = mag * cs; lim[tau * 64 + p] = mag * sn; }
            const float mag = __expf(dl * are); float sn, cs; sincosf(dl * aim, &sn, &cs);
            const float nr = mag * cs - 1.0f, ni = mag * sn, den = are * are + aim * aim, fr_ = (nr * are + ni * aim) / den, fi_ = (ni * are - nr * aim) / den;
            for (int j = 0; j < 16; ++j) { const float br = ldgf(a.in[I_C_B_RE] + ((size_t)g * 64 + p) * 16 + j), bi = ldgf(a.in[I_C_B_IM] + ((size_t)g * 64 + p) * 16 + j);
                bre[p * 16 + j] = fr_ * br - fi_ * bi; bim[p * 16 + j] = fr_ * bi + fi_ * br; } }
        for (int i = tid; i < 1024; i += NTHR) { cre[i] = ldgf(a.in[I_C_C_RE] + (size_t)g * 1024 + i); cim[i] = ldgf(a.in[I_C_C_IM] + (size_t)g * 1024 + i); }
        __syncthreads();
        for (int o = tid; o < 4096; o += NTHR) { const int tau = o >> 8, i = (o >> 4) & 15, j = o & 15; float s = 0.f;
            for (int p = 0; p < 64; ++p) { const float cr = cre[i * 64 + p], ci = cim[i * 64 + p], lr = lre[tau * 64 + p], li = lim[tau * 64 + p], xr = cr * lr - ci * li, xi = cr * li + ci * lr;
                s += xr * bre[p * 16 + j] - xi * bim[p * 16 + j]; }
            Kt[o] = s; }
        __syncthreads();
        bf16* KC = (bf16*)(a.ws + WS_S5_KC) + (size_t)g * 256 * SK; bf16* BE = (bf16*)(a.ws + WS_S5_BE) + (size_t)g * 256 * 256;
        for (int o = tid; o < 64 * (SK / 8); o += NTHR) { const int n = q4 * 64 + o / (SK / 8), k0 = (o % (SK / 8)) * 8, tt = n >> 4, i = n & 15; float v[8];
#pragma unroll
            for (int q = 0; q < 8; ++q) { const int k = k0 + q;
                if (k < 256) { const int s = k >> 4, j = k & 15; v[q] = (s <= tt) ? Kt[((tt - s) << 8) + (i << 4) + j] : 0.f; }
                else { const int p = (k - 256) & 63, im = (k - 256) >> 6; const float cr = cre[i * 64 + p], ci = cim[i * 64 + p], lr = lre[(tt + 1) * 64 + p], li = lim[(tt + 1) * 64 + p];
                    v[q] = im ? -(cr * li + ci * lr) : (cr * lr - ci * li); } }
            u32x4 w; w.x = cvt_pk_bf16(v[0], v[1]); w.y = cvt_pk_bf16(v[2], v[3]); w.z = cvt_pk_bf16(v[4], v[5]); w.w = cvt_pk_bf16(v[6], v[7]);
            stg16(KC + (size_t)n * SK + k0, w); }
        for (int o = tid; o < 64 * 32; o += NTHR) { const int n = q4 * 64 + (o >> 5), k0 = (o & 31) * 8; float v[8];
#pragma unroll
            for (int q = 0; q < 8; ++q) { const int k = k0 + q, s = k >> 4, j = k & 15;
                if (n < 128) { const int p = n & 63, im = n >> 6; const float lr = lre[(15 - s) * 64 + p], li = lim[(15 - s) * 64 + p], br = bre[p * 16 + j], bi = bim[p * 16 + j];
                    v[q] = im ? (lr * bi + li * br) : (lr * br - li * bi); } else v[q] = 0.f; }
            u32x4 w; w.x = cvt_pk_bf16(v[0], v[1]); w.y = cvt_pk_bf16(v[2], v[3]); w.z = cvt_pk_bf16(v[4], v[5]); w.w = cvt_pk_bf16(v[6], v[7]);
            stg16(BE + (size_t)n * 256 + k0, w); }
    }
    __syncthreads();
}

__device__ __forceinline__ void moe_prefix(const Args& a, int f, int (&ps)[NE], int& P, int (&cnt)[NE]) {
    const unsigned* gc = (const unsigned*)(a.ws + WS_CTL) + CW_MOE + f * 1024; int acc = 0;
#pragma unroll
    for (int e = 0; e < NE; ++e) { ps[e] = acc; const int c = __builtin_amdgcn_readfirstlane((int)__hip_atomic_load(gc + e * 64, __ATOMIC_RELAXED, __HIP_MEMORY_SCOPE_AGENT)); cnt[e] = c; acc += (c + 255) >> 8; }
    P = acc;
}
template <bool COMBINE, bool ROUTER, int OUTMODE>
__device__ __forceinline__ void ph_norm(const Args& a, LAS unsigned char* lds, int bid, int nb, const float* xsrc, float* xf, const float* gain, int f) {
    const int tid = otid(), lane = tid & 63, wave = tid >> 6;
    const int RPB = T / nb;
    LAS float* rt = (LAS float*)lds; LAS int* sel = (LAS int*)(lds + 32768); LAS int* rnk = (LAS int*)(lds + 32768 + 1024); LAS int* bases = (LAS int*)(lds + 32768 + 2048); LAS int* dstl = (LAS int*)(lds + 32768 + 3072); LAS unsigned char* rows8 = lds + 36864;
    if (ROUTER) {
        const float* router = a.in[I_E_ROUTER] + (size_t)f * D * NE;
        for (int i = tid; i < D * NE; i += NTHR) rt[(i & 7) * D + (i >> 3)] = ldgf(router + i);
        __syncthreads();
    }
    f32x4 gv[4];
#pragma unroll
    for (int j = 0; j < 4; ++j) gv[j] = ldgf4(gain + 4 * lane + 256 * j);
    bf16* HN = (bf16*)(a.ws + WS_HN); bf16* UP = (bf16*)(a.ws + WS_UP);
    const bf16* OUTB = (const bf16*)(a.ws + WS_OUT); const bf16* OUTA = (const bf16*)(a.ws + WS_AG); float* TOPW = (float*)(a.ws + WS_TOPW); int* TOPI = (int*)(a.ws + WS_TOPI);
    int cps[NE], cP = 0, ccnt[NE];
    if (COMBINE) moe_prefix(a, f, cps, cP, ccnt);
    for (int lr0 = wave; lr0 < RPB; lr0 += NWAVES * 4) {
      f32x4 vv[4][4];
#pragma unroll
      for (int k_ = 0; k_ < 4; ++k_) { const int lrk = (lr0 + k_ * NWAVES < RPB) ? lr0 + k_ * NWAVES : lr0;
#pragma unroll
        for (int j = 0; j < 4; ++j) vv[k_][j] = ldgf4(xsrc + (size_t)(bid * RPB + lrk) * D + 4 * lane + 256 * j); }
#pragma unroll
      for (int k_ = 0; k_ < 4; ++k_) { const int lr = lr0 + k_ * NWAVES; if (lr < RPB) {
        const int row = bid * RPB + lr;
        f32x4 (&v)[4] = vv[k_];
        if (COMBINE) {
            const int t1 = ldgi(TOPI + row * 2), t2 = ldgi(TOPI + row * 2 + 1); const int e1 = t1 >> 16, e2 = t2 >> 16; int s1 = 0, s2 = 0;
#pragma unroll
            for (int e = 0; e < NE; ++e) { s1 = (e1 == e) ? cps[e] : s1; s2 = (e2 == e) ? cps[e] : s2; }
            const int r1 = s1 * 256 + (t1 & 0xffff), r2 = s2 * 256 + (t2 & 0xffff); const float p1 = ldgf(TOPW + row * 2), p2 = ldgf(TOPW + row * 2 + 1);
#pragma unroll
            for (int j = 0; j < 4; ++j) { const bool one_buf = MOE_F8(f) != 0;
                const u32x2 o1 = ldg8(OUTA + (size_t)r1 * D + 4 * lane + 256 * j), o2 = ldg8(OUTA + (size_t)r2 * D + 4 * lane + 256 * j);
                u32x2 q1 = (u32x2){0u, 0u}, q2 = (u32x2){0u, 0u};
                if (!one_buf) { q1 = ldg8(OUTB + (size_t)r1 * D + 4 * lane + 256 * j); q2 = ldg8(OUTB + (size_t)r2 * D + 4 * lane + 256 * j); }
                v[j][0] += p1 * (bflo(o1.x) + bflo(q1.x)) + p2 * (bflo(o2.x) + bflo(q2.x)); v[j][1] += p1 * (bfhi(o1.x) + bfhi(q1.x)) + p2 * (bfhi(o2.x) + bfhi(q2.x));
                v[j][2] += p1 * (bflo(o1.y) + bflo(q1.y)) + p2 * (bflo(o2.y) + bflo(q2.y)); v[j][3] += p1 * (bfhi(o1.y) + bfhi(q1.y)) + p2 * (bfhi(o2.y) + bfhi(q2.y));
                if (OUTMODE != 2) stgf4(xf + (size_t)row * D + 4 * lane + 256 * j, v[j]); }
        }
        float s2 = 0.f;
#pragma unroll
        for (int j = 0; j < 4; ++j) s2 += (v[j][0] * v[j][0] + v[j][1] * v[j][1]) + (v[j][2] * v[j][2] + v[j][3] * v[j][3]);
        const float rstd = __builtin_amdgcn_rsqf(wave_sum(s2) * (1.0f / D) + EPS);
#pragma unroll
        for (int j = 0; j < 4; ++j) v[j] = v[j] * rstd * gv[j];
        if (OUTMODE == 0) {
#pragma unroll
            for (int j = 0; j < 4; ++j) { u32x2 w; w.x = cvt_pk_bf16(v[j][0], v[j][1]); w.y = cvt_pk_bf16(v[j][2], v[j][3]); stg8(HN + (size_t)row * D + 4 * lane + 256 * j, w); }
        } else if (OUTMODE == 3) {
            if (ROUTER) {
#pragma unroll
                for (int j = 0; j < 4; ++j) *(LAS int*)(rows8 + lr * D + 4 * lane + 256 * j) = (int)cvt4_fp8(v[j][0], v[j][1], v[j][2], v[j][3]);
            } else {
#pragma unroll
                for (int j = 0; j < 4; ++j) stgi((unsigned char*)HN + (size_t)row * D + 4 * lane + 256 * j, (int)cvt4_fp8(v[j][0], v[j][1], v[j][2], v[j][3]));
            }
        } else if (OUTMODE == 1) {
            const int chunk = row >> 4, s = row & 15;
#pragma unroll
            for (int j = 0; j < 4; ++j) { const int g = (lane >> 2) + 16 * j, i0 = 4 * (lane & 3); u32x2 w; w.x = cvt_pk_bf16(v[j][0], v[j][1]); w.y = cvt_pk_bf16(v[j][2], v[j][3]);
                stg8(UP + ((size_t)g * SNC + chunk) * SK + s * 16 + i0, w); }
        } else {
#pragma unroll
            for (int j = 0; j < 4; ++j) stgf4(a.out + (size_t)row * D + 4 * lane + 256 * j, v[j]);
        }
        if (ROUTER) {
            float lg[NE];
#pragma unroll
            for (int e = 0; e < NE; ++e) { float s = 0.f;
#pragma unroll
                for (int j = 0; j < 4; ++j) { const f32x4 r = *(const LAS f32x4*)(rt + e * D + 4 * lane + 256 * j); s += (v[j][0] * r[0] + v[j][1] * r[1]) + (v[j][2] * r[2] + v[j][3] * r[3]); }
                lg[e] = wave_sum(s) + ldgf(a.in[I_E_ROUTER_B] + f * NE + e); }
            int e1 = 0; float v1 = lg[0];
#pragma unroll
            for (int e = 1; e < NE; ++e) if (lg[e] > v1) { v1 = lg[e]; e1 = e; }
            int e2 = -1; float v2 = -3.0e38f;
#pragma unroll
            for (int e = 0; e < NE; ++e) if (e != e1 && lg[e] > v2) { v2 = lg[e]; e2 = e; }
            const float p1 = 1.0f / (1.0f + __expf(v2 - v1)), p2 = 1.0f - p1;
            if (lane == 0) { sel[lr * 2] = e1; sel[lr * 2 + 1] = e2; stgf(TOPW + row * 2, p1); stgf(TOPW + row * 2 + 1, p2); }
        }
      } }
    }
    if (ROUTER) {
        __syncthreads();
        if (tid < NE) { int cnt = 0;
            for (int i = 0; i < RPB * 2; ++i) if (sel[i] == tid) rnk[i] = cnt++;
            unsigned* gc = (unsigned*)(a.ws + WS_CTL) + CW_MOE + f * 1024 + tid * 64;
            bases[tid] = (int)__hip_atomic_fetch_add(gc, (unsigned)cnt, __ATOMIC_RELAXED, __HIP_MEMORY_SCOPE_AGENT); }
        __syncthreads();
        if (tid < RPB * 2) { const int e = sel[tid], pos = bases[e] + rnk[tid]; stgi(TOPI + (size_t)bid * RPB * 2 + tid, (e << 16) | pos);
            stgi((int*)(a.ws + WS_LISTE) + e * T + pos, bid * RPB + (tid >> 1));
            if (OUTMODE == 3) dstl[tid] = e * T + pos; }
        __syncthreads();
        if (OUTMODE == 3) {
            unsigned char* AGX = a.ws + WS_AGX;
            for (int p = wave; p < RPB * 2; p += NWAVES) { const u32x4 x = *(const LAS u32x4*)(rows8 + (p >> 1) * D + lane * 16); stg16(AGX + (size_t)dstl[p] * D + lane * 16, x); }
            __syncthreads(); }
    }
}
__device__ __forceinline__ void ph_rg_gates(const Args& a, LAS unsigned char* lds, int bid, int nb, int jl) {
    const int tid = otid(), lane = tid & 63, wave = tid >> 6, fr = lane & 15, fq = lane >> 4;
    constexpr int AS_OFF = 0, BS_OFF = 17408, LA_OFF = 87040, BB_OFF = 87040 + 16384, XS_OFF = 87040 + 32768, RS = 272;
    const bf16* XR = (const bf16*)(a.ws + WS_XR); bf16* HL = (bf16*)(a.ws + WS_HL); bf16* AC = (bf16*)(a.ws + WS_AC);
    float* CSA = (float*)(a.ws + WS_CSA); float* CSH = (float*)(a.ws + WS_CSH);
    const int n = bid % RNB, rnk = bid / RNB, cnt = (nb - 1 - n) / RNB + 1;
    { const bf16* WG = (const bf16*)(a.ws + WS_WA_G) + ((size_t)jl * RNB + n) * 256 * RBD;
#pragma unroll
        for (int i = 0; i < 8; ++i) { const int idx = tid + NTHR * i, row = idx >> 4, c16 = idx & 15; *(LAS u32x4*)(lds + BS_OFF + row * RS + c16 * 16) = ldg16(WG + row * RBD + c16 * 8); } }
    const int r2 = tid >> 4, cg = tid & 15, ch0 = n * RBD + cg * 8;
    f32x2 cwv[4][4], cbv[4];
    { const float* cw = a.in[I_A_CONV_W] + (size_t)jl * 4 * RW; const float* cb = a.in[I_A_CONV_B] + (size_t)jl * RW;
#pragma unroll
      for (int k = 0; k < 4; ++k) { const f32x4 w0 = ldgf4(cw + (size_t)k * RW + ch0), w1 = ldgf4(cw + (size_t)k * RW + ch0 + 4); cwv[k][0] = (f32x2){w0[0], w0[1]}; cwv[k][1] = (f32x2){w0[2], w0[3]}; cwv[k][2] = (f32x2){w1[0], w1[1]}; cwv[k][3] = (f32x2){w1[2], w1[3]}; }
      const f32x4 b0 = ldgf4(cb + ch0), b1 = ldgf4(cb + ch0 + 4); cbv[0] = (f32x2){b0[0], b0[1]}; cbv[1] = (f32x2){b0[2], b0[3]}; cbv[2] = (f32x2){b1[0], b1[1]}; cbv[3] = (f32x2){b1[2], b1[3]}; }
    const int tg = wave & 3, half = wave >> 2;
    float brq[4], biq[4], spq[4];
#pragma unroll
    for (int q = 0; q < 4; ++q) { const int ch = n * RBD + 64 * half + 16 * q + fr; const float L2E = 1.4426950408889634f;
        brq[q] = L2E * ldgf(a.in[I_A_B_R] + (size_t)jl * RW + ch); biq[q] = L2E * ldgf(a.in[I_A_B_I] + (size_t)jl * RW + ch); spq[q] = 8.0f * L2E * softplus_f(-ldgf(a.in[I_A_LAM] + (size_t)jl * RW + ch)); }
    u32x4 xr_[5];
    int c = rnk;
#define RG_LOADX(cc) do { _Pragma("unroll") for (int k = 0; k < 5; ++k) { const int tk = (cc) * RCH + 2 * r2 - 3 + k; xr_[k] = (tk >= 0) ? ldg16(XR + (size_t)tk * RW + ch0) : (u32x4){0u, 0u, 0u, 0u}; } } while (0)
    if (c < RNC) RG_LOADX(c);
    for (; c < RNC; c += cnt) {
        __syncthreads();
        {
#pragma unroll
            for (int rr = 0; rr < 2; ++rr) { f32x2 acc[4];
#pragma unroll
                for (int j = 0; j < 4; ++j) acc[j] = cbv[j];
#pragma unroll
                for (int k = 0; k < 4; ++k) { const u32x4 x = xr_[rr + k];
                    acc[0] += cwv[k][0] * (f32x2){bflo(x.x), bfhi(x.x)}; acc[1] += cwv[k][1] * (f32x2){bflo(x.y), bfhi(x.y)};
                    acc[2] += cwv[k][2] * (f32x2){bflo(x.z), bfhi(x.z)}; acc[3] += cwv[k][3] * (f32x2){bflo(x.w), bfhi(x.w)}; }
                u32x4 w0; w0.x = cvt_pk_bf16(acc[0][0], acc[0][1]); w0.y = cvt_pk_bf16(acc[1][0], acc[1][1]); w0.z = cvt_pk_bf16(acc[2][0], acc[2][1]); w0.w = cvt_pk_bf16(acc[3][0], acc[3][1]);
                *(LAS u32x4*)(lds + AS_OFF + (2 * r2 + rr) * RS + cg * 16) = w0; }
        }
        { const int cn = c + cnt; if (cn < RNC) RG_LOADX(cn); }
        __syncthreads();
        f32x4 accr[4], acci[4];
#pragma unroll
        for (int q = 0; q < 4; ++q) { accr[q] = (f32x4){0.f, 0.f, 0.f, 0.f}; acci[q] = (f32x4){0.f, 0.f, 0.f, 0.f}; }
#pragma unroll
        for (int kk = 0; kk < 4; ++kk) { const bf16x8 af = *(const LAS bf16x8*)(lds + AS_OFF + (16 * tg + fr) * RS + (kk * 32 + 8 * fq) * 2);
#pragma unroll
            for (int q = 0; q < 4; ++q) { const bf16x8 br = *(const LAS bf16x8*)(lds + BS_OFF + (64 * half + 16 * q + fr) * RS + (kk * 32 + 8 * fq) * 2);
                const bf16x8 bi = *(const LAS bf16x8*)(lds + BS_OFF + (128 + 64 * half + 16 * q + fr) * RS + (kk * 32 + 8 * fq) * 2);
                accr[q] = __builtin_amdgcn_mfma_f32_16x16x32_bf16(af, br, accr[q], 0, 0, 0); acci[q] = __builtin_amdgcn_mfma_f32_16x16x32_bf16(af, bi, acci[q], 0, 0, 0); } }
#pragma unroll
        for (int q = 0; q < 4; ++q) { const int chl = 64 * half + 16 * q + fr;
#pragma unroll
            for (int pr_ = 0; pr_ < 2; ++pr_) { const int row = 16 * tg + 4 * fq + 2 * pr_;
                const f32x2 R2 = (f32x2){accr[q][2 * pr_], accr[q][2 * pr_ + 1]} + brq[q], I2 = (f32x2){acci[q][2 * pr_], acci[q][2 * pr_ + 1]} + biq[q];
                f32x2 eR, eI; eR[0] = __builtin_amdgcn_exp2f(-R2[0]); eR[1] = __builtin_amdgcn_exp2f(-R2[1]); eI[0] = __builtin_amdgcn_exp2f(-I2[0]); eI[1] = __builtin_amdgcn_exp2f(-I2[1]);
                const f32x2 dR = eR + 1.0f, dI = eI + 1.0f; f32x2 rr, ii; rr[0] = __builtin_amdgcn_rcpf(dR[0]); rr[1] = __builtin_amdgcn_rcpf(dR[1]); ii[0] = __builtin_amdgcn_rcpf(dI[0]); ii[1] = __builtin_amdgcn_rcpf(dI[1]);
                const f32x2 la = rr * spq[q]; f32x2 a_; a_[0] = __builtin_amdgcn_exp2f(-la[0]); a_[1] = __builtin_amdgcn_exp2f(-la[1]);
                f32x2 om = 1.0f - a_; om[0] = fmaxf(om[0], 0.f); om[1] = fmaxf(om[1], 0.f);
                const f32x2 t2 = om * (a_ + 1.0f); f32x2 sq; sq[0] = __builtin_amdgcn_sqrtf(t2[0]); sq[1] = __builtin_amdgcn_sqrtf(t2[1]);
                const f32x2 xr = (f32x2){bf2f(*(const LAS bf16*)(lds + AS_OFF + row * RS + chl * 2)), bf2f(*(const LAS bf16*)(lds + AS_OFF + (row + 1) * RS + chl * 2))};
                const f32x2 bb = (sq * ii) * xr;
                *(LAS bf16*)(lds + LA_OFF + (row * 128 + chl) * 2) = f2bf(om[0]); *(LAS bf16*)(lds + LA_OFF + ((row + 1) * 128 + chl) * 2) = f2bf(om[1]);
                *(LAS bf16*)(lds + BB_OFF + (row * 128 + chl) * 2) = f2bf(bb[0]); *(LAS bf16*)(lds + BB_OFF + ((row + 1) * 128 + chl) * 2) = f2bf(bb[1]); } }
        __syncthreads();
        { const int j = tid & 127, seg = tid >> 7, ch = n * RBD + j; float hl[16], pa[16]; float h = 0.f, pr = 1.f;
#pragma unroll
            for (int i = 0; i < 16; ++i) { const float om = bf2f(*(const LAS bf16*)(lds + LA_OFF + ((16 * seg + i) * 128 + j) * 2)), bb = bf2f(*(const LAS bf16*)(lds + BB_OFF + ((16 * seg + i) * 128 + j) * 2));
                const float ai = 1.0f - om; h = ai * h + bb; pr *= ai; hl[i] = h; pa[i] = pr; }
            LAS float* xs = (LAS float*)(lds + XS_OFF); xs[(seg * 128 + j) * 2] = pr; xs[(seg * 128 + j) * 2 + 1] = h;
            __syncthreads();
            float cin_h = 0.f, cin_a = 1.f;
#pragma unroll
            for (int s = 0; s < 3; ++s) if (s < seg) { const float sa = xs[(s * 128 + j) * 2], sh = xs[(s * 128 + j) * 2 + 1]; cin_h = sa * cin_h + sh; cin_a *= sa; }
#pragma unroll
            for (int i = 0; i < 16; ++i) { const float hf = hl[i] + pa[i] * cin_h, af = pa[i] * cin_a;
                *(LAS bf16*)(lds + LA_OFF + ((16 * seg + i) * 128 + j) * 2) = f2bf(hf); *(LAS bf16*)(lds + BB_OFF + ((16 * seg + i) * 128 + j) * 2) = f2bf(af);
                if (i == 15 && seg == 3) { stgf(CSA + (size_t)c * RW + ch, af); stgf(CSH + (size_t)c * RW + ch, hf); } } }
        __syncthreads();
#pragma unroll
        for (int i = 0; i < 2; ++i) { const int idx = tid + NTHR * i, row = idx >> 4, c16 = idx & 15; const size_t o = (size_t)(c * RCH + row) * RW + n * RBD + c16 * 8;
            stg16(HL + o, *(const LAS u32x4*)(lds + LA_OFF + row * 256 + c16 * 16)); stg16(AC + o, *(const LAS u32x4*)(lds + BB_OFF + row * 256 + c16 * 16)); }
    }
#undef RG_LOADX
    __syncthreads();
}
__device__ __forceinline__ void ph_rg_carry(const Args& a, int bid, int nb) {
    const int tid = otid(), lane = tid & 63, gw = bid * NWAVES + (tid >> 6), NGW = nb * NWAVES;
    const float* CSA = (const float*)(a.ws + WS_CSA); const float* CSH = (const float*)(a.ws + WS_CSH); float* CIN = (float*)(a.ws + WS_CIN);
    for (int ch = gw; ch < RW; ch += NGW) {
        float Ak[4], Hk[4]; float A = 1.f, H = 0.f;
#pragma unroll
        for (int k = 0; k < 4; ++k) { Ak[k] = ldgf(CSA + (size_t)(4 * lane + k) * RW + ch); Hk[k] = ldgf(CSH + (size_t)(4 * lane + k) * RW + ch); H = Ak[k] * H + Hk[k]; A = Ak[k] * A; }
#pragma unroll
        for (int off = 1; off < 64; off <<= 1) { const float Ay = __shfl_up(A, off), Hy = __shfl_up(H, off); if (lane >= off) { H = A * Hy + H; A = A * Ay; } }
        float h = __shfl_up(H, 1); if (lane == 0) h = 0.f;
#pragma unroll
        for (int k = 0; k < 4; ++k) { stgf(CIN + (size_t)(4 * lane + k) * RW + ch, h); h = Ak[k] * h + Hk[k]; }
    }
}
__device__ __forceinline__ void ph_rg_fix(const Args& a, int bid, int nb) {
    const int tid = otid(); bf16* GX = (bf16*)(a.ws + WS_GX); const bf16* HL = (const bf16*)(a.ws + WS_HL); const bf16* AC = (const bf16*)(a.ws + WS_AC); const float* CIN = (const float*)(a.ws + WS_CIN);
    const int total = T * (RW / 8);
    for (int it = bid * NTHR + tid; it < total; it += nb * NTHR) {
        const int t = it / (RW / 8), ch = (it % (RW / 8)) * 8, c = t / RCH; const size_t o = (size_t)t * RW + ch;
        const u32x4 g = ldg16(GX + o), hl = ldg16(HL + o), ac = ldg16(AC + o); const f32x4 c0 = ldgf4(CIN + (size_t)c * RW + ch), c1 = ldgf4(CIN + (size_t)c * RW + ch + 4);
        float y[8];
        y[0] = gelu_tanh(bflo(g.x)) * (bflo(hl.x) + bflo(ac.x) * c0[0]); y[1] = gelu_tanh(bfhi(g.x)) * (bfhi(hl.x) + bfhi(ac.x) * c0[1]);
        y[2] = gelu_tanh(bflo(g.y)) * (bflo(hl.y) + bflo(ac.y) * c0[2]); y[3] = gelu_tanh(bfhi(g.y)) * (bfhi(hl.y) + bfhi(ac.y) * c0[3]);
        y[4] = gelu_tanh(bflo(g.z)) * (bflo(hl.z) + bflo(ac.z) * c1[0]); y[5] = gelu_tanh(bfhi(g.z)) * (bfhi(hl.z) + bfhi(ac.z) * c1[1]);
        y[6] = gelu_tanh(bflo(g.w)) * (bflo(hl.w) + bflo(ac.w) * c1[2]); y[7] = gelu_tanh(bfhi(g.w)) * (bfhi(hl.w) + bfhi(ac.w) * c1[3]);
        u32x4 w; w.x = cvt_pk_bf16(y[0], y[1]); w.y = cvt_pk_bf16(y[2], y[3]); w.z = cvt_pk_bf16(y[4], y[5]); w.w = cvt_pk_bf16(y[6], y[7]);
        stg16(GX + o, w);
    }
}

__device__ __forceinline__ void ph_ml_prep(const Args& a, LAS unsigned char* lds, int bid, int nb) {
    const bf16* XM = (const bf16*)(a.ws + WS_XM); bf16* Q = (bf16*)(a.ws + WS_Q); bf16* Kb = (bf16*)(a.ws + WS_K); bf16* XC = (bf16*)(a.ws + WS_XC);
    float* GI = (float*)(a.ws + WS_GI); float* GF = (float*)(a.ws + WS_GF);
    LAS float* red = (LAS float*)(lds + EXTRA_OFF);
    const float kscale = 0.044194173824159216f;
    for (int tb = bid; tb < T / 64; tb += nb) {
        const int t0 = tb * 64;
        {
            const int tid = otid(), lane = tid & 63, wave = tid >> 6, n4 = tid * 4;
            f32x2 cw[4][2], cb[2], wq[4][2], wk[4][2], wv[4][2], gqk[4][4], gv[4][4];
#pragma unroll
            for (int k = 0; k < 4; ++k) { const f32x4 v = ldgf4(a.in[I_B_CONV_W] + k * MI + n4); cw[k][0] = (f32x2){v[0], v[1]}; cw[k][1] = (f32x2){v[2], v[3]}; }
            { const f32x4 v = ldgf4(a.in[I_B_CONV_B] + n4); cb[0] = (f32x2){v[0], v[1]}; cb[1] = (f32x2){v[2], v[3]}; }
#pragma unroll
            for (int i = 0; i < 4; ++i) { const f32x4 q_ = ldgf4(a.in[I_B_W_Q] + tid * 16 + i * 4), k_ = ldgf4(a.in[I_B_W_K] + tid * 16 + i * 4), v_ = ldgf4(a.in[I_B_W_V] + tid * 16 + i * 4);
                wq[i][0] = (f32x2){q_[0], q_[1]}; wq[i][1] = (f32x2){q_[2], q_[3]}; wk[i][0] = (f32x2){k_[0], k_[1]}; wk[i][1] = (f32x2){k_[2], k_[3]}; wv[i][0] = (f32x2){v_[0], v_[1]}; wv[i][1] = (f32x2){v_[2], v_[3]}; }
#pragma unroll
            for (int i = 0; i < 4; ++i)
#pragma unroll
                for (int e = 0; e < 4; ++e) { gqk[i][e] = (f32x2){0.f, 0.f}; gv[i][e] = (f32x2){0.f, 0.f}; }
#pragma unroll
            for (int j = 0; j < 4; ++j) { const float* pwg = a.in[I_B_W_GATE];
                const f32x4 a0 = ldgf4(pwg + (size_t)(0 * MI + n4 + j) * 8), a1 = ldgf4(pwg + (size_t)(0 * MI + n4 + j) * 8 + 4);
                const f32x4 b0 = ldgf4(pwg + (size_t)(1 * MI + n4 + j) * 8), b1 = ldgf4(pwg + (size_t)(1 * MI + n4 + j) * 8 + 4);
                const f32x4 c0 = ldgf4(pwg + (size_t)(2 * MI + n4 + j) * 8), c1 = ldgf4(pwg + (size_t)(2 * MI + n4 + j) * 8 + 4);
                const f32x2 ga[4] = {(f32x2){a0[0], a0[1]}, (f32x2){a0[2], a0[3]}, (f32x2){a1[0], a1[1]}, (f32x2){a1[2], a1[3]}};
                const f32x2 gb[4] = {(f32x2){b0[0], b0[1]}, (f32x2){b0[2], b0[3]}, (f32x2){b1[0], b1[1]}, (f32x2){b1[2], b1[3]}};
                const f32x2 gc[4] = {(f32x2){c0[0], c0[1]}, (f32x2){c0[2], c0[3]}, (f32x2){c1[0], c1[1]}, (f32x2){c1[2], c1[3]}};
#pragma unroll
                for (int i = 0; i < 4; ++i) { const float wq_ = wq[i][j >> 1][j & 1], wk_ = wk[i][j >> 1][j & 1], wv_ = wv[i][j >> 1][j & 1];
#pragma unroll
                    for (int e = 0; e < 4; ++e) { gqk[i][e] += ga[e] * wq_ + gb[e] * wk_; gv[i][e] += gc[e] * wv_; } } }
            f32x2 x0[2], x1[2], x2[2], x3[2];
#pragma unroll
            for (int p = 0; p < 2; ++p) { x0[p] = (f32x2){0.f, 0.f}; x1[p] = x0[p]; x2[p] = x0[p]; }
            if (t0 > 0) { const u32x2 p0 = ldg8(XM + (size_t)(t0 - 3) * MI + n4), p1 = ldg8(XM + (size_t)(t0 - 2) * MI + n4), p2 = ldg8(XM + (size_t)(t0 - 1) * MI + n4);
                x0[0] = (f32x2){bflo(p0.x), bfhi(p0.x)}; x0[1] = (f32x2){bflo(p0.y), bfhi(p0.y)}; x1[0] = (f32x2){bflo(p1.x), bfhi(p1.x)}; x1[1] = (f32x2){bflo(p1.y), bfhi(p1.y)};
                x2[0] = (f32x2){bflo(p2.x), bfhi(p2.x)}; x2[1] = (f32x2){bflo(p2.y), bfhi(p2.y)}; }
            u32x2 xs[8], xn[8];
#pragma unroll
            for (int b = 0; b < 8; ++b) xs[b] = ldg8(XM + (size_t)(t0 + b) * MI + n4);
#pragma unroll 1
            for (int tl0 = 0; tl0 < 64; tl0 += 8) {
              { const int tn = (tl0 + 8 < 64) ? tl0 + 8 : tl0;
#pragma unroll
                for (int b = 0; b < 8; ++b) xn[b] = ldg8(XM + (size_t)(t0 + tn + b) * MI + n4); }
#pragma unroll 1
              for (int b = 0; b < 8; ++b) {
                const int tl = tl0 + b, t = t0 + tl;
                { const u32x2 p3 = xs[0];
#pragma unroll
                  for (int q = 0; q < 7; ++q) xs[q] = xs[q + 1];
                  x3[0] = (f32x2){bflo(p3.x), bfhi(p3.x)}; x3[1] = (f32x2){bflo(p3.y), bfhi(p3.y)}; }
                float xc[4]; f32x2 q2[2], k2[2], v2[2];
#pragma unroll
                for (int p = 0; p < 2; ++p) { const f32x2 cv = cb[p] + cw[0][p] * x0[p] + cw[1][p] * x1[p] + cw[2][p] * x2[p] + cw[3][p] * x3[p]; xc[2 * p] = silu_f(cv[0]); xc[2 * p + 1] = silu_f(cv[1]); }
                const float xm[4] = {x3[0][0], x3[0][1], x3[1][0], x3[1][1]};
#pragma unroll
                for (int p = 0; p < 2; ++p) { q2[p] = wq[0][p] * xc[0] + wq[1][p] * xc[1] + wq[2][p] * xc[2] + wq[3][p] * xc[3]; k2[p] = wk[0][p] * xc[0] + wk[1][p] * xc[1] + wk[2][p] * xc[2] + wk[3][p] * xc[3];
                    v2[p] = wv[0][p] * xm[0] + wv[1][p] * xm[1] + wv[2][p] * xm[2] + wv[3][p] * xm[3]; }
                { u32x2 w; w.x = cvt_pk_bf16(q2[0][0], q2[0][1]); w.y = cvt_pk_bf16(q2[1][0], q2[1][1]); stg8(Q + (size_t)t * MI + n4, w);
                  w.x = cvt_pk_bf16(k2[0][0] * kscale, k2[0][1] * kscale); w.y = cvt_pk_bf16(k2[1][0] * kscale, k2[1][1] * kscale); stg8(Kb + (size_t)t * MI + n4, w);
                  w.x = cvt_pk_bf16(xc[0], xc[1]); w.y = cvt_pk_bf16(xc[2], xc[3]); stg8(XC + (size_t)t * MI + n4, w);
                  (void)v2; }
                f32x2 g2[4];
#pragma unroll
                for (int e = 0; e < 4; ++e) g2[e] = gqk[0][e] * xc[0] + gqk[1][e] * xc[1] + gqk[2][e] * xc[2] + gqk[3][e] * xc[3] + gv[0][e] * xm[0] + gv[1][e] * xm[1] + gv[2][e] * xm[2] + gv[3][e] * xm[3];
                const float g[8] = {g2[0][0], g2[0][1], g2[1][0], g2[1][1], g2[2][0], g2[2][1], g2[3][0], g2[3][1]};
                { const bool h5 = (lane & 32) != 0; float k4[4];
#pragma unroll
                  for (int e = 0; e < 4; ++e) { const float snd = h5 ? g[e] : g[4 + e], kp = h5 ? g[4 + e] : g[e]; k4[e] = kp + __shfl_xor(snd, 32); }
                  const bool h4 = (lane & 16) != 0; float k2_[2];
#pragma unroll
                  for (int e = 0; e < 2; ++e) { const float snd = h4 ? k4[e] : k4[2 + e], kp = h4 ? k4[2 + e] : k4[e]; k2_[e] = kp + __shfl_xor(snd, 16); }
                  const bool h3 = (lane & 8) != 0; const float snd = h3 ? k2_[0] : k2_[1], kp = h3 ? k2_[1] : k2_[0]; float k1 = kp + __shfl_xor(snd, 8);
                  k1 += __shfl_xor(k1, 4); k1 += __shfl_xor(k1, 2); k1 += __shfl_xor(k1, 1);
                  if ((lane & 7) == 0) red[(tl * 8 + wave) * 8 + (lane >> 3)] = k1; }
#pragma unroll
                for (int p = 0; p < 2; ++p) { x0[p] = x1[p]; x1[p] = x2[p]; x2[p] = x3[p]; }
              }
#pragma unroll
              for (int b = 0; b < 8; ++b) xs[b] = xn[b];
            }
        }
        __syncthreads();
        { const int tid = otid(), tok = tid >> 3, e = tid & 7; float s = ldgf(a.in[I_B_B_GATE] + e);
#pragma unroll
            for (int w = 0; w < 8; ++w) s += red[(tok * 8 + w) * 8 + e];
            if (e < 4) stgf(GI + (size_t)e * T + t0 + tok, s); else stgf(GF + (size_t)(e - 4) * T + t0 + tok, -softplus_f(-s)); }
        __syncthreads();
    }
}
__device__ __forceinline__ void ph_ml_gscan(const Args& a, LAS unsigned char* lds, int bid, int nb) {
    const int tid = otid(), lane = tid & 63, wave = tid >> 6;
    const float* GI = (const float*)(a.ws + WS_GI); const float* GF = (const float*)(a.ws + WS_GF);
    float* GS = (float*)(a.ws + WS_GS); float* RMT = (float*)(a.ws + WS_RMT); float* EF = (float*)(a.ws + WS_EF); float* MC = (float*)(a.ws + WS_MC);
    LAS float* wt = (LAS float*)lds;
    for (int h = bid; h < MH; h += nb) {
        __syncthreads();
        float lf[32], ig[32]; float s = 0.f;
#pragma unroll
        for (int q = 0; q < 8; ++q) { const f32x4 v = ldgf4(GF + (size_t)h * T + tid * 32 + 4 * q), w = ldgf4(GI + (size_t)h * T + tid * 32 + 4 * q);
            lf[4 * q] = v[0]; lf[4 * q + 1] = v[1]; lf[4 * q + 2] = v[2]; lf[4 * q + 3] = v[3]; ig[4 * q] = w[0]; ig[4 * q + 1] = w[1]; ig[4 * q + 2] = w[2]; ig[4 * q + 3] = w[3]; }
#pragma unroll
        for (int i = 0; i < 32; ++i) s += lf[i];
        float inc = s;
#pragma unroll
        for (int off = 1; off < 64; off <<= 1) { const float y = __shfl_up(inc, off); if (lane >= off) inc += y; }
        if (lane == 63) wt[wave] = inc;
        __syncthreads();
        float base = inc - s;
#pragma unroll
        for (int w = 0; w < 8; ++w) if (w < wave) base += wt[w];
        float F = base, lmax = -3.0e38f;
#pragma unroll
        for (int i = 0; i < 32; ++i) { F += lf[i]; lf[i] = F; ig[i] = ig[i] - F; lmax = fmaxf(lmax, ig[i]); }
        float minc = lmax;
#pragma unroll
        for (int off = 1; off < 64; off <<= 1) { const float y = __shfl_up(minc, off); if (lane >= off) minc = fmaxf(minc, y); }
        __syncthreads();
        if (lane == 63) wt[8 + wave] = minc;
        __syncthreads();
        float pm = __shfl_up(minc, 1); if (lane == 0) pm = -3.0e38f;
#pragma unroll
        for (int w = 0; w < 8; ++w) if (w < wave) pm = fmaxf(pm, wt[8 + w]);
        float rm = fmaxf(pm, 0.f);
#pragma unroll
        for (int i = 0; i < 32; ++i) { rm = fmaxf(rm, ig[i]); const size_t o = (size_t)h * T + tid * 32 + i; stgf(GS + o, ig[i]); stgf(RMT + o, rm); stgf(EF + o, __expf(-lf[i] - rm)); }
        if ((tid & 7) == 7) stgf(MC + h * 80 + (tid + 1) / 8, rm);
        if (tid == 0) stgf(MC + h * 80, 0.f);
    }
    __syncthreads();
}
__device__ __forceinline__ void ph_ml_ktw(const Args& a, LAS unsigned char* lds, int bid, int nb) {
    const bf16* Kn = (const bf16*)(a.ws + WS_K); const bf16* Xm = (const bf16*)(a.ws + WS_XM); bf16* KT = (bf16*)(a.ws + WS_KT); bf16* VT = (bf16*)(a.ws + WS_VT);
    const float* GS = (const float*)(a.ws + WS_GS); const float* MC = (const float*)(a.ws + WS_MC); float* NS = (float*)(a.ws + WS_NS);
    LAS float* w = (LAS float*)(lds + EXTRA_OFF); constexpr int TS = 144;
    for (int u = bid; u < MNC * MH; u += nb) { const int c = u / MH, h = u % MH; const int tid = otid(), lane = tid & 63, wave = tid >> 6;
        LAS unsigned char* tile = lds + wave * 16384;
        __syncthreads();
        if (tid < MCH) w[tid] = __expf(ldgf(GS + (size_t)h * T + c * MCH + tid) - ldgf(MC + h * 80 + c + 1));
        __syncthreads();
        const int ch0 = h * HD + wave * 64, rr = lane >> 3, c8 = lane & 7;
        f32x2 wvv[2][4][2];
#pragma unroll
        for (int bk = 0; bk < 2; ++bk)
#pragma unroll
            for (int i = 0; i < 4; ++i) { const f32x4 wr = ldgf4(a.in[I_B_W_V] + (size_t)((ch0 + c8 * 8) / 4 + bk) * 16 + i * 4); wvv[bk][i][0] = (f32x2){wr[0], wr[1]}; wvv[bk][i][1] = (f32x2){wr[2], wr[3]}; }
        float psum[8];
#pragma unroll
        for (int i = 0; i < 8; ++i) psum[i] = 0.f;
#pragma unroll 1
        for (int pass = 0; pass < 8; ++pass) { const int isv = pass >> 2, tg = pass & 3; const bf16* src = (isv ? Xm : Kn) + (size_t)(c * MCH + tg * 64) * MI + ch0; bf16* dst = (isv ? VT : KT) + (size_t)ch0 * LDT + c * MCH + tg * 64;
            u32x4 x[8];
#pragma unroll
            for (int i = 0; i < 8; ++i) x[i] = ldg16(src + (size_t)(rr + 8 * i) * MI + c8 * 8);
            if (isv) {
#pragma unroll
                for (int i = 0; i < 8; ++i) { const u32x4 xx = x[i]; const float xa[4] = {bflo(xx.x), bfhi(xx.x), bflo(xx.y), bfhi(xx.y)}, xb[4] = {bflo(xx.z), bfhi(xx.z), bflo(xx.w), bfhi(xx.w)};
                    const f32x2 va0 = wvv[0][0][0] * xa[0] + wvv[0][1][0] * xa[1] + wvv[0][2][0] * xa[2] + wvv[0][3][0] * xa[3], va1 = wvv[0][0][1] * xa[0] + wvv[0][1][1] * xa[1] + wvv[0][2][1] * xa[2] + wvv[0][3][1] * xa[3];
                    const f32x2 vb0 = wvv[1][0][0] * xb[0] + wvv[1][1][0] * xb[1] + wvv[1][2][0] * xb[2] + wvv[1][3][0] * xb[3], vb1 = wvv[1][0][1] * xb[0] + wvv[1][1][1] * xb[1] + wvv[1][2][1] * xb[2] + wvv[1][3][1] * xb[3];
                    u32x4 o; o.x = cvt_pk_bf16(va0[0], va0[1]); o.y = cvt_pk_bf16(va1[0], va1[1]); o.z = cvt_pk_bf16(vb0[0], vb0[1]); o.w = cvt_pk_bf16(vb1[0], vb1[1]); x[i] = o; } }
#pragma unroll
            for (int i = 0; i < 8; ++i) *(LAS u32x4*)(tile + (rr + 8 * i) * TS + c8 * 16) = x[i];
            LDS_WAIT(); asm volatile("" ::: "memory");
#pragma unroll
            for (int i = 0; i < 8; ++i) { const int d = rr + 8 * i; const LAS bf16* tp = (const LAS bf16*)(tile + (c8 * 8) * TS) + d; float v[8];
#pragma unroll
                for (int q = 0; q < 8; ++q) v[q] = bf2f(tp[q * (TS / 2)]);
                if (!isv) { const LAS float* wp = w + tg * 64 + c8 * 8;
#pragma unroll
                    for (int q = 0; q < 8; ++q) v[q] *= wp[q]; }
                u32x4 o; o.x = cvt_pk_bf16(v[0], v[1]); o.y = cvt_pk_bf16(v[2], v[3]); o.z = cvt_pk_bf16(v[4], v[5]); o.w = cvt_pk_bf16(v[6], v[7]);
                if (!isv) psum[i] += (bflo(o.x) + bfhi(o.x)) + (bflo(o.y) + bfhi(o.y)) + (bflo(o.z) + bfhi(o.z)) + (bflo(o.w) + bfhi(o.w));
                stg16(dst + (size_t)d * LDT + c8 * 8, o); }
            LDS_WAIT(); asm volatile("" ::: "memory");
        }
#pragma unroll
        for (int i = 0; i < 8; ++i) { float ps = psum[i]; ps += __shfl_xor(ps, 1); ps += __shfl_xor(ps, 2); ps += __shfl_xor(ps, 4); if (c8 == 0) stgf(NS + (size_t)u * HD + wave * 64 + rr + 8 * i, ps); }
    }
    asm volatile("s_waitcnt vmcnt(0)" ::: "memory");
    __syncthreads();
}
__device__ __forceinline__ void ph_ml_sscan(const Args& a, int bid, int nb) {
    bf16* CT = (bf16*)(a.ws + WS_CT); float* NS = (float*)(a.ws + WS_NS); const float* MC = (const float*)(a.ws + WS_MC);
    { const int tid = otid(), lane = tid & 63, gw = bid * NWAVES + (tid >> 6), NGW = nb * NWAVES;
      static_assert(MNC == 64, "one lane per chunk");
      for (int it = gw; it < MH * HD; it += NGW) { const int h = it / HD, d = it % HD; float* q = NS + ((size_t)lane * MH + h) * HD + d;
          float H = ldgf(q), A = __expf(ldgf(MC + h * 80 + lane) - ldgf(MC + h * 80 + lane + 1));
#pragma unroll
          for (int off = 1; off < 64; off <<= 1) { const float Ay = __shfl_up(A, off), Hy = __shfl_up(H, off); if (lane >= off) { H = A * Hy + H; A = A * Ay; } }
          float o = __shfl_up(H, 1); if (lane == 0) o = 0.f; stgf(q, o); } }
    for (int it = bid * NTHR + otid(); it < MH * HD * (HD / 8); it += nb * NTHR) {
        const int h = it / (HD * (HD / 8)), rem = it % (HD * (HD / 8)); bf16* p = CT + (size_t)h * HD * HD + (size_t)rem * 8; const size_t cs = (size_t)MH * HD * HD;
        float run[8];
#pragma unroll
        for (int j = 0; j < 8; ++j) run[j] = 0.f;
        u32x4 sv[8], sn[8];
#pragma unroll
        for (int q = 0; q < 8; ++q) sv[q] = ldg16(p + (size_t)q * cs);
        for (int c0 = 0; c0 < MNC; c0 += 8) {
            float dec[8]; const int cn = (c0 + 8 < MNC) ? c0 + 8 : c0;
#pragma unroll
            for (int q = 0; q < 8; ++q) { sn[q] = ldg16(p + (size_t)(cn + q) * cs); dec[q] = __expf(ldgf(MC + h * 80 + c0 + q) - ldgf(MC + h * 80 + c0 + q + 1)); }
#pragma unroll
            for (int q = 0; q < 8; ++q) { u32x4 o; o.x = cvt_pk_bf16(run[0], run[1]); o.y = cvt_pk_bf16(run[2], run[3]); o.z = cvt_pk_bf16(run[4], run[5]); o.w = cvt_pk_bf16(run[6], run[7]);
                stg16(p + (size_t)(c0 + q) * cs, o);
                run[0] = dec[q] * run[0] + bflo(sv[q].x); run[1] = dec[q] * run[1] + bfhi(sv[q].x); run[2] = dec[q] * run[2] + bflo(sv[q].y); run[3] = dec[q] * run[3] + bfhi(sv[q].y);
                run[4] = dec[q] * run[4] + bflo(sv[q].z); run[5] = dec[q] * run[5] + bfhi(sv[q].z); run[6] = dec[q] * run[6] + bflo(sv[q].w); run[7] = dec[q] * run[7] + bfhi(sv[q].w); }
#pragma unroll
            for (int q = 0; q < 8; ++q) sv[q] = sn[q];
        }
    }
}
struct FinIn { u32x4 nu, qv, zv, xv; f32x4 n0, n1, dp, g0, g1, k0, k1; float mc, rmt, ef; };
__device__ __forceinline__ FinIn fin_load(const Args& a, int it, int e0) {
    const bf16* NUM = (const bf16*)(a.ws + WS_NUM); const bf16* Q = (const bf16*)(a.ws + WS_Q); const bf16* Z = (const bf16*)(a.ws + WS_Z); const bf16* XC = (const bf16*)(a.ws + WS_XC);
    const float* NS = (const float*)(a.ws + WS_NS); const float* DENP = (const float*)(a.ws + WS_DENP); const float* MC = (const float*)(a.ws + WS_MC); const float* RMT = (const float*)(a.ws + WS_RMT); const float* EF = (const float*)(a.ws + WS_EF);
    const int t = it >> 2, h = it & 3, c = t >> 8, r = t & 255; const size_t o = (size_t)t * MI + h * HD + e0, cth = (size_t)(c * MH + h);
    FinIn f; f.nu = ldg16(NUM + o); f.qv = ldg16(Q + o); f.zv = ldg16(Z + o); f.xv = ldg16(XC + o);
    f.n0 = ldgf4(NS + cth * HD + e0); f.n1 = ldgf4(NS + cth * HD + e0 + 4); f.dp = ldgf4(DENP + (cth * MCH + r) * 4);
    f.g0 = ldgf4(a.in[I_B_NORM] + h * HD + e0); f.g1 = ldgf4(a.in[I_B_NORM] + h * HD + e0 + 4); f.k0 = ldgf4(a.in[I_B_SKIP] + h * HD + e0); f.k1 = ldgf4(a.in[I_B_SKIP] + h * HD + e0 + 4);
    f.mc = ldgf(MC + h * 80 + c); f.rmt = ldgf(RMT + (size_t)h * T + t); f.ef = ldgf(EF + (size_t)h * T + t); return f;
}
__device__ __forceinline__ void fin_compute(const Args& a, int it, int e0, const FinIn& f) {
    bf16* Y = (bf16*)(a.ws + WS_Y); const int t = it >> 2, h = it & 3; const size_t o = (size_t)t * MI + h * HD + e0;
    const u32x4 nu = f.nu, qv = f.qv, zv = f.zv, xv = f.xv;
    const f32x2 num[4] = {(f32x2){bflo(nu.x), bfhi(nu.x)}, (f32x2){bflo(nu.y), bfhi(nu.y)}, (f32x2){bflo(nu.z), bfhi(nu.z)}, (f32x2){bflo(nu.w), bfhi(nu.w)}};
    const f32x2 qq[4] = {(f32x2){bflo(qv.x), bfhi(qv.x)}, (f32x2){bflo(qv.y), bfhi(qv.y)}, (f32x2){bflo(qv.z), bfhi(qv.z)}, (f32x2){bflo(qv.w), bfhi(qv.w)}};
    const f32x2 nn[4] = {(f32x2){f.n0[0], f.n0[1]}, (f32x2){f.n0[2], f.n0[3]}, (f32x2){f.n1[0], f.n1[1]}, (f32x2){f.n1[2], f.n1[3]}};
    const f32x2 qn2 = (qq[0] * nn[0] + qq[1] * nn[1]) + (qq[2] * nn[2] + qq[3] * nn[3]);
    const float qn = wave_sum(qn2[0] + qn2[1]);
    const float rs = __expf(f.mc - f.rmt), den = rs * ((f.dp[0] + f.dp[1]) + (f.dp[2] + f.dp[3]) + qn);
    const float inv = __builtin_amdgcn_rcpf(fmaxf(fabsf(den), f.ef));
    f32x2 hc[4], s2 = (f32x2){0.f, 0.f};
#pragma unroll
    for (int i = 0; i < 4; ++i) { hc[i] = num[i] * inv; s2 += hc[i] * hc[i]; }
    const float rstd = __builtin_amdgcn_rsqf(wave_sum(s2[0] + s2[1]) * (1.0f / HD) + EPS);
    const f32x2 gg[4] = {(f32x2){f.g0[0], f.g0[1]}, (f32x2){f.g0[2], f.g0[3]}, (f32x2){f.g1[0], f.g1[1]}, (f32x2){f.g1[2], f.g1[3]}};
    const f32x2 sk[4] = {(f32x2){f.k0[0], f.k0[1]}, (f32x2){f.k0[2], f.k0[3]}, (f32x2){f.k1[0], f.k1[1]}, (f32x2){f.k1[2], f.k1[3]}};
    const f32x2 zz[4] = {(f32x2){bflo(zv.x), bfhi(zv.x)}, (f32x2){bflo(zv.y), bfhi(zv.y)}, (f32x2){bflo(zv.z), bfhi(zv.z)}, (f32x2){bflo(zv.w), bfhi(zv.w)}};
    const f32x2 xx[4] = {(f32x2){bflo(xv.x), bfhi(xv.x)}, (f32x2){bflo(xv.y), bfhi(xv.y)}, (f32x2){bflo(xv.z), bfhi(xv.z)}, (f32x2){bflo(xv.w), bfhi(xv.w)}};
    f32x2 y[4];
#pragma unroll
    for (int i = 0; i < 4; ++i) { const f32x2 zl = zz[i] * -1.4426950408889634f; f32x2 e; e[0] = __builtin_amdgcn_exp2f(zl[0]); e[1] = __builtin_amdgcn_exp2f(zl[1]);
        const f32x2 d = e + 1.0f; f32x2 sg; sg[0] = __builtin_amdgcn_rcpf(d[0]); sg[1] = __builtin_amdgcn_rcpf(d[1]);
        y[i] = sg * ((hc[i] * rstd) * gg[i] + sk[i] * xx[i]); }
    u32x4 w; w.x = cvt_pk_bf16(y[0][0], y[0][1]); w.y = cvt_pk_bf16(y[1][0], y[1][1]); w.z = cvt_pk_bf16(y[2][0], y[2][1]); w.w = cvt_pk_bf16(y[3][0], y[3][1]);
    stg16(Y + o, w);
}
__device__ __forceinline__ void ph_ml_fin(const Args& a, int bid, int nb) {
    const int tid = otid(), lane = tid & 63, wave = tid >> 6, e0 = 8 * lane;
    asm volatile("s_waitcnt vmcnt(0)" ::: "memory"); __syncthreads();
    for (int p = bid; p < MNC * MH; p += nb) { const int ch = p / MH, h = p % MH;
        for (int r = wave; r < MCH; r += 4 * NWAVES) { const int i0 = ((ch * MCH + r) << 2) + h, st = NWAVES << 2;
            const FinIn f0 = fin_load(a, i0, e0), f1 = fin_load(a, i0 + st, e0), f2 = fin_load(a, i0 + 2 * st, e0), f3 = fin_load(a, i0 + 3 * st, e0);
            fin_compute(a, i0, e0, f0); fin_compute(a, i0 + st, e0, f1); fin_compute(a, i0 + 2 * st, e0, f2); fin_compute(a, i0 + 3 * st, e0, f3); } }
}

__device__ __forceinline__ void ph_s5_scan(const Args& a, LAS unsigned char* lds, int bid, int nb) {
    const int tid = otid(), pl = tid & 15, seg = tid >> 4;
    const float* EB = (const float*)(a.ws + WS_EB); bf16* UP = (bf16*)(a.ws + WS_UP); LAS float* tot = (LAS float*)lds;
    for (int u = bid; u < NG * 4; u += nb) {
        const int g = u >> 2, p = 16 * (u & 3) + pl;
        const float are = ldgf(a.in[I_C_A_RE] + g * 64 + p), aim = ldgf(a.in[I_C_A_IM] + g * 64 + p), dl = __expf(ldgf(a.in[I_C_LOG_STEP] + g));
        float lr, li; { const float mag = __expf(dl * are); float sn, cs; sincosf(dl * aim, &sn, &cs); lr = mag * cs; li = mag * sn; }
#pragma unroll
        for (int q = 0; q < 4; ++q) { const float nr = lr * lr - li * li, ni = 2.f * lr * li; lr = nr; li = ni; }
        float sr = lr, si = li;
#pragma unroll
        for (int q = 0; q < 5; ++q) { const float nr = sr * sr - si * si, ni = 2.f * sr * si; sr = nr; si = ni; }
        const float* eb = EB + ((size_t)g * SNC + seg * 32) * 128 + p;
        float str = 0.f, sti = 0.f;
#pragma unroll 8
        for (int c = 0; c < 32; ++c) { const float er = ldgf(eb + (size_t)c * 128), ei = ldgf(eb + (size_t)c * 128 + 64); const float nr = lr * str - li * sti + er, ni = lr * sti + li * str + ei; str = nr; sti = ni; }
        __syncthreads();
        tot[(seg * 16 + pl) * 2] = str; tot[(seg * 16 + pl) * 2 + 1] = sti;
        __syncthreads();
        float cr = 0.f, ci = 0.f;
        for (int s = 0; s < seg; ++s) { const float tr = tot[(s * 16 + pl) * 2], ti = tot[(s * 16 + pl) * 2 + 1]; const float nr = sr * cr - si * ci + tr, ni = sr * ci + si * cr + ti; cr = nr; ci = ni; }
        bf16* up = UP + ((size_t)g * SNC + seg * 32) * SK + 256 + p;
        str = cr; sti = ci;
#pragma unroll 8
        for (int c = 0; c < 32; ++c) { stgh(up + (size_t)c * SK, f2bf(str)); stgh(up + (size_t)c * SK + 64, f2bf(sti));
            const float er = ldgf(eb + (size_t)c * 128), ei = ldgf(eb + (size_t)c * 128 + 64); const float nr = lr * str - li * sti + er, ni = lr * sti + li * str + ei; str = nr; sti = ni; }
    }
    __syncthreads();
}
#ifndef MK_PER_PHASE
#define MK_PER_PHASE 0
#endif
constexpr int NPHASES = 38 - 4 * DEFER_NORM;
__global__ void __launch_bounds__(NTHR, 2) mega_fwd(Args args0) {
    extern __shared__ __attribute__((aligned(16))) unsigned char lds_raw[];
    LAS unsigned char* lds = (LAS unsigned char*)lds_raw;
    const int tid = threadIdx.x, bid0 = blockIdx.x, nb0 = gridDim.x;
    if (tid < 16) ((LAS unsigned*)(lds + MISC_OFF))[tid] = 0u;
    __syncthreads();
    XcdBarrier bar = xcd_barrier_post((unsigned*)(args0.ws + WS_CTL) + CW_BAR + args0.li * 4096, (volatile LAS unsigned*)(lds + MISC_OFF));
    int pc = 0; const int lo = args0.ph_lo, hi = args0.ph_hi;
#ifndef PH_REP
#define PH_REP 0ull
#endif
#ifndef PH_REPN
#define PH_REPN 1
#endif
#ifndef XBAR_EXTRA
#define XBAR_EXTRA 0
#endif
#ifndef PH_MASK
#define PH_MASK 0xFFFFFFFFull
#endif
#define PHASE(id, ...) do { if (((PH_MASK >> (id)) & 1ull) && pc >= lo && pc < hi) { { int bid = bid0, nb = nb0; unsigned char* ws = args0.ws; asm volatile("" : "+s"(bid), "+s"(nb), "+s"(ws)); Args args = args0; args.ws = ws; const int tidl = otid(), lane = tidl & 63, wave = tidl >> 6; const int gw = bid * NWAVES + wave, NGW = nb * NWAVES; bf16* HN = (bf16*)(ws + WS_HN); LAS float* scr = (LAS float*)(lds + wave * 16384); for (int rep_ = 0; rep_ < 1 + (int)((PH_REP >> (id)) & 1ull) * PH_REPN; ++rep_) { __VA_ARGS__; __syncthreads(); } } if (pc + 1 < hi) xcd_barrier(bar); } ++pc; } while (0)


#define XSRC(l) ((l) == 0 ? args.in[I_X] : (const float*)args.out)
#define GMIX(l) (args.in[I_NORM_MIX] + (l) * D)
#define GFFN(l) (args.in[I_NORM_FFN] + (l) * D)
#define DQ_TAIL(nun_, TL, TH, q_) do { if ((TL) >= 0) { const int nu__ = (nun_); const int mine_ = bid < nu__ ? (nu__ - 1 - bid) / nb + 1 : 0, mx_ = (nu__ - 1) / nb + 1; \
        if (mine_ < mx_) dq_work(args, (TL), (TH), (q_) * (mx_ - mine_), lds, scr); } } while (0)
#define DQ_DRAIN(G) do { if ((G) >= 0) { dq_work(args, (G), (G), -1, lds, scr); __syncthreads(); } } while (0)
#define RG_MIXER(l, jl, CONVF, TL, TH, RSI, EM, DR)   \
    PHASE(3, { if (RG_F8(jl)) { Sched2D S{(const char*)HN, (const char*)(ws + WS_WA_IN) + (size_t)(jl) * 2 * RW * D * 2, (unsigned)D / 2, (unsigned)D / 2, T / 256, 2 * RW / 256, nb, bid}; \
               pg8::Shape sh{D / 128, 0, (unsigned)D / 2, (unsigned)D / 2, 0u, 0u}; EpiBf16T<(RSI) != 0> E{(bf16*)(ws + WS_GX), RW, RW, (WS_XR - WS_GX) / 2, 0, 1.0f / 64.0f, (const float*)(ws + WS_RSS)}; \
               pg8::gemm_phase<EpiBf16T<(RSI) != 0>, Sched2D, false, false, true>(lds, sh, S, E); } \
               else { Sched2D S{(const char*)HN, (const char*)(ws + WS_WA_IN) + (size_t)(jl) * 2 * RW * D * 2, (unsigned)D, (unsigned)D, T / 256, 2 * RW / 256, nb, bid}; \
               pg8::Shape sh{D / 64, 0, (unsigned)D, (unsigned)D, 0u, 0u}; EpiBf16T<(RSI) != 0> E{(bf16*)(ws + WS_GX), RW, RW, (WS_XR - WS_GX) / 2, 0, 1.0f, (const float*)(ws + WS_RSS)}; \
               pg8::gemm_phase<EpiBf16T<(RSI) != 0>, Sched2D, false>(lds, sh, S, E); } DQ_TAIL((T / 256) * (2 * RW / 256), TL, TH, 2); } ); \
    PHASE(4, ph_rg_gates(args, lds, bid, nb, (jl)); ); \
    PHASE(5, ph_rg_carry(args, bid, nb); ); \
    PHASE(6, ph_rg_fix(args, bid, nb); ); \
    PHASE(7, { const bool early_ = ((bid >> 3) & 1) != 0;        \
               DQ_DRAIN(DR); \
               if ((CONVF) >= 0 && early_) { dq_work(args, DQ_MOE1, DQ_MOE1, -2, lds, scr); __syncthreads(); }     \
               { Sched2D S{(const char*)(ws + WS_GX), (const char*)(ws + WS_WA_OUT) + (size_t)(jl) * D * RW * 2, (unsigned)RW, (unsigned)RW, T / 256, D / 256, nb, bid}; \
               pg8::Shape sh{RW / 64, 0, (unsigned)RW, (unsigned)RW, 0u, 0u}; \
               if (EM) { EpiResidT<(EM) ? (EM) : 1> E{XSRC(l), args.out, ws + WS_HN, (float*)(ws + WS_RSS), (LAS float*)(lds + EXTRA_OFF), 1.0f}; pg8::gemm_phase<EpiResidT<(EM) ? (EM) : 1>, Sched2D, false>(lds, sh, S, E); } \
               else { EpiResid E{XSRC(l), args.out, nullptr, nullptr, nullptr, 1.0f}; pg8::gemm_phase<EpiResid, Sched2D, false>(lds, sh, S, E); } } \
               if ((CONVF) >= 0) { dq_work(args, DQ_MOE1, DQ_MOE1, -1, lds, scr); __syncthreads(); } } );
#define DENSE_FFN(l, W13O, W2O, GDR, TL, TH, F8, EM, DR)   \
    if (!DEFER_NORM) { PHASE(20, DQ_DRAIN(GDR); ph_norm<false, false, (F8) ? 3 : 0>(args, lds, bid, nb, args.out, args.out, GFFN(l), 0); ); } \
    PHASE(21, { if (F8) { Sched2D S{(const char*)HN, (const char*)(ws + (W13O)), (unsigned)D / 2, (unsigned)D / 2, T / 256, 2 * FF / 256, nb, bid}; \
                          pg8::Shape sh{D / 128, 0, (unsigned)D / 2, (unsigned)D / 2, 0u, 0u}; EpiSwiglu8T<DEFER_NORM != 0> E{ws + WS_H, (const float*)(ws + WS_RSS)}; \
                          pg8::gemm_phase<EpiSwiglu8T<DEFER_NORM != 0>, Sched2D, false, false, true>(lds, sh, S, E); } \
                else { Sched2D S{(const char*)HN, (const char*)(ws + (W13O)), (unsigned)D, (unsigned)D, T / 256, 2 * FF / 256, nb, bid}; \
                       pg8::Shape sh{D / 64, 0, (unsigned)D, (unsigned)D, 0u, 0u}; EpiSwigluT<DEFER_NORM != 0> E{(bf16*)(ws + WS_H), (const float*)(ws + WS_RSS)}; \
                       pg8::gemm_phase<EpiSwigluT<DEFER_NORM != 0>, Sched2D, false>(lds, sh, S, E); } \
                DQ_TAIL((T / 256) * (2 * FF / 256), TL, TH, 2); \
                if ((l) == 0 && bid >= nb / 2) s5_mats(args, lds, bid - nb / 2, nb / 2); } );     \
    PHASE(22, { if (DEFER_NORM) DQ_DRAIN(DR); \
                if (F8) { Sched2D S{(const char*)(ws + WS_H), (const char*)(ws + (W2O)), (unsigned)FF / 2, (unsigned)FF / 2, T / 256, D / 256, nb, bid}; \
                          pg8::Shape sh{FF / 128, 0, (unsigned)FF / 2, (unsigned)FF / 2, 0u, 0u}; EpiResidT<DEFER_NORM ? (EM) : 0> E{args.out, args.out, ws + WS_HN, (float*)(ws + WS_RSS), (LAS float*)(lds + EXTRA_OFF), 1.0f / 64.0f}; \
                          pg8::gemm_phase<EpiResidT<DEFER_NORM ? (EM) : 0>, Sched2D, false, false, true>(lds, sh, S, E); } \
                else { Sched2D S{(const char*)(ws + WS_H), (const char*)(ws + (W2O)), (unsigned)FF, (unsigned)FF, T / 256, D / 256, nb, bid}; \
                       pg8::Shape sh{FF / 64, 0, (unsigned)FF, (unsigned)FF, 0u, 0u}; EpiResidT<DEFER_NORM ? (EM) : 0> E{args.out, args.out, ws + WS_HN, (float*)(ws + WS_RSS), (LAS float*)(lds + EXTRA_OFF), 1.0f}; \
                       pg8::gemm_phase<EpiResidT<DEFER_NORM ? (EM) : 0>, Sched2D, false>(lds, sh, S, E); } } );
#define MOE_FFN(l, f, CONV, TL, TH, F8) \
    PHASE(23, if (CONV) { conv_moe(args, (f), gw, NGW, scr, lane); __syncthreads(); } ph_norm<false, true, (F8) ? 3 : 0>(args, lds, bid, nb, args.out, args.out, GFFN(l), (f)); ); \
    PHASE(25, { SchedMoe S; S.A = (const char*)HN; S.B = (const char*)(ws + WS_W13); S.lda = (F8) ? D / 2 : D; S.ldb = S.lda; S.bstride = (F8) ? W13_BYTES / 2 : W13_BYTES; S.nN = 2 * FF / 256; S.G = nb; S.c = bid; S.ksplit = 1; S.khbytes = 0; S.gather = 1; \
                int cnt_[NE]; moe_prefix(args, (f), S.ps, S.P, cnt_); LAS int* gt_ = (LAS int*)(lds + EXTRA_OFF); S.gt = gt_; \
                if (!(F8)) { const int* LISTE = (const int*)(ws + WS_LISTE); pg8::Unit u_; const int tid_ = otid(); \
                  _Pragma("unroll 1") for (int i_ = 0; S.next(i_, u_) && i_ < 23; ++i_) { const int e_ = u_.aux; int c_ = 0, p0_ = 0; \
                      _Pragma("unroll") for (int q_ = 0; q_ < NE; ++q_) { c_ = (e_ == q_) ? cnt_[q_] : c_; p0_ = (e_ == q_) ? S.ps[q_] : p0_; } \
                      const int r_ = (u_.pm - p0_) * 256 + tid_; if (tid_ < 256) gt_[i_ * 256 + tid_] = (r_ < c_) ? ldgi(LISTE + e_ * T + r_) : 0; } \
                  __syncthreads(); } \
                if (F8) { S.A = (const char*)(ws + WS_AGX); S.gather = 0; S.erows = T; pg8::Shape sh{D / 128, 0, (unsigned)D / 2, (unsigned)D / 2, 0u, 0u}; EpiSwiglu8 E{ws + WS_H};     \
                          pg8::gemm_phase<EpiSwiglu8, SchedMoe, false, false, true>(lds, sh, S, E); } \
                else { pg8::Shape sh{D / 64, 0, (unsigned)D, (unsigned)D, 0u, 0u}; EpiSwiglu E{(bf16*)(ws + WS_H)}; \
                       pg8::gemm_phase<EpiSwiglu, SchedMoe, false, true>(lds, sh, S, E); } \
                DQ_TAIL(S.P * S.nN, TL, TH, 2); } ); \
    PHASE(26, { SchedMoe S; S.A = (const char*)(ws + WS_H); S.B = (const char*)(ws + ((F8) ? WS_W2T8 : WS_W2T)); S.lda = (F8) ? FF / 2 : FF; S.ldb = S.lda; S.bstride = (F8) ? W2_BYTES / 2 : W2_BYTES; S.nN = D / 256; S.G = nb; S.c = bid; \
                S.ksplit = (F8) ? 1 : 2; S.khbytes = FF; S.gather = 0; S.gt = nullptr; int cnt_[NE]; moe_prefix(args, (f), S.ps, S.P, cnt_); \
                if (F8) { pg8::Shape sh{FF / 128, 0, (unsigned)FF / 2, (unsigned)FF / 2, 0u, 0u}; EpiBf16 E{(bf16*)(ws + WS_AG), D, 0, 0, 0, 1.0f / 64.0f}; \
                          pg8::gemm_phase<EpiBf16, SchedMoe, false, false, true>(lds, sh, S, E); } \
                else { pg8::Shape sh{FF / 128, 0, (unsigned)FF, (unsigned)FF, 0u, 0u}; EpiBf16 E{(bf16*)(ws + WS_AG), D, 0, 0, (WS_OUT - WS_AG) / 2}; \
                       pg8::gemm_phase<EpiBf16, SchedMoe, false>(lds, sh, S, E); } \
                DQ_TAIL(S.P * S.nN * S.ksplit, TL, TH, 3); } );

        PHASE(0, conv_a(args, 0, gw, NGW, scr, lane); __syncthreads(); ph_norm<false, false, 0>(args, lds, bid, nb, XSRC(0), args.out, GMIX(0), 0); );
    RG_MIXER(0, 0, -1, DQ_DENSE0, DQ_C, 0, DEFER_NORM ? (DENSE_F8(0) ? 2 : 1) : 0, DEFER_NORM ? DQ_DENSE0 : -1)
    DENSE_FFN(0, WS_W13, WS_W2T, DQ_DENSE0, DQ_B, DQ_C, DENSE_F8(0), 1, DQ_B)
    if (!DEFER_NORM) { PHASE(1, DQ_DRAIN(DQ_B); ph_norm<false, false, 0>(args, lds, bid, nb, XSRC(1), args.out, GMIX(1), 0); ); }
    PHASE(8, { Sched2D S{(const char*)HN, (const char*)(ws + WS_WB_IN), (unsigned)D, (unsigned)D, T / 256, 2 * MI / 256, nb, bid};
               pg8::Shape sh{D / 64, 0, (unsigned)D, (unsigned)D, 0u, 0u}; EpiBf16T<DEFER_NORM != 0> E{(bf16*)(ws + WS_XM), MI, MI, (WS_Z - WS_XM) / 2, 0, 1.0f, (const float*)(ws + WS_RSS)};
               pg8::gemm_phase<EpiBf16T<DEFER_NORM != 0>, Sched2D, false>(lds, sh, S, E); } );
    PHASE(9, ph_ml_prep(args, lds, bid, nb); );
    PHASE(10, ph_ml_gscan(args, lds, bid, nb); );
    PHASE(11, { SchedSbuild S{(const char*)(ws + WS_Q), (const char*)(ws + WS_K), nb, bid};
                pg8::Shape sh{HD / 64, 0, (unsigned)MI, (unsigned)MI, 0u, 0u}; EpiSbuild E{(bf16*)(ws + WS_SM), (float*)(ws + WS_DENP), (const float*)(ws + WS_GS), (const float*)(ws + WS_MC)};
                pg8::gemm_phase<EpiSbuild, SchedSbuild, false>(lds, sh, S, E); }
              ph_ml_ktw(args, lds, bid, nb);
              { SchedState S{(const char*)(ws + WS_VT), (const char*)(ws + WS_KT), nb, bid};
                pg8::Shape sh{MCH / 64, 0, (unsigned)LDT, (unsigned)LDT, 0u, 0u}; EpiBf16 E{(bf16*)(ws + WS_CT), HD, 0, 0, (size_t)HD * HD};
                pg8::gemm_phase<EpiBf16, SchedState, false>(lds, sh, S, E); } );
    PHASE(28, ph_ml_sscan(args, bid, nb); );
    PHASE(13, { SchedPass2 S{(const char*)(ws + WS_SM), (const char*)(ws + WS_Q), (const char*)(ws + WS_VT), (const char*)(ws + WS_CT), nb, bid};
                pg8::Shape sh{MCH / 64, HD / 64, (unsigned)MCH, (unsigned)LDT, (unsigned)MI, (unsigned)HD}; EpiNum E{(bf16*)(ws + WS_NUM), (const float*)(ws + WS_RMT), (const float*)(ws + WS_MC)};
                pg8::gemm_phase<EpiNum, SchedPass2, true>(lds, sh, S, E); }
              ph_ml_fin(args, bid, nb); );
#ifndef ML_OUT_STAGGER
#define ML_OUT_STAGGER 1
#endif
    PHASE(15, { const bool early_ = !ML_OUT_STAGGER || ((bid >> 3) & 1) != 0;
                if (early_) { conv_moe(args, 0, gw, NGW, scr, lane); __syncthreads(); }
                { Sched2D S{(const char*)(ws + WS_Y), (const char*)(ws + WS_WB_OUT), (unsigned)MI, (unsigned)MI, T / 256, D / 256, nb, bid};
                pg8::Shape sh{MI / 64, 0, (unsigned)MI, (unsigned)MI, 0u, 0u}; EpiResid E{args.out, args.out, nullptr, nullptr, nullptr, 1.0f};
                pg8::gemm_phase<EpiResid, Sched2D, false>(lds, sh, S, E); }
                if (!early_) { conv_moe(args, 0, gw, NGW, scr, lane); __syncthreads(); } } );
    MOE_FFN(1, 0, false, DQ_DENSE1, DQ_A1, MOE_F8(0))
    PHASE(2, DQ_DRAIN(DQ_C); ph_norm<true, false, 1>(args, lds, bid, nb, XSRC(2), args.out, GMIX(2), 0); );
    PHASE(16, { SchedBatch S{(const char*)(ws + WS_UP), (const char*)(ws + WS_S5_BE), (unsigned)SK, 256u, (size_t)SNC * SK * 2, (size_t)256 * 256 * 2, SNC / 256, NG, nb, bid};
                pg8::Shape sh{4, 0, (unsigned)SK, 256u, 0u, 0u}; EpiS5e E{(float*)(ws + WS_EB)};
                pg8::gemm_phase<EpiS5e, SchedBatch, false>(lds, sh, S, E); } );
    PHASE(17, ph_s5_scan(args, lds, bid, nb); );
    PHASE(18, { SchedBatch S{(const char*)(ws + WS_UP), (const char*)(ws + WS_S5_KC), (unsigned)SK, (unsigned)SK, (size_t)SNC * SK * 2, (size_t)256 * SK * 2, SNC / 256, NG, nb, bid};
                pg8::Shape sh{SK / 64, 0, (unsigned)SK, (unsigned)SK, 0u, 0u}; EpiS5y E{(const bf16*)(ws + WS_UP), args.in[I_C_D], (bf16*)(ws + WS_YA)};
                pg8::gemm_phase<EpiS5y, SchedBatch, false>(lds, sh, S, E); } );
    PHASE(19, { if (DEFER_NORM) DQ_DRAIN(DQ_DENSE1);
                Sched2D S{(const char*)(ws + WS_YA), (const char*)(ws + WS_WC_GLU), (unsigned)D, (unsigned)D, T / 256, D / 256, nb, bid};
                pg8::Shape sh{D / 64, 0, (unsigned)D, (unsigned)D, 0u, 0u}; constexpr int EM_ = DEFER_NORM ? (DENSE_F8(1) ? 2 : 1) : 0;
                EpiGluT<EM_> E{(const bf16*)(ws + WS_YA), args.in[I_C_B_GLU], args.out, ws + WS_HN, (float*)(ws + WS_RSS), (LAS float*)(lds + EXTRA_OFF)};
                pg8::gemm_phase<EpiGluT<EM_>, Sched2D, false>(lds, sh, S, E); } );
    DENSE_FFN(2, WS_WD1_13, WS_WD1_2, DQ_DENSE1, DQ_MOE1, DQ_MOE1, DENSE_F8(1), (RG_F8(1) ? 2 : 1), DQ_A1)
    if (!DEFER_NORM) PHASE(1, DQ_DRAIN(DQ_A1); if (RG_F8(1)) ph_norm<false, false, 3>(args, lds, bid, nb, XSRC(3), args.out, GMIX(3), 0); else ph_norm<false, false, 0>(args, lds, bid, nb, XSRC(3), args.out, GMIX(3), 0); );
    RG_MIXER(3, 1, 1, DQ_MOE1, DQ_MOE1, DEFER_NORM, 0, -1)
    MOE_FFN(3, 1, false, -1, -1, MOE_F8(1))
    PHASE(27, ph_norm<true, false, 2>(args, lds, bid, nb, args.out, args.out, args.in[I_NORM_FINAL], 1); );
    for (int xb_ = 0; xb_ < XBAR_EXTRA; ++xb_) xcd_barrier(bar);
#undef PHASE
}

extern "C" void kernel_launch(void* const* d_in, const int* in_sizes, int n_in, void* d_out, int out_size, void* d_ws, size_t ws_size, hipStream_t stream) {
    static int grid = 0;
    if (grid == 0) {
        if (n_in != N_IN || in_sizes[0] != T * D || out_size != T * D || ws_size < WS_END) {
            fprintf(stderr, "kernel_launch: unexpected problem (n_in %d, in0 %d, out %d, ws %zu, need %zu)\n", n_in, n_in > 0 ? in_sizes[0] : -1, out_size, ws_size, (size_t)WS_END); grid = -1; return; }
        int dev = 0, cus = 0, per_cu = 0;
        if (hipGetDevice(&dev) != hipSuccess || hipDeviceGetAttribute(&cus, hipDeviceAttributeMultiprocessorCount, dev) != hipSuccess) { fprintf(stderr, "kernel_launch: device query failed\n"); grid = -1; return; }
        if (hipFuncSetAttribute((const void*)mega_fwd, hipFuncAttributeMaxDynamicSharedMemorySize, LDS_BYTES) != hipSuccess) { fprintf(stderr, "kernel_launch: hipFuncSetAttribute failed\n"); grid = -1; return; }
        if (hipOccupancyMaxActiveBlocksPerMultiprocessor(&per_cu, (const void*)mega_fwd, NTHR, LDS_BYTES) != hipSuccess || per_cu < 1) fprintf(stderr, "kernel_launch: occupancy query reports %d blocks per CU\n", per_cu);
        (void)hipGetLastError();
        if (cus < 256) { fprintf(stderr, "kernel_launch: %d CUs < 256: the 256-workgroup grid would not be resident\n", cus); grid = -1; return; }
        grid = 256;
    }
    if (grid < 0) return;
    if (hipMemsetAsync((char*)d_ws + WS_CTL, 0, CTL_ZERO_BYTES, stream) != hipSuccess) { fprintf(stderr, "kernel_launch: memset failed\n"); return; }
    Args a{};
    for (int i = 0; i < N_IN; ++i) a.in[i] = (const float*)d_in[i];
    a.out = (float*)d_out; a.ws = (unsigned char*)d_ws; a.pad = 0;
#if MK_PER_PHASE
    for (int k = 0; k < NPHASES; ++k) { a.ph_lo = k; a.ph_hi = k + 1; a.li = k; hipLaunchKernelGGL(mega_fwd, dim3(grid), dim3(NTHR), LDS_BYTES, stream, a); }
#else
    a.ph_lo = 0; a.ph_hi = NPHASES; a.li = 0;
    hipLaunchKernelGGL(mega_fwd, dim3(grid), dim3(NTHR), LDS_BYTES, stream, a);
#endif
    const hipError_t le = hipPeekAtLastError();
    if (le != hipSuccess) fprintf(stderr, "kernel_launch: launch failed: %s\n", hipGetErrorName(le));
}
```

```cpp
#include <hip/hip_runtime.h>
#include <cstdio>
#include <cstdint>

#define LAS __attribute__((address_space(3)))
#define GAS __attribute__((address_space(1)))
typedef unsigned short bf16;
typedef short bf16x8 __attribute__((ext_vector_type(8)));
typedef float f32x4 __attribute__((ext_vector_type(4)));
typedef float f32x2 __attribute__((ext_vector_type(2)));
typedef unsigned u32x4 __attribute__((ext_vector_type(4)));
typedef unsigned u32x2 __attribute__((ext_vector_type(2)));

__device__ __forceinline__ unsigned cvt_pk_bf16(float lo, float hi) { unsigned r; asm volatile("v_cvt_pk_bf16_f32 %0, %1, %2" : "=v"(r) : "v"(lo), "v"(hi)); return r; }
__device__ __forceinline__ float bflo(unsigned u) { return __uint_as_float(u << 16); }
__device__ __forceinline__ float bfhi(unsigned u) { return __uint_as_float(u & 0xffff0000u); }
__device__ __forceinline__ float bf2f(bf16 b) { return __uint_as_float(((unsigned)b) << 16); }
__device__ __forceinline__ bf16 f2bf(float f) { return (bf16)(cvt_pk_bf16(f, 0.f) & 0xffffu); }
__device__ __forceinline__ unsigned cvt4_fp8(float a, float b, float c, float d) { int p = 0; p = __builtin_amdgcn_cvt_pk_fp8_f32(a, b, p, false); p = __builtin_amdgcn_cvt_pk_fp8_f32(c, d, p, true); return (unsigned)p; }
__device__ __forceinline__ float sigm(float x) { return __builtin_amdgcn_rcpf(1.0f + __expf(-x)); }
__device__ __forceinline__ float silu_f(float x) { return x * sigm(x); }
__device__ __forceinline__ float gelu_tanh(float x) { return x * sigm(1.5957691216057308f * (x + 0.044715f * x * x * x)); }
__device__ __forceinline__ float softplus_f(float x) { return x > 20.f ? x : log1pf(__expf(x)); }

__device__ __forceinline__ int otid() { int t = threadIdx.x; asm volatile("" : "+v"(t)); return t; }
__device__ __forceinline__ void glds16(const char* sbase, unsigned voff, unsigned lds_dst) {
    unsigned keep;
    asm volatile("s_mov_b32 %0, m0\n\ts_mov_b32 m0, %3\n\ts_nop 0\n\tglobal_load_lds_dwordx4 %1, %2\n\ts_mov_b32 m0, %0" : "=&s"(keep) : "v"(voff), "s"(sbase), "s"(lds_dst) : "memory");
}
namespace pg8 {
constexpr int BM = 256, BK = 64, HALF = 128, HTB = HALF * BK * 2, STAGE_BYTES = 8 * HTB;
__host__ __device__ __forceinline__ int lds_byte(int r, int c) { const int st = (r >> 4) * 2 + (c >> 5), rr = r & 15, cc = c & 31, ob = rr * 64 + cc * 2; return st * 1024 + (ob ^ (((ob >> 9) & 1) << 5)); }
__host__ __device__ __forceinline__ void stage_rc(int b, int& R, int& C) { const int st = b / 1024, sb = b % 1024, swz = sb ^ (((sb >> 9) & 1) << 5); R = (st >> 1) * 16 + swz / 64; C = (st & 1) * 32 + (swz % 64) / 2; }
__host__ __device__ __forceinline__ int perm32(int rho) { const int n = rho >> 4, i = rho & 15; return 8 * (i >> 2) + 4 * n + (i & 3); }

struct Unit { int pm, pn, aux; const char *A1, *B1, *A2, *B2; };
struct Shape { int nt1, nt2; unsigned lda1, ldb1, lda2, ldb2; };

typedef int pg8_v8i __attribute__((ext_vector_type(8))); typedef int pg8_v4i __attribute__((ext_vector_type(4)));
__device__ __forceinline__ pg8_v8i pg8_cat(bf16x8 lo, bf16x8 hi) { const pg8_v4i a = __builtin_bit_cast(pg8_v4i, lo), b = __builtin_bit_cast(pg8_v4i, hi); return __builtin_shufflevector(a, b, 0, 1, 2, 3, 4, 5, 6, 7); }
template <class Epi, class Sched, bool TWO, bool GATHER = false, bool FP8 = false>
__device__ __forceinline__ void gemm_phase(LAS unsigned char* lds, const Shape sh, const Sched& S, const Epi& E) {
    const int tid = otid(), wid = __builtin_amdgcn_readfirstlane(tid >> 6), lane = tid & 63, wr = wid >> 2, wc = wid & 3, fr = lane & 15, fq = lane >> 4;
    const int nt1 = sh.nt1, nt = sh.nt1 + (TWO ? sh.nt2 : 0);
    unsigned vA1[2], vB1[2], vA2[2], vB2[2]; unsigned vGc[2][2], vGn[2][2];
#pragma unroll
    for (int i = 0; i < 2; ++i) { int R, C; stage_rc(tid * 16 + i * 8192, R, C); const int Rb = Epi::PERM ? ((R & ~31) + perm32(R & 31)) : R;
        vA1[i] = (unsigned)(R * sh.lda1 + C) * 2u; vB1[i] = (unsigned)(Rb * sh.ldb1 + C) * 2u;
        vA2[i] = TWO ? (unsigned)(R * sh.lda2 + C) * 2u : 0u; vB2[i] = TWO ? (unsigned)(Rb * sh.ldb2 + C) * 2u : 0u; }
    const unsigned hA1 = 256u * sh.lda1, hB1 = 256u * sh.ldb1, hA2 = TWO ? 256u * sh.lda2 : 0u, hB2 = TWO ? 256u * sh.ldb2 : 0u;
    const unsigned ldsw = (unsigned)wid * 1024u, ldsbase = (unsigned)(unsigned long long)lds;
    const int aoff = lds_byte(wr * 64 + fr, fq * 8), boff = lds_byte(wc * 32 + fr, fq * 8);
#define PG8_SA(b, h) (((b) * 2 + (h)) * HTB)
#define PG8_SB(b, h) ((4 + (b) * 2 + (h)) * HTB)
#define PG8_LOADG(ui_, dst) do { if constexpr (GATHER) { const int tg_ = otid(); _Pragma("unroll") for (int i_ = 0; i_ < 2; ++i_) { int R_, C_; stage_rc(tg_ * 16 + i_ * 8192, R_, C_);     \
        _Pragma("unroll") for (int h_ = 0; h_ < 2; ++h_) dst[h_][i_] = (unsigned)S.gt[(ui_) * 256 + h_ * 128 + R_] * (sh.lda1 * 2u) + (unsigned)C_ * 2u; } } } while (0)
#define PG8_STG_AG(bufoff, U, tt, h, usen) do { if constexpr (GATHER) { const char* gp_ = (U).A1 + (size_t)(tt) * 128; \
        const unsigned v0_ = (usen) ? vGn[h][0] : vGc[h][0], v1_ = (usen) ? vGn[h][1] : vGc[h][1]; \
        glds16(gp_, v0_, ldsbase + (unsigned)(bufoff) + ldsw); glds16(gp_, v1_, ldsbase + (unsigned)(bufoff) + ldsw + 8192u); } else { PG8_STG_A(bufoff, U, tt, h); } } while (0)
#define PG8_STG_A(bufoff, U, tt, h) do { const bool s2_ = TWO && ((tt) >= nt1); \
        const char* gp_ = (s2_ ? (U).A2 + (size_t)((tt) - nt1) * 128 + (size_t)(h) * hA2 : (U).A1 + (size_t)(tt) * 128 + (size_t)(h) * hA1); \
        const unsigned v0_ = s2_ ? vA2[0] : vA1[0], v1_ = s2_ ? vA2[1] : vA1[1]; \
        glds16(gp_, v0_, ldsbase + (unsigned)(bufoff) + ldsw); glds16(gp_, v1_, ldsbase + (unsigned)(bufoff) + ldsw + 8192u); } while (0)
#define PG8_STG_B(bufoff, U, tt, h) do { const bool s2_ = TWO && ((tt) >= nt1); \
        const char* gp_ = (s2_ ? (U).B2 + (size_t)((tt) - nt1) * 128 + (size_t)(h) * hB2 : (U).B1 + (size_t)(tt) * 128 + (size_t)(h) * hB1); \
        const unsigned v0_ = s2_ ? vB2[0] : vB1[0], v1_ = s2_ ? vB2[1] : vB1[1]; \
        glds16(gp_, v0_, ldsbase + (unsigned)(bufoff) + ldsw); glds16(gp_, v1_, ldsbase + (unsigned)(bufoff) + ldsw + 8192u); } while (0)
#define PG8_LDA(dst, b, h) do { if constexpr (FP8) { _Pragma("unroll") for (int m = 0; m < 4; ++m) dst##8[m] = pg8_cat(*(const LAS bf16x8*)(lds + PG8_SA(b, h) + aoff + m * 2048), *(const LAS bf16x8*)(lds + PG8_SA(b, h) + aoff + m * 2048 + 1024)); } \
        else { _Pragma("unroll") for (int m = 0; m < 4; ++m) _Pragma("unroll") for (int k = 0; k < 2; ++k) dst[m][k] = *(const LAS bf16x8*)(lds + PG8_SA(b, h) + aoff + m * 2048 + k * 1024); } } while (0)
#define PG8_LDB(dst, b, h) do { if constexpr (FP8) { _Pragma("unroll") for (int n = 0; n < 2; ++n) dst##8[n] = pg8_cat(*(const LAS bf16x8*)(lds + PG8_SB(b, h) + boff + n * 2048), *(const LAS bf16x8*)(lds + PG8_SB(b, h) + boff + n * 2048 + 1024)); } \
        else { _Pragma("unroll") for (int n = 0; n < 2; ++n) _Pragma("unroll") for (int k = 0; k < 2; ++k) dst[n][k] = *(const LAS bf16x8*)(lds + PG8_SB(b, h) + boff + n * 2048 + k * 1024); } } while (0)
#define PG8_MMA(ai, bj, At, Bt) do { __builtin_amdgcn_s_setprio(1); if constexpr (FP8) { _Pragma("unroll") for (int m = 0; m < 4; ++m) _Pragma("unroll") for (int n = 0; n < 2; ++n) \
        acc[ai][bj][m][n] = __builtin_amdgcn_mfma_scale_f32_16x16x128_f8f6f4(Bt##8[n], At##8[m], acc[ai][bj][m][n], 0, 0, 0, 0x7f7f7f7f, 0, 0x7f7f7f7f); } \
        else { _Pragma("unroll") for (int m = 0; m < 4; ++m) _Pragma("unroll") for (int n = 0; n < 2; ++n) _Pragma("unroll") for (int k = 0; k < 2; ++k) \
        acc[ai][bj][m][n] = __builtin_amdgcn_mfma_f32_16x16x32_bf16(Bt[n][k], At[m][k], acc[ai][bj][m][n], 0, 0, 0); } __builtin_amdgcn_s_setprio(0); } while (0)
#define PG8_WAIT_V(n) asm volatile("s_waitcnt vmcnt(" #n ")" ::: "memory")
#define PG8_WAIT_L(n) asm volatile("s_waitcnt lgkmcnt(" #n ")" ::: "memory")
#define PG8_BAR __builtin_amdgcn_s_barrier()
#define PG8_SCHED __builtin_amdgcn_sched_barrier(0)
    Unit cur, nxt;
    if (!S.next(0, cur)) return;
    f32x4 acc[2][2][4][2];
#pragma unroll
    for (int a = 0; a < 2; ++a)
#pragma unroll
        for (int b = 0; b < 2; ++b)
#pragma unroll
            for (int m = 0; m < 4; ++m)
#pragma unroll
                for (int n = 0; n < 2; ++n) acc[a][b][m][n] = (f32x4){0.f, 0.f, 0.f, 0.f};
    bf16x8 At[4][2], B0[2][2], B1[2][2]; pg8_v8i At8[4], B08[2], B18[2];
    PG8_LOADG(0, vGc);
    PG8_STG_B(PG8_SB(0, 0), cur, 0, 0); PG8_STG_B(PG8_SB(0, 1), cur, 0, 1); PG8_STG_AG(PG8_SA(0, 0), cur, 0, 0, false); PG8_STG_AG(PG8_SA(0, 1), cur, 0, 1, false);
    if (wr == 1) PG8_BAR;
    PG8_WAIT_V(2); PG8_BAR;
    PG8_STG_B(PG8_SB(1, 0), cur, 1, 0); PG8_STG_AG(PG8_SA(1, 0), cur, 1, 0, false); PG8_STG_B(PG8_SB(1, 1), cur, 1, 1);
    PG8_WAIT_V(6); PG8_BAR;
    for (int ui = 0;; ++ui) {
        const bool has_next = S.next(ui + 1, nxt);
        if (!has_next) nxt = cur;
        if constexpr (GATHER) { if (has_next) PG8_LOADG(ui + 1, vGn); else {
#pragma unroll
            for (int h_ = 0; h_ < 2; ++h_) { vGn[h_][0] = vGc[h_][0]; vGn[h_][1] = vGc[h_][1]; } } }
#pragma unroll 1
        for (int t = 0; t < nt; t += 2) {
            const bool last = (t == nt - 2);
            const char* uA1 = last ? nxt.A1 : cur.A1; const char* uB1 = last ? nxt.B1 : cur.B1; const char* uA2 = last ? nxt.A2 : cur.A2; const char* uB2 = last ? nxt.B2 : cur.B2;
            Unit U2; U2.A1 = uA1; U2.B1 = uB1; U2.A2 = uA2; U2.B2 = uB2;
            const int t2 = last ? 0 : t + 2, t3 = t2 + 1;
            PG8_LDB(B0, 0, 0); PG8_LDB(B1, 0, 1); PG8_SCHED; PG8_LDA(At, 0, 0); PG8_STG_AG(PG8_SA(1, 1), cur, t + 1, 1, false);
            PG8_WAIT_V(8); PG8_WAIT_L(0); PG8_BAR; PG8_MMA(0, 0, At, B0); PG8_MMA(0, 1, At, B1); PG8_BAR; PG8_SCHED;
            PG8_LDA(At, 0, 1); PG8_STG_B(PG8_SB(0, 0), U2, t2, 0); PG8_STG_B(PG8_SB(0, 1), U2, t2, 1); PG8_STG_AG(PG8_SA(0, 0), U2, t2, 0, last);
            PG8_WAIT_V(8); PG8_WAIT_L(0); PG8_BAR; PG8_MMA(1, 0, At, B0); PG8_MMA(1, 1, At, B1); PG8_BAR; PG8_SCHED;
            PG8_LDB(B0, 1, 0); PG8_LDB(B1, 1, 1); PG8_SCHED; PG8_LDA(At, 1, 0); PG8_STG_AG(PG8_SA(0, 1), U2, t2, 1, last);
            PG8_WAIT_V(8); PG8_WAIT_L(0); PG8_BAR; PG8_MMA(0, 0, At, B0); PG8_MMA(0, 1, At, B1); PG8_BAR; PG8_SCHED;
            PG8_LDA(At, 1, 1); PG8_STG_B(PG8_SB(1, 0), U2, t3, 0); PG8_STG_B(PG8_SB(1, 1), U2, t3, 1); PG8_STG_AG(PG8_SA(1, 0), U2, t3, 0, last);
            PG8_WAIT_V(8); PG8_WAIT_L(0); PG8_BAR; PG8_MMA(1, 0, At, B0); PG8_MMA(1, 1, At, B1); PG8_BAR; PG8_SCHED;
        }
        if (wr == 0) PG8_BAR;
        { const int l2_ = otid() & 63; E(acc, cur, wr, wc, l2_ & 15, l2_ >> 4); }
        if (!has_next) break;
#pragma unroll
        for (int a = 0; a < 2; ++a)
#pragma unroll
            for (int b = 0; b < 2; ++b)
#pragma unroll
                for (int m = 0; m < 4; ++m)
#pragma unroll
                    for (int n = 0; n < 2; ++n) acc[a][b][m][n] = (f32x4){0.f, 0.f, 0.f, 0.f};
        cur = nxt;
        if constexpr (GATHER) {
#pragma unroll
            for (int h_ = 0; h_ < 2; ++h_) { vGc[h_][0] = vGn[h_][0]; vGc[h_][1] = vGn[h_][1]; } }
        if (wr == 1) PG8_BAR;
    }
    PG8_WAIT_V(0);
    PG8_BAR;
#undef PG8_SA
#undef PG8_SB
#undef PG8_STG_A
#undef PG8_STG_AG
#undef PG8_LOADG
#undef PG8_STG_B
#undef PG8_LDA
#undef PG8_LDB
#undef PG8_MMA
#undef PG8_WAIT_V
#undef PG8_WAIT_L
#undef PG8_BAR
#undef PG8_SCHED
}
}

#define XB_TMO      128
#define XB_XCNT(j)  (256  + 64 * (j))
#define XB_XSUB(j)  (1280 + 64 * (j))
#define XB_XGEN(j)  (2304 + 64 * (j))
#define XB_TOP      3328
#define XB_TOPGEN   3392
#define XCD_BAR_WORDS 3456
#define XB_SPIN_CAP (1u << 18)

__device__ __forceinline__ unsigned xb_ld(unsigned* p)              { return __hip_atomic_load(p, __ATOMIC_RELAXED, __HIP_MEMORY_SCOPE_AGENT); }
__device__ __forceinline__ unsigned xb_add(unsigned* p, unsigned v) { return __hip_atomic_fetch_add(p, v, __ATOMIC_RELAXED, __HIP_MEMORY_SCOPE_AGENT); }
__device__ __forceinline__ unsigned xb_xcc_id() { return (unsigned)__builtin_amdgcn_s_getreg((3 << 11) | 20) & 0xFu; }
#define XB_SPIN(cond, bar) do { unsigned _sp = 0; while (cond) { __builtin_amdgcn_s_sleep(1); \
    if ((++_sp & 255u) == 0u) { if (xb_ld(&(bar)[XB_TMO])) break; if (_sp > XB_SPIN_CAP) { atomicAdd(&(bar)[XB_TMO], 1u); break; } } } } while (0)

struct XcdBarrier {
    unsigned* bar; unsigned x;
    volatile LAS unsigned* st;
};

__device__ __forceinline__ XcdBarrier xcd_barrier_post(unsigned* bar, volatile LAS unsigned* st) {
    XcdBarrier b; b.bar = bar; b.x = xb_xcc_id(); b.st = st;
    if (threadIdx.x == 0) (void)xb_add(&bar[XB_XCNT(b.x)], 1u);
    return b;
}
__device__ __forceinline__ void xcd_barrier_complete(unsigned* bar, unsigned x, unsigned& nloc, unsigned& nx) {
    const unsigned G = gridDim.x * gridDim.y * gridDim.z;
    unsigned sum, cnt, mine, sp = 0u;
    for (;;) {
        sum = 0u; cnt = 0u; mine = 0u;
#pragma unroll
        for (unsigned j = 0; j < 16; ++j) { const unsigned c = xb_ld(&bar[XB_XCNT(j)]); sum += c; cnt += (c > 0u) ? 1u : 0u; mine = (j == x) ? c : mine; }
        if (sum == G) break;
        __builtin_amdgcn_s_sleep(1);
        if ((++sp & 255u) == 0u) { if (xb_ld(&bar[XB_TMO])) break; if (sp > XB_SPIN_CAP) { atomicAdd(&bar[XB_TMO], 1u); break; } }
    }
    nloc = mine > 0u ? mine : 1u; nx = cnt > 0u ? cnt : 1u;
}

__device__ __forceinline__ void xcd_barrier(const XcdBarrier& b) {
    asm volatile("s_waitcnt vmcnt(0)" ::: "memory");
    __syncthreads();
    if (threadIdx.x == 0) {
        unsigned* bar = b.bar;
        __builtin_amdgcn_s_waitcnt(0);
        unsigned nloc = b.st[0], nx = b.st[1];
        if (nloc == 0u) { xcd_barrier_complete(bar, b.x, nloc, nx); b.st[0] = nloc; b.st[1] = nx; }
        const unsigned old = xb_add(&bar[XB_XSUB(b.x)], 1u);
        const unsigned gen = old / nloc;
        if (old + 1u == (gen + 1u) * nloc) {
            __builtin_amdgcn_fence(__ATOMIC_RELEASE, "agent");
            asm volatile("s_waitcnt vmcnt(0)" ::: "memory");
            const unsigned og = xb_add(&bar[XB_TOP], 1u);
            const unsigned tg = og / nx;
            if (og + 1u == (tg + 1u) * nx) xb_add(&bar[XB_TOPGEN], 1u);
            else XB_SPIN(xb_ld(&bar[XB_TOPGEN]) == tg, bar);
            __builtin_amdgcn_fence(__ATOMIC_ACQUIRE, "agent");
            xb_add(&bar[XB_XGEN(b.x)], 1u);
            asm volatile("s_waitcnt vmcnt(0)" ::: "memory");
        } else {
            XB_SPIN(xb_ld(&bar[XB_XGEN(b.x)]) == gen, bar);
            __builtin_amdgcn_fence(__ATOMIC_ACQUIRE, "agent");
            asm volatile("s_waitcnt vmcnt(0)" ::: "memory");
        }
    }
    __syncthreads();
}

constexpr int T = 16384, D = 1024;
constexpr int RW = 1280, RNB = 10, RBD = 128, RCH = 64, RNC = T / RCH;
constexpr int MI = 2048, MH = 4, HD = 512, MCH = 256, MNC = T / MCH;
constexpr int LDT = T + 64;
constexpr int NG = 64, SL = 16, SNC = T / SL, SK = 384;
constexpr int FF = 2816, NE = 8, MOE_ROWS = 2 * T + NE * 256;
#ifndef MOE_F8_MASK
#define MOE_F8_MASK 3
#endif
#define MOE_F8(f) (((MOE_F8_MASK) >> (f)) & 1)
#ifndef DENSE_F8_MASK
#define DENSE_F8_MASK 2
#endif
#define DENSE_F8(f) (((DENSE_F8_MASK) >> (f)) & 1)
#ifndef RG_F8_MASK
#define RG_F8_MASK 2
#endif
#define RG_F8(j) (((RG_F8_MASK) >> (j)) & 1)
#ifndef DEFER_NORM
#define DEFER_NORM 1
#endif
constexpr float EPS = 1e-6f;
constexpr int NTHR = 512, NWAVES = 8;

enum { I_X = 0, I_NORM_MIX, I_NORM_FFN, I_NORM_FINAL, I_A_W_IN, I_A_CONV_W, I_A_CONV_B, I_A_W_R, I_A_B_R, I_A_W_I, I_A_B_I, I_A_LAM, I_A_W_OUT,
       I_B_W_IN, I_B_CONV_W, I_B_CONV_B, I_B_W_Q, I_B_W_K, I_B_W_V, I_B_W_GATE, I_B_B_GATE, I_B_NORM, I_B_SKIP, I_B_W_OUT,
       I_C_A_RE, I_C_A_IM, I_C_LOG_STEP, I_C_B_RE, I_C_B_IM, I_C_C_RE, I_C_C_IM, I_C_D, I_C_W_GLU, I_C_B_GLU,
       I_F_W1, I_F_W3, I_F_W2, I_E_ROUTER, I_E_ROUTER_B, I_E_W1, I_E_W3, I_E_W2, N_IN };

constexpr size_t MiB = 1u << 20;
constexpr size_t WS_CTL = 0, CTL_ZERO_BYTES = 1 * MiB;
constexpr size_t WS_WA_IN = 2 * MiB, WS_WA_OUT = 12 * MiB, WS_WA_G = 17 * MiB, WS_WB_IN = 19 * MiB, WS_WB_OUT = 27 * MiB, WS_WC_GLU = 31 * MiB, WS_S5_BE = 33 * MiB, WS_S5_KC = 41 * MiB;
constexpr size_t WS_RSS = 53 * MiB;
constexpr size_t SCR = 56 * MiB;
constexpr size_t WS_HN = SCR + 0 * MiB;
constexpr size_t WS_GX = SCR + 32 * MiB, WS_XR = SCR + 72 * MiB, WS_HL = SCR + 112 * MiB, WS_AC = SCR + 152 * MiB, WS_CSA = SCR + 192 * MiB, WS_CSH = SCR + 194 * MiB, WS_CIN = SCR + 196 * MiB;
constexpr size_t WS_XM = SCR + 32 * MiB, WS_Z = SCR + 96 * MiB, WS_Q = SCR + 160 * MiB, WS_K = SCR + 224 * MiB, WS_KT = SCR + 288 * MiB, WS_VT = SCR + 353 * MiB, WS_XC = SCR + 418 * MiB,
                 WS_SM = SCR + 482 * MiB, WS_CT = SCR + 514 * MiB, WS_MLS = SCR + 642 * MiB;
static_assert((size_t)MI * LDT * 2 <= 65 * MiB && WS_MLS + 4 * MiB <= SCR + 656 * MiB, "mLSTM scratch");
constexpr size_t WS_NUM = WS_XM, WS_Y = WS_XC;
constexpr size_t WS_GI = WS_MLS, WS_GF = WS_MLS + 256 * 1024, WS_GS = WS_MLS + 512 * 1024, WS_RMT = WS_MLS + 768 * 1024, WS_EF = WS_MLS + 1024 * 1024, WS_MC = WS_MLS + 1280 * 1024,
                 WS_DENP = WS_MLS + 2 * MiB, WS_NS = WS_MLS + 3 * MiB;
constexpr size_t WS_UP = SCR + 32 * MiB, WS_EB = SCR + 80 * MiB, WS_YA = SCR + 112 * MiB;
constexpr size_t WS_WFFN = SCR + 200 * MiB, WS_AG = SCR + 332 * MiB, WS_H = SCR + 400 * MiB, WS_OUT = SCR + 587 * MiB, WS_META = SCR + 655 * MiB, WS_END = SCR + 656 * MiB;
constexpr size_t WS_TOPI = WS_META, WS_TOPW = WS_META + 128 * 1024, WS_LISTE = WS_META + 384 * 1024;
constexpr size_t W13_BYTES = (size_t)2 * FF * D * 2, W2_BYTES = (size_t)D * FF * 2;
constexpr size_t WS_W13 = WS_WFFN, WS_W2T = WS_WFFN + NE * W13_BYTES;
constexpr size_t WS_WD1_13 = SCR + 144 * MiB, WS_WD1_2 = SCR + 155 * MiB;
constexpr size_t WS_W2T8 = WS_WFFN + NE * (W13_BYTES / 2);
constexpr size_t WS_AGX = WS_WFFN + NE * (W13_BYTES / 2) + NE * (W2_BYTES / 2);
static_assert(WS_AGX + (size_t)NE * T * D <= WS_H, "fp8 MoE rows");
static_assert(WS_WD1_13 + W13_BYTES <= WS_WD1_2 && WS_WD1_2 + W2_BYTES <= SCR + 161 * MiB, "dense-1 weights");
static_assert(WS_W2T + NE * W2_BYTES <= WS_AG, "ffn weights");
static_assert(WS_CIN + (size_t)RNC * RW * 4 <= WS_WFFN, "rg scratch vs dense weights");
static_assert(WS_H + (size_t)MOE_ROWS * FF * 2 <= WS_OUT && WS_OUT + (size_t)MOE_ROWS * D * 2 <= WS_META, "moe buffers");
constexpr int CW_BAR = 4096, CW_MOE = 204800, CW_DQ = 208896;

constexpr int RING_BYTES = 131072, EXTRA_OFF = RING_BYTES, EXTRA_BYTES = 24576, LDS_BYTES = RING_BYTES + EXTRA_BYTES;
constexpr int MISC_OFF = LDS_BYTES - 64;

struct Args { const float* in[N_IN]; float* out; unsigned char* ws; int ph_lo, ph_hi, li, pad; };

__device__ __forceinline__ float wave_sum(float v) {
#pragma unroll
    for (int o = 1; o < 64; o <<= 1) v += __shfl_xor(v, o);
    return v;
}
__device__ __forceinline__ float wave_max(float v) {
#pragma unroll
    for (int o = 1; o < 64; o <<= 1) v = fmaxf(v, __shfl_xor(v, o));
    return v;
}
__device__ __forceinline__ u32x4 ldg16(const void* p) { return *(const GAS u32x4*)p; }
__device__ __forceinline__ u32x2 ldg8(const void* p) { return *(const GAS u32x2*)p; }
__device__ __forceinline__ f32x4 ldgf4(const void* p) { return *(const GAS f32x4*)p; }
__device__ __forceinline__ float ldgf(const void* p) { return *(const GAS float*)p; }
__device__ __forceinline__ int ldgi(const void* p) { return *(const GAS int*)p; }
#ifndef STORE_SC1
#define STORE_SC1 0
#endif
#if STORE_SC1
__device__ __forceinline__ void stg16(void* p, u32x4 v) { asm volatile("global_store_dwordx4 %0, %1, off sc1\n\ts_nop 1" :: "v"((GAS u32x4*)p), "v"(v) : "memory"); }
__device__ __forceinline__ void stg8(void* p, u32x2 v) { asm volatile("global_store_dwordx2 %0, %1, off sc1\n\ts_nop 1" :: "v"((GAS u32x2*)p), "v"(v) : "memory"); }
__device__ __forceinline__ void stgf4(void* p, f32x4 v) { asm volatile("global_store_dwordx4 %0, %1, off sc1\n\ts_nop 1" :: "v"((GAS f32x4*)p), "v"(v) : "memory"); }
__device__ __forceinline__ void stgf(void* p, float v) { asm volatile("global_store_dword %0, %1, off sc1\n\ts_nop 1" :: "v"((GAS float*)p), "v"(v) : "memory"); }
__device__ __forceinline__ void stgi(void* p, int v) { asm volatile("global_store_dword %0, %1, off sc1\n\ts_nop 1" :: "v"((GAS int*)p), "v"(v) : "memory"); }
__device__ __forceinline__ void stgh(void* p, bf16 v) { asm volatile("global_store_short %0, %1, off sc1\n\ts_nop 1" :: "v"((GAS bf16*)p), "v"((unsigned)v) : "memory"); }
#else
__device__ __forceinline__ void stg16(void* p, u32x4 v) { *(GAS u32x4*)p = v; }
__device__ __forceinline__ void stg8(void* p, u32x2 v) { *(GAS u32x2*)p = v; }
__device__ __forceinline__ void stgf4(void* p, f32x4 v) { *(GAS f32x4*)p = v; }
__device__ __forceinline__ void stgf(void* p, float v) { *(GAS float*)p = v; }
__device__ __forceinline__ void stgi(void* p, int v) { *(GAS int*)p = v; }
__device__ __forceinline__ void stgh(void* p, bf16 v) { *(GAS bf16*)p = v; }
#endif
#define LDS_WAIT() asm volatile("s_waitcnt lgkmcnt(0)" ::: "memory")

#ifndef WGM_
#define WGM_ 8
#endif
__device__ __forceinline__ void tile_of(int L, int nM, int nN, int& pm, int& pn) {
    const int nwg = nM * nN; int wgid = L;
    { const int q = nwg / 8, r = nwg % 8, xcd = wgid % 8, off = wgid / 8; wgid = (xcd < r ? xcd * (q + 1) : r * (q + 1) + (xcd - r) * q) + off; }
    const int nig = WGM_ * nN, gid = wgid / nig, fm = gid * WGM_, gsz = (nM - fm) < WGM_ ? (nM - fm) : WGM_;
    pm = fm + ((wgid % nig) % gsz); pn = (wgid % nig) / gsz;
}
using pg8::Unit;
__device__ __forceinline__ const char* uptr(const char* p) { const unsigned long long v = (unsigned long long)p; unsigned lo = __builtin_amdgcn_readfirstlane((unsigned)v), hi = __builtin_amdgcn_readfirstlane((unsigned)(v >> 32));
    asm volatile("s_nop 4" : "+s"(lo), "+s"(hi)); return (const char*)(((unsigned long long)hi << 32) | lo); }
struct Sched2D {
    const char* A; const char* B; unsigned lda, ldb; int nM, nN, G, c;
    __device__ __forceinline__ bool next(int i, Unit& u) const {
        const int L = i * G + c; if (L >= nM * nN) return false;
        tile_of(L, nM, nN, u.pm, u.pn); u.aux = 0;
        u.A1 = uptr(A + (size_t)u.pm * 512 * lda); u.B1 = uptr(B + (size_t)u.pn * 512 * ldb); u.A2 = u.A1; u.B2 = u.B1; return true;
    }
};
struct SchedMoe {
    LAS const int* gt; int gather;
    const char* A; const char* B; unsigned lda, ldb; size_t bstride; int P, nN, G, c; int ps[NE];
    int erows = 0;
    int ksplit; unsigned khbytes;
    __device__ __forceinline__ bool next(int i, Unit& u) const {
        const int L = i * G + c, nu = P * nN; if (L >= nu * ksplit) return false;
        const int kh = L / nu;
        tile_of(L - kh * nu, P, nN, u.pm, u.pn);
        int e = 0;
#pragma unroll
        for (int j = 1; j < NE; ++j) e += (u.pm >= ps[j]) ? 1 : 0;
        u.aux = (ksplit > 1) ? kh : e;
        int arow = u.pm * 256;
        if (erows) { int pse = 0;
#pragma unroll
            for (int j = 1; j < NE; ++j) pse = (u.pm >= ps[j]) ? ps[j] : pse;
            arow = e * erows + (u.pm - pse) * 256; }
        u.A1 = gather ? A : uptr(A + (size_t)arow * 2 * lda + (size_t)kh * khbytes); u.B1 = uptr(B + (size_t)e * bstride + (size_t)u.pn * 512 * ldb + (size_t)kh * khbytes); u.A2 = u.A1; u.B2 = u.B1; return true;
    }
};
struct SchedBatch {
    const char* A; const char* B; unsigned lda, ldb; size_t astride, bstride; int nMb, nB, G, c;
    __device__ __forceinline__ bool next(int i, Unit& u) const {
        const int L = i * G + c; if (L >= nMb * nB) return false;
        u.aux = L / nMb; u.pm = L % nMb; u.pn = 0;
        u.A1 = uptr(A + (size_t)u.aux * astride + (size_t)u.pm * 512 * lda); u.B1 = uptr(B + (size_t)u.aux * bstride); u.A2 = u.A1; u.B2 = u.B1; return true;
    }
};
struct SchedSbuild {
    const char* Q; const char* K; int G, c;
    __device__ __forceinline__ bool next(int i, Unit& u) const {
        const int L = i * G + c; if (L >= MNC * MH) return false;
        const int ch = L / MH, h = L % MH; u.aux = L; u.pm = ch; u.pn = h;
        u.A1 = uptr(Q + ((size_t)ch * MCH * MI + (size_t)h * HD) * 2); u.B1 = uptr(K + ((size_t)ch * MCH * MI + (size_t)h * HD) * 2); u.A2 = u.A1; u.B2 = u.B1; return true;
    }
};
struct SchedPass2 {
    const char* SMp; const char* Q; const char* VT; const char* CT; int G, c;
    __device__ __forceinline__ bool next(int i, Unit& u) const {
        const int pr_ = (i >> 1) * G + c; if (pr_ >= MNC * MH) return false;
        const int L = pr_ * 2 + (i & 1);
        const int eh = L & 1, ch_h = L >> 1, ch = ch_h / MH, h = ch_h % MH; u.aux = ch_h; u.pm = ch; u.pn = h * 2 + eh;
        u.A1 = uptr(SMp + (size_t)ch_h * MCH * MCH * 2); u.A2 = uptr(Q + ((size_t)ch * MCH * MI + (size_t)h * HD) * 2);
        u.B1 = uptr(VT + (((size_t)ch_h * HD + eh * 256) * MCH) * 2);     u.B2 = uptr(CT + ((size_t)ch_h * HD * HD + (size_t)eh * 256 * HD) * 2); return true;
    }
};

struct SchedState {
    const char* VT; const char* KT; int G, c;
    __device__ __forceinline__ bool next(int i, Unit& u) const {
        const int pq_ = (i >> 2) * G + c; if (pq_ >= MNC * MH) return false;
        const int L = pq_ * 4 + (i & 3);
        const int ch_h = L >> 2, ch = ch_h / MH, h = ch_h % MH; u.aux = ch_h; u.pm = (L >> 1) & 1; u.pn = L & 1;
        u.A1 = uptr(VT + (((size_t)ch_h * HD + u.pm * 256) * MCH) * 2); u.B1 = uptr(KT + (((size_t)ch_h * HD + u.pn * 256) * MCH) * 2); u.A2 = u.A1; u.B2 = u.B1; return true;
    }
};

__device__ __forceinline__ float rss_rstd(const float* rss, int row) { const f32x4 p = ldgf4(rss + (size_t)row * 4); return __builtin_amdgcn_rsqf(((p[0] + p[1]) + (p[2] + p[3])) * (1.0f / D) + EPS); }
template <int EMIT> __device__ __forceinline__ float emit_x(unsigned char* hn, size_t eoff, const f32x4& x) {
    if (EMIT == 1) { u32x2 w; w.x = cvt_pk_bf16(x[0], x[1]); w.y = cvt_pk_bf16(x[2], x[3]); stg8(hn + eoff * 2, w); }
    else stgi(hn + eoff, (int)cvt4_fp8(__builtin_amdgcn_fmed3f(x[0], -448.0f, 448.0f), __builtin_amdgcn_fmed3f(x[1], -448.0f, 448.0f), __builtin_amdgcn_fmed3f(x[2], -448.0f, 448.0f), __builtin_amdgcn_fmed3f(x[3], -448.0f, 448.0f)));
    return (x[0] * x[0] + x[1] * x[1]) + (x[2] * x[2] + x[3] * x[3]);
}
__device__ __forceinline__ void emit_rss(LAS float* P, float* rss, const pg8::Unit& u) {
    LDS_WAIT(); __builtin_amdgcn_s_barrier(); asm volatile("" ::: "memory");
    const int t = otid(); if (t < 256) { const f32x4 p = *(const LAS f32x4*)(P + t * 4); stgf(rss + ((size_t)u.pm * 256 + t) * 4 + u.pn, (p[0] + p[1]) + (p[2] + p[3])); }
}

template <bool RS> struct EpiBf16T {
    static constexpr bool PERM = true;
    bf16* O; int ldc; int split_cols; size_t split_stride; size_t aux_stride;
    float scale = 1.0f; const float* rss = nullptr;
    __device__ __forceinline__ void operator()(const f32x4 (&acc)[2][2][4][2], const Unit& u, int wr, int wc, int fr, int fq) const {
        const int row0 = u.pm * 256 + wr * 64 + fr; int colt = u.pn * 256; bf16* base = O + (size_t)u.aux * aux_stride;
        if (split_cols) { const int t = colt / split_cols; base += (size_t)t * split_stride; colt -= t * split_cols; }
        const int col0 = colt + wc * 32 + 8 * fq;
#pragma unroll
        for (int ai = 0; ai < 2; ++ai)
#pragma unroll
            for (int m = 0; m < 4; ++m) { bf16* rowp = base + (size_t)(row0 + ai * 128 + m * 16) * ldc + col0; const float sc_ = RS ? scale * rss_rstd(rss, row0 + ai * 128 + m * 16) : scale;
#pragma unroll
                for (int bj = 0; bj < 2; ++bj) { const f32x4 v0 = acc[ai][bj][m][0] * sc_, v1 = acc[ai][bj][m][1] * sc_;
                    u32x4 w; w.x = cvt_pk_bf16(v0[0], v0[1]); w.y = cvt_pk_bf16(v0[2], v0[3]); w.z = cvt_pk_bf16(v1[0], v1[1]); w.w = cvt_pk_bf16(v1[2], v1[3]);
                    stg16(rowp + bj * 128, w); }
                asm volatile("" ::: "memory"); }
    }
};
using EpiBf16 = EpiBf16T<false>;
template <int EMIT> struct EpiResidT {
    static constexpr bool PERM = false;
    const float* base; float* out; unsigned char* hn; float* rss; LAS float* P; float scale;
    __device__ __forceinline__ void operator()(const f32x4 (&acc)[2][2][4][2], const Unit& u, int wr, int wc, int fr, int fq) const {
        const int row0 = u.pm * 256 + wr * 64 + fr, col0 = u.pn * 256 + wc * 32 + 4 * fq;
#pragma unroll
        for (int ai = 0; ai < 2; ++ai) { f32x4 bs[4][2][2];
#pragma unroll
            for (int m = 0; m < 4; ++m) { const size_t off = (size_t)(row0 + ai * 128 + m * 16) * D + col0;
#pragma unroll
                for (int bj = 0; bj < 2; ++bj)
#pragma unroll
                    for (int n = 0; n < 2; ++n) bs[m][bj][n] = ldgf4(base + off + bj * 128 + n * 16); }
#pragma unroll
            for (int m = 0; m < 4; ++m) { const size_t off = (size_t)(row0 + ai * 128 + m * 16) * D + col0; float ss = 0.f;
#pragma unroll
                for (int bj = 0; bj < 2; ++bj)
#pragma unroll
                    for (int n = 0; n < 2; ++n) { const f32x4 x = bs[m][bj][n] + acc[ai][bj][m][n] * scale; stgf4(out + off + bj * 128 + n * 16, x);
                        if (EMIT) ss += emit_x<EMIT>(hn, off + bj * 128 + n * 16, x); }
                if (EMIT) { ss += __shfl_xor(ss, 16); ss += __shfl_xor(ss, 32); if (fq == 0) P[(ai * 128 + wr * 64 + m * 16 + fr) * 4 + wc] = ss; } }
            asm volatile("" ::: "memory"); }
        if (EMIT) emit_rss(P, rss, u);
    }
};
using EpiResid = EpiResidT<0>;
template <bool RS> struct EpiSwigluT {
    static constexpr bool PERM = true;
    bf16* Hh; const float* rss = nullptr;
    __device__ __forceinline__ void operator()(const f32x4 (&acc)[2][2][4][2], const Unit& u, int wr, int wc, int fr, int fq) const {
        const int row0 = u.pm * 256 + wr * 64 + fr, col0 = u.pn * 128 + wc * 32 + 8 * fq;
#pragma unroll
        for (int ai = 0; ai < 2; ++ai)
#pragma unroll
            for (int m = 0; m < 4; ++m) { bf16* rowp = Hh + (size_t)(row0 + ai * 128 + m * 16) * FF + col0; const float rs_ = RS ? rss_rstd(rss, row0 + ai * 128 + m * 16) : 1.0f;
                f32x2 o[4];
#pragma unroll
                for (int n = 0; n < 2; ++n)
#pragma unroll
                    for (int hh = 0; hh < 2; ++hh) { const f32x4 a4 = acc[ai][0][m][n], b4 = acc[ai][1][m][n];
                        f32x2 a = hh ? (f32x2){a4[2], a4[3]} : (f32x2){a4[0], a4[1]}, b = hh ? (f32x2){b4[2], b4[3]} : (f32x2){b4[0], b4[1]}; if (RS) { a = a * rs_; b = b * rs_; }
                        f32x2 e; e[0] = __builtin_amdgcn_exp2f(-a[0]); e[1] = __builtin_amdgcn_exp2f(-a[1]);
                        const f32x2 d = e + 1.0f; f32x2 r; r[0] = __builtin_amdgcn_rcpf(d[0]); r[1] = __builtin_amdgcn_rcpf(d[1]);
                        o[n * 2 + hh] = (a * b) * r; }
                u32x4 w; w.x = cvt_pk_bf16(o[0][0], o[0][1]); w.y = cvt_pk_bf16(o[1][0], o[1][1]); w.z = cvt_pk_bf16(o[2][0], o[2][1]); w.w = cvt_pk_bf16(o[3][0], o[3][1]);
                stg16(rowp, w); asm volatile("" ::: "memory"); }
    }
};
using EpiSwiglu = EpiSwigluT<false>;
template <bool RS> struct EpiSwiglu8T {
    static constexpr bool PERM = true;
    unsigned char* H8; const float* rss = nullptr;
    __device__ __forceinline__ void operator()(const f32x4 (&acc)[2][2][4][2], const Unit& u, int wr, int wc, int fr, int fq) const {
        const int row0 = u.pm * 256 + wr * 64 + fr, col0 = u.pn * 128 + wc * 32 + 8 * fq;
#pragma unroll
        for (int ai = 0; ai < 2; ++ai)
#pragma unroll
            for (int m = 0; m < 4; ++m) { unsigned char* rowp = H8 + (size_t)(row0 + ai * 128 + m * 16) * FF + col0; const float rs_ = RS ? 0.03125f * rss_rstd(rss, row0 + ai * 128 + m * 16) : 0.03125f;
                f32x2 o[4];
#pragma unroll
                for (int n = 0; n < 2; ++n)
#pragma unroll
                    for (int hh = 0; hh < 2; ++hh) { const f32x4 a4 = acc[ai][0][m][n], b4 = acc[ai][1][m][n];
                        const f32x2 a = (hh ? (f32x2){a4[2], a4[3]} : (f32x2){a4[0], a4[1]}) * rs_, b = hh ? (f32x2){b4[2], b4[3]} : (f32x2){b4[0], b4[1]};
                        f32x2 e; e[0] = __builtin_amdgcn_exp2f(-a[0]); e[1] = __builtin_amdgcn_exp2f(-a[1]);
                        const f32x2 d = e + 1.0f; f32x2 r; r[0] = __builtin_amdgcn_rcpf(d[0]); r[1] = __builtin_amdgcn_rcpf(d[1]);
                        o[n * 2 + hh] = (a * (b * rs_)) * r; }
                u32x2 w; w.x = cvt4_fp8(o[0][0], o[0][1], o[1][0], o[1][1]); w.y = cvt4_fp8(o[2][0], o[2][1], o[3][0], o[3][1]);
                stg8(rowp, w); asm volatile("" ::: "memory"); }
    }
};
using EpiSwiglu8 = EpiSwiglu8T<false>;
template <int EMIT> struct EpiGluT {
    static constexpr bool PERM = false;
    const bf16* YA; const float* bglu; float* xf; unsigned char* hn = nullptr; float* rss = nullptr; LAS float* P = nullptr;
    __device__ __forceinline__ void operator()(const f32x4 (&acc)[2][2][4][2], const Unit& u, int wr, int wc, int fr, int fq) const {
        const int row0 = u.pm * 256 + wr * 64 + fr, col0 = u.pn * 256 + wc * 32 + 4 * fq;
        f32x4 bv[2][2];
#pragma unroll
        for (int bj = 0; bj < 2; ++bj)
#pragma unroll
            for (int n = 0; n < 2; ++n) bv[bj][n] = ldgf4(bglu + col0 + bj * 128 + n * 16);
#pragma unroll
        for (int ai = 0; ai < 2; ++ai)
#pragma unroll
            for (int mp = 0; mp < 2; ++mp) { f32x4 xs[2][2][2]; u32x2 yv[2][2][2];
#pragma unroll
                for (int mm = 0; mm < 2; ++mm) { const size_t off = (size_t)(row0 + ai * 128 + (2 * mp + mm) * 16) * D + col0;
#pragma unroll
                    for (int bj = 0; bj < 2; ++bj)
#pragma unroll
                        for (int n = 0; n < 2; ++n) { const size_t o2 = off + bj * 128 + n * 16; xs[mm][bj][n] = ldgf4(xf + o2); yv[mm][bj][n] = ldg8(YA + o2); } }
#pragma unroll
                for (int mm = 0; mm < 2; ++mm) { const int m = 2 * mp + mm; const size_t off = (size_t)(row0 + ai * 128 + m * 16) * D + col0; float ss = 0.f;
#pragma unroll
                    for (int bj = 0; bj < 2; ++bj)
#pragma unroll
                        for (int n = 0; n < 2; ++n) { const size_t o2 = off + bj * 128 + n * 16; const f32x4 x_ = xs[mm][bj][n]; const u32x2 y_ = yv[mm][bj][n];
                            const f32x4 z = acc[ai][bj][m][n] + bv[bj][n]; f32x4 r;
                            r[0] = x_[0] + bflo(y_.x) * sigm(z[0]); r[1] = x_[1] + bfhi(y_.x) * sigm(z[1]); r[2] = x_[2] + bflo(y_.y) * sigm(z[2]); r[3] = x_[3] + bfhi(y_.y) * sigm(z[3]);
                            stgf4(xf + o2, r); if (EMIT) ss += emit_x<EMIT>(hn, o2, r); }
                    if (EMIT) { ss += __shfl_xor(ss, 16); ss += __shfl_xor(ss, 32); if (fq == 0) P[(ai * 128 + wr * 64 + m * 16 + fr) * 4 + wc] = ss; } }
                asm volatile("" ::: "memory"); }
        if (EMIT) emit_rss(P, rss, u);
    }
};
using EpiGlu = EpiGluT<0>;
struct EpiS5e {
    static constexpr bool PERM = false;
    float* EB;
    __device__ __forceinline__ void operator()(const f32x4 (&acc)[2][2][4][2], const Unit& u, int wr, int wc, int fr, int fq) const {
        const int row0 = u.aux * SNC + u.pm * 256 + wr * 64 + fr, col0 = wc * 32 + 4 * fq;
#pragma unroll
        for (int ai = 0; ai < 2; ++ai)
#pragma unroll
            for (int m = 0; m < 4; ++m) { float* rowp = EB + (size_t)(row0 + ai * 128 + m * 16) * 128 + col0;
#pragma unroll
                for (int n = 0; n < 2; ++n) stgf4(rowp + n * 16, acc[ai][0][m][n]); }
    }
};
struct EpiS5y {
    static constexpr bool PERM = true;
    const bf16* UP; const float* dsk; bf16* YA;
    __device__ __forceinline__ void operator()(const f32x4 (&acc)[2][2][4][2], const Unit& u, int wr, int wc, int fr, int fq) const {
        const int g = u.aux, row0 = u.pm * 256 + wr * 64 + fr;
#pragma unroll
        for (int bj = 0; bj < 2; ++bj) { const int cc = bj * 128 + wc * 32 + 8 * fq, tt = cc >> 4, i0 = cc & 15;
            const f32x4 d0 = ldgf4(dsk + g * 16 + i0), d1 = ldgf4(dsk + g * 16 + i0 + 4);
#pragma unroll
            for (int ai = 0; ai < 2; ++ai) { u32x4 uvv[4];
#pragma unroll
                for (int m = 0; m < 4; ++m) uvv[m] = ldg16(UP + ((size_t)g * SNC + (row0 + ai * 128 + m * 16)) * SK + cc);
#pragma unroll
                for (int m = 0; m < 4; ++m) { const int chunk = row0 + ai * 128 + m * 16;
                    const u32x4 uv = uvv[m];
                    const f32x4 v0 = acc[ai][bj][m][0], v1 = acc[ai][bj][m][1]; float o[8];
                    o[0] = gelu_tanh(v0[0] + d0[0] * bflo(uv.x)); o[1] = gelu_tanh(v0[1] + d0[1] * bfhi(uv.x)); o[2] = gelu_tanh(v0[2] + d0[2] * bflo(uv.y)); o[3] = gelu_tanh(v0[3] + d0[3] * bfhi(uv.y));
                    o[4] = gelu_tanh(v1[0] + d1[0] * bflo(uv.z)); o[5] = gelu_tanh(v1[1] + d1[1] * bfhi(uv.z)); o[6] = gelu_tanh(v1[2] + d1[2] * bflo(uv.w)); o[7] = gelu_tanh(v1[3] + d1[3] * bfhi(uv.w));
                    u32x4 w; w.x = cvt_pk_bf16(o[0], o[1]); w.y = cvt_pk_bf16(o[2], o[3]); w.z = cvt_pk_bf16(o[4], o[5]); w.w = cvt_pk_bf16(o[6], o[7]);
                    stg16(YA + (size_t)(chunk * SL + tt) * D + g * 16 + i0, w); }
                asm volatile("" ::: "memory"); } }
    }
};
struct EpiSbuild {
    static constexpr bool PERM = true;
    bf16* SMp; float* DENP; const float* GS; const float* MC;
    __device__ __forceinline__ void operator()(const f32x4 (&acc)[2][2][4][2], const Unit& u, int wr, int wc, int fr, int fq) const {
        const int ch = u.pm, h = u.pn, ch_h = u.aux; const float mc = ldgf(MC + h * 80 + ch);
        float rs[2][4];
#pragma unroll
        for (int ai = 0; ai < 2; ++ai)
#pragma unroll
            for (int m = 0; m < 4; ++m) rs[ai][m] = 0.f;
#pragma unroll
        for (int bj = 0; bj < 2; ++bj) { const int s0 = bj * 128 + wc * 32 + 8 * fq; float w[8];
            { const f32x4 g0 = ldgf4(GS + (size_t)h * T + ch * MCH + s0), g1 = ldgf4(GS + (size_t)h * T + ch * MCH + s0 + 4);
#pragma unroll
              for (int j = 0; j < 4; ++j) { w[j] = __expf(g0[j] - mc); w[4 + j] = __expf(g1[j] - mc); } }
#pragma unroll
            for (int ai = 0; ai < 2; ++ai)
#pragma unroll
                for (int m = 0; m < 4; ++m) { const int r = ai * 128 + wr * 64 + m * 16 + fr; float o[8];
#pragma unroll
                    for (int n = 0; n < 2; ++n)
#pragma unroll
                        for (int j = 0; j < 4; ++j) { const int s = s0 + n * 4 + j; o[n * 4 + j] = (s <= r) ? acc[ai][bj][m][n][j] * w[n * 4 + j] : 0.f; }
                    u32x4 pk; pk.x = cvt_pk_bf16(o[0], o[1]); pk.y = cvt_pk_bf16(o[2], o[3]); pk.z = cvt_pk_bf16(o[4], o[5]); pk.w = cvt_pk_bf16(o[6], o[7]);
                    rs[ai][m] += (bflo(pk.x) + bfhi(pk.x)) + (bflo(pk.y) + bfhi(pk.y)) + (bflo(pk.z) + bfhi(pk.z)) + (bflo(pk.w) + bfhi(pk.w));
                    stg16(SMp + ((size_t)ch_h * MCH + r) * MCH + s0, pk); asm volatile("" ::: "memory"); } }
#pragma unroll
        for (int ai = 0; ai < 2; ++ai)
#pragma unroll
            for (int m = 0; m < 4; ++m) { const int r = ai * 128 + wr * 64 + m * 16 + fr; float v = rs[ai][m]; v += __shfl_xor(v, 16); v += __shfl_xor(v, 32);
                if (fq == 0) stgf(DENP + ((size_t)ch_h * MCH + r) * 4 + wc, v); }
    }
};
struct EpiNum {
    static constexpr bool PERM = true;
    bf16* NUM; const float* RMT; const float* MC;
    __device__ __forceinline__ void operator()(const f32x4 (&acc)[2][2][4][2], const Unit& u, int wr, int wc, int fr, int fq) const {
        const int ch = u.pm, h = u.pn >> 1, eh = u.pn & 1; const float mc = ldgf(MC + h * 80 + ch);
        const int col0 = h * HD + eh * 256 + wc * 32 + 8 * fq;
        float rmv[2][4];
#pragma unroll
        for (int ai = 0; ai < 2; ++ai)
#pragma unroll
            for (int m = 0; m < 4; ++m) rmv[ai][m] = ldgf(RMT + (size_t)h * T + ch * MCH + ai * 128 + wr * 64 + m * 16 + fr);
#pragma unroll
        for (int ai = 0; ai < 2; ++ai)
#pragma unroll
            for (int m = 0; m < 4; ++m) { const int t = ch * MCH + ai * 128 + wr * 64 + m * 16 + fr; const float sc = __expf(mc - rmv[ai][m]);
                bf16* rowp = NUM + (size_t)t * MI + col0;
#pragma unroll
                for (int bj = 0; bj < 2; ++bj) { const f32x4 v0 = acc[ai][bj][m][0] * sc, v1 = acc[ai][bj][m][1] * sc;
                    u32x4 w; w.x = cvt_pk_bf16(v0[0], v0[1]); w.y = cvt_pk_bf16(v0[2], v0[3]); w.z = cvt_pk_bf16(v1[0], v1[1]); w.w = cvt_pk_bf16(v1[2], v1[3]);
                    stg16(rowp + bj * 128, w); }
                asm volatile("" ::: "memory"); }
    }
};
struct ConvItem { const float* W; bf16* WT; int ldw, ldt, k0, n0, drow0; float scale; int f8; const float* kg; };
__device__ __forceinline__ void tr_load(const ConvItem& d, f32x2 (&v)[33], int lane) {
    const int hrow = lane >> 5, cl = lane & 31; const unsigned voff = (unsigned)(hrow * d.ldw + 2 * cl) * 4u;
    const char* rb = (const char*)(d.W + (size_t)d.k0 * d.ldw + d.n0); const size_t rstep = (size_t)d.ldw * 8;
#pragma unroll
    for (int i = 0; i < 32; ++i) v[i] = *(const GAS f32x2*)(rb + (size_t)i * rstep + voff);
    v[32][0] = d.kg ? ldgf(d.kg + d.k0 + lane) : 1.0f; v[32][1] = 0.f;
}
__device__ __forceinline__ float tr_scale(const ConvItem& d, const f32x2 (&v)[33], int i, int hrow) {
    const int gi = __float_as_int(v[32][0]); const float g0 = __int_as_float(__builtin_amdgcn_readlane(gi, 2 * i)), g1 = __int_as_float(__builtin_amdgcn_readlane(gi, 2 * i + 1)); return d.scale * (hrow ? g1 : g0);
}
__device__ __forceinline__ void tr_store8(const ConvItem& d, const f32x2 (&v)[33], LAS float* scr, int lane) {
    LAS unsigned char* tile = (LAS unsigned char*)scr; constexpr int TS8 = 68;
    const int hrow = lane >> 5, cl = lane & 31;
#pragma unroll
    for (int i = 0; i < 32; ++i) { const float s_ = tr_scale(d, v, i, hrow); *(LAS unsigned short*)(tile + (2 * i + hrow) * TS8 + cl * 2) = (unsigned short)__builtin_amdgcn_cvt_pk_fp8_f32(v[i][0] * s_, v[i][1] * s_, 0, false); }
    LDS_WAIT(); asm volatile("" ::: "memory");
    const int c = lane & 7;
#pragma unroll
    for (int j = 0; j < 8; ++j) { const int n = (lane >> 3) + 8 * j; const LAS unsigned char* sp = tile + (8 * c) * TS8 + n;
        u32x2 o; o.x = (unsigned)sp[0 * TS8] | ((unsigned)sp[1 * TS8] << 8) | ((unsigned)sp[2 * TS8] << 16) | ((unsigned)sp[3 * TS8] << 24);
        o.y = (unsigned)sp[4 * TS8] | ((unsigned)sp[5 * TS8] << 8) | ((unsigned)sp[6 * TS8] << 16) | ((unsigned)sp[7 * TS8] << 24);
        stg8((unsigned char*)d.WT + (size_t)(d.drow0 + n) * d.ldt + d.k0 + 8 * c, o); }
    LDS_WAIT(); asm volatile("" ::: "memory");
}
__device__ __forceinline__ void tr_store(const ConvItem& d, const f32x2 (&v)[33], LAS float* scr, int lane) {
    if (d.f8) { tr_store8(d, v, scr, lane); return; }
    LAS unsigned char* tile = (LAS unsigned char*)scr; constexpr int TS = 132;
    const int hrow = lane >> 5, cl = lane & 31;
#pragma unroll
    for (int i = 0; i < 32; ++i) { const float s_ = tr_scale(d, v, i, hrow); *(LAS unsigned*)(tile + (2 * i + hrow) * TS + cl * 4) = cvt_pk_bf16(v[i][0] * s_, v[i][1] * s_); }
    LDS_WAIT(); asm volatile("" ::: "memory");
    const int c = lane & 7;
#pragma unroll
    for (int j = 0; j < 8; ++j) { const int n = (lane >> 3) + 8 * j; const LAS bf16* sp = (const LAS bf16*)(tile + (8 * c) * TS) + n;
        u32x4 o; o.x = (unsigned)sp[0 * (TS / 2)] | ((unsigned)sp[1 * (TS / 2)] << 16); o.y = (unsigned)sp[2 * (TS / 2)] | ((unsigned)sp[3 * (TS / 2)] << 16);
        o.z = (unsigned)sp[4 * (TS / 2)] | ((unsigned)sp[5 * (TS / 2)] << 16); o.w = (unsigned)sp[6 * (TS / 2)] | ((unsigned)sp[7 * (TS / 2)] << 16);
        stg16(d.WT + (size_t)(d.drow0 + n) * d.ldt + d.k0 + 8 * c, o); }
    LDS_WAIT(); asm volatile("" ::: "memory");
}
__device__ __forceinline__ ConvItem conv_desc(const float* W, int K, int N, bf16* WT, int ldt, int mode, int it) {
    const int nblk = N / 64, kb = it / nblk, nb_ = it % nblk, n0 = nb_ * 64;
    ConvItem d; d.W = W; d.WT = WT; d.ldw = N; d.ldt = ldt; d.k0 = kb * 64; d.n0 = n0; d.drow0 = (mode == 0 || mode == 3) ? n0 : ((n0 >> 7) * 256 + (n0 & 127) + (mode == 2 ? 128 : 0));
    d.scale = (mode == 1 || mode == 3) ? 1.4426950408889634f : (mode == 2) ? 0.6931471805599453f : 1.0f;
    d.f8 = 0; d.kg = nullptr; return d;
}
__device__ __forceinline__ ConvItem conv_desc8(const float* W, int K, int N, unsigned char* WT, int mode, int it) {
    ConvItem d = conv_desc(W, K, N, (bf16*)WT, K, mode, it); d.f8 = 1;
    d.scale = (mode == 1) ? 32.0f * 1.4426950408889634f : (mode == 2) ? 32.0f * 0.6931471805599453f : 64.0f; return d;
}
__device__ __forceinline__ void conv_item(const float* W, int K, int N, bf16* WT, int ldt, int mode, int it, LAS float* scr, int lane) {
    const ConvItem d = conv_desc(W, K, N, WT, ldt, mode, it); f32x2 v[33]; tr_load(d, v, lane); tr_store(d, v, scr, lane);
}
__device__ __forceinline__ void conv_mat(const float* W, int K, int N, bf16* WT, int ldt, int mode, int gw, int NGW, LAS float* scr, int lane) {
    const int items = (K / 64) * (N / 64);
    int it = gw; if (it >= items) return;
    f32x2 va[33], vb[33]; ConvItem da = conv_desc(W, K, N, WT, ldt, mode, it), db = da; tr_load(da, va, lane);
    for (;;) {
        const int i1 = it + NGW; if (i1 < items) { db = conv_desc(W, K, N, WT, ldt, mode, i1); tr_load(db, vb, lane); }
        tr_store(da, va, scr, lane); if (i1 >= items) break;
        const int i2 = i1 + NGW; if (i2 < items) { da = conv_desc(W, K, N, WT, ldt, mode, i2); tr_load(da, va, lane); }
        tr_store(db, vb, scr, lane); if (i2 >= items) break;
        it = i2;
    }
}
__device__ __forceinline__ void conv_dense(const Args& a, int f, int gw, int NGW, LAS float* scr, int lane) {
    bf16* W13 = (bf16*)(a.ws + (f ? WS_WD1_13 : WS_W13)); bf16* W2T = (bf16*)(a.ws + (f ? WS_WD1_2 : WS_W2T));
    conv_mat(a.in[I_F_W1] + (size_t)f * D * FF, D, FF, W13, D, 1, gw, NGW, scr, lane);
    conv_mat(a.in[I_F_W3] + (size_t)f * D * FF, D, FF, W13, D, 2, gw, NGW, scr, lane);
    conv_mat(a.in[I_F_W2] + (size_t)f * D * FF, FF, D, W2T, FF, 0, gw, NGW, scr, lane);
}
__device__ __forceinline__ ConvItem moe_desc(const Args& a, int f, int idx) {
    constexpr int I1 = (D / 64) * (FF / 64), I2 = (FF / 64) * (D / 64), PER = 2 * I1 + I2;
    const int e = idx / PER, r = idx % PER; const size_t wo = ((size_t)f * NE + e) * D * FF;
    if (MOE_F8(f)) {
        unsigned char* W13 = a.ws + WS_W13 + (size_t)e * (W13_BYTES / 2); unsigned char* W2T = a.ws + WS_W2T8 + (size_t)e * (W2_BYTES / 2);
        if (r < I1) return conv_desc8(a.in[I_E_W1] + wo, D, FF, W13, 1, r);
        if (r < 2 * I1) return conv_desc8(a.in[I_E_W3] + wo, D, FF, W13, 2, r - I1);
        return conv_desc8(a.in[I_E_W2] + wo, FF, D, W2T, 0, r - 2 * I1); }
    bf16* W13 = (bf16*)(a.ws + WS_W13 + (size_t)e * W13_BYTES); bf16* W2T = (bf16*)(a.ws + WS_W2T + (size_t)e * W2_BYTES);
    if (r < I1) return conv_desc(a.in[I_E_W1] + wo, D, FF, W13, D, 1, r);
    if (r < 2 * I1) return conv_desc(a.in[I_E_W3] + wo, D, FF, W13, D, 2, r - I1);
    return conv_desc(a.in[I_E_W2] + wo, FF, D, W2T, FF, 0, r - 2 * I1);
}
__device__ __forceinline__ void conv_moe(const Args& a, int f, int gw, int NGW, LAS float* scr, int lane) {
    constexpr int I1 = (D / 64) * (FF / 64), I2 = (FF / 64) * (D / 64), PER = 2 * I1 + I2, items = NE * PER;
    int it = gw; if (it >= items) return;
    f32x2 va[33], vb[33]; ConvItem da = moe_desc(a, f, it), db = da; tr_load(da, va, lane);
    for (;;) {
        const int i1 = it + NGW; if (i1 < items) { db = moe_desc(a, f, i1); tr_load(db, vb, lane); }
        tr_store(da, va, scr, lane); if (i1 >= items) break;
        const int i2 = i1 + NGW; if (i2 < items) { da = moe_desc(a, f, i2); tr_load(da, va, lane); }
        tr_store(db, vb, scr, lane); if (i2 >= items) break;
        it = i2;
    }
}
enum { DQ_DENSE0 = 0, DQ_B, DQ_C, DQ_DENSE1, DQ_A1, DQ_MOE1, DQ_NG };
constexpr int DQ_I = (D / 64) * (FF / 64);
__device__ __forceinline__ int dq_size(int g) { return g == DQ_DENSE0 || g == DQ_DENSE1 ? 3 * DQ_I : g == DQ_B ? 1024 + 512 : g == DQ_C ? 256 : g == DQ_A1 ? 640 + 320 + 80 : NE * 3 * DQ_I; }
__device__ __forceinline__ ConvItem dq_desc0(const Args& a, int g, int idx) {
    if (g == DQ_DENSE0 || g == DQ_DENSE1) { const int f = (g == DQ_DENSE1) ? 1 : 0, m = idx / DQ_I, it = idx % DQ_I;
        if (DENSE_F8(f)) { unsigned char* W13 = a.ws + (f ? WS_WD1_13 : WS_W13); unsigned char* W2T = a.ws + (f ? WS_WD1_2 : WS_W2T);
            if (m == 0) return conv_desc8(a.in[I_F_W1] + (size_t)f * D * FF, D, FF, W13, 1, it);
            if (m == 1) return conv_desc8(a.in[I_F_W3] + (size_t)f * D * FF, D, FF, W13, 2, it);
            return conv_desc8(a.in[I_F_W2] + (size_t)f * D * FF, FF, D, W2T, 0, it); }
        bf16* W13 = (bf16*)(a.ws + (f ? WS_WD1_13 : WS_W13)); bf16* W2T = (bf16*)(a.ws + (f ? WS_WD1_2 : WS_W2T));
        if (m == 0) return conv_desc(a.in[I_F_W1] + (size_t)f * D * FF, D, FF, W13, D, 1, it);
        if (m == 1) return conv_desc(a.in[I_F_W3] + (size_t)f * D * FF, D, FF, W13, D, 2, it);
        return conv_desc(a.in[I_F_W2] + (size_t)f * D * FF, FF, D, W2T, FF, 0, it); }
    if (g == DQ_B) { if (idx < 1024) return conv_desc(a.in[I_B_W_IN], D, 2 * MI, (bf16*)(a.ws + WS_WB_IN), D, 0, idx);
        return conv_desc(a.in[I_B_W_OUT], MI, D, (bf16*)(a.ws + WS_WB_OUT), MI, 0, idx - 1024); }
    if (g == DQ_C) return conv_desc(a.in[I_C_W_GLU], D, D, (bf16*)(a.ws + WS_WC_GLU), D, 0, idx);
    if (g == DQ_A1) { if (idx < 640) { if (RG_F8(1)) return conv_desc8(a.in[I_A_W_IN] + (size_t)D * 2 * RW, D, 2 * RW, a.ws + WS_WA_IN + (size_t)2 * RW * D * 2, 0, idx);
            return conv_desc(a.in[I_A_W_IN] + (size_t)D * 2 * RW, D, 2 * RW, (bf16*)(a.ws + WS_WA_IN) + (size_t)2 * RW * D, D, 0, idx); }
        if (idx < 960) return conv_desc(a.in[I_A_W_OUT] + (size_t)RW * D, RW, D, (bf16*)(a.ws + WS_WA_OUT) + (size_t)D * RW, RW, 0, idx - 640);
        const int it = idx - 960, n = it / 8, r = it % 8, which = r / 4, q = r % 4;
        return conv_desc(a.in[which ? I_A_W_I : I_A_W_R] + ((size_t)RNB + n) * RBD * RBD, RBD, RBD, (bf16*)(a.ws + WS_WA_G) + ((size_t)RNB + n) * 256 * RBD + (size_t)which * 128 * RBD, RBD, 3, q); }
    return moe_desc(a, 1, idx);
}
__device__ __forceinline__ ConvItem dq_desc(const Args& a, int g, int idx) {
    ConvItem d = dq_desc0(a, g, idx);
#if DEFER_NORM
    if ((g == DQ_DENSE0 || g == DQ_DENSE1) && idx < 2 * DQ_I) d.kg = a.in[I_NORM_FFN] + (g == DQ_DENSE1 ? 2 : 0) * D;
    if (g == DQ_B && idx < 1024) d.kg = a.in[I_NORM_MIX] + 1 * D;
    if (g == DQ_A1 && idx < 640) d.kg = a.in[I_NORM_MIX] + 3 * D;
#endif
    return d;
}
__device__ __forceinline__ unsigned* dq_cursor(const Args& a, int g) { return (unsigned*)(a.ws + WS_CTL) + CW_DQ + 64 * g; }
__device__ __forceinline__ int dq_left(const Args& a, int g) { const int c = (int)__hip_atomic_load(dq_cursor(a, g), __ATOMIC_RELAXED, __HIP_MEMORY_SCOPE_AGENT), s = dq_size(g); return c >= s ? 0 : s - c; }
__device__ __forceinline__ void dq_work(const Args& a, int g_lo, int g_hi, int quota, LAS unsigned char* lds, LAS float* scr) {
    const int tid = otid(), lane = tid & 63, wave = tid >> 6; volatile LAS int* slot = (volatile LAS int*)(lds + MISC_OFF + 16);
    int done = 0;
    if (quota == -2) {
        __syncthreads(); if (tid == 0) *slot = (dq_left(a, g_lo) + 16 * (int)gridDim.x - 1) / (16 * (int)gridDim.x); __syncthreads(); quota = *slot; }
    for (int g = g_lo; g <= g_hi; ++g) {
        const int size = dq_size(g);
        for (;;) {
            if (quota >= 0 && done >= quota) return;
            __syncthreads();
            if (tid == 0) { int base = size; if (dq_left(a, g) > 0) base = (int)__hip_atomic_fetch_add(dq_cursor(a, g), 16u, __ATOMIC_RELAXED, __HIP_MEMORY_SCOPE_AGENT); *slot = base; }
            __syncthreads();
            const int base = *slot; if (base >= size) break;
            const int i0 = base + wave * 2, i1 = i0 + 1; ++done;
            if (i0 < size) { f32x2 va[33], vb[33]; const ConvItem da = dq_desc(a, g, i0); tr_load(da, va, lane);
                if (i1 < size) { const ConvItem db = dq_desc(a, g, i1); tr_load(db, vb, lane); tr_store(da, va, scr, lane); tr_store(db, vb, scr, lane); }
                else tr_store(da, va, scr, lane); }
        }
    }
}
__device__ __forceinline__ void conv_a(const Args& a, int j, int gw, int NGW, LAS float* scr, int lane) {
    conv_mat(a.in[I_A_W_IN] + (size_t)j * D * 2 * RW, D, 2 * RW, (bf16*)(a.ws + WS_WA_IN) + (size_t)j * 2 * RW * D, D, 0, gw, NGW, scr, lane);
    conv_mat(a.in[I_A_W_OUT] + (size_t)j * RW * D, RW, D, (bf16*)(a.ws + WS_WA_OUT) + (size_t)j * D * RW, RW, 0, gw, NGW, scr, lane);
    for (int it = gw; it < RNB * 2 * 4; it += NGW) { const int n = it / 8, r = it % 8, which = r / 4, q = r % 4;
        const float* W = a.in[which ? I_A_W_I : I_A_W_R] + ((size_t)j * RNB + n) * RBD * RBD;
        bf16* WT = (bf16*)(a.ws + WS_WA_G) + ((size_t)j * RNB + n) * 256 * RBD + (size_t)which * 128 * RBD;
        conv_item(W, RBD, RBD, WT, RBD, 3, q, scr, lane); }
}
__device__ __forceinline__ void conv_perm(const Args& a, int gw, int NGW, LAS float* scr, int lane) {
    for (int j = 0; j < 2; ++j) {
        conv_mat(a.in[I_A_W_IN] + (size_t)j * D * 2 * RW, D, 2 * RW, (bf16*)(a.ws + WS_WA_IN) + (size_t)j * 2 * RW * D, D, 0, gw, NGW, scr, lane);
        conv_mat(a.in[I_A_W_OUT] + (size_t)j * RW * D, RW, D, (bf16*)(a.ws + WS_WA_OUT) + (size_t)j * D * RW, RW, 0, gw, NGW, scr, lane);
        for (int it = gw; it < RNB * 2 * 4; it += NGW) { const int n = it / 8, r = it % 8, which = r / 4, q = r % 4;
            const float* W = a.in[which ? I_A_W_I : I_A_W_R] + ((size_t)j * RNB + n) * RBD * RBD;
            bf16* WT = (bf16*)(a.ws + WS_WA_G) + ((size_t)j * RNB + n) * 256 * RBD + (size_t)which * 128 * RBD;
            conv_item(W, RBD, RBD, WT, RBD, 3, q, scr, lane); }
    }
    conv_mat(a.in[I_B_W_IN], D, 2 * MI, (bf16*)(a.ws + WS_WB_IN), D, 0, gw, NGW, scr, lane);
    conv_mat(a.in[I_B_W_OUT], MI, D, (bf16*)(a.ws + WS_WB_OUT), MI, 0, gw, NGW, scr, lane);
    conv_mat(a.in[I_C_W_GLU], D, D, (bf16*)(a.ws + WS_WC_GLU), D, 0, gw, NGW, scr, lane);
}
__device__ __forceinline__ void s5_mats(const Args& a, LAS unsigned char* lds, int bid, int nb) {
    LAS float* lre = (LAS float*)lds; LAS float* lim = lre + 17 * 64; LAS float* bre = lim + 17 * 64; LAS float* bim = bre + 1024; LAS float* cre = bim + 1024; LAS float* cim = cre + 1024; LAS float* Kt = cim + 1024;
    const int tid = otid();
    for (int gq = bid; gq < NG * 4; gq += nb) {
        const int g = gq >> 2, q4 = gq & 3;
        __syncthreads();
        if (tid < 64) { const int p = tid; const float are = ldgf(a.in[I_C_A_RE] + g * 64 + p), aim = ldgf(a.in[I_C_A_IM] + g * 64 + p), dl = __expf(ldgf(a.in[I_C_LOG_STEP] + g));
            for (int tau = 0; tau <= 16; ++tau) { const float mag = __expf((float)tau * dl * are); float sn, cs; sincosf((float)tau * dl * aim, &sn, &cs); lre[tau * 64 + p] = mag * cs; lim[tau * 64 + p] = mag * sn; }
            const float mag = __expf(dl * are); float sn, cs; sincosf(dl * aim, &sn, &cs);
            const float nr = mag * cs - 1.0f, ni = mag * sn, den = are * are + aim * aim, fr_ = (nr * are + ni * aim) / den, fi_ = (ni * are - nr * aim) / den;
            for (int j = 0; j < 16; ++j) { const float br = ldgf(a.in[I_C_B_RE] + ((size_t)g * 64 + p) * 16 + j), bi = ldgf(a.in[I_C_B_IM] + ((size_t)g * 64 + p) * 16 + j);
                bre[p * 16 + j] = fr_ * br - fi_ * bi; bim[p * 16 + j] = fr_ * bi + fi_ * br; } }
        for (int i = tid; i < 1024; i += NTHR) { cre[i] = ldgf(a.in[I_C_C_RE] + (size_t)g * 1024 + i); cim[i] = ldgf(a.in[I_C_C_IM] + (size_t)g * 1024 + i); }
        __syncthreads();
        for (int o = tid; o < 4096; o += NTHR) { const int tau = o >> 8, i = (o >> 4) & 15, j = o & 15; float s = 0.f;
            for (int p = 0; p < 64; ++p) { const float cr = cre[i * 64 + p], ci = cim[i * 64 + p], lr = lre[tau * 64 + p], li = lim[tau * 64 + p], xr = cr * lr - ci * li, xi = cr * li + ci * lr;
                s += xr * bre[p * 16 + j] - xi * bim[p * 16 + j]; }
            Kt[o] = s; }
        __syncthreads();
        bf16* KC = (bf16*)(a.ws + WS_S5_KC) + (size_t)g * 256 * SK; bf16* BE = (bf16*)(a.ws + WS_S5_BE) + (size_t)g * 256 * 256;
        for (int o = tid; o < 64 * (SK / 8); o += NTHR) { const int n = q4 * 64 + o / (SK / 8), k0 = (o % (SK / 8)) * 8, tt = n >> 4, i = n & 15; float v[8];
#pragma unroll
            for (int q = 0; q < 8; ++q) { const int k = k0 + q;
                if (k < 256) { const int s = k >> 4, j = k & 15; v[q] = (s <= tt) ? Kt[((tt - s) << 8) + (i << 4) + j] : 0.f; }
                else { const int p = (k - 256) & 63, im = (k - 256) >> 6; const float cr = cre[i * 64 + p], ci = cim[i * 64 + p], lr = lre[(tt + 1) * 64 + p], li = lim[(tt + 1) * 64 + p];
                    v[q] = im ? -(cr * li + ci * lr) : (cr * lr - ci * li); } }
            u32x4 w; w.x = cvt_pk_bf16(v[0], v[1]); w.y = cvt_pk_bf16(v[2], v[3]); w.z = cvt_pk_bf16(v[4], v[5]); w.w = cvt_pk_bf16(v[6], v[7]);
            stg16(KC + (size_t)n * SK + k0, w); }
        for (int o = tid; o < 64 * 32; o += NTHR) { const int n = q4 * 64 + (o >> 5), k0 = (o & 31) * 8; float v[8];
#pragma unroll
            for (int q = 0; q < 8; ++q) { const int k = k0 + q, s = k >> 4, j = k & 15;
                if (n < 128) { const int p = n & 63, im = n >> 6; const float lr = lre[(15 - s) * 64 + p], li = lim[(15 - s) * 64 + p], br = bre[p * 16 + j], bi = bim[p * 16 + j];
                    v[q] = im ? (lr * bi + li * br) : (lr * br - li * bi); } else v[q] = 0.f; }
            u32x4 w; w.x = cvt_pk_bf16(v[0], v[1]); w.y = cvt_pk_bf16(v[2], v[3]); w.z = cvt_pk_bf16(v[4], v[5]); w.w = cvt_pk_bf16(v[6], v[7]);
            stg16(BE + (size_t)n * 256 + k0, w); }
    }
    __syncthreads();
}

__device__ __forceinline__ void moe_prefix(const Args& a, int f, int (&ps)[NE], int& P, int (&cnt)[NE]) {
    const unsigned* gc = (const unsigned*)(a.ws + WS_CTL) + CW_MOE + f * 1024; int acc = 0;
#pragma unroll
    for (int e = 0; e < NE; ++e) { ps[e] = acc; const int c = __builtin_amdgcn_readfirstlane((int)__hip_atomic_load(gc + e * 64, __ATOMIC_RELAXED, __HIP_MEMORY_SCOPE_AGENT)); cnt[e] = c; acc += (c + 255) >> 8; }
    P = acc;
}
template <bool COMBINE, bool ROUTER, int OUTMODE>
__device__ __forceinline__ void ph_norm(const Args& a, LAS unsigned char* lds, int bid, int nb, const float* xsrc, float* xf, const float* gain, int f) {
    const int tid = otid(), lane = tid & 63, wave = tid >> 6;
    const int RPB = T / nb;
    LAS float* rt = (LAS float*)lds; LAS int* sel = (LAS int*)(lds + 32768); LAS int* rnk = (LAS int*)(lds + 32768 + 1024); LAS int* bases = (LAS int*)(lds + 32768 + 2048); LAS int* dstl = (LAS int*)(lds + 32768 + 3072); LAS unsigned char* rows8 = lds + 36864;
    if (ROUTER) {
        const float* router = a.in[I_E_ROUTER] + (size_t)f * D * NE;
        for (int i = tid; i < D * NE; i += NTHR) rt[(i & 7) * D + (i >> 3)] = ldgf(router + i);
        __syncthreads();
    }
    f32x4 gv[4];
#pragma unroll
    for (int j = 0; j < 4; ++j) gv[j] = ldgf4(gain + 4 * lane + 256 * j);
    bf16* HN = (bf16*)(a.ws + WS_HN); bf16* UP = (bf16*)(a.ws + WS_UP);
    const bf16* OUTB = (const bf16*)(a.ws + WS_OUT); const bf16* OUTA = (const bf16*)(a.ws + WS_AG); float* TOPW = (float*)(a.ws + WS_TOPW); int* TOPI = (int*)(a.ws + WS_TOPI);
    int cps[NE], cP = 0, ccnt[NE];
    if (COMBINE) moe_prefix(a, f, cps, cP, ccnt);
#pragma unroll 1
    for (int lr0 = wave; lr0 < RPB; lr0 += NWAVES * 4) {
      f32x4 vv[4][4];
#pragma unroll
      for (int k_ = 0; k_ < 4; ++k_) { const int lrk = (lr0 + k_ * NWAVES < RPB) ? lr0 + k_ * NWAVES : lr0;
#pragma unroll
        for (int j = 0; j < 4; ++j) vv[k_][j] = ldgf4(xsrc + (size_t)(bid * RPB + lrk) * D + 4 * lane + 256 * j); }
#pragma unroll
      for (int k_ = 0; k_ < 4; ++k_) { const int lr = lr0 + k_ * NWAVES; if (lr < RPB) {
        const int row = bid * RPB + lr;
        f32x4 (&v)[4] = vv[k_];
        if (COMBINE) {
            const int t1 = ldgi(TOPI + row * 2), t2 = ldgi(TOPI + row * 2 + 1); const int e1 = t1 >> 16, e2 = t2 >> 16; int s1 = 0, s2 = 0;
#pragma unroll
            for (int e = 0; e < NE; ++e) { s1 = (e1 == e) ? cps[e] : s1; s2 = (e2 == e) ? cps[e] : s2; }
            const int r1 = s1 * 256 + (t1 & 0xffff), r2 = s2 * 256 + (t2 & 0xffff); const float p1 = ldgf(TOPW + row * 2), p2 = ldgf(TOPW + row * 2 + 1);
#pragma unroll
            for (int j = 0; j < 4; ++j) { const bool one_buf = MOE_F8(f) != 0;
                const u32x2 o1 = ldg8(OUTA + (size_t)r1 * D + 4 * lane + 256 * j), o2 = ldg8(OUTA + (size_t)r2 * D + 4 * lane + 256 * j);
                u32x2 q1 = (u32x2){0u, 0u}, q2 = (u32x2){0u, 0u};
                if (!one_buf) { q1 = ldg8(OUTB + (size_t)r1 * D + 4 * lane + 256 * j); q2 = ldg8(OUTB + (size_t)r2 * D + 4 * lane + 256 * j); }
                v[j][0] += p1 * (bflo(o1.x) + bflo(q1.x)) + p2 * (bflo(o2.x) + bflo(q2.x)); v[j][1] += p1 * (bfhi(o1.x) + bfhi(q1.x)) + p2 * (bfhi(o2.x) + bfhi(q2.x));
                v[j][2] += p1 * (bflo(o1.y) + bflo(q1.y)) + p2 * (bflo(o2.y) + bflo(q2.y)); v[j][3] += p1 * (bfhi(o1.y) + bfhi(q1.y)) + p2 * (bfhi(o2.y) + bfhi(q2.y));
                if (OUTMODE != 2) stgf4(xf + (size_t)row * D + 4 * lane + 256 * j, v[j]); }
        }
        float s2 = 0.f;
#pragma unroll
        for (int j = 0; j < 4; ++j) s2 += (v[j][0] * v[j][0] + v[j][1] * v[j][1]) + (v[j][2] * v[j][2] + v[j][3] * v[j][3]);
        const float rstd = __builtin_amdgcn_rsqf(wave_sum(s2) * (1.0f / D) + EPS);
#pragma unroll
        for (int j = 0; j < 4; ++j) v[j] = v[j] * rstd * gv[j];
        if (OUTMODE == 0) {
#pragma unroll
            for (int j = 0; j < 4; ++j) { u32x2 w; w.x = cvt_pk_bf16(v[j][0], v[j][1]); w.y = cvt_pk_bf16(v[j][2], v[j][3]); stg8(HN + (size_t)row * D + 4 * lane + 256 * j, w); }
        } else if (OUTMODE == 3) {
            if (ROUTER) {
#pragma unroll
                for (int j = 0; j < 4; ++j) *(LAS int*)(rows8 + lr * D + 4 * lane + 256 * j) = (int)cvt4_fp8(v[j][0], v[j][1], v[j][2], v[j][3]);
            } else {
#pragma unroll
                for (int j = 0; j < 4; ++j) stgi((unsigned char*)HN + (size_t)row * D + 4 * lane + 256 * j, (int)cvt4_fp8(v[j][0], v[j][1], v[j][2], v[j][3]));
            }
        } else if (OUTMODE == 1) {
            const int chunk = row >> 4, s = row & 15;
#pragma unroll
            for (int j = 0; j < 4; ++j) { const int g = (lane >> 2) + 16 * j, i0 = 4 * (lane & 3); u32x2 w; w.x = cvt_pk_bf16(v[j][0], v[j][1]); w.y = cvt_pk_bf16(v[j][2], v[j][3]);
                stg8(UP + ((size_t)g * SNC + chunk) * SK + s * 16 + i0, w); }
        } else {
#pragma unroll
            for (int j = 0; j < 4; ++j) stgf4(a.out + (size_t)row * D + 4 * lane + 256 * j, v[j]);
        }
      } }
      if (ROUTER) {
          float x[32];
#pragma unroll
          for (int i = 0; i < 32; ++i) x[i] = 0.f;
#pragma unroll
          for (int e = 0; e < NE; ++e)
#pragma unroll
              for (int j = 0; j < 4; ++j) { const f32x4 r = *(const LAS f32x4*)(rt + e * D + 4 * lane + 256 * j);
#pragma unroll
                  for (int k_ = 0; k_ < 4; ++k_) x[k_ * 8 + e] += (vv[k_][j][0] * r[0] + vv[k_][j][1] * r[1]) + (vv[k_][j][2] * r[2] + vv[k_][j][3] * r[3]);
                  if (j & 1) asm volatile("" ::: "memory"); }
#define RS_STEP(HB) { const bool up_ = (lane & (2 * (HB))) != 0; _Pragma("unroll") for (int i = 0; i < (HB); ++i) { const float send = up_ ? x[i] : x[i + (HB)], keep = up_ ? x[i + (HB)] : x[i]; x[i] = keep + __shfl_xor(send, 2 * (HB)); } }
          RS_STEP(16) RS_STEP(8) RS_STEP(4) RS_STEP(2) RS_STEP(1)
#undef RS_STEP
          const float z = x[0] + __shfl_xor(x[0], 1);
          float rb[NE];
#pragma unroll
          for (int e = 0; e < NE; ++e) rb[e] = ldgf(a.in[I_E_ROUTER_B] + f * NE + e);
#pragma unroll
          for (int k_ = 0; k_ < 4; ++k_) { const int lr = lr0 + k_ * NWAVES; if (lr < RPB) { const int row = bid * RPB + lr;
              float lg[NE];
#pragma unroll
              for (int e = 0; e < NE; ++e) lg[e] = __int_as_float(__builtin_amdgcn_readlane(__float_as_int(z), 2 * (k_ * 8 + e))) + rb[e];
              int e1 = 0; float v1 = lg[0];
#pragma unroll
              for (int e = 1; e < NE; ++e) if (lg[e] > v1) { v1 = lg[e]; e1 = e; }
              int e2 = -1; float v2 = -3.0e38f;
#pragma unroll
              for (int e = 0; e < NE; ++e) if (e != e1 && lg[e] > v2) { v2 = lg[e]; e2 = e; }
              const float p1 = 1.0f / (1.0f + __expf(v2 - v1)), p2 = 1.0f - p1;
              if (lane == 0) { sel[lr * 2] = e1; sel[lr * 2 + 1] = e2; stgf(TOPW + row * 2, p1); stgf(TOPW + row * 2 + 1, p2); } } }
      }
    }
    if (ROUTER) {
        __syncthreads();
        LAS int* wc = (LAS int*)(lds + 32768 + 3584);
        int mye = 0, myrank = 0;
        if (tid < RPB * 2) { mye = sel[tid];
#pragma unroll
            for (int q = 0; q < NE; ++q) { const unsigned long long m = __ballot(mye == q); if (mye == q) myrank = __popcll(m & ((1ull << lane) - 1ull)); if (lane == 0) wc[wave * NE + q] = __popcll(m); } }
        __syncthreads();
        if (tid < NE) { const int cnt = wc[tid] + wc[NE + tid];
            unsigned* gc = (unsigned*)(a.ws + WS_CTL) + CW_MOE + f * 1024 + tid * 64;
            bases[tid] = (int)__hip_atomic_fetch_add(gc, (unsigned)cnt, __ATOMIC_RELAXED, __HIP_MEMORY_SCOPE_AGENT); }
        __syncthreads();
        if (tid < RPB * 2) { const int e = mye, pos = bases[e] + myrank + (wave == 1 ? wc[e] : 0); stgi(TOPI + (size_t)bid * RPB * 2 + tid, (e << 16) | pos);
            stgi((int*)(a.ws + WS_LISTE) + e * T + pos, bid * RPB + (tid >> 1));
            if (OUTMODE == 3) dstl[tid] = e * T + pos; }
        __syncthreads();
        if (OUTMODE == 3) {
            unsigned char* AGX = a.ws + WS_AGX;
            for (int p = wave; p < RPB * 2; p += NWAVES) { const u32x4 x = *(const LAS u32x4*)(rows8 + (p >> 1) * D + lane * 16); stg16(AGX + (size_t)dstl[p] * D + lane * 16, x); }
            __syncthreads(); }
    }
}
__device__ __forceinline__ void ph_rg_gates(const Args& a, LAS unsigned char* lds, int bid, int nb, int jl) {
    const int tid = otid(), lane = tid & 63, wave = tid >> 6, fr = lane & 15, fq = lane >> 4;
    constexpr int AS_OFF = 0, BS_OFF = 17408, LA_OFF = 87040, BB_OFF = 87040 + 16384, XS_OFF = 87040 + 32768, RS = 272;
    const bf16* XR = (const bf16*)(a.ws + WS_XR); bf16* HL = (bf16*)(a.ws + WS_HL); bf16* AC = (bf16*)(a.ws + WS_AC);
    float* CSA = (float*)(a.ws + WS_CSA); float* CSH = (float*)(a.ws + WS_CSH);
    const int n = bid % RNB, rnk = bid / RNB, cnt = (nb - 1 - n) / RNB + 1;
    { const bf16* WG = (const bf16*)(a.ws + WS_WA_G) + ((size_t)jl * RNB + n) * 256 * RBD;
#pragma unroll
        for (int i = 0; i < 8; ++i) { const int idx = tid + NTHR * i, row = idx >> 4, c16 = idx & 15; *(LAS u32x4*)(lds + BS_OFF + row * RS + c16 * 16) = ldg16(WG + row * RBD + c16 * 8); } }
    const int r2 = tid >> 4, cg = tid & 15, ch0 = n * RBD + cg * 8;
    f32x2 cwv[4][4], cbv[4];
    { const float* cw = a.in[I_A_CONV_W] + (size_t)jl * 4 * RW; const float* cb = a.in[I_A_CONV_B] + (size_t)jl * RW;
#pragma unroll
      for (int k = 0; k < 4; ++k) { const f32x4 w0 = ldgf4(cw + (size_t)k * RW + ch0), w1 = ldgf4(cw + (size_t)k * RW + ch0 + 4); cwv[k][0] = (f32x2){w0[0], w0[1]}; cwv[k][1] = (f32x2){w0[2], w0[3]}; cwv[k][2] = (f32x2){w1[0], w1[1]}; cwv[k][3] = (f32x2){w1[2], w1[3]}; }
      const f32x4 b0 = ldgf4(cb + ch0), b1 = ldgf4(cb + ch0 + 4); cbv[0] = (f32x2){b0[0], b0[1]}; cbv[1] = (f32x2){b0[2], b0[3]}; cbv[2] = (f32x2){b1[0], b1[1]}; cbv[3] = (f32x2){b1[2], b1[3]}; }
    const int tg = wave & 3, half = wave >> 2;
    float brq[4], biq[4], spq[4];
#pragma unroll
    for (int q = 0; q < 4; ++q) { const int ch = n * RBD + 64 * half + 16 * q + fr; const float L2E = 1.4426950408889634f;
        brq[q] = L2E * ldgf(a.in[I_A_B_R] + (size_t)jl * RW + ch); biq[q] = L2E * ldgf(a.in[I_A_B_I] + (size_t)jl * RW + ch); spq[q] = 8.0f * L2E * softplus_f(-ldgf(a.in[I_A_LAM] + (size_t)jl * RW + ch)); }
    u32x4 xr_[5];
    int c = rnk;
#define RG_LOADX(cc) do { _Pragma("unroll") for (int k = 0; k < 5; ++k) { const int tk = (cc) * RCH + 2 * r2 - 3 + k; xr_[k] = (tk >= 0) ? ldg16(XR + (size_t)tk * RW + ch0) : (u32x4){0u, 0u, 0u, 0u}; } } while (0)
    if (c < RNC) RG_LOADX(c);
    for (; c < RNC; c += cnt) {
        __syncthreads();
        {
#pragma unroll
            for (int rr = 0; rr < 2; ++rr) { f32x2 acc[4];
#pragma unroll
                for (int j = 0; j < 4; ++j) acc[j] = cbv[j];
#pragma unroll
                for (int k = 0; k < 4; ++k) { const u32x4 x = xr_[rr + k];
                    acc[0] += cwv[k][0] * (f32x2){bflo(x.x), bfhi(x.x)}; acc[1] += cwv[k][1] * (f32x2){bflo(x.y), bfhi(x.y)};
                    acc[2] += cwv[k][2] * (f32x2){bflo(x.z), bfhi(x.z)}; acc[3] += cwv[k][3] * (f32x2){bflo(x.w), bfhi(x.w)}; }
                u32x4 w0; w0.x = cvt_pk_bf16(acc[0][0], acc[0][1]); w0.y = cvt_pk_bf16(acc[1][0], acc[1][1]); w0.z = cvt_pk_bf16(acc[2][0], acc[2][1]); w0.w = cvt_pk_bf16(acc[3][0], acc[3][1]);
                *(LAS u32x4*)(lds + AS_OFF + (2 * r2 + rr) * RS + cg * 16) = w0; }
        }
        { const int cn = c + cnt; if (cn < RNC) RG_LOADX(cn); }
        __syncthreads();
        f32x4 accr[4], acci[4];
#pragma unroll
        for (int q = 0; q < 4; ++q) { accr[q] = (f32x4){0.f, 0.f, 0.f, 0.f}; acci[q] = (f32x4){0.f, 0.f, 0.f, 0.f}; }
#pragma unroll
        for (int kk = 0; kk < 4; ++kk) { const bf16x8 af = *(const LAS bf16x8*)(lds + AS_OFF + (16 * tg + fr) * RS + (kk * 32 + 8 * fq) * 2);
#pragma unroll
            for (int q = 0; q < 4; ++q) { const bf16x8 br = *(const LAS bf16x8*)(lds + BS_OFF + (64 * half + 16 * q + fr) * RS + (kk * 32 + 8 * fq) * 2);
                const bf16x8 bi = *(const LAS bf16x8*)(lds + BS_OFF + (128 + 64 * half + 16 * q + fr) * RS + (kk * 32 + 8 * fq) * 2);
                accr[q] = __builtin_amdgcn_mfma_f32_16x16x32_bf16(af, br, accr[q], 0, 0, 0); acci[q] = __builtin_amdgcn_mfma_f32_16x16x32_bf16(af, bi, acci[q], 0, 0, 0); } }
#pragma unroll
        for (int q = 0; q < 4; ++q) { const int chl = 64 * half + 16 * q + fr;
#pragma unroll
            for (int pr_ = 0; pr_ < 2; ++pr_) { const int row = 16 * tg + 4 * fq + 2 * pr_;
                const f32x2 R2 = (f32x2){accr[q][2 * pr_], accr[q][2 * pr_ + 1]} + brq[q], I2 = (f32x2){acci[q][2 * pr_], acci[q][2 * pr_ + 1]} + biq[q];
                f32x2 eR, eI; eR[0] = __builtin_amdgcn_exp2f(-R2[0]); eR[1] = __builtin_amdgcn_exp2f(-R2[1]); eI[0] = __builtin_amdgcn_exp2f(-I2[0]); eI[1] = __builtin_amdgcn_exp2f(-I2[1]);
                const f32x2 dR = eR + 1.0f, dI = eI + 1.0f; f32x2 rr, ii; rr[0] = __builtin_amdgcn_rcpf(dR[0]); rr[1] = __builtin_amdgcn_rcpf(dR[1]); ii[0] = __builtin_amdgcn_rcpf(dI[0]); ii[1] = __builtin_amdgcn_rcpf(dI[1]);
                const f32x2 la = rr * spq[q]; f32x2 a_; a_[0] = __builtin_amdgcn_exp2f(-la[0]); a_[1] = __builtin_amdgcn_exp2f(-la[1]);
                f32x2 om = 1.0f - a_; om[0] = fmaxf(om[0], 0.f); om[1] = fmaxf(om[1], 0.f);
                const f32x2 t2 = om * (a_ + 1.0f); f32x2 sq; sq[0] = __builtin_amdgcn_sqrtf(t2[0]); sq[1] = __builtin_amdgcn_sqrtf(t2[1]);
                const f32x2 xr = (f32x2){bf2f(*(const LAS bf16*)(lds + AS_OFF + row * RS + chl * 2)), bf2f(*(const LAS bf16*)(lds + AS_OFF + (row + 1) * RS + chl * 2))};
                const f32x2 bb = (sq * ii) * xr;
                *(LAS bf16*)(lds + LA_OFF + (row * 128 + chl) * 2) = f2bf(om[0]); *(LAS bf16*)(lds + LA_OFF + ((row + 1) * 128 + chl) * 2) = f2bf(om[1]);
                *(LAS bf16*)(lds + BB_OFF + (row * 128 + chl) * 2) = f2bf(bb[0]); *(LAS bf16*)(lds + BB_OFF + ((row + 1) * 128 + chl) * 2) = f2bf(bb[1]); } }
        __syncthreads();
        { const int j = tid & 127, seg = tid >> 7, ch = n * RBD + j; float hl[16], pa[16]; float h = 0.f, pr = 1.f;
#pragma unroll
            for (int i = 0; i < 16; ++i) { const float om = bf2f(*(const LAS bf16*)(lds + LA_OFF + ((16 * seg + i) * 128 + j) * 2)), bb = bf2f(*(const LAS bf16*)(lds + BB_OFF + ((16 * seg + i) * 128 + j) * 2));
                const float ai = 1.0f - om; h = ai * h + bb; pr *= ai; hl[i] = h; pa[i] = pr; }
            LAS float* xs = (LAS float*)(lds + XS_OFF); xs[(seg * 128 + j) * 2] = pr; xs[(seg * 128 + j) * 2 + 1] = h;
            __syncthreads();
            float cin_h = 0.f, cin_a = 1.f;
#pragma unroll
            for (int s = 0; s < 3; ++s) if (s < seg) { const float sa = xs[(s * 128 + j) * 2], sh = xs[(s * 128 + j) * 2 + 1]; cin_h = sa * cin_h + sh; cin_a *= sa; }
#pragma unroll
            for (int i = 0; i < 16; ++i) { const float hf = hl[i] + pa[i] * cin_h, af = pa[i] * cin_a;
                *(LAS bf16*)(lds + LA_OFF + ((16 * seg + i) * 128 + j) * 2) = f2bf(hf); *(LAS bf16*)(lds + BB_OFF + ((16 * seg + i) * 128 + j) * 2) = f2bf(af);
                if (i == 15 && seg == 3) { stgf(CSA + (size_t)c * RW + ch, af); stgf(CSH + (size_t)c * RW + ch, hf); } } }
        __syncthreads();
#pragma unroll
        for (int i = 0; i < 2; ++i) { const int idx = tid + NTHR * i, row = idx >> 4, c16 = idx & 15; const size_t o = (size_t)(c * RCH + row) * RW + n * RBD + c16 * 8;
            stg16(HL + o, *(const LAS u32x4*)(lds + LA_OFF + row * 256 + c16 * 16)); stg16(AC + o, *(const LAS u32x4*)(lds + BB_OFF + row * 256 + c16 * 16)); }
    }
#undef RG_LOADX
    __syncthreads();
}
__device__ __forceinline__ void ph_rg_carry(const Args& a, int bid, int nb) {
    const int tid = otid(), lane = tid & 63, gw = bid * NWAVES + (tid >> 6), NGW = nb * NWAVES;
    const float* CSA = (const float*)(a.ws + WS_CSA); const float* CSH = (const float*)(a.ws + WS_CSH); float* CIN = (float*)(a.ws + WS_CIN);
    for (int ch = gw; ch < RW; ch += NGW) {
        float Ak[4], Hk[4]; float A = 1.f, H = 0.f;
#pragma unroll
        for (int k = 0; k < 4; ++k) { Ak[k] = ldgf(CSA + (size_t)(4 * lane + k) * RW + ch); Hk[k] = ldgf(CSH + (size_t)(4 * lane + k) * RW + ch); H = Ak[k] * H + Hk[k]; A = Ak[k] * A; }
#pragma unroll
        for (int off = 1; off < 64; off <<= 1) { const float Ay = __shfl_up(A, off), Hy = __shfl_up(H, off); if (lane >= off) { H = A * Hy + H; A = A * Ay; } }
        float h = __shfl_up(H, 1); if (lane == 0) h = 0.f;
#pragma unroll
        for (int k = 0; k < 4; ++k) { stgf(CIN + (size_t)(4 * lane + k) * RW + ch, h); h = Ak[k] * h + Hk[k]; }
    }
}
__device__ __forceinline__ void ph_rg_fix(const Args& a, int bid, int nb) {
    const int tid = otid(); bf16* GX = (bf16*)(a.ws + WS_GX); const bf16* HL = (const bf16*)(a.ws + WS_HL); const bf16* AC = (const bf16*)(a.ws + WS_AC); const float* CIN = (const float*)(a.ws + WS_CIN);
    const int total = T * (RW / 8);
    for (int it = bid * NTHR + tid; it < total; it += nb * NTHR) {
        const int t = it / (RW / 8), ch = (it % (RW / 8)) * 8, c = t / RCH; const size_t o = (size_t)t * RW + ch;
        const u32x4 g = ldg16(GX + o), hl = ldg16(HL + o), ac = ldg16(AC + o); const f32x4 c0 = ldgf4(CIN + (size_t)c * RW + ch), c1 = ldgf4(CIN + (size_t)c * RW + ch + 4);
        float y[8];
        y[0] = gelu_tanh(bflo(g.x)) * (bflo(hl.x) + bflo(ac.x) * c0[0]); y[1] = gelu_tanh(bfhi(g.x)) * (bfhi(hl.x) + bfhi(ac.x) * c0[1]);
        y[2] = gelu_tanh(bflo(g.y)) * (bflo(hl.y) + bflo(ac.y) * c0[2]); y[3] = gelu_tanh(bfhi(g.y)) * (bfhi(hl.y) + bfhi(ac.y) * c0[3]);
        y[4] = gelu_tanh(bflo(g.z)) * (bflo(hl.z) + bflo(ac.z) * c1[0]); y[5] = gelu_tanh(bfhi(g.z)) * (bfhi(hl.z) + bfhi(ac.z) * c1[1]);
        y[6] = gelu_tanh(bflo(g.w)) * (bflo(hl.w) + bflo(ac.w) * c1[2]); y[7] = gelu_tanh(bfhi(g.w)) * (bfhi(hl.w) + bfhi(ac.w) * c1[3]);
        u32x4 w; w.x = cvt_pk_bf16(y[0], y[1]); w.y = cvt_pk_bf16(y[2], y[3]); w.z = cvt_pk_bf16(y[4], y[5]); w.w = cvt_pk_bf16(y[6], y[7]);
        stg16(GX + o, w);
    }
}

__device__ __forceinline__ void ph_ml_prep(const Args& a, LAS unsigned char* lds, int bid, int nb) {
    const bf16* XM = (const bf16*)(a.ws + WS_XM); bf16* Q = (bf16*)(a.ws + WS_Q); bf16* Kb = (bf16*)(a.ws + WS_K); bf16* XC = (bf16*)(a.ws + WS_XC);
    float* GI = (float*)(a.ws + WS_GI); float* GF = (float*)(a.ws + WS_GF);
    LAS float* red = (LAS float*)(lds + EXTRA_OFF);
    const float kscale = 0.044194173824159216f;
    for (int tb = bid; tb < T / 64; tb += nb) {
        const int t0 = tb * 64;
        {
            const int tid = otid(), lane = tid & 63, wave = tid >> 6, n4 = tid * 4;
            f32x2 cw[4][2], cb[2], wq[4][2], wk[4][2], wv[4][2], gqk[4][4], gv[4][4];
#pragma unroll
            for (int k = 0; k < 4; ++k) { const f32x4 v = ldgf4(a.in[I_B_CONV_W] + k * MI + n4); cw[k][0] = (f32x2){v[0], v[1]}; cw[k][1] = (f32x2){v[2], v[3]}; }
            { const f32x4 v = ldgf4(a.in[I_B_CONV_B] + n4); cb[0] = (f32x2){v[0], v[1]}; cb[1] = (f32x2){v[2], v[3]}; }
#pragma unroll
            for (int i = 0; i < 4; ++i) { const f32x4 q_ = ldgf4(a.in[I_B_W_Q] + tid * 16 + i * 4), k_ = ldgf4(a.in[I_B_W_K] + tid * 16 + i * 4), v_ = ldgf4(a.in[I_B_W_V] + tid * 16 + i * 4);
                wq[i][0] = (f32x2){q_[0], q_[1]}; wq[i][1] = (f32x2){q_[2], q_[3]}; wk[i][0] = (f32x2){k_[0], k_[1]}; wk[i][1] = (f32x2){k_[2], k_[3]}; wv[i][0] = (f32x2){v_[0], v_[1]}; wv[i][1] = (f32x2){v_[2], v_[3]}; }
#pragma unroll
            for (int i = 0; i < 4; ++i)
#pragma unroll
                for (int e = 0; e < 4; ++e) { gqk[i][e] = (f32x2){0.f, 0.f}; gv[i][e] = (f32x2){0.f, 0.f}; }
#pragma unroll
            for (int j = 0; j < 4; ++j) { const float* pwg = a.in[I_B_W_GATE];
                const f32x4 a0 = ldgf4(pwg + (size_t)(0 * MI + n4 + j) * 8), a1 = ldgf4(pwg + (size_t)(0 * MI + n4 + j) * 8 + 4);
                const f32x4 b0 = ldgf4(pwg + (size_t)(1 * MI + n4 + j) * 8), b1 = ldgf4(pwg + (size_t)(1 * MI + n4 + j) * 8 + 4);
                const f32x4 c0 = ldgf4(pwg + (size_t)(2 * MI + n4 + j) * 8), c1 = ldgf4(pwg + (size_t)(2 * MI + n4 + j) * 8 + 4);
                const f32x2 ga[4] = {(f32x2){a0[0], a0[1]}, (f32x2){a0[2], a0[3]}, (f32x2){a1[0], a1[1]}, (f32x2){a1[2], a1[3]}};
                const f32x2 gb[4] = {(f32x2){b0[0], b0[1]}, (f32x2){b0[2], b0[3]}, (f32x2){b1[0], b1[1]}, (f32x2){b1[2], b1[3]}};
                const f32x2 gc[4] = {(f32x2){c0[0], c0[1]}, (f32x2){c0[2], c0[3]}, (f32x2){c1[0], c1[1]}, (f32x2){c1[2], c1[3]}};
#pragma unroll
                for (int i = 0; i < 4; ++i) { const float wq_ = wq[i][j >> 1][j & 1], wk_ = wk[i][j >> 1][j & 1], wv_ = wv[i][j >> 1][j & 1];
#pragma unroll
                    for (int e = 0; e < 4; ++e) { gqk[i][e] += ga[e] * wq_ + gb[e] * wk_; gv[i][e] += gc[e] * wv_; } } }
            f32x2 x0[2], x1[2], x2[2], x3[2];
#pragma unroll
            for (int p = 0; p < 2; ++p) { x0[p] = (f32x2){0.f, 0.f}; x1[p] = x0[p]; x2[p] = x0[p]; }
            if (t0 > 0) { const u32x2 p0 = ldg8(XM + (size_t)(t0 - 3) * MI + n4), p1 = ldg8(XM + (size_t)(t0 - 2) * MI + n4), p2 = ldg8(XM + (size_t)(t0 - 1) * MI + n4);
                x0[0] = (f32x2){bflo(p0.x), bfhi(p0.x)}; x0[1] = (f32x2){bflo(p0.y), bfhi(p0.y)}; x1[0] = (f32x2){bflo(p1.x), bfhi(p1.x)}; x1[1] = (f32x2){bflo(p1.y), bfhi(p1.y)};
                x2[0] = (f32x2){bflo(p2.x), bfhi(p2.x)}; x2[1] = (f32x2){bflo(p2.y), bfhi(p2.y)}; }
            u32x2 xs[8], xn[8];
#pragma unroll
            for (int b = 0; b < 8; ++b) xs[b] = ldg8(XM + (size_t)(t0 + b) * MI + n4);
#pragma unroll 1
            for (int tl0 = 0; tl0 < 64; tl0 += 8) {
              { const int tn = (tl0 + 8 < 64) ? tl0 + 8 : tl0;
#pragma unroll
                for (int b = 0; b < 8; ++b) xn[b] = ldg8(XM + (size_t)(t0 + tn + b) * MI + n4); }
#pragma unroll 1
              for (int b = 0; b < 8; ++b) {
                const int tl = tl0 + b, t = t0 + tl;
                { const u32x2 p3 = xs[0];
#pragma unroll
                  for (int q = 0; q < 7; ++q) xs[q] = xs[q + 1];
                  x3[0] = (f32x2){bflo(p3.x), bfhi(p3.x)}; x3[1] = (f32x2){bflo(p3.y), bfhi(p3.y)}; }
                float xc[4]; f32x2 q2[2], k2[2], v2[2];
#pragma unroll
                for (int p = 0; p < 2; ++p) { const f32x2 cv = cb[p] + cw[0][p] * x0[p] + cw[1][p] * x1[p] + cw[2][p] * x2[p] + cw[3][p] * x3[p]; xc[2 * p] = silu_f(cv[0]); xc[2 * p + 1] = silu_f(cv[1]); }
                const float xm[4] = {x3[0][0], x3[0][1], x3[1][0], x3[1][1]};
#pragma unroll
                for (int p = 0; p < 2; ++p) { q2[p] = wq[0][p] * xc[0] + wq[1][p] * xc[1] + wq[2][p] * xc[2] + wq[3][p] * xc[3]; k2[p] = wk[0][p] * xc[0] + wk[1][p] * xc[1] + wk[2][p] * xc[2] + wk[3][p] * xc[3];
                    v2[p] = wv[0][p] * xm[0] + wv[1][p] * xm[1] + wv[2][p] * xm[2] + wv[3][p] * xm[3]; }
                { u32x2 w; w.x = cvt_pk_bf16(q2[0][0], q2[0][1]); w.y = cvt_pk_bf16(q2[1][0], q2[1][1]); stg8(Q + (size_t)t * MI + n4, w);
                  w.x = cvt_pk_bf16(k2[0][0] * kscale, k2[0][1] * kscale); w.y = cvt_pk_bf16(k2[1][0] * kscale, k2[1][1] * kscale); stg8(Kb + (size_t)t * MI + n4, w);
                  w.x = cvt_pk_bf16(xc[0], xc[1]); w.y = cvt_pk_bf16(xc[2], xc[3]); stg8(XC + (size_t)t * MI + n4, w);
                  (void)v2; }
                f32x2 g2[4];
#pragma unroll
                for (int e = 0; e < 4; ++e) g2[e] = gqk[0][e] * xc[0] + gqk[1][e] * xc[1] + gqk[2][e] * xc[2] + gqk[3][e] * xc[3] + gv[0][e] * xm[0] + gv[1][e] * xm[1] + gv[2][e] * xm[2] + gv[3][e] * xm[3];
                const float g[8] = {g2[0][0], g2[0][1], g2[1][0], g2[1][1], g2[2][0], g2[2][1], g2[3][0], g2[3][1]};
                { const bool h5 = (lane & 32) != 0; float k4[4];
#pragma unroll
                  for (int e = 0; e < 4; ++e) { const float snd = h5 ? g[e] : g[4 + e], kp = h5 ? g[4 + e] : g[e]; k4[e] = kp + __shfl_xor(snd, 32); }
                  const bool h4 = (lane & 16) != 0; float k2_[2];
#pragma unroll
                  for (int e = 0; e < 2; ++e) { const float snd = h4 ? k4[e] : k4[2 + e], kp = h4 ? k4[2 + e] : k4[e]; k2_[e] = kp + __shfl_xor(snd, 16); }
                  const bool h3 = (lane & 8) != 0; const float snd = h3 ? k2_[0] : k2_[1], kp = h3 ? k2_[1] : k2_[0]; float k1 = kp + __shfl_xor(snd, 8);
                  k1 += __shfl_xor(k1, 4); k1 += __shfl_xor(k1, 2); k1 += __shfl_xor(k1, 1);
                  if ((lane & 7) == 0) red[(tl * 8 + wave) * 8 + (lane >> 3)] = k1; }
#pragma unroll
                for (int p = 0; p < 2; ++p) { x0[p] = x1[p]; x1[p] = x2[p]; x2[p] = x3[p]; }
              }
#pragma unroll
              for (int b = 0; b < 8; ++b) xs[b] = xn[b];
            }
        }
        __syncthreads();
        { const int tid = otid(), tok = tid >> 3, e = tid & 7; float s = ldgf(a.in[I_B_B_GATE] + e);
#pragma unroll
            for (int w = 0; w < 8; ++w) s += red[(tok * 8 + w) * 8 + e];
            if (e < 4) stgf(GI + (size_t)e * T + t0 + tok, s); else stgf(GF + (size_t)(e - 4) * T + t0 + tok, -softplus_f(-s)); }
        __syncthreads();
    }
}
__device__ __forceinline__ void ph_ml_gscan(const Args& a, LAS unsigned char* lds, int bid, int nb) {
    const int tid = otid(), lane = tid & 63, wave = tid >> 6;
    const float* GI = (const float*)(a.ws + WS_GI); const float* GF = (const float*)(a.ws + WS_GF);
    float* GS = (float*)(a.ws + WS_GS); float* RMT = (float*)(a.ws + WS_RMT); float* EF = (float*)(a.ws + WS_EF); float* MC = (float*)(a.ws + WS_MC);
    LAS float* wt = (LAS float*)lds;
    for (int h = bid; h < MH; h += nb) {
        __syncthreads();
        float lf[32], ig[32]; float s = 0.f;
#pragma unroll
        for (int q = 0; q < 8; ++q) { const f32x4 v = ldgf4(GF + (size_t)h * T + tid * 32 + 4 * q), w = ldgf4(GI + (size_t)h * T + tid * 32 + 4 * q);
            lf[4 * q] = v[0]; lf[4 * q + 1] = v[1]; lf[4 * q + 2] = v[2]; lf[4 * q + 3] = v[3]; ig[4 * q] = w[0]; ig[4 * q + 1] = w[1]; ig[4 * q + 2] = w[2]; ig[4 * q + 3] = w[3]; }
#pragma unroll
        for (int i = 0; i < 32; ++i) s += lf[i];
        float inc = s;
#pragma unroll
        for (int off = 1; off < 64; off <<= 1) { const float y = __shfl_up(inc, off); if (lane >= off) inc += y; }
        if (lane == 63) wt[wave] = inc;
        __syncthreads();
        float base = inc - s;
#pragma unroll
        for (int w = 0; w < 8; ++w) if (w < wave) base += wt[w];
        float F = base, lmax = -3.0e38f;
#pragma unroll
        for (int i = 0; i < 32; ++i) { F += lf[i]; lf[i] = F; ig[i] = ig[i] - F; lmax = fmaxf(lmax, ig[i]); }
        float minc = lmax;
#pragma unroll
        for (int off = 1; off < 64; off <<= 1) { const float y = __shfl_up(minc, off); if (lane >= off) minc = fmaxf(minc, y); }
        __syncthreads();
        if (lane == 63) wt[8 + wave] = minc;
        __syncthreads();
        float pm = __shfl_up(minc, 1); if (lane == 0) pm = -3.0e38f;
#pragma unroll
        for (int w = 0; w < 8; ++w) if (w < wave) pm = fmaxf(pm, wt[8 + w]);
        float rm = fmaxf(pm, 0.f);
#pragma unroll
        for (int i = 0; i < 32; ++i) { rm = fmaxf(rm, ig[i]); const size_t o = (size_t)h * T + tid * 32 + i; stgf(GS + o, ig[i]); stgf(RMT + o, rm); stgf(EF + o, __expf(-lf[i] - rm)); }
        if ((tid & 7) == 7) stgf(MC + h * 80 + (tid + 1) / 8, rm);
        if (tid == 0) stgf(MC + h * 80, 0.f);
    }
    __syncthreads();
}
__device__ __forceinline__ void ph_ml_ktw(const Args& a, LAS unsigned char* lds, int bid, int nb) {
    const bf16* Kn = (const bf16*)(a.ws + WS_K); const bf16* Xm = (const bf16*)(a.ws + WS_XM); bf16* KT = (bf16*)(a.ws + WS_KT); bf16* VT = (bf16*)(a.ws + WS_VT);
    const float* GS = (const float*)(a.ws + WS_GS); const float* MC = (const float*)(a.ws + WS_MC); float* NS = (float*)(a.ws + WS_NS);
    LAS float* w = (LAS float*)(lds + EXTRA_OFF); constexpr int TS = 144;
    for (int u = bid; u < MNC * MH; u += nb) { const int c = u / MH, h = u % MH; const int tid = otid(), lane = tid & 63, wave = tid >> 6;
        LAS unsigned char* tile = lds + wave * 16384;
        __syncthreads();
        if (tid < MCH) w[tid] = __expf(ldgf(GS + (size_t)h * T + c * MCH + tid) - ldgf(MC + h * 80 + c + 1));
        __syncthreads();
        const int ch0 = h * HD + wave * 64, rr = lane >> 3, c8 = lane & 7;
        f32x2 wvv[2][4][2];
#pragma unroll
        for (int bk = 0; bk < 2; ++bk)
#pragma unroll
            for (int i = 0; i < 4; ++i) { const f32x4 wr = ldgf4(a.in[I_B_W_V] + (size_t)((ch0 + c8 * 8) / 4 + bk) * 16 + i * 4); wvv[bk][i][0] = (f32x2){wr[0], wr[1]}; wvv[bk][i][1] = (f32x2){wr[2], wr[3]}; }
        float psum[8];
#pragma unroll
        for (int i = 0; i < 8; ++i) psum[i] = 0.f;
#pragma unroll 1
        for (int pass = 0; pass < 8; ++pass) { const int isv = pass >> 2, tg = pass & 3; const bf16* src = (isv ? Xm : Kn) + (size_t)(c * MCH + tg * 64) * MI + ch0; bf16* dst = (isv ? VT : KT) + ((size_t)u * HD + wave * 64) * MCH + tg * 64;
            u32x4 x[8];
#pragma unroll
            for (int i = 0; i < 8; ++i) x[i] = ldg16(src + (size_t)(rr + 8 * i) * MI + c8 * 8);
            if (isv) {
#pragma unroll
                for (int i = 0; i < 8; ++i) { const u32x4 xx = x[i]; const float xa[4] = {bflo(xx.x), bfhi(xx.x), bflo(xx.y), bfhi(xx.y)}, xb[4] = {bflo(xx.z), bfhi(xx.z), bflo(xx.w), bfhi(xx.w)};
                    const f32x2 va0 = wvv[0][0][0] * xa[0] + wvv[0][1][0] * xa[1] + wvv[0][2][0] * xa[2] + wvv[0][3][0] * xa[3], va1 = wvv[0][0][1] * xa[0] + wvv[0][1][1] * xa[1] + wvv[0][2][1] * xa[2] + wvv[0][3][1] * xa[3];
                    const f32x2 vb0 = wvv[1][0][0] * xb[0] + wvv[1][1][0] * xb[1] + wvv[1][2][0] * xb[2] + wvv[1][3][0] * xb[3], vb1 = wvv[1][0][1] * xb[0] + wvv[1][1][1] * xb[1] + wvv[1][2][1] * xb[2] + wvv[1][3][1] * xb[3];
                    u32x4 o; o.x = cvt_pk_bf16(va0[0], va0[1]); o.y = cvt_pk_bf16(va1[0], va1[1]); o.z = cvt_pk_bf16(vb0[0], vb0[1]); o.w = cvt_pk_bf16(vb1[0], vb1[1]); x[i] = o; } }
#pragma unroll
            for (int i = 0; i < 8; ++i) *(LAS u32x4*)(tile + (rr + 8 * i) * TS + c8 * 16) = x[i];
            LDS_WAIT(); asm volatile("" ::: "memory");
#pragma unroll
            for (int i = 0; i < 8; ++i) { const int d = rr + 8 * i; const LAS bf16* tp = (const LAS bf16*)(tile + (c8 * 8) * TS) + d; float v[8];
#pragma unroll
                for (int q = 0; q < 8; ++q) v[q] = bf2f(tp[q * (TS / 2)]);
                if (!isv) { const LAS float* wp = w + tg * 64 + c8 * 8;
#pragma unroll
                    for (int q = 0; q < 8; ++q) v[q] *= wp[q]; }
                u32x4 o; o.x = cvt_pk_bf16(v[0], v[1]); o.y = cvt_pk_bf16(v[2], v[3]); o.z = cvt_pk_bf16(v[4], v[5]); o.w = cvt_pk_bf16(v[6], v[7]);
                if (!isv) psum[i] += (bflo(o.x) + bfhi(o.x)) + (bflo(o.y) + bfhi(o.y)) + (bflo(o.z) + bfhi(o.z)) + (bflo(o.w) + bfhi(o.w));
                stg16(dst + (size_t)d * MCH + c8 * 8, o); }
            LDS_WAIT(); asm volatile("" ::: "memory");
        }
#pragma unroll
        for (int i = 0; i < 8; ++i) { float ps = psum[i]; ps += __shfl_xor(ps, 1); ps += __shfl_xor(ps, 2); ps += __shfl_xor(ps, 4); if (c8 == 0) stgf(NS + (size_t)u * HD + wave * 64 + rr + 8 * i, ps); }
    }
    asm volatile("s_waitcnt vmcnt(0)" ::: "memory");
    __syncthreads();
}
__device__ __forceinline__ void ph_ml_sscan(const Args& a, int bid, int nb) {
    bf16* CT = (bf16*)(a.ws + WS_CT); float* NS = (float*)(a.ws + WS_NS); const float* MC = (const float*)(a.ws + WS_MC);
    { const int tid = otid(), lane = tid & 63, gw = bid * NWAVES + (tid >> 6), NGW = nb * NWAVES;
      static_assert(MNC == 64, "one lane per chunk");
      for (int it = gw; it < MH * HD; it += NGW) { const int h = it / HD, d = it % HD; float* q = NS + ((size_t)lane * MH + h) * HD + d;
          float H = ldgf(q), A = __expf(ldgf(MC + h * 80 + lane) - ldgf(MC + h * 80 + lane + 1));
#pragma unroll
          for (int off = 1; off < 64; off <<= 1) { const float Ay = __shfl_up(A, off), Hy = __shfl_up(H, off); if (lane >= off) { H = A * Hy + H; A = A * Ay; } }
          float o = __shfl_up(H, 1); if (lane == 0) o = 0.f; stgf(q, o); } }
    for (int it = bid * NTHR + otid(); it < MH * HD * (HD / 8); it += nb * NTHR) {
        const int h = it / (HD * (HD / 8)), rem = it % (HD * (HD / 8)); bf16* p = CT + (size_t)h * HD * HD + (size_t)rem * 8; const size_t cs = (size_t)MH * HD * HD;
        float run[8];
#pragma unroll
        for (int j = 0; j < 8; ++j) run[j] = 0.f;
        u32x4 sv[8], sn[8];
#pragma unroll
        for (int q = 0; q < 8; ++q) sv[q] = ldg16(p + (size_t)q * cs);
        for (int c0 = 0; c0 < MNC; c0 += 8) {
            float dec[8]; const int cn = (c0 + 8 < MNC) ? c0 + 8 : c0;
#pragma unroll
            for (int q = 0; q < 8; ++q) { sn[q] = ldg16(p + (size_t)(cn + q) * cs); dec[q] = __expf(ldgf(MC + h * 80 + c0 + q) - ldgf(MC + h * 80 + c0 + q + 1)); }
#pragma unroll
            for (int q = 0; q < 8; ++q) { u32x4 o; o.x = cvt_pk_bf16(run[0], run[1]); o.y = cvt_pk_bf16(run[2], run[3]); o.z = cvt_pk_bf16(run[4], run[5]); o.w = cvt_pk_bf16(run[6], run[7]);
                stg16(p + (size_t)(c0 + q) * cs, o);
                run[0] = dec[q] * run[0] + bflo(sv[q].x); run[1] = dec[q] * run[1] + bfhi(sv[q].x); run[2] = dec[q] * run[2] + bflo(sv[q].y); run[3] = dec[q] * run[3] + bfhi(sv[q].y);
                run[4] = dec[q] * run[4] + bflo(sv[q].z); run[5] = dec[q] * run[5] + bfhi(sv[q].z); run[6] = dec[q] * run[6] + bflo(sv[q].w); run[7] = dec[q] * run[7] + bfhi(sv[q].w); }
#pragma unroll
            for (int q = 0; q < 8; ++q) sv[q] = sn[q];
        }
    }
}
struct FinIn { u32x4 nu, qv, zv, xv; f32x4 n0, n1, dp, g0, g1, k0, k1; float mc, rmt, ef; };
__device__ __forceinline__ FinIn fin_load(const Args& a, int it, int e0) {
    const bf16* NUM = (const bf16*)(a.ws + WS_NUM); const bf16* Q = (const bf16*)(a.ws + WS_Q); const bf16* Z = (const bf16*)(a.ws + WS_Z); const bf16* XC = (const bf16*)(a.ws + WS_XC);
    const float* NS = (const float*)(a.ws + WS_NS); const float* DENP = (const float*)(a.ws + WS_DENP); const float* MC = (const float*)(a.ws + WS_MC); const float* RMT = (const float*)(a.ws + WS_RMT); const float* EF = (const float*)(a.ws + WS_EF);
    const int t = it >> 2, h = it & 3, c = t >> 8, r = t & 255; const size_t o = (size_t)t * MI + h * HD + e0, cth = (size_t)(c * MH + h);
    FinIn f; f.nu = ldg16(NUM + o); f.qv = ldg16(Q + o); f.zv = ldg16(Z + o); f.xv = ldg16(XC + o);
    f.n0 = ldgf4(NS + cth * HD + e0); f.n1 = ldgf4(NS + cth * HD + e0 + 4); f.dp = ldgf4(DENP + (cth * MCH + r) * 4);
    f.g0 = ldgf4(a.in[I_B_NORM] + h * HD + e0); f.g1 = ldgf4(a.in[I_B_NORM] + h * HD + e0 + 4); f.k0 = ldgf4(a.in[I_B_SKIP] + h * HD + e0); f.k1 = ldgf4(a.in[I_B_SKIP] + h * HD + e0 + 4);
    f.mc = ldgf(MC + h * 80 + c); f.rmt = ldgf(RMT + (size_t)h * T + t); f.ef = ldgf(EF + (size_t)h * T + t); return f;
}
__device__ __forceinline__ void fin_compute(const Args& a, int it, int e0, const FinIn& f) {
    bf16* Y = (bf16*)(a.ws + WS_Y); const int t = it >> 2, h = it & 3; const size_t o = (size_t)t * MI + h * HD + e0;
    const u32x4 nu = f.nu, qv = f.qv, zv = f.zv, xv = f.xv;
    const f32x2 num[4] = {(f32x2){bflo(nu.x), bfhi(nu.x)}, (f32x2){bflo(nu.y), bfhi(nu.y)}, (f32x2){bflo(nu.z), bfhi(nu.z)}, (f32x2){bflo(nu.w), bfhi(nu.w)}};
    const f32x2 qq[4] = {(f32x2){bflo(qv.x), bfhi(qv.x)}, (f32x2){bflo(qv.y), bfhi(qv.y)}, (f32x2){bflo(qv.z), bfhi(qv.z)}, (f32x2){bflo(qv.w), bfhi(qv.w)}};
    const f32x2 nn[4] = {(f32x2){f.n0[0], f.n0[1]}, (f32x2){f.n0[2], f.n0[3]}, (f32x2){f.n1[0], f.n1[1]}, (f32x2){f.n1[2], f.n1[3]}};
    const f32x2 qn2 = (qq[0] * nn[0] + qq[1] * nn[1]) + (qq[2] * nn[2] + qq[3] * nn[3]);
    const float qn = wave_sum(qn2[0] + qn2[1]);
    const float rs = __expf(f.mc - f.rmt), den = rs * ((f.dp[0] + f.dp[1]) + (f.dp[2] + f.dp[3]) + qn);
    const float inv = __builtin_amdgcn_rcpf(fmaxf(fabsf(den), f.ef));
    f32x2 hc[4], s2 = (f32x2){0.f, 0.f};
#pragma unroll
    for (int i = 0; i < 4; ++i) { hc[i] = num[i] * inv; s2 += hc[i] * hc[i]; }
    const float rstd = __builtin_amdgcn_rsqf(wave_sum(s2[0] + s2[1]) * (1.0f / HD) + EPS);
    const f32x2 gg[4] = {(f32x2){f.g0[0], f.g0[1]}, (f32x2){f.g0[2], f.g0[3]}, (f32x2){f.g1[0], f.g1[1]}, (f32x2){f.g1[2], f.g1[3]}};
    const f32x2 sk[4] = {(f32x2){f.k0[0], f.k0[1]}, (f32x2){f.k0[2], f.k0[3]}, (f32x2){f.k1[0], f.k1[1]}, (f32x2){f.k1[2], f.k1[3]}};
    const f32x2 zz[4] = {(f32x2){bflo(zv.x), bfhi(zv.x)}, (f32x2){bflo(zv.y), bfhi(zv.y)}, (f32x2){bflo(zv.z), bfhi(zv.z)}, (f32x2){bflo(zv.w), bfhi(zv.w)}};
    const f32x2 xx[4] = {(f32x2){bflo(xv.x), bfhi(xv.x)}, (f32x2){bflo(xv.y), bfhi(xv.y)}, (f32x2){bflo(xv.z), bfhi(xv.z)}, (f32x2){bflo(xv.w), bfhi(xv.w)}};
    f32x2 y[4];
#pragma unroll
    for (int i = 0; i < 4; ++i) { const f32x2 zl = zz[i] * -1.4426950408889634f; f32x2 e; e[0] = __builtin_amdgcn_exp2f(zl[0]); e[1] = __builtin_amdgcn_exp2f(zl[1]);
        const f32x2 d = e + 1.0f; f32x2 sg; sg[0] = __builtin_amdgcn_rcpf(d[0]); sg[1] = __builtin_amdgcn_rcpf(d[1]);
        y[i] = sg * ((hc[i] * rstd) * gg[i] + sk[i] * xx[i]); }
    u32x4 w; w.x = cvt_pk_bf16(y[0][0], y[0][1]); w.y = cvt_pk_bf16(y[1][0], y[1][1]); w.z = cvt_pk_bf16(y[2][0], y[2][1]); w.w = cvt_pk_bf16(y[3][0], y[3][1]);
    stg16(Y + o, w);
}
__device__ __forceinline__ void ph_ml_fin(const Args& a, int bid, int nb) {
    const int tid = otid(), lane = tid & 63, wave = tid >> 6, e0 = 8 * lane;
    asm volatile("s_waitcnt vmcnt(0)" ::: "memory"); __syncthreads();
    for (int p = bid; p < MNC * MH; p += nb) { const int ch = p / MH, h = p % MH;
        for (int r = wave; r < MCH; r += 4 * NWAVES) { const int i0 = ((ch * MCH + r) << 2) + h, st = NWAVES << 2;
            const FinIn f0 = fin_load(a, i0, e0), f1 = fin_load(a, i0 + st, e0), f2 = fin_load(a, i0 + 2 * st, e0), f3 = fin_load(a, i0 + 3 * st, e0);
            fin_compute(a, i0, e0, f0); fin_compute(a, i0 + st, e0, f1); fin_compute(a, i0 + 2 * st, e0, f2); fin_compute(a, i0 + 3 * st, e0, f3); } }
}

__device__ __forceinline__ void ph_s5_scan(const Args& a, LAS unsigned char* lds, int bid, int nb) {
    const int tid = otid(), pl = tid & 15, seg = tid >> 4;
    const float* EB = (const float*)(a.ws + WS_EB); bf16* UP = (bf16*)(a.ws + WS_UP); LAS float* tot = (LAS float*)lds;
    for (int u = bid; u < NG * 4; u += nb) {
        const int g = u >> 2, p = 16 * (u & 3) + pl;
        const float are = ldgf(a.in[I_C_A_RE] + g * 64 + p), aim = ldgf(a.in[I_C_A_IM] + g * 64 + p), dl = __expf(ldgf(a.in[I_C_LOG_STEP] + g));
        float lr, li; { const float mag = __expf(dl * are); float sn, cs; sincosf(dl * aim, &sn, &cs); lr = mag * cs; li = mag * sn; }
#pragma unroll
        for (int q = 0; q < 4; ++q) { const float nr = lr * lr - li * li, ni = 2.f * lr * li; lr = nr; li = ni; }
        float sr = lr, si = li;
#pragma unroll
        for (int q = 0; q < 5; ++q) { const float nr = sr * sr - si * si, ni = 2.f * sr * si; sr = nr; si = ni; }
        const float* eb = EB + ((size_t)g * SNC + seg * 32) * 128 + p;
        float str = 0.f, sti = 0.f;
#pragma unroll 8
        for (int c = 0; c < 32; ++c) { const float er = ldgf(eb + (size_t)c * 128), ei = ldgf(eb + (size_t)c * 128 + 64); const float nr = lr * str - li * sti + er, ni = lr * sti + li * str + ei; str = nr; sti = ni; }
        __syncthreads();
        tot[(seg * 16 + pl) * 2] = str; tot[(seg * 16 + pl) * 2 + 1] = sti;
        __syncthreads();
        float cr = 0.f, ci = 0.f;
        for (int s = 0; s < seg; ++s) { const float tr = tot[(s * 16 + pl) * 2], ti = tot[(s * 16 + pl) * 2 + 1]; const float nr = sr * cr - si * ci + tr, ni = sr * ci + si * cr + ti; cr = nr; ci = ni; }
        bf16* up = UP + ((size_t)g * SNC + seg * 32) * SK + 256 + p;
        str = cr; sti = ci;
#pragma unroll 8
        for (int c = 0; c < 32; ++c) { stgh(up + (size_t)c * SK, f2bf(str)); stgh(up + (size_t)c * SK + 64, f2bf(sti));
            const float er = ldgf(eb + (size_t)c * 128), ei = ldgf(eb + (size_t)c * 128 + 64); const float nr = lr * str - li * sti + er, ni = lr * sti + li * str + ei; str = nr; sti = ni; }
    }
    __syncthreads();
}
#ifndef MK_PER_PHASE
#define MK_PER_PHASE 0
#endif
constexpr int NPHASES = 38 - 4 * DEFER_NORM;
__global__ void __launch_bounds__(NTHR, 2) mega_fwd(Args args0) {
    extern __shared__ __attribute__((aligned(16))) unsigned char lds_raw[];
    LAS unsigned char* lds = (LAS unsigned char*)lds_raw;
    const int tid = threadIdx.x, bid0 = blockIdx.x, nb0 = gridDim.x;
    if (tid < 16) ((LAS unsigned*)(lds + MISC_OFF))[tid] = 0u;
    __syncthreads();
    XcdBarrier bar = xcd_barrier_post((unsigned*)(args0.ws + WS_CTL) + CW_BAR + args0.li * 4096, (volatile LAS unsigned*)(lds + MISC_OFF));
    int pc = 0; const int lo = args0.ph_lo, hi = args0.ph_hi;
#ifndef PH_REP
#define PH_REP 0ull
#endif
#ifndef PH_REPN
#define PH_REPN 1
#endif
#ifndef XBAR_EXTRA
#define XBAR_EXTRA 0
#endif
#ifndef PH_MASK
#define PH_MASK 0xFFFFFFFFull
#endif
#ifdef PROBE_LO
    long long tacc_ = 0;
#define PROBE_T0 if (pc >= PROBE_LO && pc < PROBE_HI) tacc_ -= (long long)__builtin_amdgcn_s_memrealtime();
#define PROBE_T1 if (pc >= PROBE_LO && pc < PROBE_HI) tacc_ += (long long)__builtin_amdgcn_s_memrealtime();
#else
#define PROBE_T0
#define PROBE_T1
#endif
#define PHASE(id, ...) do { if (((PH_MASK >> (id)) & 1ull) && pc >= lo && pc < hi) { PROBE_T0 { int bid = bid0, nb = nb0; unsigned char* ws = args0.ws; asm volatile("" : "+s"(bid), "+s"(nb), "+s"(ws)); Args args = args0; args.ws = ws; const int tidl = otid(), lane = tidl & 63, wave = tidl >> 6; const int gw = bid * NWAVES + wave, NGW = nb * NWAVES; bf16* HN = (bf16*)(ws + WS_HN); LAS float* scr = (LAS float*)(lds + wave * 16384); for (int rep_ = 0; rep_ < 1 + (int)((PH_REP >> (id)) & 1ull) * PH_REPN; ++rep_) { __VA_ARGS__; __syncthreads(); } } if (pc + 1 < hi) xcd_barrier(bar); PROBE_T1 } ++pc; } while (0)


#define XSRC(l) ((l) == 0 ? args.in[I_X] : (const float*)args.out)
#define GMIX(l) (args.in[I_NORM_MIX] + (l) * D)
#define GFFN(l) (args.in[I_NORM_FFN] + (l) * D)
#define DQ_TAIL(nun_, TL, TH, q_) do { if ((TL) >= 0) { const int nu__ = (nun_); const int mine_ = bid < nu__ ? (nu__ - 1 - bid) / nb + 1 : 0, mx_ = (nu__ - 1) / nb + 1; \
        if (mine_ < mx_) dq_work(args, (TL), (TH), (q_) * (mx_ - mine_), lds, scr); } } while (0)
#define DQ_DRAIN(G) do { if ((G) >= 0) { dq_work(args, (G), (G), -1, lds, scr); __syncthreads(); } } while (0)
#define RG_MIXER(l, jl, CONVF, TL, TH, RSI, EM, DR)   \
    PHASE(3, { if (RG_F8(jl)) { Sched2D S{(const char*)HN, (const char*)(ws + WS_WA_IN) + (size_t)(jl) * 2 * RW * D * 2, (unsigned)D / 2, (unsigned)D / 2, T / 256, 2 * RW / 256, nb, bid}; \
               pg8::Shape sh{D / 128, 0, (unsigned)D / 2, (unsigned)D / 2, 0u, 0u}; EpiBf16T<(RSI) != 0> E{(bf16*)(ws + WS_GX), RW, RW, (WS_XR - WS_GX) / 2, 0, 1.0f / 64.0f, (const float*)(ws + WS_RSS)}; \
               pg8::gemm_phase<EpiBf16T<(RSI) != 0>, Sched2D, false, false, true>(lds, sh, S, E); } \
               else { Sched2D S{(const char*)HN, (const char*)(ws + WS_WA_IN) + (size_t)(jl) * 2 * RW * D * 2, (unsigned)D, (unsigned)D, T / 256, 2 * RW / 256, nb, bid}; \
               pg8::Shape sh{D / 64, 0, (unsigned)D, (unsigned)D, 0u, 0u}; EpiBf16T<(RSI) != 0> E{(bf16*)(ws + WS_GX), RW, RW, (WS_XR - WS_GX) / 2, 0, 1.0f, (const float*)(ws + WS_RSS)}; \
               pg8::gemm_phase<EpiBf16T<(RSI) != 0>, Sched2D, false>(lds, sh, S, E); } DQ_TAIL((T / 256) * (2 * RW / 256), TL, TH, 2); } ); \
    PHASE(4, ph_rg_gates(args, lds, bid, nb, (jl)); ); \
    PHASE(5, ph_rg_carry(args, bid, nb); ); \
    PHASE(6, ph_rg_fix(args, bid, nb); ); \
    PHASE(7, { const bool early_ = ((bid >> 3) & 1) != 0;        \
               DQ_DRAIN(DR); \
               if ((CONVF) >= 0 && early_) { dq_work(args, DQ_MOE1, DQ_MOE1, -2, lds, scr); __syncthreads(); }     \
               { Sched2D S{(const char*)(ws + WS_GX), (const char*)(ws + WS_WA_OUT) + (size_t)(jl) * D * RW * 2, (unsigned)RW, (unsigned)RW, T / 256, D / 256, nb, bid}; \
               pg8::Shape sh{RW / 64, 0, (unsigned)RW, (unsigned)RW, 0u, 0u}; \
               if (EM) { EpiResidT<(EM) ? (EM) : 1> E{XSRC(l), args.out, ws + WS_HN, (float*)(ws + WS_RSS), (LAS float*)(lds + EXTRA_OFF), 1.0f}; pg8::gemm_phase<EpiResidT<(EM) ? (EM) : 1>, Sched2D, false>(lds, sh, S, E); } \
               else { EpiResid E{XSRC(l), args.out, nullptr, nullptr, nullptr, 1.0f}; pg8::gemm_phase<EpiResid, Sched2D, false>(lds, sh, S, E); } } \
               if ((CONVF) >= 0) { dq_work(args, DQ_MOE1, DQ_MOE1, -1, lds, scr); __syncthreads(); } } );
#define DENSE_FFN(l, W13O, W2O, GDR, TL, TH, F8, EM, DR)   \
    if (!DEFER_NORM) { PHASE(20, DQ_DRAIN(GDR); ph_norm<false, false, (F8) ? 3 : 0>(args, lds, bid, nb, args.out, args.out, GFFN(l), 0); ); } \
    PHASE(21, { if (F8) { Sched2D S{(const char*)HN, (const char*)(ws + (W13O)), (unsigned)D / 2, (unsigned)D / 2, T / 256, 2 * FF / 256, nb, bid}; \
                          pg8::Shape sh{D / 128, 0, (unsigned)D / 2, (unsigned)D / 2, 0u, 0u}; EpiSwiglu8T<DEFER_NORM != 0> E{ws + WS_H, (const float*)(ws + WS_RSS)}; \
                          pg8::gemm_phase<EpiSwiglu8T<DEFER_NORM != 0>, Sched2D, false, false, true>(lds, sh, S, E); } \
                else { Sched2D S{(const char*)HN, (const char*)(ws + (W13O)), (unsigned)D, (unsigned)D, T / 256, 2 * FF / 256, nb, bid}; \
                       pg8::Shape sh{D / 64, 0, (unsigned)D, (unsigned)D, 0u, 0u}; EpiSwigluT<DEFER_NORM != 0> E{(bf16*)(ws + WS_H), (const float*)(ws + WS_RSS)}; \
                       pg8::gemm_phase<EpiSwigluT<DEFER_NORM != 0>, Sched2D, false>(lds, sh, S, E); } \
                DQ_TAIL((T / 256) * (2 * FF / 256), TL, TH, 2); \
                if ((l) == 0 && bid >= nb / 2) s5_mats(args, lds, bid - nb / 2, nb / 2); } );     \
    PHASE(22, { if (DEFER_NORM) DQ_DRAIN(DR); \
                if (F8) { Sched2D S{(const char*)(ws + WS_H), (const char*)(ws + (W2O)), (unsigned)FF / 2, (unsigned)FF / 2, T / 256, D / 256, nb, bid}; \
                          pg8::Shape sh{FF / 128, 0, (unsigned)FF / 2, (unsigned)FF / 2, 0u, 0u}; EpiResidT<DEFER_NORM ? (EM) : 0> E{args.out, args.out, ws + WS_HN, (float*)(ws + WS_RSS), (LAS float*)(lds + EXTRA_OFF), 1.0f / 64.0f}; \
                          pg8::gemm_phase<EpiResidT<DEFER_NORM ? (EM) : 0>, Sched2D, false, false, true>(lds, sh, S, E); } \
                else { Sched2D S{(const char*)(ws + WS_H), (const char*)(ws + (W2O)), (unsigned)FF, (unsigned)FF, T / 256, D / 256, nb, bid}; \
                       pg8::Shape sh{FF / 64, 0, (unsigned)FF, (unsigned)FF, 0u, 0u}; EpiResidT<DEFER_NORM ? (EM) : 0> E{args.out, args.out, ws + WS_HN, (float*)(ws + WS_RSS), (LAS float*)(lds + EXTRA_OFF), 1.0f}; \
                       pg8::gemm_phase<EpiResidT<DEFER_NORM ? (EM) : 0>, Sched2D, false>(lds, sh, S, E); } } );
#define MOE_FFN(l, f, CONV, TL, TH, F8) \
    PHASE(23, if (CONV) { conv_moe(args, (f), gw, NGW, scr, lane); __syncthreads(); } ph_norm<false, true, (F8) ? 3 : 0>(args, lds, bid, nb, args.out, args.out, GFFN(l), (f)); ); \
    PHASE(25, { SchedMoe S; S.A = (const char*)HN; S.B = (const char*)(ws + WS_W13); S.lda = (F8) ? D / 2 : D; S.ldb = S.lda; S.bstride = (F8) ? W13_BYTES / 2 : W13_BYTES; S.nN = 2 * FF / 256; S.G = nb; S.c = bid; S.ksplit = 1; S.khbytes = 0; S.gather = 1; \
                int cnt_[NE]; moe_prefix(args, (f), S.ps, S.P, cnt_); LAS int* gt_ = (LAS int*)(lds + EXTRA_OFF); S.gt = gt_; \
                if (!(F8)) { const int* LISTE = (const int*)(ws + WS_LISTE); pg8::Unit u_; const int tid_ = otid(); \
                  _Pragma("unroll 1") for (int i_ = 0; S.next(i_, u_) && i_ < 23; ++i_) { const int e_ = u_.aux; int c_ = 0, p0_ = 0; \
                      _Pragma("unroll") for (int q_ = 0; q_ < NE; ++q_) { c_ = (e_ == q_) ? cnt_[q_] : c_; p0_ = (e_ == q_) ? S.ps[q_] : p0_; } \
                      const int r_ = (u_.pm - p0_) * 256 + tid_; if (tid_ < 256) gt_[i_ * 256 + tid_] = (r_ < c_) ? ldgi(LISTE + e_ * T + r_) : 0; } \
                  __syncthreads(); } \
                if (F8) { S.A = (const char*)(ws + WS_AGX); S.gather = 0; S.erows = T; pg8::Shape sh{D / 128, 0, (unsigned)D / 2, (unsigned)D / 2, 0u, 0u}; EpiSwiglu8 E{ws + WS_H};     \
                          pg8::gemm_phase<EpiSwiglu8, SchedMoe, false, false, true>(lds, sh, S, E); } \
                else { pg8::Shape sh{D / 64, 0, (unsigned)D, (unsigned)D, 0u, 0u}; EpiSwiglu E{(bf16*)(ws + WS_H)}; \
                       pg8::gemm_phase<EpiSwiglu, SchedMoe, false, true>(lds, sh, S, E); } \
                DQ_TAIL(S.P * S.nN, TL, TH, 2); } ); \
    PHASE(26, { SchedMoe S; S.A = (const char*)(ws + WS_H); S.B = (const char*)(ws + ((F8) ? WS_W2T8 : WS_W2T)); S.lda = (F8) ? FF / 2 : FF; S.ldb = S.lda; S.bstride = (F8) ? W2_BYTES / 2 : W2_BYTES; S.nN = D / 256; S.G = nb; S.c = bid; \
                S.ksplit = (F8) ? 1 : 2; S.khbytes = FF; S.gather = 0; S.gt = nullptr; int cnt_[NE]; moe_prefix(args, (f), S.ps, S.P, cnt_); \
                if (F8) { pg8::Shape sh{FF / 128, 0, (unsigned)FF / 2, (unsigned)FF / 2, 0u, 0u}; EpiBf16 E{(bf16*)(ws + WS_AG), D, 0, 0, 0, 1.0f / 64.0f}; \
                          pg8::gemm_phase<EpiBf16, SchedMoe, false, false, true>(lds, sh, S, E); } \
                else { pg8::Shape sh{FF / 128, 0, (unsigned)FF, (unsigned)FF, 0u, 0u}; EpiBf16 E{(bf16*)(ws + WS_AG), D, 0, 0, (WS_OUT - WS_AG) / 2}; \
                       pg8::gemm_phase<EpiBf16, SchedMoe, false>(lds, sh, S, E); } \
                DQ_TAIL(S.P * S.nN * S.ksplit, TL, TH, 3); } );

        PHASE(0, conv_a(args, 0, gw, NGW, scr, lane); __syncthreads(); ph_norm<false, false, 0>(args, lds, bid, nb, XSRC(0), args.out, GMIX(0), 0); );
    RG_MIXER(0, 0, -1, DQ_DENSE0, DQ_C, 0, DEFER_NORM ? (DENSE_F8(0) ? 2 : 1) : 0, DEFER_NORM ? DQ_DENSE0 : -1)
    DENSE_FFN(0, WS_W13, WS_W2T, DQ_DENSE0, DQ_B, DQ_C, DENSE_F8(0), 1, DQ_B)
    if (!DEFER_NORM) { PHASE(1, DQ_DRAIN(DQ_B); ph_norm<false, false, 0>(args, lds, bid, nb, XSRC(1), args.out, GMIX(1), 0); ); }
    PHASE(8, { Sched2D S{(const char*)HN, (const char*)(ws + WS_WB_IN), (unsigned)D, (unsigned)D, T / 256, 2 * MI / 256, nb, bid};
               pg8::Shape sh{D / 64, 0, (unsigned)D, (unsigned)D, 0u, 0u}; EpiBf16T<DEFER_NORM != 0> E{(bf16*)(ws + WS_XM), MI, MI, (WS_Z - WS_XM) / 2, 0, 1.0f, (const float*)(ws + WS_RSS)};
               pg8::gemm_phase<EpiBf16T<DEFER_NORM != 0>, Sched2D, false>(lds, sh, S, E); } );
    PHASE(9, ph_ml_prep(args, lds, bid, nb); );
    PHASE(10, ph_ml_gscan(args, lds, bid, nb); );
    PHASE(11, { SchedSbuild S{(const char*)(ws + WS_Q), (const char*)(ws + WS_K), nb, bid};
                pg8::Shape sh{HD / 64, 0, (unsigned)MI, (unsigned)MI, 0u, 0u}; EpiSbuild E{(bf16*)(ws + WS_SM), (float*)(ws + WS_DENP), (const float*)(ws + WS_GS), (const float*)(ws + WS_MC)};
                pg8::gemm_phase<EpiSbuild, SchedSbuild, false>(lds, sh, S, E); }
#ifdef PROBE_KTW
              tacc_ -= (long long)__builtin_amdgcn_s_memrealtime();
#endif
              ph_ml_ktw(args, lds, bid, nb);
#ifdef PROBE_KTW
              tacc_ += (long long)__builtin_amdgcn_s_memrealtime();
#endif
#ifdef PROBE_STATE
              tacc_ -= (long long)__builtin_amdgcn_s_memrealtime();
#endif
              { SchedState S{(const char*)(ws + WS_VT), (const char*)(ws + WS_KT), nb, bid};
                pg8::Shape sh{MCH / 64, 0, (unsigned)MCH, (unsigned)MCH, 0u, 0u}; EpiBf16 E{(bf16*)(ws + WS_CT), HD, 0, 0, (size_t)HD * HD};
                pg8::gemm_phase<EpiBf16, SchedState, false>(lds, sh, S, E); }
#ifdef PROBE_STATE
              tacc_ += (long long)__builtin_amdgcn_s_memrealtime();
#endif
              );
    PHASE(28, ph_ml_sscan(args, bid, nb); );
    PHASE(13, { SchedPass2 S{(const char*)(ws + WS_SM), (const char*)(ws + WS_Q), (const char*)(ws + WS_VT), (const char*)(ws + WS_CT), nb, bid};
                pg8::Shape sh{MCH / 64, HD / 64, (unsigned)MCH, (unsigned)MCH, (unsigned)MI, (unsigned)HD}; EpiNum E{(bf16*)(ws + WS_NUM), (const float*)(ws + WS_RMT), (const float*)(ws + WS_MC)};
                pg8::gemm_phase<EpiNum, SchedPass2, true>(lds, sh, S, E); }
              ph_ml_fin(args, bid, nb); );
#ifndef ML_OUT_STAGGER
#define ML_OUT_STAGGER 1
#endif
    PHASE(15, { const bool early_ = !ML_OUT_STAGGER || ((bid >> 3) & 1) != 0;
                if (early_) { conv_moe(args, 0, gw, NGW, scr, lane); __syncthreads(); }
                { Sched2D S{(const char*)(ws + WS_Y), (const char*)(ws + WS_WB_OUT), (unsigned)MI, (unsigned)MI, T / 256, D / 256, nb, bid};
                pg8::Shape sh{MI / 64, 0, (unsigned)MI, (unsigned)MI, 0u, 0u}; EpiResid E{args.out, args.out, nullptr, nullptr, nullptr, 1.0f};
                pg8::gemm_phase<EpiResid, Sched2D, false>(lds, sh, S, E); }
                if (!early_) { conv_moe(args, 0, gw, NGW, scr, lane); __syncthreads(); } } );
    MOE_FFN(1, 0, false, DQ_DENSE1, DQ_A1, MOE_F8(0))
    PHASE(2, DQ_DRAIN(DQ_C); ph_norm<true, false, 1>(args, lds, bid, nb, XSRC(2), args.out, GMIX(2), 0); );
    PHASE(16, { SchedBatch S{(const char*)(ws + WS_UP), (const char*)(ws + WS_S5_BE), (unsigned)SK, 256u, (size_t)SNC * SK * 2, (size_t)256 * 256 * 2, SNC / 256, NG, nb, bid};
                pg8::Shape sh{4, 0, (unsigned)SK, 256u, 0u, 0u}; EpiS5e E{(float*)(ws + WS_EB)};
                pg8::gemm_phase<EpiS5e, SchedBatch, false>(lds, sh, S, E); } );
    PHASE(17, ph_s5_scan(args, lds, bid, nb); );
    PHASE(18, { SchedBatch S{(const char*)(ws + WS_UP), (const char*)(ws + WS_S5_KC), (unsigned)SK, (unsigned)SK, (size_t)SNC * SK * 2, (size_t)256 * SK * 2, SNC / 256, NG, nb, bid};
                pg8::Shape sh{SK / 64, 0, (unsigned)SK, (unsigned)SK, 0u, 0u}; EpiS5y E{(const bf16*)(ws + WS_UP), args.in[I_C_D], (bf16*)(ws + WS_YA)};
                pg8::gemm_phase<EpiS5y, SchedBatch, false>(lds, sh, S, E); } );
    PHASE(19, { if (DEFER_NORM) DQ_DRAIN(DQ_DENSE1);
                Sched2D S{(const char*)(ws + WS_YA), (const char*)(ws + WS_WC_GLU), (unsigned)D, (unsigned)D, T / 256, D / 256, nb, bid};
                pg8::Shape sh{D / 64, 0, (unsigned)D, (unsigned)D, 0u, 0u}; constexpr int EM_ = DEFER_NORM ? (DENSE_F8(1) ? 2 : 1) : 0;
                EpiGluT<EM_> E{(const bf16*)(ws + WS_YA), args.in[I_C_B_GLU], args.out, ws + WS_HN, (float*)(ws + WS_RSS), (LAS float*)(lds + EXTRA_OFF)};
                pg8::gemm_phase<EpiGluT<EM_>, Sched2D, false>(lds, sh, S, E); } );
    DENSE_FFN(2, WS_WD1_13, WS_WD1_2, DQ_DENSE1, DQ_MOE1, DQ_MOE1, DENSE_F8(1), (RG_F8(1) ? 2 : 1), DQ_A1)
    if (!DEFER_NORM) PHASE(1, DQ_DRAIN(DQ_A1); if (RG_F8(1)) ph_norm<false, false, 3>(args, lds, bid, nb, XSRC(3), args.out, GMIX(3), 0); else ph_norm<false, false, 0>(args, lds, bid, nb, XSRC(3), args.out, GMIX(3), 0); );
    RG_MIXER(3, 1, 1, DQ_MOE1, DQ_MOE1, DEFER_NORM, 0, -1)
    MOE_FFN(3, 1, false, -1, -1, MOE_F8(1))
    PHASE(27, ph_norm<true, false, 2>(args, lds, bid, nb, args.out, args.out, args.in[I_NORM_FINAL], 1); );
    for (int xb_ = 0; xb_ < XBAR_EXTRA; ++xb_) xcd_barrier(bar);
#ifdef PROBE_LO
    if (bid0 == 0 && tid == 0) { const long long te_ = (long long)__builtin_amdgcn_s_memrealtime() + (long long)(PROBE_N) * tacc_; while ((long long)__builtin_amdgcn_s_memrealtime() < te_) __builtin_amdgcn_s_sleep(16); }
#endif
#undef PHASE
}

extern "C" void kernel_launch(void* const* d_in, const int* in_sizes, int n_in, void* d_out, int out_size, void* d_ws, size_t ws_size, hipStream_t stream) {
    static int grid = 0;
    if (grid == 0) {
        if (n_in != N_IN || in_sizes[0] != T * D || out_size != T * D || ws_size < WS_END) {
            fprintf(stderr, "kernel_launch: unexpected problem (n_in %d, in0 %d, out %d, ws %zu, need %zu)\n", n_in, n_in > 0 ? in_sizes[0] : -1, out_size, ws_size, (size_t)WS_END); grid = -1; return; }
        int dev = 0, cus = 0, per_cu = 0;
        if (hipGetDevice(&dev) != hipSuccess || hipDeviceGetAttribute(&cus, hipDeviceAttributeMultiprocessorCount, dev) != hipSuccess) { fprintf(stderr, "kernel_launch: device query failed\n"); grid = -1; return; }
        if (hipFuncSetAttribute((const void*)mega_fwd, hipFuncAttributeMaxDynamicSharedMemorySize, LDS_BYTES) != hipSuccess) { fprintf(stderr, "kernel_launch: hipFuncSetAttribute failed\n"); grid = -1; return; }
        if (hipOccupancyMaxActiveBlocksPerMultiprocessor(&per_cu, (const void*)mega_fwd, NTHR, LDS_BYTES) != hipSuccess || per_cu < 1) fprintf(stderr, "kernel_launch: occupancy query reports %d blocks per CU\n", per_cu);
        (void)hipGetLastError();
        if (cus < 256) { fprintf(stderr, "kernel_launch: %d CUs < 256: the 256-workgroup grid would not be resident\n", cus); grid = -1; return; }
        grid = 256;
    }
    if (grid < 0) return;
    if (hipMemsetAsync((char*)d_ws + WS_CTL, 0, CTL_ZERO_BYTES, stream) != hipSuccess) { fprintf(stderr, "kernel_launch: memset failed\n"); return; }
    Args a{};
    for (int i = 0; i < N_IN; ++i) a.in[i] = (const float*)d_in[i];
    a.out = (float*)d_out; a.ws = (unsigned char*)d_ws; a.pad = 0;
#if MK_PER_PHASE
    for (int k = 0; k < NPHASES; ++k) { a.ph_lo = k; a.ph_hi = k + 1; a.li = k; hipLaunchKernelGGL(mega_fwd, dim3(grid), dim3(NTHR), LDS_BYTES, stream, a); }
#else
    a.ph_lo = 0; a.ph_hi = NPHASES; a.li = 0;
    hipLaunchKernelGGL(mega_fwd, dim3(grid), dim3(NTHR), LDS_BYTES, stream, a);
#endif
    const hipError_t le = hipPeekAtLastError();
    if (le != hipSuccess) fprintf(stderr, "kernel_launch: launch failed: %s\n", hipGetErrorName(le));
}
```

```cpp
#include <hip/hip_runtime.h>
#include <cstdio>
#include <cstdint>

#define LAS __attribute__((address_space(3)))
#define GAS __attribute__((address_space(1)))
typedef unsigned short bf16;
typedef short bf16x8 __attribute__((ext_vector_type(8)));
typedef float f32x4 __attribute__((ext_vector_type(4)));
typedef float f32x2 __attribute__((ext_vector_type(2)));
typedef unsigned u32x4 __attribute__((ext_vector_type(4)));
typedef unsigned u32x2 __attribute__((ext_vector_type(2)));

__device__ __forceinline__ unsigned cvt_pk_bf16(float lo, float hi) { unsigned r; asm volatile("v_cvt_pk_bf16_f32 %0, %1, %2" : "=v"(r) : "v"(lo), "v"(hi)); return r; }
__device__ __forceinline__ float bflo(unsigned u) { return __uint_as_float(u << 16); }
__device__ __forceinline__ float bfhi(unsigned u) { return __uint_as_float(u & 0xffff0000u); }
__device__ __forceinline__ float bf2f(bf16 b) { return __uint_as_float(((unsigned)b) << 16); }
__device__ __forceinline__ bf16 f2bf(float f) { return (bf16)(cvt_pk_bf16(f, 0.f) & 0xffffu); }
__device__ __forceinline__ unsigned cvt4_fp8(float a, float b, float c, float d) { int p = 0; p = __builtin_amdgcn_cvt_pk_fp8_f32(a, b, p, false); p = __builtin_amdgcn_cvt_pk_fp8_f32(c, d, p, true); return (unsigned)p; }
__device__ __forceinline__ float sigm(float x) { return __builtin_amdgcn_rcpf(1.0f + __expf(-x)); }
__device__ __forceinline__ float silu_f(float x) { return x * sigm(x); }
__device__ __forceinline__ float gelu_tanh(float x) { return x * sigm(1.5957691216057308f * (x + 0.044715f * x * x * x)); }
__device__ __forceinline__ float softplus_f(float x) { return x > 20.f ? x : log1pf(__expf(x)); }

__device__ __forceinline__ int otid() { int t = threadIdx.x; asm volatile("" : "+v"(t)); return t; }
__device__ __forceinline__ void glds16(const char* sbase, unsigned voff, unsigned lds_dst) {
    unsigned keep;
    asm volatile("s_mov_b32 %0, m0\n\ts_mov_b32 m0, %3\n\ts_nop 0\n\tglobal_load_lds_dwordx4 %1, %2\n\ts_mov_b32 m0, %0" : "=&s"(keep) : "v"(voff), "s"(sbase), "s"(lds_dst) : "memory");
}
namespace pg8 {
constexpr int BM = 256, BK = 64, HALF = 128, HTB = HALF * BK * 2, STAGE_BYTES = 8 * HTB;
__host__ __device__ __forceinline__ int lds_byte(int r, int c) { const int st = (r >> 4) * 2 + (c >> 5), rr = r & 15, cc = c & 31, ob = rr * 64 + cc * 2; return st * 1024 + (ob ^ (((ob >> 9) & 1) << 5)); }
__host__ __device__ __forceinline__ void stage_rc(int b, int& R, int& C) { const int st = b / 1024, sb = b % 1024, swz = sb ^ (((sb >> 9) & 1) << 5); R = (st >> 1) * 16 + swz / 64; C = (st & 1) * 32 + (swz % 64) / 2; }
__host__ __device__ __forceinline__ int perm32(int rho) { const int n = rho >> 4, i = rho & 15; return 8 * (i >> 2) + 4 * n + (i & 3); }

struct Unit { int pm, pn, aux; const char *A1, *B1, *A2, *B2; };
struct Shape { int nt1, nt2; unsigned lda1, ldb1, lda2, ldb2; unsigned kstepA = 128u, agstride = 0u; };

typedef int pg8_v8i __attribute__((ext_vector_type(8))); typedef int pg8_v4i __attribute__((ext_vector_type(4)));
__device__ __forceinline__ pg8_v8i pg8_cat(bf16x8 lo, bf16x8 hi) { const pg8_v4i a = __builtin_bit_cast(pg8_v4i, lo), b = __builtin_bit_cast(pg8_v4i, hi); return __builtin_shufflevector(a, b, 0, 1, 2, 3, 4, 5, 6, 7); }
template <class Epi, class Sched, bool TWO, bool GATHER = false, bool FP8 = false>
__device__ __forceinline__ void gemm_phase(LAS unsigned char* lds, const Shape sh, const Sched& S, const Epi& E) {
    const int tid = otid(), wid = __builtin_amdgcn_readfirstlane(tid >> 6), lane = tid & 63, wr = wid >> 2, wc = wid & 3, fr = lane & 15, fq = lane >> 4;
    const int nt1 = sh.nt1, nt = sh.nt1 + (TWO ? sh.nt2 : 0);
    unsigned vA1[2], vB1[2], vA2[2], vB2[2]; unsigned vGc[2][2], vGn[2][2];
#pragma unroll
    for (int i = 0; i < 2; ++i) { int R, C; stage_rc(tid * 16 + i * 8192, R, C); const int Rb = Epi::PERM ? ((R & ~31) + perm32(R & 31)) : R;
        vA1[i] = sh.agstride ? (unsigned)(C >> 4) * sh.agstride + (unsigned)(R * 32 + (C & 15) * 2) : (unsigned)(R * sh.lda1 + C) * 2u; vB1[i] = (unsigned)(Rb * sh.ldb1 + C) * 2u;
        vA2[i] = TWO ? (unsigned)(R * sh.lda2 + C) * 2u : 0u; vB2[i] = TWO ? (unsigned)(Rb * sh.ldb2 + C) * 2u : 0u; }
    const unsigned hA1 = 256u * sh.lda1, hB1 = 256u * sh.ldb1, hA2 = TWO ? 256u * sh.lda2 : 0u, hB2 = TWO ? 256u * sh.ldb2 : 0u;
    const unsigned kstepA = sh.kstepA;
    const unsigned ldsw = (unsigned)wid * 1024u, ldsbase = (unsigned)(unsigned long long)lds;
    const int aoff = lds_byte(wr * 64 + fr, fq * 8), boff = lds_byte(wc * 32 + fr, fq * 8);
#define PG8_SA(b, h) (((b) * 2 + (h)) * HTB)
#define PG8_SB(b, h) ((4 + (b) * 2 + (h)) * HTB)
#define PG8_LOADG(ui_, dst) do { if constexpr (GATHER) { const int tg_ = otid(); _Pragma("unroll") for (int i_ = 0; i_ < 2; ++i_) { int R_, C_; stage_rc(tg_ * 16 + i_ * 8192, R_, C_);     \
        _Pragma("unroll") for (int h_ = 0; h_ < 2; ++h_) dst[h_][i_] = (unsigned)S.gt[(ui_) * 256 + h_ * 128 + R_] * (sh.lda1 * 2u) + (unsigned)C_ * 2u; } } } while (0)
#define PG8_STG_AG(bufoff, U, tt, h, usen) do { if constexpr (GATHER) { const char* gp_ = (U).A1 + (size_t)(tt) * 128; \
        const unsigned v0_ = (usen) ? vGn[h][0] : vGc[h][0], v1_ = (usen) ? vGn[h][1] : vGc[h][1]; \
        glds16(gp_, v0_, ldsbase + (unsigned)(bufoff) + ldsw); glds16(gp_, v1_, ldsbase + (unsigned)(bufoff) + ldsw + 8192u); } else { PG8_STG_A(bufoff, U, tt, h); } } while (0)
#define PG8_STG_A(bufoff, U, tt, h) do { const bool s2_ = TWO && ((tt) >= nt1); \
        const char* gp_ = (s2_ ? (U).A2 + (size_t)((tt) - nt1) * 128 + (size_t)(h) * hA2 : (U).A1 + (size_t)(tt) * kstepA + (size_t)(h) * hA1); \
        const unsigned v0_ = s2_ ? vA2[0] : vA1[0], v1_ = s2_ ? vA2[1] : vA1[1]; \
        glds16(gp_, v0_, ldsbase + (unsigned)(bufoff) + ldsw); glds16(gp_, v1_, ldsbase + (unsigned)(bufoff) + ldsw + 8192u); } while (0)
#define PG8_STG_B(bufoff, U, tt, h) do { const bool s2_ = TWO && ((tt) >= nt1); \
        const char* gp_ = (s2_ ? (U).B2 + (size_t)((tt) - nt1) * 128 + (size_t)(h) * hB2 : (U).B1 + (size_t)(tt) * 128 + (size_t)(h) * hB1); \
        const unsigned v0_ = s2_ ? vB2[0] : vB1[0], v1_ = s2_ ? vB2[1] : vB1[1]; \
        glds16(gp_, v0_, ldsbase + (unsigned)(bufoff) + ldsw); glds16(gp_, v1_, ldsbase + (unsigned)(bufoff) + ldsw + 8192u); } while (0)
#define PG8_LDA(dst, b, h) do { if constexpr (FP8) { _Pragma("unroll") for (int m = 0; m < 4; ++m) dst##8[m] = pg8_cat(*(const LAS bf16x8*)(lds + PG8_SA(b, h) + aoff + m * 2048), *(const LAS bf16x8*)(lds + PG8_SA(b, h) + aoff + m * 2048 + 1024)); } \
        else { _Pragma("unroll") for (int m = 0; m < 4; ++m) _Pragma("unroll") for (int k = 0; k < 2; ++k) dst[m][k] = *(const LAS bf16x8*)(lds + PG8_SA(b, h) + aoff + m * 2048 + k * 1024); } } while (0)
#define PG8_LDB(dst, b, h) do { if constexpr (FP8) { _Pragma("unroll") for (int n = 0; n < 2; ++n) dst##8[n] = pg8_cat(*(const LAS bf16x8*)(lds + PG8_SB(b, h) + boff + n * 2048), *(const LAS bf16x8*)(lds + PG8_SB(b, h) + boff + n * 2048 + 1024)); } \
        else { _Pragma("unroll") for (int n = 0; n < 2; ++n) _Pragma("unroll") for (int k = 0; k < 2; ++k) dst[n][k] = *(const LAS bf16x8*)(lds + PG8_SB(b, h) + boff + n * 2048 + k * 1024); } } while (0)
#define PG8_MMA(ai, bj, At, Bt) do { __builtin_amdgcn_s_setprio(1); if constexpr (FP8) { _Pragma("unroll") for (int m = 0; m < 4; ++m) _Pragma("unroll") for (int n = 0; n < 2; ++n) \
        acc[ai][bj][m][n] = __builtin_amdgcn_mfma_scale_f32_16x16x128_f8f6f4(Bt##8[n], At##8[m], acc[ai][bj][m][n], 0, 0, 0, 0x7f7f7f7f, 0, 0x7f7f7f7f); } \
        else { _Pragma("unroll") for (int m = 0; m < 4; ++m) _Pragma("unroll") for (int n = 0; n < 2; ++n) _Pragma("unroll") for (int k = 0; k < 2; ++k) \
        acc[ai][bj][m][n] = __builtin_amdgcn_mfma_f32_16x16x32_bf16(Bt[n][k], At[m][k], acc[ai][bj][m][n], 0, 0, 0); } __builtin_amdgcn_s_setprio(0); } while (0)
#define PG8_WAIT_V(n) asm volatile("s_waitcnt vmcnt(" #n ")" ::: "memory")
#define PG8_WAIT_L(n) asm volatile("s_waitcnt lgkmcnt(" #n ")" ::: "memory")
#define PG8_BAR __builtin_amdgcn_s_barrier()
#define PG8_SCHED __builtin_amdgcn_sched_barrier(0)
    Unit cur, nxt;
    if (!S.next(0, cur)) return;
    f32x4 acc[2][2][4][2];
#pragma unroll
    for (int a = 0; a < 2; ++a)
#pragma unroll
        for (int b = 0; b < 2; ++b)
#pragma unroll
            for (int m = 0; m < 4; ++m)
#pragma unroll
                for (int n = 0; n < 2; ++n) acc[a][b][m][n] = (f32x4){0.f, 0.f, 0.f, 0.f};
    bf16x8 At[4][2], B0[2][2], B1[2][2]; pg8_v8i At8[4], B08[2], B18[2];
    PG8_LOADG(0, vGc);
    PG8_STG_B(PG8_SB(0, 0), cur, 0, 0); PG8_STG_B(PG8_SB(0, 1), cur, 0, 1); PG8_STG_AG(PG8_SA(0, 0), cur, 0, 0, false); PG8_STG_AG(PG8_SA(0, 1), cur, 0, 1, false);
    if (wr == 1) PG8_BAR;
    PG8_WAIT_V(2); PG8_BAR;
    PG8_STG_B(PG8_SB(1, 0), cur, 1, 0); PG8_STG_AG(PG8_SA(1, 0), cur, 1, 0, false); PG8_STG_B(PG8_SB(1, 1), cur, 1, 1);
    PG8_WAIT_V(6); PG8_BAR;
    for (int ui = 0;; ++ui) {
        const bool has_next = S.next(ui + 1, nxt);
        if (!has_next) nxt = cur;
        if constexpr (GATHER) { if (has_next) PG8_LOADG(ui + 1, vGn); else {
#pragma unroll
            for (int h_ = 0; h_ < 2; ++h_) { vGn[h_][0] = vGc[h_][0]; vGn[h_][1] = vGc[h_][1]; } } }
#pragma unroll 1
        for (int t = 0; t < nt; t += 2) {
            const bool last = (t == nt - 2);
            const char* uA1 = last ? nxt.A1 : cur.A1; const char* uB1 = last ? nxt.B1 : cur.B1; const char* uA2 = last ? nxt.A2 : cur.A2; const char* uB2 = last ? nxt.B2 : cur.B2;
            Unit U2; U2.A1 = uA1; U2.B1 = uB1; U2.A2 = uA2; U2.B2 = uB2;
            const int t2 = last ? 0 : t + 2, t3 = t2 + 1;
            PG8_LDB(B0, 0, 0); PG8_LDB(B1, 0, 1); PG8_SCHED; PG8_LDA(At, 0, 0); PG8_STG_AG(PG8_SA(1, 1), cur, t + 1, 1, false);
            PG8_WAIT_V(8); PG8_WAIT_L(0); PG8_BAR; PG8_MMA(0, 0, At, B0); PG8_MMA(0, 1, At, B1); PG8_BAR; PG8_SCHED;
            PG8_LDA(At, 0, 1); PG8_STG_B(PG8_SB(0, 0), U2, t2, 0); PG8_STG_B(PG8_SB(0, 1), U2, t2, 1); PG8_STG_AG(PG8_SA(0, 0), U2, t2, 0, last);
            PG8_WAIT_V(8); PG8_WAIT_L(0); PG8_BAR; PG8_MMA(1, 0, At, B0); PG8_MMA(1, 1, At, B1); PG8_BAR; PG8_SCHED;
            PG8_LDB(B0, 1, 0); PG8_LDB(B1, 1, 1); PG8_SCHED; PG8_LDA(At, 1, 0); PG8_STG_AG(PG8_SA(0, 1), U2, t2, 1, last);
            PG8_WAIT_V(8); PG8_WAIT_L(0); PG8_BAR; PG8_MMA(0, 0, At, B0); PG8_MMA(0, 1, At, B1); PG8_BAR; PG8_SCHED;
            PG8_LDA(At, 1, 1); PG8_STG_B(PG8_SB(1, 0), U2, t3, 0); PG8_STG_B(PG8_SB(1, 1), U2, t3, 1); PG8_STG_AG(PG8_SA(1, 0), U2, t3, 0, last);
            PG8_WAIT_V(8); PG8_WAIT_L(0); PG8_BAR; PG8_MMA(1, 0, At, B0); PG8_MMA(1, 1, At, B1); PG8_BAR; PG8_SCHED;
        }
        if (wr == 0) PG8_BAR;
        { const int l2_ = otid() & 63; E(acc, cur, wr, wc, l2_ & 15, l2_ >> 4); }
        if (!has_next) break;
#pragma unroll
        for (int a = 0; a < 2; ++a)
#pragma unroll
            for (int b = 0; b < 2; ++b)
#pragma unroll
                for (int m = 0; m < 4; ++m)
#pragma unroll
                    for (int n = 0; n < 2; ++n) acc[a][b][m][n] = (f32x4){0.f, 0.f, 0.f, 0.f};
        cur = nxt;
        if constexpr (GATHER) {
#pragma unroll
            for (int h_ = 0; h_ < 2; ++h_) { vGc[h_][0] = vGn[h_][0]; vGc[h_][1] = vGn[h_][1]; } }
        if (wr == 1) PG8_BAR;
    }
    PG8_WAIT_V(0);
    PG8_BAR;
#undef PG8_SA
#undef PG8_SB
#undef PG8_STG_A
#undef PG8_STG_AG
#undef PG8_LOADG
#undef PG8_STG_B
#undef PG8_LDA
#undef PG8_LDB
#undef PG8_MMA
#undef PG8_WAIT_V
#undef PG8_WAIT_L
#undef PG8_BAR
#undef PG8_SCHED
}
}

#define XB_TMO      128
#define XB_XCNT(j)  (256  + 64 * (j))
#define XB_XSUB(j)  (1280 + 64 * (j))
#define XB_XGEN(j)  (2304 + 64 * (j))
#define XB_TOP      3328
#define XB_TOPGEN   3392
#define XCD_BAR_WORDS 3456
#define XB_SPIN_CAP (1u << 18)

__device__ __forceinline__ unsigned xb_ld(unsigned* p)              { return __hip_atomic_load(p, __ATOMIC_RELAXED, __HIP_MEMORY_SCOPE_AGENT); }
__device__ __forceinline__ unsigned xb_add(unsigned* p, unsigned v) { return __hip_atomic_fetch_add(p, v, __ATOMIC_RELAXED, __HIP_MEMORY_SCOPE_AGENT); }
__device__ __forceinline__ unsigned xb_xcc_id() { return (unsigned)__builtin_amdgcn_s_getreg((3 << 11) | 20) & 0xFu; }
#define XB_SPIN(cond, bar) do { unsigned _sp = 0; while (cond) { __builtin_amdgcn_s_sleep(1); \
    if ((++_sp & 255u) == 0u) { if (xb_ld(&(bar)[XB_TMO])) break; if (_sp > XB_SPIN_CAP) { atomicAdd(&(bar)[XB_TMO], 1u); break; } } } } while (0)

struct XcdBarrier {
    unsigned* bar; unsigned x;
    volatile LAS unsigned* st;
};

__device__ __forceinline__ XcdBarrier xcd_barrier_post(unsigned* bar, volatile LAS unsigned* st) {
    XcdBarrier b; b.bar = bar; b.x = xb_xcc_id(); b.st = st;
    if (threadIdx.x == 0) (void)xb_add(&bar[XB_XCNT(b.x)], 1u);
    return b;
}
__device__ __forceinline__ void xcd_barrier_complete(unsigned* bar, unsigned x, unsigned& nloc, unsigned& nx) {
    const unsigned G = gridDim.x * gridDim.y * gridDim.z;
    unsigned sum, cnt, mine, sp = 0u;
    for (;;) {
        sum = 0u; cnt = 0u; mine = 0u;
#pragma unroll
        for (unsigned j = 0; j < 16; ++j) { const unsigned c = xb_ld(&bar[XB_XCNT(j)]); sum += c; cnt += (c > 0u) ? 1u : 0u; mine = (j == x) ? c : mine; }
        if (sum == G) break;
        __builtin_amdgcn_s_sleep(1);
        if ((++sp & 255u) == 0u) { if (xb_ld(&bar[XB_TMO])) break; if (sp > XB_SPIN_CAP) { atomicAdd(&bar[XB_TMO], 1u); break; } }
    }
    nloc = mine > 0u ? mine : 1u; nx = cnt > 0u ? cnt : 1u;
}

__device__ __forceinline__ void xcd_barrier(const XcdBarrier& b) {
    asm volatile("s_waitcnt vmcnt(0)" ::: "memory");
    __syncthreads();
    if (threadIdx.x == 0) {
        unsigned* bar = b.bar;
        __builtin_amdgcn_s_waitcnt(0);
        unsigned nloc = b.st[0], nx = b.st[1];
        if (nloc == 0u) { xcd_barrier_complete(bar, b.x, nloc, nx); b.st[0] = nloc; b.st[1] = nx; }
        const unsigned old = xb_add(&bar[XB_XSUB(b.x)], 1u);
        const unsigned gen = old / nloc;
        if (old + 1u == (gen + 1u) * nloc) {
            __builtin_amdgcn_fence(__ATOMIC_RELEASE, "agent");
            asm volatile("s_waitcnt vmcnt(0)" ::: "memory");
            const unsigned og = xb_add(&bar[XB_TOP], 1u);
            const unsigned tg = og / nx;
            if (og + 1u == (tg + 1u) * nx) xb_add(&bar[XB_TOPGEN], 1u);
            else XB_SPIN(xb_ld(&bar[XB_TOPGEN]) == tg, bar);
            __builtin_amdgcn_fence(__ATOMIC_ACQUIRE, "agent");
            xb_add(&bar[XB_XGEN(b.x)], 1u);
            asm volatile("s_waitcnt vmcnt(0)" ::: "memory");
        } else {
            XB_SPIN(xb_ld(&bar[XB_XGEN(b.x)]) == gen, bar);
            __builtin_amdgcn_fence(__ATOMIC_ACQUIRE, "agent");
            asm volatile("s_waitcnt vmcnt(0)" ::: "memory");
        }
    }
    __syncthreads();
}

constexpr int T = 16384, D = 1024;
constexpr int RW = 1280, RNB = 10, RBD = 128, RCH = 64, RNC = T / RCH;
constexpr int MI = 2048, MH = 4, HD = 512, MCH = 256, MNC = T / MCH;
constexpr int LDT = T + 64;
constexpr int NG = 64, SL = 16, SNC = T / SL, SK = 384;
constexpr int FF = 2816, NE = 8, MOE_ROWS = 2 * T + NE * 256;
#ifndef MOE_F8_MASK
#define MOE_F8_MASK 3
#endif
#define MOE_F8(f) (((MOE_F8_MASK) >> (f)) & 1)
#ifndef DENSE_F8_MASK
#define DENSE_F8_MASK 2
#endif
#define DENSE_F8(f) (((DENSE_F8_MASK) >> (f)) & 1)
#ifndef RG_F8_MASK
#define RG_F8_MASK 2
#endif
#define RG_F8(j) (((RG_F8_MASK) >> (j)) & 1)
#ifndef DEFER_NORM
#define DEFER_NORM 1
#endif
constexpr float EPS = 1e-6f;
constexpr int NTHR = 512, NWAVES = 8;

enum { I_X = 0, I_NORM_MIX, I_NORM_FFN, I_NORM_FINAL, I_A_W_IN, I_A_CONV_W, I_A_CONV_B, I_A_W_R, I_A_B_R, I_A_W_I, I_A_B_I, I_A_LAM, I_A_W_OUT,
       I_B_W_IN, I_B_CONV_W, I_B_CONV_B, I_B_W_Q, I_B_W_K, I_B_W_V, I_B_W_GATE, I_B_B_GATE, I_B_NORM, I_B_SKIP, I_B_W_OUT,
       I_C_A_RE, I_C_A_IM, I_C_LOG_STEP, I_C_B_RE, I_C_B_IM, I_C_C_RE, I_C_C_IM, I_C_D, I_C_W_GLU, I_C_B_GLU,
       I_F_W1, I_F_W3, I_F_W2, I_E_ROUTER, I_E_ROUTER_B, I_E_W1, I_E_W3, I_E_W2, N_IN };

constexpr size_t MiB = 1u << 20;
constexpr size_t WS_CTL = 0, CTL_ZERO_BYTES = 1 * MiB;
constexpr size_t WS_WA_IN = 2 * MiB, WS_WA_OUT = 12 * MiB, WS_WA_G = 17 * MiB, WS_WB_IN = 19 * MiB, WS_WB_OUT = 27 * MiB, WS_WC_GLU = 31 * MiB, WS_S5_BE = 33 * MiB, WS_S5_KC = 41 * MiB;
constexpr size_t WS_RSS = 53 * MiB;
constexpr size_t SCR = 56 * MiB;
constexpr size_t WS_HN = SCR + 0 * MiB;
constexpr size_t WS_GX = SCR + 32 * MiB, WS_XR = SCR + 72 * MiB, WS_HL = SCR + 112 * MiB, WS_AC = SCR + 152 * MiB, WS_CSA = SCR + 192 * MiB, WS_CSH = SCR + 194 * MiB, WS_CIN = SCR + 196 * MiB;
constexpr size_t WS_XM = SCR + 32 * MiB, WS_Z = SCR + 96 * MiB, WS_Q = SCR + 160 * MiB, WS_K = SCR + 224 * MiB, WS_KT = SCR + 288 * MiB, WS_VT = SCR + 353 * MiB, WS_XC = SCR + 418 * MiB,
                 WS_SM = SCR + 482 * MiB, WS_CT = SCR + 514 * MiB, WS_MLS = SCR + 642 * MiB;
static_assert((size_t)MI * LDT * 2 <= 65 * MiB && WS_MLS + 4 * MiB <= SCR + 656 * MiB, "mLSTM scratch");
constexpr size_t WS_NUM = WS_XM, WS_Y = WS_XC;
constexpr size_t WS_GI = WS_MLS, WS_GF = WS_MLS + 256 * 1024, WS_GS = WS_MLS + 512 * 1024, WS_RMT = WS_MLS + 768 * 1024, WS_EF = WS_MLS + 1024 * 1024, WS_MC = WS_MLS + 1280 * 1024,
                 WS_DENP = WS_MLS + 2 * MiB, WS_NS = WS_MLS + 3 * MiB;
constexpr size_t WS_UP = SCR + 32 * MiB, WS_EB = SCR + 80 * MiB, WS_YA = SCR + 112 * MiB;
constexpr size_t WS_WFFN = SCR + 200 * MiB, WS_AG = SCR + 332 * MiB, WS_H = SCR + 400 * MiB, WS_OUT = SCR + 587 * MiB, WS_META = SCR + 655 * MiB, WS_END = SCR + 656 * MiB;
constexpr size_t WS_TOPI = WS_META, WS_TOPW = WS_META + 128 * 1024, WS_LISTE = WS_META + 384 * 1024;
constexpr size_t W13_BYTES = (size_t)2 * FF * D * 2, W2_BYTES = (size_t)D * FF * 2;
constexpr size_t WS_W13 = WS_WFFN, WS_W2T = WS_WFFN + NE * W13_BYTES;
constexpr size_t WS_WD1_13 = SCR + 144 * MiB, WS_WD1_2 = SCR + 155 * MiB;
constexpr size_t WS_W2T8 = WS_WFFN + NE * (W13_BYTES / 2);
constexpr size_t WS_AGX = WS_WFFN + NE * (W13_BYTES / 2) + NE * (W2_BYTES / 2);
static_assert(WS_AGX + (size_t)NE * T * D <= WS_H, "fp8 MoE rows");
static_assert(WS_WD1_13 + W13_BYTES <= WS_WD1_2 && WS_WD1_2 + W2_BYTES <= SCR + 161 * MiB, "dense-1 weights");
static_assert(WS_W2T + NE * W2_BYTES <= WS_AG, "ffn weights");
static_assert(WS_CIN + (size_t)RNC * RW * 4 <= WS_WFFN, "rg scratch vs dense weights");
static_assert(WS_H + (size_t)MOE_ROWS * FF * 2 <= WS_OUT && WS_OUT + (size_t)MOE_ROWS * D * 2 <= WS_META, "moe buffers");
constexpr int CW_BAR = 4096, CW_MOE = 204800, CW_DQ = 208896;

constexpr int RING_BYTES = 131072, EXTRA_OFF = RING_BYTES, EXTRA_BYTES = 24576, LDS_BYTES = RING_BYTES + EXTRA_BYTES;
constexpr int MISC_OFF = LDS_BYTES - 64;

struct Args { const float* in[N_IN]; float* out; unsigned char* ws; int ph_lo, ph_hi, li, pad; };

__device__ __forceinline__ float wave_sum(float v) {
#pragma unroll
    for (int o = 1; o < 64; o <<= 1) v += __shfl_xor(v, o);
    return v;
}
__device__ __forceinline__ float wave_max(float v) {
#pragma unroll
    for (int o = 1; o < 64; o <<= 1) v = fmaxf(v, __shfl_xor(v, o));
    return v;
}
__device__ __forceinline__ u32x4 ldg16(const void* p) { return *(const GAS u32x4*)p; }
__device__ __forceinline__ u32x2 ldg8(const void* p) { return *(const GAS u32x2*)p; }
__device__ __forceinline__ f32x4 ldgf4(const void* p) { return *(const GAS f32x4*)p; }
__device__ __forceinline__ float ldgf(const void* p) { return *(const GAS float*)p; }
__device__ __forceinline__ int ldgi(const void* p) { return *(const GAS int*)p; }
#ifndef STORE_SC1
#define STORE_SC1 0
#endif
#if STORE_SC1
__device__ __forceinline__ void stg16(void* p, u32x4 v) { asm volatile("global_store_dwordx4 %0, %1, off sc1\n\ts_nop 1" :: "v"((GAS u32x4*)p), "v"(v) : "memory"); }
__device__ __forceinline__ void stg8(void* p, u32x2 v) { asm volatile("global_store_dwordx2 %0, %1, off sc1\n\ts_nop 1" :: "v"((GAS u32x2*)p), "v"(v) : "memory"); }
__device__ __forceinline__ void stgf4(void* p, f32x4 v) { asm volatile("global_store_dwordx4 %0, %1, off sc1\n\ts_nop 1" :: "v"((GAS f32x4*)p), "v"(v) : "memory"); }
__device__ __forceinline__ void stgf(void* p, float v) { asm volatile("global_store_dword %0, %1, off sc1\n\ts_nop 1" :: "v"((GAS float*)p), "v"(v) : "memory"); }
__device__ __forceinline__ void stgi(void* p, int v) { asm volatile("global_store_dword %0, %1, off sc1\n\ts_nop 1" :: "v"((GAS int*)p), "v"(v) : "memory"); }
__device__ __forceinline__ void stgh(void* p, bf16 v) { asm volatile("global_store_short %0, %1, off sc1\n\ts_nop 1" :: "v"((GAS bf16*)p), "v"((unsigned)v) : "memory"); }
#else
__device__ __forceinline__ void stg16(void* p, u32x4 v) { *(GAS u32x4*)p = v; }
__device__ __forceinline__ void stg8(void* p, u32x2 v) { *(GAS u32x2*)p = v; }
__device__ __forceinline__ void stgf4(void* p, f32x4 v) { *(GAS f32x4*)p = v; }
__device__ __forceinline__ void stgf(void* p, float v) { *(GAS float*)p = v; }
__device__ __forceinline__ void stgi(void* p, int v) { *(GAS int*)p = v; }
__device__ __forceinline__ void stgh(void* p, bf16 v) { *(GAS bf16*)p = v; }
#endif
#define LDS_WAIT() asm volatile("s_waitcnt lgkmcnt(0)" ::: "memory")

#ifndef WGM_
#define WGM_ 8
#endif
__device__ __forceinline__ void tile_of(int L, int nM, int nN, int& pm, int& pn) {
    const int nwg = nM * nN; int wgid = L;
    { const int q = nwg / 8, r = nwg % 8, xcd = wgid % 8, off = wgid / 8; wgid = (xcd < r ? xcd * (q + 1) : r * (q + 1) + (xcd - r) * q) + off; }
    const int nig = WGM_ * nN, gid = wgid / nig, fm = gid * WGM_, gsz = (nM - fm) < WGM_ ? (nM - fm) : WGM_;
    pm = fm + ((wgid % nig) % gsz); pn = (wgid % nig) / gsz;
}
using pg8::Unit;
__device__ __forceinline__ const char* uptr(const char* p) { const unsigned long long v = (unsigned long long)p; unsigned lo = __builtin_amdgcn_readfirstlane((unsigned)v), hi = __builtin_amdgcn_readfirstlane((unsigned)(v >> 32));
    asm volatile("s_nop 4" : "+s"(lo), "+s"(hi)); return (const char*)(((unsigned long long)hi << 32) | lo); }
struct Sched2D {
    const char* A; const char* B; unsigned lda, ldb; int nM, nN, G, c;
    __device__ __forceinline__ bool next(int i, Unit& u) const {
        const int L = i * G + c; if (L >= nM * nN) return false;
        tile_of(L, nM, nN, u.pm, u.pn); u.aux = 0;
        u.A1 = uptr(A + (size_t)u.pm * 512 * lda); u.B1 = uptr(B + (size_t)u.pn * 512 * ldb); u.A2 = u.A1; u.B2 = u.B1; return true;
    }
};
struct SchedMoe {
    LAS const int* gt; int gather;
    const char* A; const char* B; unsigned lda, ldb; size_t bstride; int P, nN, G, c; int ps[NE];
    int erows = 0;
    int ksplit; unsigned khbytes;
    __device__ __forceinline__ bool next(int i, Unit& u) const {
        const int L = i * G + c, nu = P * nN; if (L >= nu * ksplit) return false;
        const int kh = L / nu;
        tile_of(L - kh * nu, P, nN, u.pm, u.pn);
        int e = 0;
#pragma unroll
        for (int j = 1; j < NE; ++j) e += (u.pm >= ps[j]) ? 1 : 0;
        u.aux = (ksplit > 1) ? kh : e;
        int arow = u.pm * 256;
        if (erows) { int pse = 0;
#pragma unroll
            for (int j = 1; j < NE; ++j) pse = (u.pm >= ps[j]) ? ps[j] : pse;
            arow = e * erows + (u.pm - pse) * 256; }
        u.A1 = gather ? A : uptr(A + (size_t)arow * 2 * lda + (size_t)kh * khbytes); u.B1 = uptr(B + (size_t)e * bstride + (size_t)u.pn * 512 * ldb + (size_t)kh * khbytes); u.A2 = u.A1; u.B2 = u.B1; return true;
    }
};
struct SchedBatch {
    const char* A; const char* B; unsigned lda, ldb; size_t astride, bstride; int nMb, nB, G, c;
    __device__ __forceinline__ bool next(int i, Unit& u) const {
        const int L = i * G + c; if (L >= nMb * nB) return false;
        u.aux = L / nMb; u.pm = L % nMb; u.pn = 0;
        u.A1 = uptr(A + (size_t)u.aux * astride + (size_t)u.pm * 512 * lda); u.B1 = uptr(B + (size_t)u.aux * bstride); u.A2 = u.A1; u.B2 = u.B1; return true;
    }
};
struct SchedSbuild {
    const char* Q; const char* K; int G, c;
    __device__ __forceinline__ bool next(int i, Unit& u) const {
        const int L = i * G + c; if (L >= MNC * MH) return false;
        const int ch = L / MH, h = L % MH; u.aux = L; u.pm = ch; u.pn = h;
        u.A1 = uptr(Q + ((size_t)ch * MCH * MI + (size_t)h * HD) * 2); u.B1 = uptr(K + ((size_t)ch * MCH * MI + (size_t)h * HD) * 2); u.A2 = u.A1; u.B2 = u.B1; return true;
    }
};
struct SchedPass2 {
    const char* SMp; const char* Q; const char* VT; const char* CT; int G, c;
    __device__ __forceinline__ bool next(int i, Unit& u) const {
        const int pr_ = (i >> 1) * G + c; if (pr_ >= MNC * MH) return false;
        const int L = pr_ * 2 + (i & 1);
        const int eh = L & 1, ch_h = L >> 1, ch = ch_h / MH, h = ch_h % MH; u.aux = ch_h; u.pm = ch; u.pn = h * 2 + eh;
        u.A1 = uptr(SMp + (size_t)ch_h * MCH * MCH * 2); u.A2 = uptr(Q + ((size_t)ch * MCH * MI + (size_t)h * HD) * 2);
        u.B1 = uptr(VT + (((size_t)ch_h * HD + eh * 256) * MCH) * 2);     u.B2 = uptr(CT + ((size_t)ch_h * HD * HD + (size_t)eh * 256 * HD) * 2); return true;
    }
};

struct SchedState {
    const char* VT; const char* KT; int G, c;
    __device__ __forceinline__ bool next(int i, Unit& u) const {
        const int pq_ = (i >> 2) * G + c; if (pq_ >= MNC * MH) return false;
        const int L = pq_ * 4 + (i & 3);
        const int ch_h = L >> 2, ch = ch_h / MH, h = ch_h % MH; u.aux = ch_h; u.pm = (L >> 1) & 1; u.pn = L & 1;
        u.A1 = uptr(VT + (((size_t)ch_h * HD + u.pm * 256) * MCH) * 2); u.B1 = uptr(KT + (((size_t)ch_h * HD + u.pn * 256) * MCH) * 2); u.A2 = u.A1; u.B2 = u.B1; return true;
    }
};

__device__ __forceinline__ float rss_rstd(const float* rss, int row) { const f32x4 p = ldgf4(rss + (size_t)row * 4); return __builtin_amdgcn_rsqf(((p[0] + p[1]) + (p[2] + p[3])) * (1.0f / D) + EPS); }
template <int EMIT> __device__ __forceinline__ float emit_x(unsigned char* hn, size_t eoff, const f32x4& x) {
    if (EMIT == 1) { u32x2 w; w.x = cvt_pk_bf16(x[0], x[1]); w.y = cvt_pk_bf16(x[2], x[3]); stg8(hn + eoff * 2, w); }
    else stgi(hn + eoff, (int)cvt4_fp8(__builtin_amdgcn_fmed3f(x[0], -448.0f, 448.0f), __builtin_amdgcn_fmed3f(x[1], -448.0f, 448.0f), __builtin_amdgcn_fmed3f(x[2], -448.0f, 448.0f), __builtin_amdgcn_fmed3f(x[3], -448.0f, 448.0f)));
    return (x[0] * x[0] + x[1] * x[1]) + (x[2] * x[2] + x[3] * x[3]);
}
__device__ __forceinline__ void emit_rss(LAS float* P, float* rss, const pg8::Unit& u) {
    LDS_WAIT(); __builtin_amdgcn_s_barrier(); asm volatile("" ::: "memory");
    const int t = otid(); if (t < 256) { const f32x4 p = *(const LAS f32x4*)(P + t * 4); stgf(rss + ((size_t)u.pm * 256 + t) * 4 + u.pn, (p[0] + p[1]) + (p[2] + p[3])); }
}

template <bool RS> struct EpiBf16T {
    static constexpr bool PERM = true;
    bf16* O; int ldc; int split_cols; size_t split_stride; size_t aux_stride;
    float scale = 1.0f; const float* rss = nullptr;
    __device__ __forceinline__ void operator()(const f32x4 (&acc)[2][2][4][2], const Unit& u, int wr, int wc, int fr, int fq) const {
        const int row0 = u.pm * 256 + wr * 64 + fr; int colt = u.pn * 256; bf16* base = O + (size_t)u.aux * aux_stride;
        if (split_cols) { const int t = colt / split_cols; base += (size_t)t * split_stride; colt -= t * split_cols; }
        const int col0 = colt + wc * 32 + 8 * fq;
#pragma unroll
        for (int ai = 0; ai < 2; ++ai)
#pragma unroll
            for (int m = 0; m < 4; ++m) { bf16* rowp = base + (size_t)(row0 + ai * 128 + m * 16) * ldc + col0; const float sc_ = RS ? scale * rss_rstd(rss, row0 + ai * 128 + m * 16) : scale;
#pragma unroll
                for (int bj = 0; bj < 2; ++bj) { const f32x4 v0 = acc[ai][bj][m][0] * sc_, v1 = acc[ai][bj][m][1] * sc_;
                    u32x4 w; w.x = cvt_pk_bf16(v0[0], v0[1]); w.y = cvt_pk_bf16(v0[2], v0[3]); w.z = cvt_pk_bf16(v1[0], v1[1]); w.w = cvt_pk_bf16(v1[2], v1[3]);
                    stg16(rowp + bj * 128, w); }
                asm volatile("" ::: "memory"); }
    }
};
using EpiBf16 = EpiBf16T<false>;
template <int EMIT> struct EpiResidT {
    static constexpr bool PERM = false;
    const float* base; float* out; unsigned char* hn; float* rss; LAS float* P; float scale;
    __device__ __forceinline__ void operator()(const f32x4 (&acc)[2][2][4][2], const Unit& u, int wr, int wc, int fr, int fq) const {
        const int row0 = u.pm * 256 + wr * 64 + fr, col0 = u.pn * 256 + wc * 32 + 4 * fq;
#pragma unroll
        for (int ai = 0; ai < 2; ++ai) { f32x4 bs[4][2][2];
#pragma unroll
            for (int m = 0; m < 4; ++m) { const size_t off = (size_t)(row0 + ai * 128 + m * 16) * D + col0;
#pragma unroll
                for (int bj = 0; bj < 2; ++bj)
#pragma unroll
                    for (int n = 0; n < 2; ++n) bs[m][bj][n] = ldgf4(base + off + bj * 128 + n * 16); }
#pragma unroll
            for (int m = 0; m < 4; ++m) { const size_t off = (size_t)(row0 + ai * 128 + m * 16) * D + col0; float ss = 0.f;
#pragma unroll
                for (int bj = 0; bj < 2; ++bj)
#pragma unroll
                    for (int n = 0; n < 2; ++n) { const f32x4 x = bs[m][bj][n] + acc[ai][bj][m][n] * scale; stgf4(out + off + bj * 128 + n * 16, x);
                        if (EMIT) ss += emit_x<EMIT>(hn, off + bj * 128 + n * 16, x); }
                if (EMIT) { ss += __shfl_xor(ss, 16); ss += __shfl_xor(ss, 32); if (fq == 0) P[(ai * 128 + wr * 64 + m * 16 + fr) * 4 + wc] = ss; } }
            asm volatile("" ::: "memory"); }
        if (EMIT) emit_rss(P, rss, u);
    }
};
using EpiResid = EpiResidT<0>;
template <bool RS> struct EpiSwigluT {
    static constexpr bool PERM = true;
    bf16* Hh; const float* rss = nullptr;
    __device__ __forceinline__ void operator()(const f32x4 (&acc)[2][2][4][2], const Unit& u, int wr, int wc, int fr, int fq) const {
        const int row0 = u.pm * 256 + wr * 64 + fr, col0 = u.pn * 128 + wc * 32 + 8 * fq;
#pragma unroll
        for (int ai = 0; ai < 2; ++ai)
#pragma unroll
            for (int m = 0; m < 4; ++m) { bf16* rowp = Hh + (size_t)(row0 + ai * 128 + m * 16) * FF + col0; const float rs_ = RS ? rss_rstd(rss, row0 + ai * 128 + m * 16) : 1.0f;
                f32x2 o[4];
#pragma unroll
                for (int n = 0; n < 2; ++n)
#pragma unroll
                    for (int hh = 0; hh < 2; ++hh) { const f32x4 a4 = acc[ai][0][m][n], b4 = acc[ai][1][m][n];
                        f32x2 a = hh ? (f32x2){a4[2], a4[3]} : (f32x2){a4[0], a4[1]}, b = hh ? (f32x2){b4[2], b4[3]} : (f32x2){b4[0], b4[1]}; if (RS) { a = a * rs_; b = b * rs_; }
                        f32x2 e; e[0] = __builtin_amdgcn_exp2f(-a[0]); e[1] = __builtin_amdgcn_exp2f(-a[1]);
                        const f32x2 d = e + 1.0f; f32x2 r; r[0] = __builtin_amdgcn_rcpf(d[0]); r[1] = __builtin_amdgcn_rcpf(d[1]);
                        o[n * 2 + hh] = (a * b) * r; }
                u32x4 w; w.x = cvt_pk_bf16(o[0][0], o[0][1]); w.y = cvt_pk_bf16(o[1][0], o[1][1]); w.z = cvt_pk_bf16(o[2][0], o[2][1]); w.w = cvt_pk_bf16(o[3][0], o[3][1]);
                stg16(rowp, w); asm volatile("" ::: "memory"); }
    }
};
using EpiSwiglu = EpiSwigluT<false>;
template <bool RS> struct EpiSwiglu8T {
    static constexpr bool PERM = true;
    unsigned char* H8; const float* rss = nullptr;
    __device__ __forceinline__ void operator()(const f32x4 (&acc)[2][2][4][2], const Unit& u, int wr, int wc, int fr, int fq) const {
        const int row0 = u.pm * 256 + wr * 64 + fr, col0 = u.pn * 128 + wc * 32 + 8 * fq;
#pragma unroll
        for (int ai = 0; ai < 2; ++ai)
#pragma unroll
            for (int m = 0; m < 4; ++m) { unsigned char* rowp = H8 + (size_t)(row0 + ai * 128 + m * 16) * FF + col0; const float rs_ = RS ? 0.03125f * rss_rstd(rss, row0 + ai * 128 + m * 16) : 0.03125f;
                f32x2 o[4];
#pragma unroll
                for (int n = 0; n < 2; ++n)
#pragma unroll
                    for (int hh = 0; hh < 2; ++hh) { const f32x4 a4 = acc[ai][0][m][n], b4 = acc[ai][1][m][n];
                        const f32x2 a = (hh ? (f32x2){a4[2], a4[3]} : (f32x2){a4[0], a4[1]}) * rs_, b = hh ? (f32x2){b4[2], b4[3]} : (f32x2){b4[0], b4[1]};
                        f32x2 e; e[0] = __builtin_amdgcn_exp2f(-a[0]); e[1] = __builtin_amdgcn_exp2f(-a[1]);
                        const f32x2 d = e + 1.0f; f32x2 r; r[0] = __builtin_amdgcn_rcpf(d[0]); r[1] = __builtin_amdgcn_rcpf(d[1]);
                        o[n * 2 + hh] = (a * (b * rs_)) * r; }
                u32x2 w; w.x = cvt4_fp8(o[0][0], o[0][1], o[1][0], o[1][1]); w.y = cvt4_fp8(o[2][0], o[2][1], o[3][0], o[3][1]);
                stg8(rowp, w); asm volatile("" ::: "memory"); }
    }
};
using EpiSwiglu8 = EpiSwiglu8T<false>;
template <int EMIT> struct EpiGluT {
    static constexpr bool PERM = false;
    const bf16* YA; const float* bglu; float* xf; unsigned char* hn = nullptr; float* rss = nullptr; LAS float* P = nullptr;
    __device__ __forceinline__ void operator()(const f32x4 (&acc)[2][2][4][2], const Unit& u, int wr, int wc, int fr, int fq) const {
        const int row0 = u.pm * 256 + wr * 64 + fr, col0 = u.pn * 256 + wc * 32 + 4 * fq;
        f32x4 bv[2][2];
#pragma unroll
        for (int bj = 0; bj < 2; ++bj)
#pragma unroll
            for (int n = 0; n < 2; ++n) bv[bj][n] = ldgf4(bglu + col0 + bj * 128 + n * 16);
#pragma unroll
        for (int ai = 0; ai < 2; ++ai)
#pragma unroll
            for (int mp = 0; mp < 2; ++mp) { f32x4 xs[2][2][2]; u32x2 yv[2][2][2];
#pragma unroll
                for (int mm = 0; mm < 2; ++mm) { const size_t off = (size_t)(row0 + ai * 128 + (2 * mp + mm) * 16) * D + col0;
#pragma unroll
                    for (int bj = 0; bj < 2; ++bj)
#pragma unroll
                        for (int n = 0; n < 2; ++n) { const size_t o2 = off + bj * 128 + n * 16; xs[mm][bj][n] = ldgf4(xf + o2); const int col_ = col0 + bj * 128 + n * 16, row_ = row0 + ai * 128 + (2 * mp + mm) * 16; yv[mm][bj][n] = ldg8(YA + ((size_t)(col_ >> 4) * T + row_) * 16 + (col_ & 15)); } }
#pragma unroll
                for (int mm = 0; mm < 2; ++mm) { const int m = 2 * mp + mm; const size_t off = (size_t)(row0 + ai * 128 + m * 16) * D + col0; float ss = 0.f;
#pragma unroll
                    for (int bj = 0; bj < 2; ++bj)
#pragma unroll
                        for (int n = 0; n < 2; ++n) { const size_t o2 = off + bj * 128 + n * 16; const f32x4 x_ = xs[mm][bj][n]; const u32x2 y_ = yv[mm][bj][n];
                            const f32x4 z = acc[ai][bj][m][n] + bv[bj][n]; f32x4 r;
                            r[0] = x_[0] + bflo(y_.x) * sigm(z[0]); r[1] = x_[1] + bfhi(y_.x) * sigm(z[1]); r[2] = x_[2] + bflo(y_.y) * sigm(z[2]); r[3] = x_[3] + bfhi(y_.y) * sigm(z[3]);
                            stgf4(xf + o2, r); if (EMIT) ss += emit_x<EMIT>(hn, o2, r); }
                    if (EMIT) { ss += __shfl_xor(ss, 16); ss += __shfl_xor(ss, 32); if (fq == 0) P[(ai * 128 + wr * 64 + m * 16 + fr) * 4 + wc] = ss; } }
                asm volatile("" ::: "memory"); }
        if (EMIT) emit_rss(P, rss, u);
    }
};
using EpiGlu = EpiGluT<0>;
struct EpiS5e {
    static constexpr bool PERM = false;
    float* EB;
    __device__ __forceinline__ void operator()(const f32x4 (&acc)[2][2][4][2], const Unit& u, int wr, int wc, int fr, int fq) const {
        const int row0 = u.aux * SNC + u.pm * 256 + wr * 64 + fr, col0 = wc * 32 + 4 * fq;
#pragma unroll
        for (int ai = 0; ai < 2; ++ai)
#pragma unroll
            for (int m = 0; m < 4; ++m) { float* rowp = EB + (size_t)(row0 + ai * 128 + m * 16) * 128 + col0;
#pragma unroll
                for (int n = 0; n < 2; ++n) stgf4(rowp + n * 16, acc[ai][0][m][n]); }
    }
};
struct EpiS5y {
    static constexpr bool PERM = true;
    const bf16* UP; const float* dsk; bf16* YA;
    __device__ __forceinline__ void operator()(const f32x4 (&acc)[2][2][4][2], const Unit& u, int wr, int wc, int fr, int fq) const {
        const int g = u.aux, row0 = u.pm * 256 + wr * 64 + fr;
#pragma unroll
        for (int bj = 0; bj < 2; ++bj) { const int cc = bj * 128 + wc * 32 + 8 * fq, tt = cc >> 4, i0 = cc & 15;
            const f32x4 d0 = ldgf4(dsk + g * 16 + i0), d1 = ldgf4(dsk + g * 16 + i0 + 4);
#pragma unroll
            for (int ai = 0; ai < 2; ++ai) { u32x4 uvv[4];
#pragma unroll
                for (int m = 0; m < 4; ++m) uvv[m] = ldg16(UP + ((size_t)g * SNC + (row0 + ai * 128 + m * 16)) * SK + cc);
#pragma unroll
                for (int m = 0; m < 4; ++m) { const int chunk = row0 + ai * 128 + m * 16;
                    const u32x4 uv = uvv[m];
                    const f32x4 v0 = acc[ai][bj][m][0], v1 = acc[ai][bj][m][1]; float o[8];
                    o[0] = gelu_tanh(v0[0] + d0[0] * bflo(uv.x)); o[1] = gelu_tanh(v0[1] + d0[1] * bfhi(uv.x)); o[2] = gelu_tanh(v0[2] + d0[2] * bflo(uv.y)); o[3] = gelu_tanh(v0[3] + d0[3] * bfhi(uv.y));
                    o[4] = gelu_tanh(v1[0] + d1[0] * bflo(uv.z)); o[5] = gelu_tanh(v1[1] + d1[1] * bfhi(uv.z)); o[6] = gelu_tanh(v1[2] + d1[2] * bflo(uv.w)); o[7] = gelu_tanh(v1[3] + d1[3] * bfhi(uv.w));
                    u32x4 w; w.x = cvt_pk_bf16(o[0], o[1]); w.y = cvt_pk_bf16(o[2], o[3]); w.z = cvt_pk_bf16(o[4], o[5]); w.w = cvt_pk_bf16(o[6], o[7]);
                    stg16(YA + ((size_t)g * T + (size_t)(chunk * SL + tt)) * 16 + i0, w); }
                asm volatile("" ::: "memory"); } }
    }
};
struct EpiSbuild {
    static constexpr bool PERM = true;
    bf16* SMp; float* DENP; const float* GS; const float* MC;
    __device__ __forceinline__ void operator()(const f32x4 (&acc)[2][2][4][2], const Unit& u, int wr, int wc, int fr, int fq) const {
        const int ch = u.pm, h = u.pn, ch_h = u.aux; const float mc = ldgf(MC + h * 80 + ch);
        float rs[2][4];
#pragma unroll
        for (int ai = 0; ai < 2; ++ai)
#pragma unroll
            for (int m = 0; m < 4; ++m) rs[ai][m] = 0.f;
#pragma unroll
        for (int bj = 0; bj < 2; ++bj) { const int s0 = bj * 128 + wc * 32 + 8 * fq; float w[8];
            { const f32x4 g0 = ldgf4(GS + (size_t)h * T + ch * MCH + s0), g1 = ldgf4(GS + (size_t)h * T + ch * MCH + s0 + 4);
#pragma unroll
              for (int j = 0; j < 4; ++j) { w[j] = __expf(g0[j] - mc); w[4 + j] = __expf(g1[j] - mc); } }
#pragma unroll
            for (int ai = 0; ai < 2; ++ai)
#pragma unroll
                for (int m = 0; m < 4; ++m) { const int r = ai * 128 + wr * 64 + m * 16 + fr; float o[8];
#pragma unroll
                    for (int n = 0; n < 2; ++n)
#pragma unroll
                        for (int j = 0; j < 4; ++j) { const int s = s0 + n * 4 + j; o[n * 4 + j] = (s <= r) ? acc[ai][bj][m][n][j] * w[n * 4 + j] : 0.f; }
                    u32x4 pk; pk.x = cvt_pk_bf16(o[0], o[1]); pk.y = cvt_pk_bf16(o[2], o[3]); pk.z = cvt_pk_bf16(o[4], o[5]); pk.w = cvt_pk_bf16(o[6], o[7]);
                    rs[ai][m] += (bflo(pk.x) + bfhi(pk.x)) + (bflo(pk.y) + bfhi(pk.y)) + (bflo(pk.z) + bfhi(pk.z)) + (bflo(pk.w) + bfhi(pk.w));
                    stg16(SMp + ((size_t)ch_h * MCH + r) * MCH + s0, pk); asm volatile("" ::: "memory"); } }
#pragma unroll
        for (int ai = 0; ai < 2; ++ai)
#pragma unroll
            for (int m = 0; m < 4; ++m) { const int r = ai * 128 + wr * 64 + m * 16 + fr; float v = rs[ai][m]; v += __shfl_xor(v, 16); v += __shfl_xor(v, 32);
                if (fq == 0) stgf(DENP + ((size_t)ch_h * MCH + r) * 4 + wc, v); }
    }
};
struct EpiNum {
    static constexpr bool PERM = true;
    bf16* NUM; const float* RMT; const float* MC;
    __device__ __forceinline__ void operator()(const f32x4 (&acc)[2][2][4][2], const Unit& u, int wr, int wc, int fr, int fq) const {
        const int ch = u.pm, h = u.pn >> 1, eh = u.pn & 1; const float mc = ldgf(MC + h * 80 + ch);
        const int col0 = h * HD + eh * 256 + wc * 32 + 8 * fq;
        float rmv[2][4];
#pragma unroll
        for (int ai = 0; ai < 2; ++ai)
#pragma unroll
            for (int m = 0; m < 4; ++m) rmv[ai][m] = ldgf(RMT + (size_t)h * T + ch * MCH + ai * 128 + wr * 64 + m * 16 + fr);
#pragma unroll
        for (int ai = 0; ai < 2; ++ai)
#pragma unroll
            for (int m = 0; m < 4; ++m) { const int t = ch * MCH + ai * 128 + wr * 64 + m * 16 + fr; const float sc = __expf(mc - rmv[ai][m]);
                bf16* rowp = NUM + (size_t)t * MI + col0;
#pragma unroll
                for (int bj = 0; bj < 2; ++bj) { const f32x4 v0 = acc[ai][bj][m][0] * sc, v1 = acc[ai][bj][m][1] * sc;
                    u32x4 w; w.x = cvt_pk_bf16(v0[0], v0[1]); w.y = cvt_pk_bf16(v0[2], v0[3]); w.z = cvt_pk_bf16(v1[0], v1[1]); w.w = cvt_pk_bf16(v1[2], v1[3]);
                    stg16(rowp + bj * 128, w); }
                asm volatile("" ::: "memory"); }
    }
};
struct ConvItem { const float* W; bf16* WT; int ldw, ldt, k0, n0, drow0; float scale; int f8; const float* kg; };
__device__ __forceinline__ void tr_load(const ConvItem& d, f32x2 (&v)[33], int lane) {
    const int hrow = lane >> 5, cl = lane & 31; const unsigned voff = (unsigned)(hrow * d.ldw + 2 * cl) * 4u;
    const char* rb = (const char*)(d.W + (size_t)d.k0 * d.ldw + d.n0); const size_t rstep = (size_t)d.ldw * 8;
#pragma unroll
    for (int i = 0; i < 32; ++i) v[i] = *(const GAS f32x2*)(rb + (size_t)i * rstep + voff);
    v[32][0] = d.kg ? ldgf(d.kg + d.k0 + lane) : 1.0f; v[32][1] = 0.f;
}
__device__ __forceinline__ float tr_scale(const ConvItem& d, const f32x2 (&v)[33], int i, int hrow) {
    const int gi = __float_as_int(v[32][0]); const float g0 = __int_as_float(__builtin_amdgcn_readlane(gi, 2 * i)), g1 = __int_as_float(__builtin_amdgcn_readlane(gi, 2 * i + 1)); return d.scale * (hrow ? g1 : g0);
}
__device__ __forceinline__ void tr_store8(const ConvItem& d, const f32x2 (&v)[33], LAS float* scr, int lane) {
    LAS unsigned char* tile = (LAS unsigned char*)scr; constexpr int TS8 = 68;
    const int hrow = lane >> 5, cl = lane & 31;
#pragma unroll
    for (int i = 0; i < 32; ++i) { const float s_ = tr_scale(d, v, i, hrow); *(LAS unsigned short*)(tile + (2 * i + hrow) * TS8 + cl * 2) = (unsigned short)__builtin_amdgcn_cvt_pk_fp8_f32(v[i][0] * s_, v[i][1] * s_, 0, false); }
    LDS_WAIT(); asm volatile("" ::: "memory");
    const int c = lane & 7;
#pragma unroll
    for (int j = 0; j < 8; ++j) { const int n = (lane >> 3) + 8 * j; const LAS unsigned char* sp = tile + (8 * c) * TS8 + n;
        u32x2 o; o.x = (unsigned)sp[0 * TS8] | ((unsigned)sp[1 * TS8] << 8) | ((unsigned)sp[2 * TS8] << 16) | ((unsigned)sp[3 * TS8] << 24);
        o.y = (unsigned)sp[4 * TS8] | ((unsigned)sp[5 * TS8] << 8) | ((unsigned)sp[6 * TS8] << 16) | ((unsigned)sp[7 * TS8] << 24);
        stg8((unsigned char*)d.WT + (size_t)(d.drow0 + n) * d.ldt + d.k0 + 8 * c, o); }
    LDS_WAIT(); asm volatile("" ::: "memory");
}
__device__ __forceinline__ void tr_store(const ConvItem& d, const f32x2 (&v)[33], LAS float* scr, int lane) {
    if (d.f8) { tr_store8(d, v, scr, lane); return; }
    LAS unsigned char* tile = (LAS unsigned char*)scr; constexpr int TS = 132;
    const int hrow = lane >> 5, cl = lane & 31;
#pragma unroll
    for (int i = 0; i < 32; ++i) { const float s_ = tr_scale(d, v, i, hrow); *(LAS unsigned*)(tile + (2 * i + hrow) * TS + cl * 4) = cvt_pk_bf16(v[i][0] * s_, v[i][1] * s_); }
    LDS_WAIT(); asm volatile("" ::: "memory");
    const int c = lane & 7;
#pragma unroll
    for (int j = 0; j < 8; ++j) { const int n = (lane >> 3) + 8 * j; const LAS bf16* sp = (const LAS bf16*)(tile + (8 * c) * TS) + n;
        u32x4 o; o.x = (unsigned)sp[0 * (TS / 2)] | ((unsigned)sp[1 * (TS / 2)] << 16); o.y = (unsigned)sp[2 * (TS / 2)] | ((unsigned)sp[3 * (TS / 2)] << 16);
        o.z = (unsigned)sp[4 * (TS / 2)] | ((unsigned)sp[5 * (TS / 2)] << 16); o.w = (unsigned)sp[6 * (TS / 2)] | ((unsigned)sp[7 * (TS / 2)] << 16);
        stg16(d.WT + (size_t)(d.drow0 + n) * d.ldt + d.k0 + 8 * c, o); }
    LDS_WAIT(); asm volatile("" ::: "memory");
}
__device__ __forceinline__ ConvItem conv_desc(const float* W, int K, int N, bf16* WT, int ldt, int mode, int it) {
    const int nblk = N / 64, kb = it / nblk, nb_ = it % nblk, n0 = nb_ * 64;
    ConvItem d; d.W = W; d.WT = WT; d.ldw = N; d.ldt = ldt; d.k0 = kb * 64; d.n0 = n0; d.drow0 = (mode == 0 || mode == 3) ? n0 : ((n0 >> 7) * 256 + (n0 & 127) + (mode == 2 ? 128 : 0));
    d.scale = (mode == 1 || mode == 3) ? 1.4426950408889634f : (mode == 2) ? 0.6931471805599453f : 1.0f;
    d.f8 = 0; d.kg = nullptr; return d;
}
__device__ __forceinline__ ConvItem conv_desc8(const float* W, int K, int N, unsigned char* WT, int mode, int it) {
    ConvItem d = conv_desc(W, K, N, (bf16*)WT, K, mode, it); d.f8 = 1;
    d.scale = (mode == 1) ? 32.0f * 1.4426950408889634f : (mode == 2) ? 32.0f * 0.6931471805599453f : 64.0f; return d;
}
__device__ __forceinline__ void conv_item(const float* W, int K, int N, bf16* WT, int ldt, int mode, int it, LAS float* scr, int lane) {
    const ConvItem d = conv_desc(W, K, N, WT, ldt, mode, it); f32x2 v[33]; tr_load(d, v, lane); tr_store(d, v, scr, lane);
}
__device__ __forceinline__ void conv_mat(const float* W, int K, int N, bf16* WT, int ldt, int mode, int gw, int NGW, LAS float* scr, int lane) {
    const int items = (K / 64) * (N / 64);
    int it = gw; if (it >= items) return;
    f32x2 va[33], vb[33]; ConvItem da = conv_desc(W, K, N, WT, ldt, mode, it), db = da; tr_load(da, va, lane);
    for (;;) {
        const int i1 = it + NGW; if (i1 < items) { db = conv_desc(W, K, N, WT, ldt, mode, i1); tr_load(db, vb, lane); }
        tr_store(da, va, scr, lane); if (i1 >= items) break;
        const int i2 = i1 + NGW; if (i2 < items) { da = conv_desc(W, K, N, WT, ldt, mode, i2); tr_load(da, va, lane); }
        tr_store(db, vb, scr, lane); if (i2 >= items) break;
        it = i2;
    }
}
__device__ __forceinline__ void conv_dense(const Args& a, int f, int gw, int NGW, LAS float* scr, int lane) {
    bf16* W13 = (bf16*)(a.ws + (f ? WS_WD1_13 : WS_W13)); bf16* W2T = (bf16*)(a.ws + (f ? WS_WD1_2 : WS_W2T));
    conv_mat(a.in[I_F_W1] + (size_t)f * D * FF, D, FF, W13, D, 1, gw, NGW, scr, lane);
    conv_mat(a.in[I_F_W3] + (size_t)f * D * FF, D, FF, W13, D, 2, gw, NGW, scr, lane);
    conv_mat(a.in[I_F_W2] + (size_t)f * D * FF, FF, D, W2T, FF, 0, gw, NGW, scr, lane);
}
__device__ __forceinline__ ConvItem moe_desc(const Args& a, int f, int idx) {
    constexpr int I1 = (D / 64) * (FF / 64), I2 = (FF / 64) * (D / 64), PER = 2 * I1 + I2;
    const int e = idx / PER, r = idx % PER; const size_t wo = ((size_t)f * NE + e) * D * FF;
    if (MOE_F8(f)) {
        unsigned char* W13 = a.ws + WS_W13 + (size_t)e * (W13_BYTES / 2); unsigned char* W2T = a.ws + WS_W2T8 + (size_t)e * (W2_BYTES / 2);
        if (r < I1) return conv_desc8(a.in[I_E_W1] + wo, D, FF, W13, 1, r);
        if (r < 2 * I1) return conv_desc8(a.in[I_E_W3] + wo, D, FF, W13, 2, r - I1);
        return conv_desc8(a.in[I_E_W2] + wo, FF, D, W2T, 0, r - 2 * I1); }
    bf16* W13 = (bf16*)(a.ws + WS_W13 + (size_t)e * W13_BYTES); bf16* W2T = (bf16*)(a.ws + WS_W2T + (size_t)e * W2_BYTES);
    if (r < I1) return conv_desc(a.in[I_E_W1] + wo, D, FF, W13, D, 1, r);
    if (r < 2 * I1) return conv_desc(a.in[I_E_W3] + wo, D, FF, W13, D, 2, r - I1);
    return conv_desc(a.in[I_E_W2] + wo, FF, D, W2T, FF, 0, r - 2 * I1);
}
__device__ __forceinline__ void conv_moe(const Args& a, int f, int gw, int NGW, LAS float* scr, int lane) {
    constexpr int I1 = (D / 64) * (FF / 64), I2 = (FF / 64) * (D / 64), PER = 2 * I1 + I2, items = NE * PER;
    int it = gw; if (it >= items) return;
    f32x2 va[33], vb[33]; ConvItem da = moe_desc(a, f, it), db = da; tr_load(da, va, lane);
    for (;;) {
        const int i1 = it + NGW; if (i1 < items) { db = moe_desc(a, f, i1); tr_load(db, vb, lane); }
        tr_store(da, va, scr, lane); if (i1 >= items) break;
        const int i2 = i1 + NGW; if (i2 < items) { da = moe_desc(a, f, i2); tr_load(da, va, lane); }
        tr_store(db, vb, scr, lane); if (i2 >= items) break;
        it = i2;
    }
}
enum { DQ_DENSE0 = 0, DQ_B, DQ_C, DQ_DENSE1, DQ_A1, DQ_MOE1, DQ_NG };
constexpr int DQ_I = (D / 64) * (FF / 64);
__device__ __forceinline__ int dq_size(int g) { return g == DQ_DENSE0 || g == DQ_DENSE1 ? 3 * DQ_I : g == DQ_B ? 1024 + 512 : g == DQ_C ? 256 : g == DQ_A1 ? 640 + 320 + 80 : NE * 3 * DQ_I; }
__device__ __forceinline__ ConvItem dq_desc0(const Args& a, int g, int idx) {
    if (g == DQ_DENSE0 || g == DQ_DENSE1) { const int f = (g == DQ_DENSE1) ? 1 : 0, m = idx / DQ_I, it = idx % DQ_I;
        if (DENSE_F8(f)) { unsigned char* W13 = a.ws + (f ? WS_WD1_13 : WS_W13); unsigned char* W2T = a.ws + (f ? WS_WD1_2 : WS_W2T);
            if (m == 0) return conv_desc8(a.in[I_F_W1] + (size_t)f * D * FF, D, FF, W13, 1, it);
            if (m == 1) return conv_desc8(a.in[I_F_W3] + (size_t)f * D * FF, D, FF, W13, 2, it);
            return conv_desc8(a.in[I_F_W2] + (size_t)f * D * FF, FF, D, W2T, 0, it); }
        bf16* W13 = (bf16*)(a.ws + (f ? WS_WD1_13 : WS_W13)); bf16* W2T = (bf16*)(a.ws + (f ? WS_WD1_2 : WS_W2T));
        if (m == 0) return conv_desc(a.in[I_F_W1] + (size_t)f * D * FF, D, FF, W13, D, 1, it);
        if (m == 1) return conv_desc(a.in[I_F_W3] + (size_t)f * D * FF, D, FF, W13, D, 2, it);
        return conv_desc(a.in[I_F_W2] + (size_t)f * D * FF, FF, D, W2T, FF, 0, it); }
    if (g == DQ_B) { if (idx < 1024) return conv_desc(a.in[I_B_W_IN], D, 2 * MI, (bf16*)(a.ws + WS_WB_IN), D, 0, idx);
        return conv_desc(a.in[I_B_W_OUT], MI, D, (bf16*)(a.ws + WS_WB_OUT), MI, 0, idx - 1024); }
    if (g == DQ_C) return conv_desc(a.in[I_C_W_GLU], D, D, (bf16*)(a.ws + WS_WC_GLU), D, 0, idx);
    if (g == DQ_A1) { if (idx < 640) { if (RG_F8(1)) return conv_desc8(a.in[I_A_W_IN] + (size_t)D * 2 * RW, D, 2 * RW, a.ws + WS_WA_IN + (size_t)2 * RW * D * 2, 0, idx);
            return conv_desc(a.in[I_A_W_IN] + (size_t)D * 2 * RW, D, 2 * RW, (bf16*)(a.ws + WS_WA_IN) + (size_t)2 * RW * D, D, 0, idx); }
        if (idx < 960) return conv_desc(a.in[I_A_W_OUT] + (size_t)RW * D, RW, D, (bf16*)(a.ws + WS_WA_OUT) + (size_t)D * RW, RW, 0, idx - 640);
        const int it = idx - 960, n = it / 8, r = it % 8, which = r / 4, q = r % 4;
        return conv_desc(a.in[which ? I_A_W_I : I_A_W_R] + ((size_t)RNB + n) * RBD * RBD, RBD, RBD, (bf16*)(a.ws + WS_WA_G) + ((size_t)RNB + n) * 256 * RBD + (size_t)which * 128 * RBD, RBD, 3, q); }
    return moe_desc(a, 1, idx);
}
__device__ __forceinline__ ConvItem dq_desc(const Args& a, int g, int idx) {
    ConvItem d = dq_desc0(a, g, idx);
#if DEFER_NORM
    if ((g == DQ_DENSE0 || g == DQ_DENSE1) && idx < 2 * DQ_I) d.kg = a.in[I_NORM_FFN] + (g == DQ_DENSE1 ? 2 : 0) * D;
    if (g == DQ_B && idx < 1024) d.kg = a.in[I_NORM_MIX] + 1 * D;
    if (g == DQ_A1 && idx < 640) d.kg = a.in[I_NORM_MIX] + 3 * D;
#endif
    return d;
}
__device__ __forceinline__ unsigned* dq_cursor(const Args& a, int g) { return (unsigned*)(a.ws + WS_CTL) + CW_DQ + 64 * g; }
__device__ __forceinline__ int dq_left(const Args& a, int g) { const int c = (int)__hip_atomic_load(dq_cursor(a, g), __ATOMIC_RELAXED, __HIP_MEMORY_SCOPE_AGENT), s = dq_size(g); return c >= s ? 0 : s - c; }
__device__ __forceinline__ void dq_work(const Args& a, int g_lo, int g_hi, int quota, LAS unsigned char* lds, LAS float* scr) {
    const int tid = otid(), lane = tid & 63, wave = tid >> 6; volatile LAS int* slot = (volatile LAS int*)(lds + MISC_OFF + 16);
    int done = 0;
    if (quota == -2) {
        __syncthreads(); if (tid == 0) *slot = (dq_left(a, g_lo) + 16 * (int)gridDim.x - 1) / (16 * (int)gridDim.x); __syncthreads(); quota = *slot; }
    for (int g = g_lo; g <= g_hi; ++g) {
        const int size = dq_size(g);
        for (;;) {
            if (quota >= 0 && done >= quota) return;
            __syncthreads();
            if (tid == 0) { int base = size; if (dq_left(a, g) > 0) base = (int)__hip_atomic_fetch_add(dq_cursor(a, g), 16u, __ATOMIC_RELAXED, __HIP_MEMORY_SCOPE_AGENT); *slot = base; }
            __syncthreads();
            const int base = *slot; if (base >= size) break;
            const int i0 = base + wave * 2, i1 = i0 + 1; ++done;
            if (i0 < size) { f32x2 va[33], vb[33]; const ConvItem da = dq_desc(a, g, i0); tr_load(da, va, lane);
                if (i1 < size) { const ConvItem db = dq_desc(a, g, i1); tr_load(db, vb, lane); tr_store(da, va, scr, lane); tr_store(db, vb, scr, lane); }
                else tr_store(da, va, scr, lane); }
        }
    }
}
__device__ __forceinline__ void conv_a(const Args& a, int j, int gw, int NGW, LAS float* scr, int lane) {
    conv_mat(a.in[I_A_W_IN] + (size_t)j * D * 2 * RW, D, 2 * RW, (bf16*)(a.ws + WS_WA_IN) + (size_t)j * 2 * RW * D, D, 0, gw, NGW, scr, lane);
    conv_mat(a.in[I_A_W_OUT] + (size_t)j * RW * D, RW, D, (bf16*)(a.ws + WS_WA_OUT) + (size_t)j * D * RW, RW, 0, gw, NGW, scr, lane);
    for (int it = gw; it < RNB * 2 * 4; it += NGW) { const int n = it / 8, r = it % 8, which = r / 4, q = r % 4;
        const float* W = a.in[which ? I_A_W_I : I_A_W_R] + ((size_t)j * RNB + n) * RBD * RBD;
        bf16* WT = (bf16*)(a.ws + WS_WA_G) + ((size_t)j * RNB + n) * 256 * RBD + (size_t)which * 128 * RBD;
        conv_item(W, RBD, RBD, WT, RBD, 3, q, scr, lane); }
}
__device__ __forceinline__ void conv_perm(const Args& a, int gw, int NGW, LAS float* scr, int lane) {
    for (int j = 0; j < 2; ++j) {
        conv_mat(a.in[I_A_W_IN] + (size_t)j * D * 2 * RW, D, 2 * RW, (bf16*)(a.ws + WS_WA_IN) + (size_t)j * 2 * RW * D, D, 0, gw, NGW, scr, lane);
        conv_mat(a.in[I_A_W_OUT] + (size_t)j * RW * D, RW, D, (bf16*)(a.ws + WS_WA_OUT) + (size_t)j * D * RW, RW, 0, gw, NGW, scr, lane);
        for (int it = gw; it < RNB * 2 * 4; it += NGW) { const int n = it / 8, r = it % 8, which = r / 4, q = r % 4;
            const float* W = a.in[which ? I_A_W_I : I_A_W_R] + ((size_t)j * RNB + n) * RBD * RBD;
            bf16* WT = (bf16*)(a.ws + WS_WA_G) + ((size_t)j * RNB + n) * 256 * RBD + (size_t)which * 128 * RBD;
            conv_item(W, RBD, RBD, WT, RBD, 3, q, scr, lane); }
    }
    conv_mat(a.in[I_B_W_IN], D, 2 * MI, (bf16*)(a.ws + WS_WB_IN), D, 0, gw, NGW, scr, lane);
    conv_mat(a.in[I_B_W_OUT], MI, D, (bf16*)(a.ws + WS_WB_OUT), MI, 0, gw, NGW, scr, lane);
    conv_mat(a.in[I_C_W_GLU], D, D, (bf16*)(a.ws + WS_WC_GLU), D, 0, gw, NGW, scr, lane);
}
__device__ __forceinline__ void s5_mats(const Args& a, LAS unsigned char* lds, int bid, int nb) {
    LAS float* lre = (LAS float*)lds; LAS float* lim = lre + 17 * 64; LAS float* bre = lim + 17 * 64; LAS float* bim = bre + 1024; LAS float* cre = bim + 1024; LAS float* cim = cre + 1024; LAS float* Kt = cim + 1024;
    const int tid = otid();
    for (int gq = bid; gq < NG * 4; gq += nb) {
        const int g = gq >> 2, q4 = gq & 3;
        __syncthreads();
        if (tid < 64) { const int p = tid; const float are = ldgf(a.in[I_C_A_RE] + g * 64 + p), aim = ldgf(a.in[I_C_A_IM] + g * 64 + p), dl = __expf(ldgf(a.in[I_C_LOG_STEP] + g));
            for (int tau = 0; tau <= 16; ++tau) { const float mag = __expf((float)tau * dl * are); float sn, cs; sincosf((float)tau * dl * aim, &sn, &cs); lre[tau * 64 + p] = mag * cs; lim[tau * 64 + p] = mag * sn; }
            const float mag = __expf(dl * are); float sn, cs; sincosf(dl * aim, &sn, &cs);
            const float nr = mag * cs - 1.0f, ni = mag * sn, den = are * are + aim * aim, fr_ = (nr * are + ni * aim) / den, fi_ = (ni * are - nr * aim) / den;
            for (int j = 0; j < 16; ++j) { const float br = ldgf(a.in[I_C_B_RE] + ((size_t)g * 64 + p) * 16 + j), bi = ldgf(a.in[I_C_B_IM] + ((size_t)g * 64 + p) * 16 + j);
                bre[p * 16 + j] = fr_ * br - fi_ * bi; bim[p * 16 + j] = fr_ * bi + fi_ * br; } }
        for (int i = tid; i < 1024; i += NTHR) { cre[i] = ldgf(a.in[I_C_C_RE] + (size_t)g * 1024 + i); cim[i] = ldgf(a.in[I_C_C_IM] + (size_t)g * 1024 + i); }
        __syncthreads();
        for (int o = tid; o < 4096; o += NTHR) { const int tau = o >> 8, i = (o >> 4) & 15, j = o & 15; float s = 0.f;
            for (int p = 0; p < 64; ++p) { const float cr = cre[i * 64 + p], ci = cim[i * 64 + p], lr = lre[tau * 64 + p], li = lim[tau * 64 + p], xr = cr * lr - ci * li, xi = cr * li + ci * lr;
                s += xr * bre[p * 16 + j] - xi * bim[p * 16 + j]; }
            Kt[o] = s; }
        __syncthreads();
        bf16* KC = (bf16*)(a.ws + WS_S5_KC) + (size_t)g * 256 * SK; bf16* BE = (bf16*)(a.ws + WS_S5_BE) + (size_t)g * 256 * 256;
        for (int o = tid; o < 64 * (SK / 8); o += NTHR) { const int n = q4 * 64 + o / (SK / 8), k0 = (o % (SK / 8)) * 8, tt = n >> 4, i = n & 15; float v[8];
#pragma unroll
            for (int q = 0; q < 8; ++q) { const int k = k0 + q;
                if (k < 256) { const int s = k >> 4, j = k & 15; v[q] = (s <= tt) ? Kt[((tt - s) << 8) + (i << 4) + j] : 0.f; }
                else { const int p = (k - 256) & 63, im = (k - 256) >> 6; const float cr = cre[i * 64 + p], ci = cim[i * 64 + p], lr = lre[(tt + 1) * 64 + p], li = lim[(tt + 1) * 64 + p];
                    v[q] = im ? -(cr * li + ci * lr) : (cr * lr - ci * li); } }
            u32x4 w; w.x = cvt_pk_bf16(v[0], v[1]); w.y = cvt_pk_bf16(v[2], v[3]); w.z = cvt_pk_bf16(v[4], v[5]); w.w = cvt_pk_bf16(v[6], v[7]);
            stg16(KC + (size_t)n * SK + k0, w); }
        for (int o = tid; o < 64 * 32; o += NTHR) { const int n = q4 * 64 + (o >> 5), k0 = (o & 31) * 8; float v[8];
#pragma unroll
            for (int q = 0; q < 8; ++q) { const int k = k0 + q, s = k >> 4, j = k & 15;
                if (n < 128) { const int p = n & 63, im = n >> 6; const float lr = lre[(15 - s) * 64 + p], li = lim[(15 - s) * 64 + p], br = bre[p * 16 + j], bi = bim[p * 16 + j];
                    v[q] = im ? (lr * bi + li * br) : (lr * br - li * bi); } else v[q] = 0.f; }
            u32x4 w; w.x = cvt_pk_bf16(v[0], v[1]); w.y = cvt_pk_bf16(v[2], v[3]); w.z = cvt_pk_bf16(v[4], v[5]); w.w = cvt_pk_bf16(v[6], v[7]);
            stg16(BE + (size_t)n * 256 + k0, w); }
    }
    __syncthreads();
}

__device__ __forceinline__ void moe_prefix(const Args& a, int f, int (&ps)[NE], int& P, int (&cnt)[NE]) {
    const unsigned* gc = (const unsigned*)(a.ws + WS_CTL) + CW_MOE + f * 1024; int acc = 0;
#pragma unroll
    for (int e = 0; e < NE; ++e) { ps[e] = acc; const int c = __builtin_amdgcn_readfirstlane((int)__hip_atomic_load(gc + e * 64, __ATOMIC_RELAXED, __HIP_MEMORY_SCOPE_AGENT)); cnt[e] = c; acc += (c + 255) >> 8; }
    P = acc;
}
template <bool COMBINE, bool ROUTER, int OUTMODE>
__device__ __forceinline__ void ph_norm(const Args& a, LAS unsigned char* lds, int bid, int nb, const float* xsrc, float* xf, const float* gain, int f) {
    const int tid = otid(), lane = tid & 63, wave = tid >> 6;
    const int RPB = T / nb;
    LAS float* rt = (LAS float*)lds; LAS int* sel = (LAS int*)(lds + 32768); LAS int* rnk = (LAS int*)(lds + 32768 + 1024); LAS int* bases = (LAS int*)(lds + 32768 + 2048); LAS int* dstl = (LAS int*)(lds + 32768 + 3072); LAS unsigned char* rows8 = lds + 36864;
    if (ROUTER) {
        const float* router = a.in[I_E_ROUTER] + (size_t)f * D * NE;
        for (int i = tid; i < D * NE; i += NTHR) rt[(i & 7) * D + (i >> 3)] = ldgf(router + i);
        __syncthreads();
    }
    f32x4 gv[4];
#pragma unroll
    for (int j = 0; j < 4; ++j) gv[j] = ldgf4(gain + 4 * lane + 256 * j);
    bf16* HN = (bf16*)(a.ws + WS_HN); bf16* UP = (bf16*)(a.ws + WS_UP);
    const bf16* OUTB = (const bf16*)(a.ws + WS_OUT); const bf16* OUTA = (const bf16*)(a.ws + WS_AG); float* TOPW = (float*)(a.ws + WS_TOPW); int* TOPI = (int*)(a.ws + WS_TOPI);
    int cps[NE], cP = 0, ccnt[NE];
    if (COMBINE) moe_prefix(a, f, cps, cP, ccnt);
#pragma unroll 1
    for (int lr0 = wave; lr0 < RPB; lr0 += NWAVES * 4) {
      f32x4 vv[4][4];
#pragma unroll
      for (int k_ = 0; k_ < 4; ++k_) { const int lrk = (lr0 + k_ * NWAVES < RPB) ? lr0 + k_ * NWAVES : lr0;
#pragma unroll
        for (int j = 0; j < 4; ++j) vv[k_][j] = ldgf4(xsrc + (size_t)(bid * RPB + lrk) * D + 4 * lane + 256 * j); }
#pragma unroll
      for (int k_ = 0; k_ < 4; ++k_) { const int lr = lr0 + k_ * NWAVES; if (lr < RPB) {
        const int row = bid * RPB + lr;
        f32x4 (&v)[4] = vv[k_];
        if (COMBINE) {
            const int t1 = ldgi(TOPI + row * 2), t2 = ldgi(TOPI + row * 2 + 1); const int e1 = t1 >> 16, e2 = t2 >> 16; int s1 = 0, s2 = 0;
#pragma unroll
            for (int e = 0; e < NE; ++e) { s1 = (e1 == e) ? cps[e] : s1; s2 = (e2 == e) ? cps[e] : s2; }
            const int r1 = s1 * 256 + (t1 & 0xffff), r2 = s2 * 256 + (t2 & 0xffff); const float p1 = ldgf(TOPW + row * 2), p2 = ldgf(TOPW + row * 2 + 1);
#pragma unroll
            for (int j = 0; j < 4; ++j) { const bool one_buf = MOE_F8(f) != 0;
                const u32x2 o1 = ldg8(OUTA + (size_t)r1 * D + 4 * lane + 256 * j), o2 = ldg8(OUTA + (size_t)r2 * D + 4 * lane + 256 * j);
                u32x2 q1 = (u32x2){0u, 0u}, q2 = (u32x2){0u, 0u};
                if (!one_buf) { q1 = ldg8(OUTB + (size_t)r1 * D + 4 * lane + 256 * j); q2 = ldg8(OUTB + (size_t)r2 * D + 4 * lane + 256 * j); }
                v[j][0] += p1 * (bflo(o1.x) + bflo(q1.x)) + p2 * (bflo(o2.x) + bflo(q2.x)); v[j][1] += p1 * (bfhi(o1.x) + bfhi(q1.x)) + p2 * (bfhi(o2.x) + bfhi(q2.x));
                v[j][2] += p1 * (bflo(o1.y) + bflo(q1.y)) + p2 * (bflo(o2.y) + bflo(q2.y)); v[j][3] += p1 * (bfhi(o1.y) + bfhi(q1.y)) + p2 * (bfhi(o2.y) + bfhi(q2.y));
                if (OUTMODE != 2) stgf4(xf + (size_t)row * D + 4 * lane + 256 * j, v[j]); }
        }
        float s2 = 0.f;
#pragma unroll
        for (int j = 0; j < 4; ++j) s2 += (v[j][0] * v[j][0] + v[j][1] * v[j][1]) + (v[j][2] * v[j][2] + v[j][3] * v[j][3]);
        const float rstd = __builtin_amdgcn_rsqf(wave_sum(s2) * (1.0f / D) + EPS);
#pragma unroll
        for (int j = 0; j < 4; ++j) v[j] = v[j] * rstd * gv[j];
        if (OUTMODE == 0) {
#pragma unroll
            for (int j = 0; j < 4; ++j) { u32x2 w; w.x = cvt_pk_bf16(v[j][0], v[j][1]); w.y = cvt_pk_bf16(v[j][2], v[j][3]); stg8(HN + (size_t)row * D + 4 * lane + 256 * j, w); }
        } else if (OUTMODE == 3) {
            if (ROUTER) {
#pragma unroll
                for (int j = 0; j < 4; ++j) *(LAS int*)(rows8 + lr * D + 4 * lane + 256 * j) = (int)cvt4_fp8(v[j][0], v[j][1], v[j][2], v[j][3]);
            } else {
#pragma unroll
                for (int j = 0; j < 4; ++j) stgi((unsigned char*)HN + (size_t)row * D + 4 * lane + 256 * j, (int)cvt4_fp8(v[j][0], v[j][1], v[j][2], v[j][3]));
            }
        } else if (OUTMODE == 1) {
            const int chunk = row >> 4, s = row & 15;
#pragma unroll
            for (int j = 0; j < 4; ++j) { const int g = (lane >> 2) + 16 * j, i0 = 4 * (lane & 3); u32x2 w; w.x = cvt_pk_bf16(v[j][0], v[j][1]); w.y = cvt_pk_bf16(v[j][2], v[j][3]);
                stg8(UP + ((size_t)g * SNC + chunk) * SK + s * 16 + i0, w); }
        } else {
#pragma unroll
            for (int j = 0; j < 4; ++j) stgf4(a.out + (size_t)row * D + 4 * lane + 256 * j, v[j]);
        }
      } }
      if (ROUTER) {
          float x[32];
#pragma unroll
          for (int i = 0; i < 32; ++i) x[i] = 0.f;
#pragma unroll
          for (int e = 0; e < NE; ++e)
#pragma unroll
              for (int j = 0; j < 4; ++j) { const f32x4 r = *(const LAS f32x4*)(rt + e * D + 4 * lane + 256 * j);
#pragma unroll
                  for (int k_ = 0; k_ < 4; ++k_) x[k_ * 8 + e] += (vv[k_][j][0] * r[0] + vv[k_][j][1] * r[1]) + (vv[k_][j][2] * r[2] + vv[k_][j][3] * r[3]);
                  if (j & 1) asm volatile("" ::: "memory"); }
#define RS_STEP(HB) { const bool up_ = (lane & (2 * (HB))) != 0; _Pragma("unroll") for (int i = 0; i < (HB); ++i) { const float send = up_ ? x[i] : x[i + (HB)], keep = up_ ? x[i + (HB)] : x[i]; x[i] = keep + __shfl_xor(send, 2 * (HB)); } }
          RS_STEP(16) RS_STEP(8) RS_STEP(4) RS_STEP(2) RS_STEP(1)
#undef RS_STEP
          const float z = x[0] + __shfl_xor(x[0], 1);
          float rb[NE];
#pragma unroll
          for (int e = 0; e < NE; ++e) rb[e] = ldgf(a.in[I_E_ROUTER_B] + f * NE + e);
#pragma unroll
          for (int k_ = 0; k_ < 4; ++k_) { const int lr = lr0 + k_ * NWAVES; if (lr < RPB) { const int row = bid * RPB + lr;
              float lg[NE];
#pragma unroll
              for (int e = 0; e < NE; ++e) lg[e] = __int_as_float(__builtin_amdgcn_readlane(__float_as_int(z), 2 * (k_ * 8 + e))) + rb[e];
              int e1 = 0; float v1 = lg[0];
#pragma unroll
              for (int e = 1; e < NE; ++e) if (lg[e] > v1) { v1 = lg[e]; e1 = e; }
              int e2 = -1; float v2 = -3.0e38f;
#pragma unroll
              for (int e = 0; e < NE; ++e) if (e != e1 && lg[e] > v2) { v2 = lg[e]; e2 = e; }
              const float p1 = 1.0f / (1.0f + __expf(v2 - v1)), p2 = 1.0f - p1;
              if (lane == 0) { sel[lr * 2] = e1; sel[lr * 2 + 1] = e2; stgf(TOPW + row * 2, p1); stgf(TOPW + row * 2 + 1, p2); } } }
      }
    }
    if (ROUTER) {
        __syncthreads();
        LAS int* wc = (LAS int*)(lds + 32768 + 3584);
        int mye = 0, myrank = 0;
        if (tid < RPB * 2) { mye = sel[tid];
#pragma unroll
            for (int q = 0; q < NE; ++q) { const unsigned long long m = __ballot(mye == q); if (mye == q) myrank = __popcll(m & ((1ull << lane) - 1ull)); if (lane == 0) wc[wave * NE + q] = __popcll(m); } }
        __syncthreads();
        if (tid < NE) { const int cnt = wc[tid] + wc[NE + tid];
            unsigned* gc = (unsigned*)(a.ws + WS_CTL) + CW_MOE + f * 1024 + tid * 64;
            bases[tid] = (int)__hip_atomic_fetch_add(gc, (unsigned)cnt, __ATOMIC_RELAXED, __HIP_MEMORY_SCOPE_AGENT); }
        __syncthreads();
        if (tid < RPB * 2) { const int e = mye, pos = bases[e] + myrank + (wave == 1 ? wc[e] : 0); stgi(TOPI + (size_t)bid * RPB * 2 + tid, (e << 16) | pos);
            stgi((int*)(a.ws + WS_LISTE) + e * T + pos, bid * RPB + (tid >> 1));
            if (OUTMODE == 3) dstl[tid] = e * T + pos; }
        __syncthreads();
        if (OUTMODE == 3) {
            unsigned char* AGX = a.ws + WS_AGX;
            for (int p = wave; p < RPB * 2; p += NWAVES) { const u32x4 x = *(const LAS u32x4*)(rows8 + (p >> 1) * D + lane * 16); stg16(AGX + (size_t)dstl[p] * D + lane * 16, x); }
            __syncthreads(); }
    }
}
__device__ __forceinline__ void ph_rg_gates(const Args& a, LAS unsigned char* lds, int bid, int nb, int jl) {
    const int tid = otid(), lane = tid & 63, wave = tid >> 6, fr = lane & 15, fq = lane >> 4;
    constexpr int AS_OFF = 0, BS_OFF = 17408, LA_OFF = 87040, BB_OFF = 87040 + 16384, XS_OFF = 87040 + 32768, RS = 272;
    const bf16* XR = (const bf16*)(a.ws + WS_XR); bf16* HL = (bf16*)(a.ws + WS_HL); bf16* AC = (bf16*)(a.ws + WS_AC);
    float* CSA = (float*)(a.ws + WS_CSA); float* CSH = (float*)(a.ws + WS_CSH);
    const int n = bid % RNB, rnk = bid / RNB, cnt = (nb - 1 - n) / RNB + 1;
    { const bf16* WG = (const bf16*)(a.ws + WS_WA_G) + ((size_t)jl * RNB + n) * 256 * RBD;
#pragma unroll
        for (int i = 0; i < 8; ++i) { const int idx = tid + NTHR * i, row = idx >> 4, c16 = idx & 15; *(LAS u32x4*)(lds + BS_OFF + row * RS + c16 * 16) = ldg16(WG + row * RBD + c16 * 8); } }
    const int r2 = tid >> 4, cg = tid & 15, ch0 = n * RBD + cg * 8;
    f32x2 cwv[4][4], cbv[4];
    { const float* cw = a.in[I_A_CONV_W] + (size_t)jl * 4 * RW; const float* cb = a.in[I_A_CONV_B] + (size_t)jl * RW;
#pragma unroll
      for (int k = 0; k < 4; ++k) { const f32x4 w0 = ldgf4(cw + (size_t)k * RW + ch0), w1 = ldgf4(cw + (size_t)k * RW + ch0 + 4); cwv[k][0] = (f32x2){w0[0], w0[1]}; cwv[k][1] = (f32x2){w0[2], w0[3]}; cwv[k][2] = (f32x2){w1[0], w1[1]}; cwv[k][3] = (f32x2){w1[2], w1[3]}; }
      const f32x4 b0 = ldgf4(cb + ch0), b1 = ldgf4(cb + ch0 + 4); cbv[0] = (f32x2){b0[0], b0[1]}; cbv[1] = (f32x2){b0[2], b0[3]}; cbv[2] = (f32x2){b1[0], b1[1]}; cbv[3] = (f32x2){b1[2], b1[3]}; }
    const int tg = wave & 3, half = wave >> 2;
    float brq[4], biq[4], spq[4];
#pragma unroll
    for (int q = 0; q < 4; ++q) { const int ch = n * RBD + 64 * half + 16 * q + fr; const float L2E = 1.4426950408889634f;
        brq[q] = L2E * ldgf(a.in[I_A_B_R] + (size_t)jl * RW + ch); biq[q] = L2E * ldgf(a.in[I_A_B_I] + (size_t)jl * RW + ch); spq[q] = 8.0f * L2E * softplus_f(-ldgf(a.in[I_A_LAM] + (size_t)jl * RW + ch)); }
    u32x4 xr_[5];
    int c = rnk;
#define RG_LOADX(cc) do { _Pragma("unroll") for (int k = 0; k < 5; ++k) { const int tk = (cc) * RCH + 2 * r2 - 3 + k; xr_[k] = (tk >= 0) ? ldg16(XR + (size_t)tk * RW + ch0) : (u32x4){0u, 0u, 0u, 0u}; } } while (0)
    if (c < RNC) RG_LOADX(c);
    for (; c < RNC; c += cnt) {
        __syncthreads();
        {
#pragma unroll
            for (int rr = 0; rr < 2; ++rr) { f32x2 acc[4];
#pragma unroll
                for (int j = 0; j < 4; ++j) acc[j] = cbv[j];
#pragma unroll
                for (int k = 0; k < 4; ++k) { const u32x4 x = xr_[rr + k];
                    acc[0] += cwv[k][0] * (f32x2){bflo(x.x), bfhi(x.x)}; acc[1] += cwv[k][1] * (f32x2){bflo(x.y), bfhi(x.y)};
                    acc[2] += cwv[k][2] * (f32x2){bflo(x.z), bfhi(x.z)}; acc[3] += cwv[k][3] * (f32x2){bflo(x.w), bfhi(x.w)}; }
                u32x4 w0; w0.x = cvt_pk_bf16(acc[0][0], acc[0][1]); w0.y = cvt_pk_bf16(acc[1][0], acc[1][1]); w0.z = cvt_pk_bf16(acc[2][0], acc[2][1]); w0.w = cvt_pk_bf16(acc[3][0], acc[3][1]);
                *(LAS u32x4*)(lds + AS_OFF + (2 * r2 + rr) * RS + cg * 16) = w0; }
        }
        { const int cn = c + cnt; if (cn < RNC) RG_LOADX(cn); }
        __syncthreads();
        f32x4 accr[4], acci[4];
#pragma unroll
        for (int q = 0; q < 4; ++q) { accr[q] = (f32x4){0.f, 0.f, 0.f, 0.f}; acci[q] = (f32x4){0.f, 0.f, 0.f, 0.f}; }
#pragma unroll
        for (int kk = 0; kk < 4; ++kk) { const bf16x8 af = *(const LAS bf16x8*)(lds + AS_OFF + (16 * tg + fr) * RS + (kk * 32 + 8 * fq) * 2);
#pragma unroll
            for (int q = 0; q < 4; ++q) { const bf16x8 br = *(const LAS bf16x8*)(lds + BS_OFF + (64 * half + 16 * q + fr) * RS + (kk * 32 + 8 * fq) * 2);
                const bf16x8 bi = *(const LAS bf16x8*)(lds + BS_OFF + (128 + 64 * half + 16 * q + fr) * RS + (kk * 32 + 8 * fq) * 2);
                accr[q] = __builtin_amdgcn_mfma_f32_16x16x32_bf16(af, br, accr[q], 0, 0, 0); acci[q] = __builtin_amdgcn_mfma_f32_16x16x32_bf16(af, bi, acci[q], 0, 0, 0); } }
#pragma unroll
        for (int q = 0; q < 4; ++q) { const int chl = 64 * half + 16 * q + fr;
#pragma unroll
            for (int pr_ = 0; pr_ < 2; ++pr_) { const int row = 16 * tg + 4 * fq + 2 * pr_;
                const f32x2 R2 = (f32x2){accr[q][2 * pr_], accr[q][2 * pr_ + 1]} + brq[q], I2 = (f32x2){acci[q][2 * pr_], acci[q][2 * pr_ + 1]} + biq[q];
                f32x2 eR, eI; eR[0] = __builtin_amdgcn_exp2f(-R2[0]); eR[1] = __builtin_amdgcn_exp2f(-R2[1]); eI[0] = __builtin_amdgcn_exp2f(-I2[0]); eI[1] = __builtin_amdgcn_exp2f(-I2[1]);
                const f32x2 dR = eR + 1.0f, dI = eI + 1.0f; f32x2 rr, ii; rr[0] = __builtin_amdgcn_rcpf(dR[0]); rr[1] = __builtin_amdgcn_rcpf(dR[1]); ii[0] = __builtin_amdgcn_rcpf(dI[0]); ii[1] = __builtin_amdgcn_rcpf(dI[1]);
                const f32x2 la = rr * spq[q]; f32x2 a_; a_[0] = __builtin_amdgcn_exp2f(-la[0]); a_[1] = __builtin_amdgcn_exp2f(-la[1]);
                f32x2 om = 1.0f - a_; om[0] = fmaxf(om[0], 0.f); om[1] = fmaxf(om[1], 0.f);
                const f32x2 t2 = om * (a_ + 1.0f); f32x2 sq; sq[0] = __builtin_amdgcn_sqrtf(t2[0]); sq[1] = __builtin_amdgcn_sqrtf(t2[1]);
                const f32x2 xr = (f32x2){bf2f(*(const LAS bf16*)(lds + AS_OFF + row * RS + chl * 2)), bf2f(*(const LAS bf16*)(lds + AS_OFF + (row + 1) * RS + chl * 2))};
                const f32x2 bb = (sq * ii) * xr;
                *(LAS bf16*)(lds + LA_OFF + (row * 128 + chl) * 2) = f2bf(om[0]); *(LAS bf16*)(lds + LA_OFF + ((row + 1) * 128 + chl) * 2) = f2bf(om[1]);
                *(LAS bf16*)(lds + BB_OFF + (row * 128 + chl) * 2) = f2bf(bb[0]); *(LAS bf16*)(lds + BB_OFF + ((row + 1) * 128 + chl) * 2) = f2bf(bb[1]); } }
        __syncthreads();
        { const int j = tid & 127, seg = tid >> 7, ch = n * RBD + j; float hl[16], pa[16]; float h = 0.f, pr = 1.f;
#pragma unroll
            for (int i = 0; i < 16; ++i) { const float om = bf2f(*(const LAS bf16*)(lds + LA_OFF + ((16 * seg + i) * 128 + j) * 2)), bb = bf2f(*(const LAS bf16*)(lds + BB_OFF + ((16 * seg + i) * 128 + j) * 2));
                const float ai = 1.0f - om; h = ai * h + bb; pr *= ai; hl[i] = h; pa[i] = pr; }
            LAS float* xs = (LAS float*)(lds + XS_OFF); xs[(seg * 128 + j) * 2] = pr; xs[(seg * 128 + j) * 2 + 1] = h;
            __syncthreads();
            float cin_h = 0.f, cin_a = 1.f;
#pragma unroll
            for (int s = 0; s < 3; ++s) if (s < seg) { const float sa = xs[(s * 128 + j) * 2], sh = xs[(s * 128 + j) * 2 + 1]; cin_h = sa * cin_h + sh; cin_a *= sa; }
#pragma unroll
            for (int i = 0; i < 16; ++i) { const float hf = hl[i] + pa[i] * cin_h, af = pa[i] * cin_a;
                *(LAS bf16*)(lds + LA_OFF + ((16 * seg + i) * 128 + j) * 2) = f2bf(hf); *(LAS bf16*)(lds + BB_OFF + ((16 * seg + i) * 128 + j) * 2) = f2bf(af);
                if (i == 15 && seg == 3) { stgf(CSA + (size_t)c * RW + ch, af); stgf(CSH + (size_t)c * RW + ch, hf); } } }
        __syncthreads();
#pragma unroll
        for (int i = 0; i < 2; ++i) { const int idx = tid + NTHR * i, row = idx >> 4, c16 = idx & 15; const size_t o = (size_t)(c * RCH + row) * RW + n * RBD + c16 * 8;
            stg16(HL + o, *(const LAS u32x4*)(lds + LA_OFF + row * 256 + c16 * 16)); stg16(AC + o, *(const LAS u32x4*)(lds + BB_OFF + row * 256 + c16 * 16)); }
    }
#undef RG_LOADX
    __syncthreads();
}
__device__ __forceinline__ void ph_rg_carry(const Args& a, int bid, int nb) {
    const int tid = otid(), lane = tid & 63, gw = bid * NWAVES + (tid >> 6), NGW = nb * NWAVES;
    const float* CSA = (const float*)(a.ws + WS_CSA); const float* CSH = (const float*)(a.ws + WS_CSH); float* CIN = (float*)(a.ws + WS_CIN);
    for (int ch = gw; ch < RW; ch += NGW) {
        float Ak[4], Hk[4]; float A = 1.f, H = 0.f;
#pragma unroll
        for (int k = 0; k < 4; ++k) { Ak[k] = ldgf(CSA + (size_t)(4 * lane + k) * RW + ch); Hk[k] = ldgf(CSH + (size_t)(4 * lane + k) * RW + ch); H = Ak[k] * H + Hk[k]; A = Ak[k] * A; }
#pragma unroll
        for (int off = 1; off < 64; off <<= 1) { const float Ay = __shfl_up(A, off), Hy = __shfl_up(H, off); if (lane >= off) { H = A * Hy + H; A = A * Ay; } }
        float h = __shfl_up(H, 1); if (lane == 0) h = 0.f;
#pragma unroll
        for (int k = 0; k < 4; ++k) { stgf(CIN + (size_t)(4 * lane + k) * RW + ch, h); h = Ak[k] * h + Hk[k]; }
    }
}
__device__ __forceinline__ void ph_rg_fix(const Args& a, int bid, int nb) {
    const int tid = otid(); bf16* GX = (bf16*)(a.ws + WS_GX); const bf16* HL = (const bf16*)(a.ws + WS_HL); const bf16* AC = (const bf16*)(a.ws + WS_AC); const float* CIN = (const float*)(a.ws + WS_CIN);
    const int total = T * (RW / 8);
    for (int it = bid * NTHR + tid; it < total; it += nb * NTHR) {
        const int t = it / (RW / 8), ch = (it % (RW / 8)) * 8, c = t / RCH; const size_t o = (size_t)t * RW + ch;
        const u32x4 g = ldg16(GX + o), hl = ldg16(HL + o), ac = ldg16(AC + o); const f32x4 c0 = ldgf4(CIN + (size_t)c * RW + ch), c1 = ldgf4(CIN + (size_t)c * RW + ch + 4);
        float y[8];
        y[0] = gelu_tanh(bflo(g.x)) * (bflo(hl.x) + bflo(ac.x) * c0[0]); y[1] = gelu_tanh(bfhi(g.x)) * (bfhi(hl.x) + bfhi(ac.x) * c0[1]);
        y[2] = gelu_tanh(bflo(g.y)) * (bflo(hl.y) + bflo(ac.y) * c0[2]); y[3] = gelu_tanh(bfhi(g.y)) * (bfhi(hl.y) + bfhi(ac.y) * c0[3]);
        y[4] = gelu_tanh(bflo(g.z)) * (bflo(hl.z) + bflo(ac.z) * c1[0]); y[5] = gelu_tanh(bfhi(g.z)) * (bfhi(hl.z) + bfhi(ac.z) * c1[1]);
        y[6] = gelu_tanh(bflo(g.w)) * (bflo(hl.w) + bflo(ac.w) * c1[2]); y[7] = gelu_tanh(bfhi(g.w)) * (bfhi(hl.w) + bfhi(ac.w) * c1[3]);
        u32x4 w; w.x = cvt_pk_bf16(y[0], y[1]); w.y = cvt_pk_bf16(y[2], y[3]); w.z = cvt_pk_bf16(y[4], y[5]); w.w = cvt_pk_bf16(y[6], y[7]);
        stg16(GX + o, w);
    }
}

__device__ __forceinline__ void ph_ml_prep(const Args& a, LAS unsigned char* lds, int bid, int nb) {
    const bf16* XM = (const bf16*)(a.ws + WS_XM); bf16* Q = (bf16*)(a.ws + WS_Q); bf16* Kb = (bf16*)(a.ws + WS_K); bf16* XC = (bf16*)(a.ws + WS_XC);
    float* GI = (float*)(a.ws + WS_GI); float* GF = (float*)(a.ws + WS_GF);
    LAS float* red = (LAS float*)(lds + EXTRA_OFF);
    const float kscale = 0.044194173824159216f;
    for (int tb = bid; tb < T / 64; tb += nb) {
        const int t0 = tb * 64;
        {
            const int tid = otid(), lane = tid & 63, wave = tid >> 6, n4 = tid * 4;
            f32x2 cw[4][2], cb[2], wq[4][2], wk[4][2], wv[4][2], gqk[4][4], gv[4][4];
#pragma unroll
            for (int k = 0; k < 4; ++k) { const f32x4 v = ldgf4(a.in[I_B_CONV_W] + k * MI + n4); cw[k][0] = (f32x2){v[0], v[1]}; cw[k][1] = (f32x2){v[2], v[3]}; }
            { const f32x4 v = ldgf4(a.in[I_B_CONV_B] + n4); cb[0] = (f32x2){v[0], v[1]}; cb[1] = (f32x2){v[2], v[3]}; }
#pragma unroll
            for (int i = 0; i < 4; ++i) { const f32x4 q_ = ldgf4(a.in[I_B_W_Q] + tid * 16 + i * 4), k_ = ldgf4(a.in[I_B_W_K] + tid * 16 + i * 4), v_ = ldgf4(a.in[I_B_W_V] + tid * 16 + i * 4);
                wq[i][0] = (f32x2){q_[0], q_[1]}; wq[i][1] = (f32x2){q_[2], q_[3]}; wk[i][0] = (f32x2){k_[0], k_[1]}; wk[i][1] = (f32x2){k_[2], k_[3]}; wv[i][0] = (f32x2){v_[0], v_[1]}; wv[i][1] = (f32x2){v_[2], v_[3]}; }
#pragma unroll
            for (int i = 0; i < 4; ++i)
#pragma unroll
                for (int e = 0; e < 4; ++e) { gqk[i][e] = (f32x2){0.f, 0.f}; gv[i][e] = (f32x2){0.f, 0.f}; }
#pragma unroll
            for (int j = 0; j < 4; ++j) { const float* pwg = a.in[I_B_W_GATE];
                const f32x4 a0 = ldgf4(pwg + (size_t)(0 * MI + n4 + j) * 8), a1 = ldgf4(pwg + (size_t)(0 * MI + n4 + j) * 8 + 4);
                const f32x4 b0 = ldgf4(pwg + (size_t)(1 * MI + n4 + j) * 8), b1 = ldgf4(pwg + (size_t)(1 * MI + n4 + j) * 8 + 4);
                const f32x4 c0 = ldgf4(pwg + (size_t)(2 * MI + n4 + j) * 8), c1 = ldgf4(pwg + (size_t)(2 * MI + n4 + j) * 8 + 4);
                const f32x2 ga[4] = {(f32x2){a0[0], a0[1]}, (f32x2){a0[2], a0[3]}, (f32x2){a1[0], a1[1]}, (f32x2){a1[2], a1[3]}};
                const f32x2 gb[4] = {(f32x2){b0[0], b0[1]}, (f32x2){b0[2], b0[3]}, (f32x2){b1[0], b1[1]}, (f32x2){b1[2], b1[3]}};
                const f32x2 gc[4] = {(f32x2){c0[0], c0[1]}, (f32x2){c0[2], c0[3]}, (f32x2){c1[0], c1[1]}, (f32x2){c1[2], c1[3]}};
#pragma unroll
                for (int i = 0; i < 4; ++i) { const float wq_ = wq[i][j >> 1][j & 1], wk_ = wk[i][j >> 1][j & 1], wv_ = wv[i][j >> 1][j & 1];
#pragma unroll
                    for (int e = 0; e < 4; ++e) { gqk[i][e] += ga[e] * wq_ + gb[e] * wk_; gv[i][e] += gc[e] * wv_; } } }
            f32x2 x0[2], x1[2], x2[2], x3[2];
#pragma unroll
            for (int p = 0; p < 2; ++p) { x0[p] = (f32x2){0.f, 0.f}; x1[p] = x0[p]; x2[p] = x0[p]; }
            if (t0 > 0) { const u32x2 p0 = ldg8(XM + (size_t)(t0 - 3) * MI + n4), p1 = ldg8(XM + (size_t)(t0 - 2) * MI + n4), p2 = ldg8(XM + (size_t)(t0 - 1) * MI + n4);
                x0[0] = (f32x2){bflo(p0.x), bfhi(p0.x)}; x0[1] = (f32x2){bflo(p0.y), bfhi(p0.y)}; x1[0] = (f32x2){bflo(p1.x), bfhi(p1.x)}; x1[1] = (f32x2){bflo(p1.y), bfhi(p1.y)};
                x2[0] = (f32x2){bflo(p2.x), bfhi(p2.x)}; x2[1] = (f32x2){bflo(p2.y), bfhi(p2.y)}; }
            u32x2 xs[8], xn[8];
#pragma unroll
            for (int b = 0; b < 8; ++b) xs[b] = ldg8(XM + (size_t)(t0 + b) * MI + n4);
#pragma unroll 1
            for (int tl0 = 0; tl0 < 64; tl0 += 8) {
              { const int tn = (tl0 + 8 < 64) ? tl0 + 8 : tl0;
#pragma unroll
                for (int b = 0; b < 8; ++b) xn[b] = ldg8(XM + (size_t)(t0 + tn + b) * MI + n4); }
#pragma unroll 1
              for (int b = 0; b < 8; ++b) {
                const int tl = tl0 + b, t = t0 + tl;
                { const u32x2 p3 = xs[0];
#pragma unroll
                  for (int q = 0; q < 7; ++q) xs[q] = xs[q + 1];
                  x3[0] = (f32x2){bflo(p3.x), bfhi(p3.x)}; x3[1] = (f32x2){bflo(p3.y), bfhi(p3.y)}; }
                float xc[4]; f32x2 q2[2], k2[2], v2[2];
#pragma unroll
                for (int p = 0; p < 2; ++p) { const f32x2 cv = cb[p] + cw[0][p] * x0[p] + cw[1][p] * x1[p] + cw[2][p] * x2[p] + cw[3][p] * x3[p]; xc[2 * p] = silu_f(cv[0]); xc[2 * p + 1] = silu_f(cv[1]); }
                const float xm[4] = {x3[0][0], x3[0][1], x3[1][0], x3[1][1]};
#pragma unroll
                for (int p = 0; p < 2; ++p) { q2[p] = wq[0][p] * xc[0] + wq[1][p] * xc[1] + wq[2][p] * xc[2] + wq[3][p] * xc[3]; k2[p] = wk[0][p] * xc[0] + wk[1][p] * xc[1] + wk[2][p] * xc[2] + wk[3][p] * xc[3];
                    v2[p] = wv[0][p] * xm[0] + wv[1][p] * xm[1] + wv[2][p] * xm[2] + wv[3][p] * xm[3]; }
                { u32x2 w; w.x = cvt_pk_bf16(q2[0][0], q2[0][1]); w.y = cvt_pk_bf16(q2[1][0], q2[1][1]); stg8(Q + (size_t)t * MI + n4, w);
                  w.x = cvt_pk_bf16(k2[0][0] * kscale, k2[0][1] * kscale); w.y = cvt_pk_bf16(k2[1][0] * kscale, k2[1][1] * kscale); stg8(Kb + (size_t)t * MI + n4, w);
                  w.x = cvt_pk_bf16(xc[0], xc[1]); w.y = cvt_pk_bf16(xc[2], xc[3]); stg8(XC + (size_t)t * MI + n4, w);
                  (void)v2; }
                f32x2 g2[4];
#pragma unroll
                for (int e = 0; e < 4; ++e) g2[e] = gqk[0][e] * xc[0] + gqk[1][e] * xc[1] + gqk[2][e] * xc[2] + gqk[3][e] * xc[3] + gv[0][e] * xm[0] + gv[1][e] * xm[1] + gv[2][e] * xm[2] + gv[3][e] * xm[3];
                const float g[8] = {g2[0][0], g2[0][1], g2[1][0], g2[1][1], g2[2][0], g2[2][1], g2[3][0], g2[3][1]};
                { const bool h5 = (lane & 32) != 0; float k4[4];
#pragma unroll
                  for (int e = 0; e < 4; ++e) { const float snd = h5 ? g[e] : g[4 + e], kp = h5 ? g[4 + e] : g[e]; k4[e] = kp + __shfl_xor(snd, 32); }
                  const bool h4 = (lane & 16) != 0; float k2_[2];
#pragma unroll
                  for (int e = 0; e < 2; ++e) { const float snd = h4 ? k4[e] : k4[2 + e], kp = h4 ? k4[2 + e] : k4[e]; k2_[e] = kp + __shfl_xor(snd, 16); }
                  const bool h3 = (lane & 8) != 0; const float snd = h3 ? k2_[0] : k2_[1], kp = h3 ? k2_[1] : k2_[0]; float k1 = kp + __shfl_xor(snd, 8);
                  k1 += __shfl_xor(k1, 4); k1 += __shfl_xor(k1, 2); k1 += __shfl_xor(k1, 1);
                  if ((lane & 7) == 0) red[(tl * 8 + wave) * 8 + (lane >> 3)] = k1; }
#pragma unroll
                for (int p = 0; p < 2; ++p) { x0[p] = x1[p]; x1[p] = x2[p]; x2[p] = x3[p]; }
              }
#pragma unroll
              for (int b = 0; b < 8; ++b) xs[b] = xn[b];
            }
        }
        __syncthreads();
        { const int tid = otid(), tok = tid >> 3, e = tid & 7; float s = ldgf(a.in[I_B_B_GATE] + e);
#pragma unroll
            for (int w = 0; w < 8; ++w) s += red[(tok * 8 + w) * 8 + e];
            if (e < 4) stgf(GI + (size_t)e * T + t0 + tok, s); else stgf(GF + (size_t)(e - 4) * T + t0 + tok, -softplus_f(-s)); }
        __syncthreads();
    }
}
__device__ __forceinline__ void ph_ml_gscan(const Args& a, LAS unsigned char* lds, int bid, int nb) {
    const int tid = otid(), lane = tid & 63, wave = tid >> 6;
    const float* GI = (const float*)(a.ws + WS_GI); const float* GF = (const float*)(a.ws + WS_GF);
    float* GS = (float*)(a.ws + WS_GS); float* RMT = (float*)(a.ws + WS_RMT); float* EF = (float*)(a.ws + WS_EF); float* MC = (float*)(a.ws + WS_MC);
    LAS float* wt = (LAS float*)lds;
    for (int h = bid; h < MH; h += nb) {
        __syncthreads();
        float lf[32], ig[32]; float s = 0.f;
#pragma unroll
        for (int q = 0; q < 8; ++q) { const f32x4 v = ldgf4(GF + (size_t)h * T + tid * 32 + 4 * q), w = ldgf4(GI + (size_t)h * T + tid * 32 + 4 * q);
            lf[4 * q] = v[0]; lf[4 * q + 1] = v[1]; lf[4 * q + 2] = v[2]; lf[4 * q + 3] = v[3]; ig[4 * q] = w[0]; ig[4 * q + 1] = w[1]; ig[4 * q + 2] = w[2]; ig[4 * q + 3] = w[3]; }
#pragma unroll
        for (int i = 0; i < 32; ++i) s += lf[i];
        float inc = s;
#pragma unroll
        for (int off = 1; off < 64; off <<= 1) { const float y = __shfl_up(inc, off); if (lane >= off) inc += y; }
        if (lane == 63) wt[wave] = inc;
        __syncthreads();
        float base = inc - s;
#pragma unroll
        for (int w = 0; w < 8; ++w) if (w < wave) base += wt[w];
        float F = base, lmax = -3.0e38f;
#pragma unroll
        for (int i = 0; i < 32; ++i) { F += lf[i]; lf[i] = F; ig[i] = ig[i] - F; lmax = fmaxf(lmax, ig[i]); }
        float minc = lmax;
#pragma unroll
        for (int off = 1; off < 64; off <<= 1) { const float y = __shfl_up(minc, off); if (lane >= off) minc = fmaxf(minc, y); }
        __syncthreads();
        if (lane == 63) wt[8 + wave] = minc;
        __syncthreads();
        float pm = __shfl_up(minc, 1); if (lane == 0) pm = -3.0e38f;
#pragma unroll
        for (int w = 0; w < 8; ++w) if (w < wave) pm = fmaxf(pm, wt[8 + w]);
        float rm = fmaxf(pm, 0.f);
#pragma unroll
        for (int i = 0; i < 32; ++i) { rm = fmaxf(rm, ig[i]); const size_t o = (size_t)h * T + tid * 32 + i; stgf(GS + o, ig[i]); stgf(RMT + o, rm); stgf(EF + o, __expf(-lf[i] - rm)); }
        if ((tid & 7) == 7) stgf(MC + h * 80 + (tid + 1) / 8, rm);
        if (tid == 0) stgf(MC + h * 80, 0.f);
    }
    __syncthreads();
}
__device__ __forceinline__ void ph_ml_ktw(const Args& a, LAS unsigned char* lds, int bid, int nb) {
    const bf16* Kn = (const bf16*)(a.ws + WS_K); const bf16* Xm = (const bf16*)(a.ws + WS_XM); bf16* KT = (bf16*)(a.ws + WS_KT); bf16* VT = (bf16*)(a.ws + WS_VT);
    const float* GS = (const float*)(a.ws + WS_GS); const float* MC = (const float*)(a.ws + WS_MC); float* NS = (float*)(a.ws + WS_NS);
    LAS float* w = (LAS float*)(lds + EXTRA_OFF); constexpr int TS = 144;
    for (int u = bid; u < MNC * MH; u += nb) { const int c = u / MH, h = u % MH; const int tid = otid(), lane = tid & 63, wave = tid >> 6;
        LAS unsigned char* tile = lds + wave * 16384;
        __syncthreads();
        if (tid < MCH) w[tid] = __expf(ldgf(GS + (size_t)h * T + c * MCH + tid) - ldgf(MC + h * 80 + c + 1));
        __syncthreads();
        const int ch0 = h * HD + wave * 64, rr = lane >> 3, c8 = lane & 7;
        f32x2 wvv[2][4][2];
#pragma unroll
        for (int bk = 0; bk < 2; ++bk)
#pragma unroll
            for (int i = 0; i < 4; ++i) { const f32x4 wr = ldgf4(a.in[I_B_W_V] + (size_t)((ch0 + c8 * 8) / 4 + bk) * 16 + i * 4); wvv[bk][i][0] = (f32x2){wr[0], wr[1]}; wvv[bk][i][1] = (f32x2){wr[2], wr[3]}; }
        float psum[8];
#pragma unroll
        for (int i = 0; i < 8; ++i) psum[i] = 0.f;
#pragma unroll 1
        for (int pass = 0; pass < 8; ++pass) { const int isv = pass >> 2, tg = pass & 3; const bf16* src = (isv ? Xm : Kn) + (size_t)(c * MCH + tg * 64) * MI + ch0; bf16* dst = (isv ? VT : KT) + ((size_t)u * HD + wave * 64) * MCH + tg * 64;
            u32x4 x[8];
#pragma unroll
            for (int i = 0; i < 8; ++i) x[i] = ldg16(src + (size_t)(rr + 8 * i) * MI + c8 * 8);
            if (isv) {
#pragma unroll
                for (int i = 0; i < 8; ++i) { const u32x4 xx = x[i]; const float xa[4] = {bflo(xx.x), bfhi(xx.x), bflo(xx.y), bfhi(xx.y)}, xb[4] = {bflo(xx.z), bfhi(xx.z), bflo(xx.w), bfhi(xx.w)};
                    const f32x2 va0 = wvv[0][0][0] * xa[0] + wvv[0][1][0] * xa[1] + wvv[0][2][0] * xa[2] + wvv[0][3][0] * xa[3], va1 = wvv[0][0][1] * xa[0] + wvv[0][1][1] * xa[1] + wvv[0][2][1] * xa[2] + wvv[0][3][1] * xa[3];
                    const f32x2 vb0 = wvv[1][0][0] * xb[0] + wvv[1][1][0] * xb[1] + wvv[1][2][0] * xb[2] + wvv[1][3][0] * xb[3], vb1 = wvv[1][0][1] * xb[0] + wvv[1][1][1] * xb[1] + wvv[1][2][1] * xb[2] + wvv[1][3][1] * xb[3];
                    u32x4 o; o.x = cvt_pk_bf16(va0[0], va0[1]); o.y = cvt_pk_bf16(va1[0], va1[1]); o.z = cvt_pk_bf16(vb0[0], vb0[1]); o.w = cvt_pk_bf16(vb1[0], vb1[1]); x[i] = o; } }
#pragma unroll
            for (int i = 0; i < 8; ++i) *(LAS u32x4*)(tile + (rr + 8 * i) * TS + c8 * 16) = x[i];
            LDS_WAIT(); asm volatile("" ::: "memory");
#pragma unroll
            for (int i = 0; i < 8; ++i) { const int d = rr + 8 * i; const LAS bf16* tp = (const LAS bf16*)(tile + (c8 * 8) * TS) + d; float v[8];
#pragma unroll
                for (int q = 0; q < 8; ++q) v[q] = bf2f(tp[q * (TS / 2)]);
                if (!isv) { const LAS float* wp = w + tg * 64 + c8 * 8;
#pragma unroll
                    for (int q = 0; q < 8; ++q) v[q] *= wp[q]; }
                u32x4 o; o.x = cvt_pk_bf16(v[0], v[1]); o.y = cvt_pk_bf16(v[2], v[3]); o.z = cvt_pk_bf16(v[4], v[5]); o.w = cvt_pk_bf16(v[6], v[7]);
                if (!isv) psum[i] += (bflo(o.x) + bfhi(o.x)) + (bflo(o.y) + bfhi(o.y)) + (bflo(o.z) + bfhi(o.z)) + (bflo(o.w) + bfhi(o.w));
                stg16(dst + (size_t)d * MCH + c8 * 8, o); }
            LDS_WAIT(); asm volatile("" ::: "memory");
        }
#pragma unroll
        for (int i = 0; i < 8; ++i) { float ps = psum[i]; ps += __shfl_xor(ps, 1); ps += __shfl_xor(ps, 2); ps += __shfl_xor(ps, 4); if (c8 == 0) stgf(NS + (size_t)u * HD + wave * 64 + rr + 8 * i, ps); }
    }
    asm volatile("s_waitcnt vmcnt(0)" ::: "memory");
    __syncthreads();
}
__device__ __forceinline__ void ph_ml_sscan(const Args& a, int bid, int nb) {
    bf16* CT = (bf16*)(a.ws + WS_CT); float* NS = (float*)(a.ws + WS_NS); const float* MC = (const float*)(a.ws + WS_MC);
    { const int tid = otid(), lane = tid & 63, gw = bid * NWAVES + (tid >> 6), NGW = nb * NWAVES;
      static_assert(MNC == 64, "one lane per chunk");
      for (int it = gw; it < MH * HD; it += NGW) { const int h = it / HD, d = it % HD; float* q = NS + ((size_t)lane * MH + h) * HD + d;
          float H = ldgf(q), A = __expf(ldgf(MC + h * 80 + lane) - ldgf(MC + h * 80 + lane + 1));
#pragma unroll
          for (int off = 1; off < 64; off <<= 1) { const float Ay = __shfl_up(A, off), Hy = __shfl_up(H, off); if (lane >= off) { H = A * Hy + H; A = A * Ay; } }
          float o = __shfl_up(H, 1); if (lane == 0) o = 0.f; stgf(q, o); } }
    for (int it = bid * NTHR + otid(); it < MH * HD * (HD / 8); it += nb * NTHR) {
        const int h = it / (HD * (HD / 8)), rem = it % (HD * (HD / 8)); bf16* p = CT + (size_t)h * HD * HD + (size_t)rem * 8; const size_t cs = (size_t)MH * HD * HD;
        float run[8];
#pragma unroll
        for (int j = 0; j < 8; ++j) run[j] = 0.f;
        u32x4 sv[8], sn[8];
#pragma unroll
        for (int q = 0; q < 8; ++q) sv[q] = ldg16(p + (size_t)q * cs);
        for (int c0 = 0; c0 < MNC; c0 += 8) {
            float dec[8]; const int cn = (c0 + 8 < MNC) ? c0 + 8 : c0;
#pragma unroll
            for (int q = 0; q < 8; ++q) { sn[q] = ldg16(p + (size_t)(cn + q) * cs); dec[q] = __expf(ldgf(MC + h * 80 + c0 + q) - ldgf(MC + h * 80 + c0 + q + 1)); }
#pragma unroll
            for (int q = 0; q < 8; ++q) { u32x4 o; o.x = cvt_pk_bf16(run[0], run[1]); o.y = cvt_pk_bf16(run[2], run[3]); o.z = cvt_pk_bf16(run[4], run[5]); o.w = cvt_pk_bf16(run[6], run[7]);
                stg16(p + (size_t)(c0 + q) * cs, o);
                run[0] = dec[q] * run[0] + bflo(sv[q].x); run[1] = dec[q] * run[1] + bfhi(sv[q].x); run[2] = dec[q] * run[2] + bflo(sv[q].y); run[3] = dec[q] * run[3] + bfhi(sv[q].y);
                run[4] = dec[q] * run[4] + bflo(sv[q].z); run[5] = dec[q] * run[5] + bfhi(sv[q].z); run[6] = dec[q] * run[6] + bflo(sv[q].w); run[7] = dec[q] * run[7] + bfhi(sv[q].w); }
#pragma unroll
            for (int q = 0; q < 8; ++q) sv[q] = sn[q];
        }
    }
}
struct FinIn { u32x4 nu, qv, zv, xv; f32x4 n0, n1, dp, g0, g1, k0, k1; float mc, rmt, ef; };
__device__ __forceinline__ FinIn fin_load(const Args& a, int it, int e0) {
    const bf16* NUM = (const bf16*)(a.ws + WS_NUM); const bf16* Q = (const bf16*)(a.ws + WS_Q); const bf16* Z = (const bf16*)(a.ws + WS_Z); const bf16* XC = (const bf16*)(a.ws + WS_XC);
    const float* NS = (const float*)(a.ws + WS_NS); const float* DENP = (const float*)(a.ws + WS_DENP); const float* MC = (const float*)(a.ws + WS_MC); const float* RMT = (const float*)(a.ws + WS_RMT); const float* EF = (const float*)(a.ws + WS_EF);
    const int t = it >> 2, h = it & 3, c = t >> 8, r = t & 255; const size_t o = (size_t)t * MI + h * HD + e0, cth = (size_t)(c * MH + h);
    FinIn f; f.nu = ldg16(NUM + o); f.qv = ldg16(Q + o); f.zv = ldg16(Z + o); f.xv = ldg16(XC + o);
    f.n0 = ldgf4(NS + cth * HD + e0); f.n1 = ldgf4(NS + cth * HD + e0 + 4); f.dp = ldgf4(DENP + (cth * MCH + r) * 4);
    f.g0 = ldgf4(a.in[I_B_NORM] + h * HD + e0); f.g1 = ldgf4(a.in[I_B_NORM] + h * HD + e0 + 4); f.k0 = ldgf4(a.in[I_B_SKIP] + h * HD + e0); f.k1 = ldgf4(a.in[I_B_SKIP] + h * HD + e0 + 4);
    f.mc = ldgf(MC + h * 80 + c); f.rmt = ldgf(RMT + (size_t)h * T + t); f.ef = ldgf(EF + (size_t)h * T + t); return f;
}
__device__ __forceinline__ void fin_compute(const Args& a, int it, int e0, const FinIn& f) {
    bf16* Y = (bf16*)(a.ws + WS_Y); const int t = it >> 2, h = it & 3; const size_t o = (size_t)t * MI + h * HD + e0;
    const u32x4 nu = f.nu, qv = f.qv, zv = f.zv, xv = f.xv;
    const f32x2 num[4] = {(f32x2){bflo(nu.x), bfhi(nu.x)}, (f32x2){bflo(nu.y), bfhi(nu.y)}, (f32x2){bflo(nu.z), bfhi(nu.z)}, (f32x2){bflo(nu.w), bfhi(nu.w)}};
    const f32x2 qq[4] = {(f32x2){bflo(qv.x), bfhi(qv.x)}, (f32x2){bflo(qv.y), bfhi(qv.y)}, (f32x2){bflo(qv.z), bfhi(qv.z)}, (f32x2){bflo(qv.w), bfhi(qv.w)}};
    const f32x2 nn[4] = {(f32x2){f.n0[0], f.n0[1]}, (f32x2){f.n0[2], f.n0[3]}, (f32x2){f.n1[0], f.n1[1]}, (f32x2){f.n1[2], f.n1[3]}};
    const f32x2 qn2 = (qq[0] * nn[0] + qq[1] * nn[1]) + (qq[2] * nn[2] + qq[3] * nn[3]);
    const float qn = wave_sum(qn2[0] + qn2[1]);
    const float rs = __expf(f.mc - f.rmt), den = rs * ((f.dp[0] + f.dp[1]) + (f.dp[2] + f.dp[3]) + qn);
    const float inv = __builtin_amdgcn_rcpf(fmaxf(fabsf(den), f.ef));
    f32x2 hc[4], s2 = (f32x2){0.f, 0.f};
#pragma unroll
    for (int i = 0; i < 4; ++i) { hc[i] = num[i] * inv; s2 += hc[i] * hc[i]; }
    const float rstd = __builtin_amdgcn_rsqf(wave_sum(s2[0] + s2[1]) * (1.0f / HD) + EPS);
    const f32x2 gg[4] = {(f32x2){f.g0[0], f.g0[1]}, (f32x2){f.g0[2], f.g0[3]}, (f32x2){f.g1[0], f.g1[1]}, (f32x2){f.g1[2], f.g1[3]}};
    const f32x2 sk[4] = {(f32x2){f.k0[0], f.k0[1]}, (f32x2){f.k0[2], f.k0[3]}, (f32x2){f.k1[0], f.k1[1]}, (f32x2){f.k1[2], f.k1[3]}};
    const f32x2 zz[4] = {(f32x2){bflo(zv.x), bfhi(zv.x)}, (f32x2){bflo(zv.y), bfhi(zv.y)}, (f32x2){bflo(zv.z), bfhi(zv.z)}, (f32x2){bflo(zv.w), bfhi(zv.w)}};
    const f32x2 xx[4] = {(f32x2){bflo(xv.x), bfhi(xv.x)}, (f32x2){bflo(xv.y), bfhi(xv.y)}, (f32x2){bflo(xv.z), bfhi(xv.z)}, (f32x2){bflo(xv.w), bfhi(xv.w)}};
    f32x2 y[4];
#pragma unroll
    for (int i = 0; i < 4; ++i) { const f32x2 zl = zz[i] * -1.4426950408889634f; f32x2 e; e[0] = __builtin_amdgcn_exp2f(zl[0]); e[1] = __builtin_amdgcn_exp2f(zl[1]);
        const f32x2 d = e + 1.0f; f32x2 sg; sg[0] = __builtin_amdgcn_rcpf(d[0]); sg[1] = __builtin_amdgcn_rcpf(d[1]);
        y[i] = sg * ((hc[i] * rstd) * gg[i] + sk[i] * xx[i]); }
    u32x4 w; w.x = cvt_pk_bf16(y[0][0], y[0][1]); w.y = cvt_pk_bf16(y[1][0], y[1][1]); w.z = cvt_pk_bf16(y[2][0], y[2][1]); w.w = cvt_pk_bf16(y[3][0], y[3][1]);
    stg16(Y + o, w);
}
__device__ __forceinline__ void ph_ml_fin(const Args& a, int bid, int nb) {
    const int tid = otid(), lane = tid & 63, wave = tid >> 6, e0 = 8 * lane;
    asm volatile("s_waitcnt vmcnt(0)" ::: "memory"); __syncthreads();
    for (int p = bid; p < MNC * MH; p += nb) { const int ch = p / MH, h = p % MH;
        for (int r = wave; r < MCH; r += 4 * NWAVES) { const int i0 = ((ch * MCH + r) << 2) + h, st = NWAVES << 2;
            const FinIn f0 = fin_load(a, i0, e0), f1 = fin_load(a, i0 + st, e0), f2 = fin_load(a, i0 + 2 * st, e0), f3 = fin_load(a, i0 + 3 * st, e0);
            fin_compute(a, i0, e0, f0); fin_compute(a, i0 + st, e0, f1); fin_compute(a, i0 + 2 * st, e0, f2); fin_compute(a, i0 + 3 * st, e0, f3); } }
}

__device__ __forceinline__ void ph_s5_scan(const Args& a, LAS unsigned char* lds, int bid, int nb) {
    const int tid = otid(), pl = tid & 15, seg = tid >> 4;
    const float* EB = (const float*)(a.ws + WS_EB); bf16* UP = (bf16*)(a.ws + WS_UP); LAS float* tot = (LAS float*)lds;
    for (int u = bid; u < NG * 4; u += nb) {
        const int g = u >> 2, p = 16 * (u & 3) + pl;
        const float are = ldgf(a.in[I_C_A_RE] + g * 64 + p), aim = ldgf(a.in[I_C_A_IM] + g * 64 + p), dl = __expf(ldgf(a.in[I_C_LOG_STEP] + g));
        float lr, li; { const float mag = __expf(dl * are); float sn, cs; sincosf(dl * aim, &sn, &cs); lr = mag * cs; li = mag * sn; }
#pragma unroll
        for (int q = 0; q < 4; ++q) { const float nr = lr * lr - li * li, ni = 2.f * lr * li; lr = nr; li = ni; }
        float sr = lr, si = li;
#pragma unroll
        for (int q = 0; q < 5; ++q) { const float nr = sr * sr - si * si, ni = 2.f * sr * si; sr = nr; si = ni; }
        const float* eb = EB + ((size_t)g * SNC + seg * 32) * 128 + p;
        float str = 0.f, sti = 0.f;
#pragma unroll 8
        for (int c = 0; c < 32; ++c) { const float er = ldgf(eb + (size_t)c * 128), ei = ldgf(eb + (size_t)c * 128 + 64); const float nr = lr * str - li * sti + er, ni = lr * sti + li * str + ei; str = nr; sti = ni; }
        __syncthreads();
        tot[(seg * 16 + pl) * 2] = str; tot[(seg * 16 + pl) * 2 + 1] = sti;
        __syncthreads();
        float cr = 0.f, ci = 0.f;
        for (int s = 0; s < seg; ++s) { const float tr = tot[(s * 16 + pl) * 2], ti = tot[(s * 16 + pl) * 2 + 1]; const float nr = sr * cr - si * ci + tr, ni = sr * ci + si * cr + ti; cr = nr; ci = ni; }
        bf16* up = UP + ((size_t)g * SNC + seg * 32) * SK + 256 + p;
        str = cr; sti = ci;
#pragma unroll 8
        for (int c = 0; c < 32; ++c) { stgh(up + (size_t)c * SK, f2bf(str)); stgh(up + (size_t)c * SK + 64, f2bf(sti));
            const float er = ldgf(eb + (size_t)c * 128), ei = ldgf(eb + (size_t)c * 128 + 64); const float nr = lr * str - li * sti + er, ni = lr * sti + li * str + ei; str = nr; sti = ni; }
    }
    __syncthreads();
}
#ifndef MK_PER_PHASE
#define MK_PER_PHASE 0
#endif
constexpr int NPHASES = 38 - 4 * DEFER_NORM;
__global__ void __launch_bounds__(NTHR, 2) mega_fwd(Args args0) {
    extern __shared__ __attribute__((aligned(16))) unsigned char lds_raw[];
    LAS unsigned char* lds = (LAS unsigned char*)lds_raw;
    const int tid = threadIdx.x, bid0 = blockIdx.x, nb0 = gridDim.x;
    if (tid < 16) ((LAS unsigned*)(lds + MISC_OFF))[tid] = 0u;
    __syncthreads();
    XcdBarrier bar = xcd_barrier_post((unsigned*)(args0.ws + WS_CTL) + CW_BAR + args0.li * 4096, (volatile LAS unsigned*)(lds + MISC_OFF));
    int pc = 0; const int lo = args0.ph_lo, hi = args0.ph_hi;
#ifndef PH_REP
#define PH_REP 0ull
#endif
#ifndef PH_REPN
#define PH_REPN 1
#endif
#ifndef XBAR_EXTRA
#define XBAR_EXTRA 0
#endif
#ifndef PH_MASK
#define PH_MASK 0xFFFFFFFFull
#endif
#ifdef PROBE_LO
    long long tacc_ = 0;
#define PROBE_T0 if (pc >= PROBE_LO && pc < PROBE_HI) tacc_ -= (long long)__builtin_amdgcn_s_memrealtime();
#define PROBE_T1 if (pc >= PROBE_LO && pc < PROBE_HI) tacc_ += (long long)__builtin_amdgcn_s_memrealtime();
#else
#define PROBE_T0
#define PROBE_T1
#endif
#define PHASE(id, ...) do { if (((PH_MASK >> (id)) & 1ull) && pc >= lo && pc < hi) { PROBE_T0 { int bid = bid0, nb = nb0; unsigned char* ws = args0.ws; asm volatile("" : "+s"(bid), "+s"(nb), "+s"(ws)); Args args = args0; args.ws = ws; const int tidl = otid(), lane = tidl & 63, wave = tidl >> 6; const int gw = bid * NWAVES + wave, NGW = nb * NWAVES; bf16* HN = (bf16*)(ws + WS_HN); LAS float* scr = (LAS float*)(lds + wave * 16384); for (int rep_ = 0; rep_ < 1 + (int)((PH_REP >> (id)) & 1ull) * PH_REPN; ++rep_) { __VA_ARGS__; __syncthreads(); } } if (pc + 1 < hi) xcd_barrier(bar); PROBE_T1 } ++pc; } while (0)


#define XSRC(l) ((l) == 0 ? args.in[I_X] : (const float*)args.out)
#define GMIX(l) (args.in[I_NORM_MIX] + (l) * D)
#define GFFN(l) (args.in[I_NORM_FFN] + (l) * D)
#define DQ_TAIL(nun_, TL, TH, q_) do { if ((TL) >= 0) { const int nu__ = (nun_); const int mine_ = bid < nu__ ? (nu__ - 1 - bid) / nb + 1 : 0, mx_ = (nu__ - 1) / nb + 1; \
        if (mine_ < mx_) dq_work(args, (TL), (TH), (q_) * (mx_ - mine_), lds, scr); } } while (0)
#define DQ_DRAIN(G) do { if ((G) >= 0) { dq_work(args, (G), (G), -1, lds, scr); __syncthreads(); } } while (0)
#define RG_MIXER(l, jl, CONVF, TL, TH, RSI, EM, DR)   \
    PHASE(3, { if (RG_F8(jl)) { Sched2D S{(const char*)HN, (const char*)(ws + WS_WA_IN) + (size_t)(jl) * 2 * RW * D * 2, (unsigned)D / 2, (unsigned)D / 2, T / 256, 2 * RW / 256, nb, bid}; \
               pg8::Shape sh{D / 128, 0, (unsigned)D / 2, (unsigned)D / 2, 0u, 0u}; EpiBf16T<(RSI) != 0> E{(bf16*)(ws + WS_GX), RW, RW, (WS_XR - WS_GX) / 2, 0, 1.0f / 64.0f, (const float*)(ws + WS_RSS)}; \
               pg8::gemm_phase<EpiBf16T<(RSI) != 0>, Sched2D, false, false, true>(lds, sh, S, E); } \
               else { Sched2D S{(const char*)HN, (const char*)(ws + WS_WA_IN) + (size_t)(jl) * 2 * RW * D * 2, (unsigned)D, (unsigned)D, T / 256, 2 * RW / 256, nb, bid}; \
               pg8::Shape sh{D / 64, 0, (unsigned)D, (unsigned)D, 0u, 0u}; EpiBf16T<(RSI) != 0> E{(bf16*)(ws + WS_GX), RW, RW, (WS_XR - WS_GX) / 2, 0, 1.0f, (const float*)(ws + WS_RSS)}; \
               pg8::gemm_phase<EpiBf16T<(RSI) != 0>, Sched2D, false>(lds, sh, S, E); } DQ_TAIL((T / 256) * (2 * RW / 256), TL, TH, 2); } ); \
    PHASE(4, ph_rg_gates(args, lds, bid, nb, (jl)); ); \
    PHASE(5, ph_rg_carry(args, bid, nb); ); \
    PHASE(6, ph_rg_fix(args, bid, nb); ); \
    PHASE(7, { const bool early_ = ((bid >> 3) & 1) != 0;        \
               DQ_DRAIN(DR); \
               if ((CONVF) >= 0 && early_) { dq_work(args, DQ_MOE1, DQ_MOE1, -2, lds, scr); __syncthreads(); }     \
               { Sched2D S{(const char*)(ws + WS_GX), (const char*)(ws + WS_WA_OUT) + (size_t)(jl) * D * RW * 2, (unsigned)RW, (unsigned)RW, T / 256, D / 256, nb, bid}; \
               pg8::Shape sh{RW / 64, 0, (unsigned)RW, (unsigned)RW, 0u, 0u}; \
               if (EM) { EpiResidT<(EM) ? (EM) : 1> E{XSRC(l), args.out, ws + WS_HN, (float*)(ws + WS_RSS), (LAS float*)(lds + EXTRA_OFF), 1.0f}; pg8::gemm_phase<EpiResidT<(EM) ? (EM) : 1>, Sched2D, false>(lds, sh, S, E); } \
               else { EpiResid E{XSRC(l), args.out, nullptr, nullptr, nullptr, 1.0f}; pg8::gemm_phase<EpiResid, Sched2D, false>(lds, sh, S, E); } } \
               if ((CONVF) >= 0) { dq_work(args, DQ_MOE1, DQ_MOE1, -1, lds, scr); __syncthreads(); } } );
#define DENSE_FFN(l, W13O, W2O, GDR, TL, TH, F8, EM, DR)   \
    if (!DEFER_NORM) { PHASE(20, DQ_DRAIN(GDR); ph_norm<false, false, (F8) ? 3 : 0>(args, lds, bid, nb, args.out, args.out, GFFN(l), 0); ); } \
    PHASE(21, { if (F8) { Sched2D S{(const char*)HN, (const char*)(ws + (W13O)), (unsigned)D / 2, (unsigned)D / 2, T / 256, 2 * FF / 256, nb, bid}; \
                          pg8::Shape sh{D / 128, 0, (unsigned)D / 2, (unsigned)D / 2, 0u, 0u}; EpiSwiglu8T<DEFER_NORM != 0> E{ws + WS_H, (const float*)(ws + WS_RSS)}; \
                          pg8::gemm_phase<EpiSwiglu8T<DEFER_NORM != 0>, Sched2D, false, false, true>(lds, sh, S, E); } \
                else { Sched2D S{(const char*)HN, (const char*)(ws + (W13O)), (unsigned)D, (unsigned)D, T / 256, 2 * FF / 256, nb, bid}; \
                       pg8::Shape sh{D / 64, 0, (unsigned)D, (unsigned)D, 0u, 0u}; EpiSwigluT<DEFER_NORM != 0> E{(bf16*)(ws + WS_H), (const float*)(ws + WS_RSS)}; \
                       pg8::gemm_phase<EpiSwigluT<DEFER_NORM != 0>, Sched2D, false>(lds, sh, S, E); } \
                DQ_TAIL((T / 256) * (2 * FF / 256), TL, TH, 2); \
                if ((l) == 0 && bid >= nb / 2) s5_mats(args, lds, bid - nb / 2, nb / 2); } );     \
    PHASE(22, { if (DEFER_NORM) DQ_DRAIN(DR); \
                if (F8) { Sched2D S{(const char*)(ws + WS_H), (const char*)(ws + (W2O)), (unsigned)FF / 2, (unsigned)FF / 2, T / 256, D / 256, nb, bid}; \
                          pg8::Shape sh{FF / 128, 0, (unsigned)FF / 2, (unsigned)FF / 2, 0u, 0u}; EpiResidT<DEFER_NORM ? (EM) : 0> E{args.out, args.out, ws + WS_HN, (float*)(ws + WS_RSS), (LAS float*)(lds + EXTRA_OFF), 1.0f / 64.0f}; \
                          pg8::gemm_phase<EpiResidT<DEFER_NORM ? (EM) : 0>, Sched2D, false, false, true>(lds, sh, S, E); } \
                else { Sched2D S{(const char*)(ws + WS_H), (const char*)(ws + (W2O)), (unsigned)FF, (unsigned)FF, T / 256, D / 256, nb, bid}; \
                       pg8::Shape sh{FF / 64, 0, (unsigned)FF, (unsigned)FF, 0u, 0u}; EpiResidT<DEFER_NORM ? (EM) : 0> E{args.out, args.out, ws + WS_HN, (float*)(ws + WS_RSS), (LAS float*)(lds + EXTRA_OFF), 1.0f}; \
                       pg8::gemm_phase<EpiResidT<DEFER_NORM ? (EM) : 0>, Sched2D, false>(lds, sh, S, E); } } );
#define MOE_FFN(l, f, CONV, TL, TH, F8) \
    PHASE(23, if (CONV) { conv_moe(args, (f), gw, NGW, scr, lane); __syncthreads(); } ph_norm<false, true, (F8) ? 3 : 0>(args, lds, bid, nb, args.out, args.out, GFFN(l), (f)); ); \
    PHASE(25, { SchedMoe S; S.A = (const char*)HN; S.B = (const char*)(ws + WS_W13); S.lda = (F8) ? D / 2 : D; S.ldb = S.lda; S.bstride = (F8) ? W13_BYTES / 2 : W13_BYTES; S.nN = 2 * FF / 256; S.G = nb; S.c = bid; S.ksplit = 1; S.khbytes = 0; S.gather = 1; \
                int cnt_[NE]; moe_prefix(args, (f), S.ps, S.P, cnt_); LAS int* gt_ = (LAS int*)(lds + EXTRA_OFF); S.gt = gt_; \
                if (!(F8)) { const int* LISTE = (const int*)(ws + WS_LISTE); pg8::Unit u_; const int tid_ = otid(); \
                  _Pragma("unroll 1") for (int i_ = 0; S.next(i_, u_) && i_ < 23; ++i_) { const int e_ = u_.aux; int c_ = 0, p0_ = 0; \
                      _Pragma("unroll") for (int q_ = 0; q_ < NE; ++q_) { c_ = (e_ == q_) ? cnt_[q_] : c_; p0_ = (e_ == q_) ? S.ps[q_] : p0_; } \
                      const int r_ = (u_.pm - p0_) * 256 + tid_; if (tid_ < 256) gt_[i_ * 256 + tid_] = (r_ < c_) ? ldgi(LISTE + e_ * T + r_) : 0; } \
                  __syncthreads(); } \
                if (F8) { S.A = (const char*)(ws + WS_AGX); S.gather = 0; S.erows = T; pg8::Shape sh{D / 128, 0, (unsigned)D / 2, (unsigned)D / 2, 0u, 0u}; EpiSwiglu8 E{ws + WS_H};     \
                          pg8::gemm_phase<EpiSwiglu8, SchedMoe, false, false, true>(lds, sh, S, E); } \
                else { pg8::Shape sh{D / 64, 0, (unsigned)D, (unsigned)D, 0u, 0u}; EpiSwiglu E{(bf16*)(ws + WS_H)}; \
                       pg8::gemm_phase<EpiSwiglu, SchedMoe, false, true>(lds, sh, S, E); } \
                DQ_TAIL(S.P * S.nN, TL, TH, 2); } ); \
    PHASE(26, { SchedMoe S; S.A = (const char*)(ws + WS_H); S.B = (const char*)(ws + ((F8) ? WS_W2T8 : WS_W2T)); S.lda = (F8) ? FF / 2 : FF; S.ldb = S.lda; S.bstride = (F8) ? W2_BYTES / 2 : W2_BYTES; S.nN = D / 256; S.G = nb; S.c = bid; \
                S.ksplit = (F8) ? 1 : 2; S.khbytes = FF; S.gather = 0; S.gt = nullptr; int cnt_[NE]; moe_prefix(args, (f), S.ps, S.P, cnt_); \
                if (F8) { pg8::Shape sh{FF / 128, 0, (unsigned)FF / 2, (unsigned)FF / 2, 0u, 0u}; EpiBf16 E{(bf16*)(ws + WS_AG), D, 0, 0, 0, 1.0f / 64.0f}; \
                          pg8::gemm_phase<EpiBf16, SchedMoe, false, false, true>(lds, sh, S, E); } \
                else { pg8::Shape sh{FF / 128, 0, (unsigned)FF, (unsigned)FF, 0u, 0u}; EpiBf16 E{(bf16*)(ws + WS_AG), D, 0, 0, (WS_OUT - WS_AG) / 2}; \
                       pg8::gemm_phase<EpiBf16, SchedMoe, false>(lds, sh, S, E); } \
                DQ_TAIL(S.P * S.nN * S.ksplit, TL, TH, 3); } );

        PHASE(0, conv_a(args, 0, gw, NGW, scr, lane); __syncthreads(); ph_norm<false, false, 0>(args, lds, bid, nb, XSRC(0), args.out, GMIX(0), 0); );
    RG_MIXER(0, 0, -1, DQ_DENSE0, DQ_C, 0, DEFER_NORM ? (DENSE_F8(0) ? 2 : 1) : 0, DEFER_NORM ? DQ_DENSE0 : -1)
    DENSE_FFN(0, WS_W13, WS_W2T, DQ_DENSE0, DQ_B, DQ_C, DENSE_F8(0), 1, DQ_B)
    if (!DEFER_NORM) { PHASE(1, DQ_DRAIN(DQ_B); ph_norm<false, false, 0>(args, lds, bid, nb, XSRC(1), args.out, GMIX(1), 0); ); }
    PHASE(8, { Sched2D S{(const char*)HN, (const char*)(ws + WS_WB_IN), (unsigned)D, (unsigned)D, T / 256, 2 * MI / 256, nb, bid};
               pg8::Shape sh{D / 64, 0, (unsigned)D, (unsigned)D, 0u, 0u}; EpiBf16T<DEFER_NORM != 0> E{(bf16*)(ws + WS_XM), MI, MI, (WS_Z - WS_XM) / 2, 0, 1.0f, (const float*)(ws + WS_RSS)};
               pg8::gemm_phase<EpiBf16T<DEFER_NORM != 0>, Sched2D, false>(lds, sh, S, E); } );
    PHASE(9, ph_ml_prep(args, lds, bid, nb); );
    PHASE(10, ph_ml_gscan(args, lds, bid, nb); );
    PHASE(11, { SchedSbuild S{(const char*)(ws + WS_Q), (const char*)(ws + WS_K), nb, bid};
                pg8::Shape sh{HD / 64, 0, (unsigned)MI, (unsigned)MI, 0u, 0u}; EpiSbuild E{(bf16*)(ws + WS_SM), (float*)(ws + WS_DENP), (const float*)(ws + WS_GS), (const float*)(ws + WS_MC)};
                pg8::gemm_phase<EpiSbuild, SchedSbuild, false>(lds, sh, S, E); }
#ifdef PROBE_KTW
              tacc_ -= (long long)__builtin_amdgcn_s_memrealtime();
#endif
              ph_ml_ktw(args, lds, bid, nb);
#ifdef PROBE_KTW
              tacc_ += (long long)__builtin_amdgcn_s_memrealtime();
#endif
#ifdef PROBE_STATE
              tacc_ -= (long long)__builtin_amdgcn_s_memrealtime();
#endif
              { SchedState S{(const char*)(ws + WS_VT), (const char*)(ws + WS_KT), nb, bid};
                pg8::Shape sh{MCH / 64, 0, (unsigned)MCH, (unsigned)MCH, 0u, 0u}; EpiBf16 E{(bf16*)(ws + WS_CT), HD, 0, 0, (size_t)HD * HD};
                pg8::gemm_phase<EpiBf16, SchedState, false>(lds, sh, S, E); }
#ifdef PROBE_STATE
              tacc_ += (long long)__builtin_amdgcn_s_memrealtime();
#endif
              );
    PHASE(28, ph_ml_sscan(args, bid, nb); );
    PHASE(13, { SchedPass2 S{(const char*)(ws + WS_SM), (const char*)(ws + WS_Q), (const char*)(ws + WS_VT), (const char*)(ws + WS_CT), nb, bid};
                pg8::Shape sh{MCH / 64, HD / 64, (unsigned)MCH, (unsigned)MCH, (unsigned)MI, (unsigned)HD}; EpiNum E{(bf16*)(ws + WS_NUM), (const float*)(ws + WS_RMT), (const float*)(ws + WS_MC)};
                pg8::gemm_phase<EpiNum, SchedPass2, true>(lds, sh, S, E); }
              ph_ml_fin(args, bid, nb); );
#ifndef ML_OUT_STAGGER
#define ML_OUT_STAGGER 1
#endif
    PHASE(15, { const bool early_ = !ML_OUT_STAGGER || ((bid >> 3) & 1) != 0;
                if (early_) { conv_moe(args, 0, gw, NGW, scr, lane); __syncthreads(); }
                { Sched2D S{(const char*)(ws + WS_Y), (const char*)(ws + WS_WB_OUT), (unsigned)MI, (unsigned)MI, T / 256, D / 256, nb, bid};
                pg8::Shape sh{MI / 64, 0, (unsigned)MI, (unsigned)MI, 0u, 0u}; EpiResid E{args.out, args.out, nullptr, nullptr, nullptr, 1.0f};
                pg8::gemm_phase<EpiResid, Sched2D, false>(lds, sh, S, E); }
                if (!early_) { conv_moe(args, 0, gw, NGW, scr, lane); __syncthreads(); } } );
    MOE_FFN(1, 0, false, DQ_DENSE1, DQ_A1, MOE_F8(0))
    PHASE(2, DQ_DRAIN(DQ_C); ph_norm<true, false, 1>(args, lds, bid, nb, XSRC(2), args.out, GMIX(2), 0); );
    PHASE(16, { SchedBatch S{(const char*)(ws + WS_UP), (const char*)(ws + WS_S5_BE), (unsigned)SK, 256u, (size_t)SNC * SK * 2, (size_t)256 * 256 * 2, SNC / 256, NG, nb, bid};
                pg8::Shape sh{4, 0, (unsigned)SK, 256u, 0u, 0u}; EpiS5e E{(float*)(ws + WS_EB)};
                pg8::gemm_phase<EpiS5e, SchedBatch, false>(lds, sh, S, E); } );
    PHASE(17, ph_s5_scan(args, lds, bid, nb); );
    PHASE(18, { SchedBatch S{(const char*)(ws + WS_UP), (const char*)(ws + WS_S5_KC), (unsigned)SK, (unsigned)SK, (size_t)SNC * SK * 2, (size_t)256 * SK * 2, SNC / 256, NG, nb, bid};
                pg8::Shape sh{SK / 64, 0, (unsigned)SK, (unsigned)SK, 0u, 0u}; EpiS5y E{(const bf16*)(ws + WS_UP), args.in[I_C_D], (bf16*)(ws + WS_YA)};
                pg8::gemm_phase<EpiS5y, SchedBatch, false>(lds, sh, S, E); } );
    PHASE(19, { if (DEFER_NORM) DQ_DRAIN(DQ_DENSE1);
                Sched2D S{(const char*)(ws + WS_YA), (const char*)(ws + WS_WC_GLU), 16u, (unsigned)D, T / 256, D / 256, nb, bid};
                pg8::Shape sh{D / 64, 0, 16u, (unsigned)D, 0u, 0u, 4u * T * 32u, T * 32u}; constexpr int EM_ = DEFER_NORM ? (DENSE_F8(1) ? 2 : 1) : 0;
                EpiGluT<EM_> E{(const bf16*)(ws + WS_YA), args.in[I_C_B_GLU], args.out, ws + WS_HN, (float*)(ws + WS_RSS), (LAS float*)(lds + EXTRA_OFF)};
                pg8::gemm_phase<EpiGluT<EM_>, Sched2D, false>(lds, sh, S, E); } );
    DENSE_FFN(2, WS_WD1_13, WS_WD1_2, DQ_DENSE1, DQ_MOE1, DQ_MOE1, DENSE_F8(1), (RG_F8(1) ? 2 : 1), DQ_A1)
    if (!DEFER_NORM) PHASE(1, DQ_DRAIN(DQ_A1); if (RG_F8(1)) ph_norm<false, false, 3>(args, lds, bid, nb, XSRC(3), args.out, GMIX(3), 0); else ph_norm<false, false, 0>(args, lds, bid, nb, XSRC(3), args.out, GMIX(3), 0); );
    RG_MIXER(3, 1, 1, DQ_MOE1, DQ_MOE1, DEFER_NORM, 0, -1)
    MOE_FFN(3, 1, false, -1, -1, MOE_F8(1))
    PHASE(27, ph_norm<true, false, 2>(args, lds, bid, nb, args.out, args.out, args.in[I_NORM_FINAL], 1); );
    for (int xb_ = 0; xb_ < XBAR_EXTRA; ++xb_) xcd_barrier(bar);
#ifdef PROBE_LO
    if (bid0 == 0 && tid == 0) { const long long te_ = (long long)__builtin_amdgcn_s_memrealtime() + (long long)(PROBE_N) * tacc_; while ((long long)__builtin_amdgcn_s_memrealtime() < te_) __builtin_amdgcn_s_sleep(16); }
#endif
#undef PHASE
}

extern "C" void kernel_launch(void* const* d_in, const int* in_sizes, int n_in, void* d_out, int out_size, void* d_ws, size_t ws_size, hipStream_t stream) {
    static int grid = 0;
    if (grid == 0) {
        if (n_in != N_IN || in_sizes[0] != T * D || out_size != T * D || ws_size < WS_END) {
            fprintf(stderr, "kernel_launch: unexpected problem (n_in %d, in0 %d, out %d, ws %zu, need %zu)\n", n_in, n_in > 0 ? in_sizes[0] : -1, out_size, ws_size, (size_t)WS_END); grid = -1; return; }
        int dev = 0, cus = 0, per_cu = 0;
        if (hipGetDevice(&dev) != hipSuccess || hipDeviceGetAttribute(&cus, hipDeviceAttributeMultiprocessorCount, dev) != hipSuccess) { fprintf(stderr, "kernel_launch: device query failed\n"); grid = -1; return; }
        if (hipFuncSetAttribute((const void*)mega_fwd, hipFuncAttributeMaxDynamicSharedMemorySize, LDS_BYTES) != hipSuccess) { fprintf(stderr, "kernel_launch: hipFuncSetAttribute failed\n"); grid = -1; return; }
        if (hipOccupancyMaxActiveBlocksPerMultiprocessor(&per_cu, (const void*)mega_fwd, NTHR, LDS_BYTES) != hipSuccess || per_cu < 1) fprintf(stderr, "kernel_launch: occupancy query reports %d blocks per CU\n", per_cu);
        (void)hipGetLastError();
        if (cus < 256) { fprintf(stderr, "kernel_launch: %d CUs < 256: the 256-workgroup grid would not be resident\n", cus); grid = -1; return; }
        grid = 256;
    }
    if (grid < 0) return;
    if (hipMemsetAsync((char*)d_ws + WS_CTL, 0, CTL_ZERO_BYTES, stream) != hipSuccess) { fprintf(stderr, "kernel_launch: memset failed\n"); return; }
    Args a{};
    for (int i = 0; i < N_IN; ++i) a.in[i] = (const float*)d_in[i];
    a.out = (float*)d_out; a.ws = (unsigned char*)d_ws; a.pad = 0;
#if MK_PER_PHASE
    for (int k = 0; k < NPHASES; ++k) { a.ph_lo = k; a.ph_hi = k + 1; a.li = k; hipLaunchKernelGGL(mega_fwd, dim3(grid), dim3(NTHR), LDS_BYTES, stream, a); }
#else
    a.ph_lo = 0; a.ph_hi = NPHASES; a.li = 0;
    hipLaunchKernelGGL(mega_fwd, dim3(grid), dim3(NTHR), LDS_BYTES, stream, a);
#endif
    const hipError_t le = hipPeekAtLastError();
    if (le != hipSuccess) fprintf(stderr, "kernel_launch: launch failed: %s\n", hipGetErrorName(le));
}
```

```cpp
#include <hip/hip_runtime.h>
#include <cstdio>
#include <cstdint>

#define LAS __attribute__((address_space(3)))
#define GAS __attribute__((address_space(1)))
typedef unsigned short bf16;
typedef short bf16x8 __attribute__((ext_vector_type(8)));
typedef float f32x4 __attribute__((ext_vector_type(4)));
typedef float f32x2 __attribute__((ext_vector_type(2)));
typedef unsigned u32x4 __attribute__((ext_vector_type(4)));
typedef unsigned u32x2 __attribute__((ext_vector_type(2)));

__device__ __forceinline__ unsigned cvt_pk_bf16(float lo, float hi) { unsigned r; asm volatile("v_cvt_pk_bf16_f32 %0, %1, %2" : "=v"(r) : "v"(lo), "v"(hi)); return r; }
__device__ __forceinline__ float bflo(unsigned u) { return __uint_as_float(u << 16); }
__device__ __forceinline__ float bfhi(unsigned u) { return __uint_as_float(u & 0xffff0000u); }
__device__ __forceinline__ float bf2f(bf16 b) { return __uint_as_float(((unsigned)b) << 16); }
__device__ __forceinline__ bf16 f2bf(float f) { return (bf16)(cvt_pk_bf16(f, 0.f) & 0xffffu); }
__device__ __forceinline__ unsigned cvt4_fp8(float a, float b, float c, float d) { int p = 0; p = __builtin_amdgcn_cvt_pk_fp8_f32(a, b, p, false); p = __builtin_amdgcn_cvt_pk_fp8_f32(c, d, p, true); return (unsigned)p; }
__device__ __forceinline__ float sigm(float x) { return __builtin_amdgcn_rcpf(1.0f + __expf(-x)); }
__device__ __forceinline__ float silu_f(float x) { return x * sigm(x); }
__device__ __forceinline__ float gelu_tanh(float x) { return x * sigm(1.5957691216057308f * (x + 0.044715f * x * x * x)); }
__device__ __forceinline__ float softplus_f(float x) { return x > 20.f ? x : log1pf(__expf(x)); }

__device__ __forceinline__ int otid() { int t = threadIdx.x; asm volatile("" : "+v"(t)); return t; }
__device__ __forceinline__ void glds16(const char* sbase, unsigned voff, unsigned lds_dst) {
    unsigned keep;
    asm volatile("s_mov_b32 %0, m0\n\ts_mov_b32 m0, %3\n\ts_nop 0\n\tglobal_load_lds_dwordx4 %1, %2\n\ts_mov_b32 m0, %0" : "=&s"(keep) : "v"(voff), "s"(sbase), "s"(lds_dst) : "memory");
}
namespace pg8 {
constexpr int BM = 256, BK = 64, HALF = 128, HTB = HALF * BK * 2, STAGE_BYTES = 8 * HTB;
__host__ __device__ __forceinline__ int lds_byte(int r, int c) { const int st = (r >> 4) * 2 + (c >> 5), rr = r & 15, cc = c & 31, ob = rr * 64 + cc * 2; return st * 1024 + (ob ^ (((ob >> 9) & 1) << 5)); }
__host__ __device__ __forceinline__ void stage_rc(int b, int& R, int& C) { const int st = b / 1024, sb = b % 1024, swz = sb ^ (((sb >> 9) & 1) << 5); R = (st >> 1) * 16 + swz / 64; C = (st & 1) * 32 + (swz % 64) / 2; }
__host__ __device__ __forceinline__ int perm32(int rho) { const int n = rho >> 4, i = rho & 15; return 8 * (i >> 2) + 4 * n + (i & 3); }

struct Unit { int pm, pn, aux; const char *A1, *B1, *A2, *B2; };
struct Shape { int nt1, nt2; unsigned lda1, ldb1, lda2, ldb2; unsigned kstepA = 128u, agstride = 0u; };

typedef int pg8_v8i __attribute__((ext_vector_type(8))); typedef int pg8_v4i __attribute__((ext_vector_type(4)));
__device__ __forceinline__ pg8_v8i pg8_cat(bf16x8 lo, bf16x8 hi) { const pg8_v4i a = __builtin_bit_cast(pg8_v4i, lo), b = __builtin_bit_cast(pg8_v4i, hi); return __builtin_shufflevector(a, b, 0, 1, 2, 3, 4, 5, 6, 7); }
template <class Epi, class Sched, bool TWO, bool GATHER = false, bool FP8 = false>
__device__ __forceinline__ void gemm_phase(LAS unsigned char* lds, const Shape sh, const Sched& S, const Epi& E) {
    const int tid = otid(), wid = __builtin_amdgcn_readfirstlane(tid >> 6), lane = tid & 63, wr = wid >> 2, wc = wid & 3, fr = lane & 15, fq = lane >> 4;
    const int nt1 = sh.nt1, nt = sh.nt1 + (TWO ? sh.nt2 : 0);
    unsigned vA1[2], vB1[2], vA2[2], vB2[2]; unsigned vGc[2][2], vGn[2][2];
#pragma unroll
    for (int i = 0; i < 2; ++i) { int R, C; stage_rc(tid * 16 + i * 8192, R, C); const int Rb = Epi::PERM ? ((R & ~31) + perm32(R & 31)) : R;
        vA1[i] = sh.agstride ? (unsigned)(C >> 4) * sh.agstride + (unsigned)(R * 32 + (C & 15) * 2) : (unsigned)(R * sh.lda1 + C) * 2u; vB1[i] = (unsigned)(Rb * sh.ldb1 + C) * 2u;
        vA2[i] = TWO ? (unsigned)(R * sh.lda2 + C) * 2u : 0u; vB2[i] = TWO ? (unsigned)(Rb * sh.ldb2 + C) * 2u : 0u; }
    const unsigned hA1 = 256u * sh.lda1, hB1 = 256u * sh.ldb1, hA2 = TWO ? 256u * sh.lda2 : 0u, hB2 = TWO ? 256u * sh.ldb2 : 0u;
    const unsigned kstepA = sh.kstepA;
    const unsigned ldsw = (unsigned)wid * 1024u, ldsbase = (unsigned)(unsigned long long)lds;
    const int aoff = lds_byte(wr * 64 + fr, fq * 8), boff = lds_byte(wc * 32 + fr, fq * 8);
#define PG8_SA(b, h) (((b) * 2 + (h)) * HTB)
#define PG8_SB(b, h) ((4 + (b) * 2 + (h)) * HTB)
#define PG8_LOADG(ui_, dst) do { if constexpr (GATHER) { const int tg_ = otid(); _Pragma("unroll") for (int i_ = 0; i_ < 2; ++i_) { int R_, C_; stage_rc(tg_ * 16 + i_ * 8192, R_, C_);     \
        _Pragma("unroll") for (int h_ = 0; h_ < 2; ++h_) dst[h_][i_] = (unsigned)S.gt[(ui_) * 256 + h_ * 128 + R_] * (sh.lda1 * 2u) + (unsigned)C_ * 2u; } } } while (0)
#define PG8_STG_AG(bufoff, U, tt, h, usen) do { if constexpr (GATHER) { const char* gp_ = (U).A1 + (size_t)(tt) * 128; \
        const unsigned v0_ = (usen) ? vGn[h][0] : vGc[h][0], v1_ = (usen) ? vGn[h][1] : vGc[h][1]; \
        glds16(gp_, v0_, ldsbase + (unsigned)(bufoff) + ldsw); glds16(gp_, v1_, ldsbase + (unsigned)(bufoff) + ldsw + 8192u); } else { PG8_STG_A(bufoff, U, tt, h); } } while (0)
#define PG8_STG_A(bufoff, U, tt, h) do { const bool s2_ = TWO && ((tt) >= nt1); \
        const char* gp_ = (s2_ ? (U).A2 + (size_t)((tt) - nt1) * 128 + (size_t)(h) * hA2 : (U).A1 + (size_t)(tt) * kstepA + (size_t)(h) * hA1); \
        const unsigned v0_ = s2_ ? vA2[0] : vA1[0], v1_ = s2_ ? vA2[1] : vA1[1]; \
        glds16(gp_, v0_, ldsbase + (unsigned)(bufoff) + ldsw); glds16(gp_, v1_, ldsbase + (unsigned)(bufoff) + ldsw + 8192u); } while (0)
#define PG8_STG_B(bufoff, U, tt, h) do { const bool s2_ = TWO && ((tt) >= nt1); \
        const char* gp_ = (s2_ ? (U).B2 + (size_t)((tt) - nt1) * 128 + (size_t)(h) * hB2 : (U).B1 + (size_t)(tt) * 128 + (size_t)(h) * hB1); \
        const unsigned v0_ = s2_ ? vB2[0] : vB1[0], v1_ = s2_ ? vB2[1] : vB1[1]; \
        glds16(gp_, v0_, ldsbase + (unsigned)(bufoff) + ldsw); glds16(gp_, v1_, ldsbase + (unsigned)(bufoff) + ldsw + 8192u); } while (0)
#define PG8_LDA(dst, b, h) do { if constexpr (FP8) { _Pragma("unroll") for (int m = 0; m < 4; ++m) dst##8[m] = pg8_cat(*(const LAS bf16x8*)(lds + PG8_SA(b, h) + aoff + m * 2048), *(const LAS bf16x8*)(lds + PG8_SA(b, h) + aoff + m * 2048 + 1024)); } \
        else { _Pragma("unroll") for (int m = 0; m < 4; ++m) _Pragma("unroll") for (int k = 0; k < 2; ++k) dst[m][k] = *(const LAS bf16x8*)(lds + PG8_SA(b, h) + aoff + m * 2048 + k * 1024); } } while (0)
#define PG8_LDB(dst, b, h) do { if constexpr (FP8) { _Pragma("unroll") for (int n = 0; n < 2; ++n) dst##8[n] = pg8_cat(*(const LAS bf16x8*)(lds + PG8_SB(b, h) + boff + n * 2048), *(const LAS bf16x8*)(lds + PG8_SB(b, h) + boff + n * 2048 + 1024)); } \
        else { _Pragma("unroll") for (int n = 0; n < 2; ++n) _Pragma("unroll") for (int k = 0; k < 2; ++k) dst[n][k] = *(const LAS bf16x8*)(lds + PG8_SB(b, h) + boff + n * 2048 + k * 1024); } } while (0)
#define PG8_MMA(ai, bj, At, Bt) do { __builtin_amdgcn_s_setprio(1); if constexpr (FP8) { _Pragma("unroll") for (int m = 0; m < 4; ++m) _Pragma("unroll") for (int n = 0; n < 2; ++n) \
        acc[ai][bj][m][n] = __builtin_amdgcn_mfma_scale_f32_16x16x128_f8f6f4(Bt##8[n], At##8[m], acc[ai][bj][m][n], 0, 0, 0, 0x7f7f7f7f, 0, 0x7f7f7f7f); } \
        else { _Pragma("unroll") for (int m = 0; m < 4; ++m) _Pragma("unroll") for (int n = 0; n < 2; ++n) _Pragma("unroll") for (int k = 0; k < 2; ++k) \
        acc[ai][bj][m][n] = __builtin_amdgcn_mfma_f32_16x16x32_bf16(Bt[n][k], At[m][k], acc[ai][bj][m][n], 0, 0, 0); } __builtin_amdgcn_s_setprio(0); } while (0)
#define PG8_WAIT_V(n) asm volatile("s_waitcnt vmcnt(" #n ")" ::: "memory")
#define PG8_WAIT_L(n) asm volatile("s_waitcnt lgkmcnt(" #n ")" ::: "memory")
#define PG8_BAR __builtin_amdgcn_s_barrier()
#define PG8_SCHED __builtin_amdgcn_sched_barrier(0)
    Unit cur, nxt;
    if (!S.next(0, cur)) return;
    f32x4 acc[2][2][4][2];
#pragma unroll
    for (int a = 0; a < 2; ++a)
#pragma unroll
        for (int b = 0; b < 2; ++b)
#pragma unroll
            for (int m = 0; m < 4; ++m)
#pragma unroll
                for (int n = 0; n < 2; ++n) acc[a][b][m][n] = (f32x4){0.f, 0.f, 0.f, 0.f};
    bf16x8 At[4][2], B0[2][2], B1[2][2]; pg8_v8i At8[4], B08[2], B18[2];
    PG8_LOADG(0, vGc);
    PG8_STG_B(PG8_SB(0, 0), cur, 0, 0); PG8_STG_B(PG8_SB(0, 1), cur, 0, 1); PG8_STG_AG(PG8_SA(0, 0), cur, 0, 0, false); PG8_STG_AG(PG8_SA(0, 1), cur, 0, 1, false);
    if (wr == 1) PG8_BAR;
    PG8_WAIT_V(2); PG8_BAR;
    PG8_STG_B(PG8_SB(1, 0), cur, 1, 0); PG8_STG_AG(PG8_SA(1, 0), cur, 1, 0, false); PG8_STG_B(PG8_SB(1, 1), cur, 1, 1);
    PG8_WAIT_V(6); PG8_BAR;
    for (int ui = 0;; ++ui) {
        const bool has_next = S.next(ui + 1, nxt);
        if (!has_next) nxt = cur;
        if constexpr (GATHER) { if (has_next) PG8_LOADG(ui + 1, vGn); else {
#pragma unroll
            for (int h_ = 0; h_ < 2; ++h_) { vGn[h_][0] = vGc[h_][0]; vGn[h_][1] = vGc[h_][1]; } } }
#pragma unroll 1
        for (int t = 0; t < nt; t += 2) {
            const bool last = (t == nt - 2);
            const char* uA1 = last ? nxt.A1 : cur.A1; const char* uB1 = last ? nxt.B1 : cur.B1; const char* uA2 = last ? nxt.A2 : cur.A2; const char* uB2 = last ? nxt.B2 : cur.B2;
            Unit U2; U2.A1 = uA1; U2.B1 = uB1; U2.A2 = uA2; U2.B2 = uB2;
            const int t2 = last ? 0 : t + 2, t3 = t2 + 1;
            PG8_LDB(B0, 0, 0); PG8_LDB(B1, 0, 1); PG8_SCHED; PG8_LDA(At, 0, 0); PG8_STG_AG(PG8_SA(1, 1), cur, t + 1, 1, false);
            PG8_WAIT_V(8); PG8_WAIT_L(0); PG8_BAR; PG8_MMA(0, 0, At, B0); PG8_MMA(0, 1, At, B1); PG8_BAR; PG8_SCHED;
            PG8_LDA(At, 0, 1); PG8_STG_B(PG8_SB(0, 0), U2, t2, 0); PG8_STG_B(PG8_SB(0, 1), U2, t2, 1); PG8_STG_AG(PG8_SA(0, 0), U2, t2, 0, last);
            PG8_WAIT_V(8); PG8_WAIT_L(0); PG8_BAR; PG8_MMA(1, 0, At, B0); PG8_MMA(1, 1, At, B1); PG8_BAR; PG8_SCHED;
            PG8_LDB(B0, 1, 0); PG8_LDB(B1, 1, 1); PG8_SCHED; PG8_LDA(At, 1, 0); PG8_STG_AG(PG8_SA(0, 1), U2, t2, 1, last);
            PG8_WAIT_V(8); PG8_WAIT_L(0); PG8_BAR; PG8_MMA(0, 0, At, B0); PG8_MMA(0, 1, At, B1); PG8_BAR; PG8_SCHED;
            PG8_LDA(At, 1, 1); PG8_STG_B(PG8_SB(1, 0), U2, t3, 0); PG8_STG_B(PG8_SB(1, 1), U2, t3, 1); PG8_STG_AG(PG8_SA(1, 0), U2, t3, 0, last);
            PG8_WAIT_V(8); PG8_WAIT_L(0); PG8_BAR; PG8_MMA(1, 0, At, B0); PG8_MMA(1, 1, At, B1); PG8_BAR; PG8_SCHED;
        }
        if (wr == 0) PG8_BAR;
        { const int l2_ = otid() & 63; E(acc, cur, wr, wc, l2_ & 15, l2_ >> 4); }
        if (!has_next) break;
#pragma unroll
        for (int a = 0; a < 2; ++a)
#pragma unroll
            for (int b = 0; b < 2; ++b)
#pragma unroll
                for (int m = 0; m < 4; ++m)
#pragma unroll
                    for (int n = 0; n < 2; ++n) acc[a][b][m][n] = (f32x4){0.f, 0.f, 0.f, 0.f};
        cur = nxt;
        if constexpr (GATHER) {
#pragma unroll
            for (int h_ = 0; h_ < 2; ++h_) { vGc[h_][0] = vGn[h_][0]; vGc[h_][1] = vGn[h_][1]; } }
        if (wr == 1) PG8_BAR;
    }
    PG8_WAIT_V(0);
    PG8_BAR;
#undef PG8_SA
#undef PG8_SB
#undef PG8_STG_A
#undef PG8_STG_AG
#undef PG8_LOADG
#undef PG8_STG_B
#undef PG8_LDA
#undef PG8_LDB
#undef PG8_MMA
#undef PG8_WAIT_V
#undef PG8_WAIT_L
#undef PG8_BAR
#undef PG8_SCHED
}
}

#define XB_TMO      128
#define XB_XCNT(j)  (256  + 64 * (j))
#define XB_XSUB(j)  (1280 + 64 * (j))
#define XB_XGEN(j)  (2304 + 64 * (j))
#define XB_TOP      3328
#define XB_TOPGEN   3392
#define XCD_BAR_WORDS 3456
#define XB_SPIN_CAP (1u << 18)

__device__ __forceinline__ unsigned xb_ld(unsigned* p)              { return __hip_atomic_load(p, __ATOMIC_RELAXED, __HIP_MEMORY_SCOPE_AGENT); }
__device__ __forceinline__ unsigned xb_add(unsigned* p, unsigned v) { return __hip_atomic_fetch_add(p, v, __ATOMIC_RELAXED, __HIP_MEMORY_SCOPE_AGENT); }
__device__ __forceinline__ unsigned xb_xcc_id() { return (unsigned)__builtin_amdgcn_s_getreg((3 << 11) | 20) & 0xFu; }
#define XB_SPIN(cond, bar) do { unsigned _sp = 0; while (cond) { __builtin_amdgcn_s_sleep(1); \
    if ((++_sp & 255u) == 0u) { if (xb_ld(&(bar)[XB_TMO])) break; if (_sp > XB_SPIN_CAP) { atomicAdd(&(bar)[XB_TMO], 1u); break; } } } } while (0)

struct XcdBarrier {
    unsigned* bar; unsigned x;
    volatile LAS unsigned* st;
};

__device__ __forceinline__ XcdBarrier xcd_barrier_post(unsigned* bar, volatile LAS unsigned* st) {
    XcdBarrier b; b.bar = bar; b.x = xb_xcc_id(); b.st = st;
    if (threadIdx.x == 0) (void)xb_add(&bar[XB_XCNT(b.x)], 1u);
    return b;
}
__device__ __forceinline__ void xcd_barrier_complete(unsigned* bar, unsigned x, unsigned& nloc, unsigned& nx) {
    const unsigned G = gridDim.x * gridDim.y * gridDim.z;
    unsigned sum, cnt, mine, sp = 0u;
    for (;;) {
        sum = 0u; cnt = 0u; mine = 0u;
#pragma unroll
        for (unsigned j = 0; j < 16; ++j) { const unsigned c = xb_ld(&bar[XB_XCNT(j)]); sum += c; cnt += (c > 0u) ? 1u : 0u; mine = (j == x) ? c : mine; }
        if (sum == G) break;
        __builtin_amdgcn_s_sleep(1);
        if ((++sp & 255u) == 0u) { if (xb_ld(&bar[XB_TMO])) break; if (sp > XB_SPIN_CAP) { atomicAdd(&bar[XB_TMO], 1u); break; } }
    }
    nloc = mine > 0u ? mine : 1u; nx = cnt > 0u ? cnt : 1u;
}

__device__ __forceinline__ void xcd_barrier(const XcdBarrier& b) {
    asm volatile("s_waitcnt vmcnt(0)" ::: "memory");
    __syncthreads();
    if (threadIdx.x == 0) {
        unsigned* bar = b.bar;
        __builtin_amdgcn_s_waitcnt(0);
        unsigned nloc = b.st[0], nx = b.st[1];
        if (nloc == 0u) { xcd_barrier_complete(bar, b.x, nloc, nx); b.st[0] = nloc; b.st[1] = nx; }
        const unsigned old = xb_add(&bar[XB_XSUB(b.x)], 1u);
        const unsigned gen = old / nloc;
        if (old + 1u == (gen + 1u) * nloc) {
            __builtin_amdgcn_fence(__ATOMIC_RELEASE, "agent");
            asm volatile("s_waitcnt vmcnt(0)" ::: "memory");
            const unsigned og = xb_add(&bar[XB_TOP], 1u);
            const unsigned tg = og / nx;
            if (og + 1u == (tg + 1u) * nx) xb_add(&bar[XB_TOPGEN], 1u);
            else XB_SPIN(xb_ld(&bar[XB_TOPGEN]) == tg, bar);
            __builtin_amdgcn_fence(__ATOMIC_ACQUIRE, "agent");
            xb_add(&bar[XB_XGEN(b.x)], 1u);
            asm volatile("s_waitcnt vmcnt(0)" ::: "memory");
        } else {
            XB_SPIN(xb_ld(&bar[XB_XGEN(b.x)]) == gen, bar);
            __builtin_amdgcn_fence(__ATOMIC_ACQUIRE, "agent");
            asm volatile("s_waitcnt vmcnt(0)" ::: "memory");
        }
    }
    __syncthreads();
}

constexpr int T = 16384, D = 1024;
constexpr int RW = 1280, RNB = 10, RBD = 128, RCH = 64, RNC = T / RCH;
constexpr int MI = 2048, MH = 4, HD = 512, MCH = 256, MNC = T / MCH;
constexpr int LDT = T + 64;
constexpr int NG = 64, SL = 16, SNC = T / SL, SK = 384;
constexpr int FF = 2816, NE = 8, MOE_ROWS = 2 * T + NE * 256;
#ifndef MOE_F8_MASK
#define MOE_F8_MASK 3
#endif
#define MOE_F8(f) (((MOE_F8_MASK) >> (f)) & 1)
#ifndef DENSE_F8_MASK
#define DENSE_F8_MASK 2
#endif
#define DENSE_F8(f) (((DENSE_F8_MASK) >> (f)) & 1)
#ifndef RG_F8_MASK
#define RG_F8_MASK 2
#endif
#define RG_F8(j) (((RG_F8_MASK) >> (j)) & 1)
#ifndef DEFER_NORM
#define DEFER_NORM 1
#endif
constexpr float EPS = 1e-6f;
constexpr int NTHR = 512, NWAVES = 8;

enum { I_X = 0, I_NORM_MIX, I_NORM_FFN, I_NORM_FINAL, I_A_W_IN, I_A_CONV_W, I_A_CONV_B, I_A_W_R, I_A_B_R, I_A_W_I, I_A_B_I, I_A_LAM, I_A_W_OUT,
       I_B_W_IN, I_B_CONV_W, I_B_CONV_B, I_B_W_Q, I_B_W_K, I_B_W_V, I_B_W_GATE, I_B_B_GATE, I_B_NORM, I_B_SKIP, I_B_W_OUT,
       I_C_A_RE, I_C_A_IM, I_C_LOG_STEP, I_C_B_RE, I_C_B_IM, I_C_C_RE, I_C_C_IM, I_C_D, I_C_W_GLU, I_C_B_GLU,
       I_F_W1, I_F_W3, I_F_W2, I_E_ROUTER, I_E_ROUTER_B, I_E_W1, I_E_W3, I_E_W2, N_IN };

constexpr size_t MiB = 1u << 20;
constexpr size_t WS_CTL = 0, CTL_ZERO_BYTES = 1 * MiB;
constexpr size_t WS_WA_IN = 2 * MiB, WS_WA_OUT = 12 * MiB, WS_WA_G = 17 * MiB, WS_WB_IN = 19 * MiB, WS_WB_OUT = 27 * MiB, WS_WC_GLU = 31 * MiB, WS_S5_BE = 33 * MiB, WS_S5_KC = 41 * MiB;
constexpr size_t WS_RSS = 53 * MiB;
constexpr size_t SCR = 56 * MiB;
constexpr size_t WS_HN = SCR + 0 * MiB;
constexpr size_t WS_GX = SCR + 32 * MiB, WS_XR = SCR + 72 * MiB, WS_HL = SCR + 112 * MiB, WS_AC = SCR + 152 * MiB, WS_CSA = SCR + 192 * MiB, WS_CSH = SCR + 194 * MiB, WS_CIN = SCR + 196 * MiB;
constexpr size_t WS_XM = SCR + 32 * MiB, WS_Z = SCR + 96 * MiB, WS_Q = SCR + 160 * MiB, WS_K = SCR + 224 * MiB, WS_KT = SCR + 288 * MiB, WS_VT = SCR + 353 * MiB, WS_XC = SCR + 418 * MiB,
                 WS_SM = SCR + 482 * MiB, WS_CT = SCR + 514 * MiB, WS_MLS = SCR + 642 * MiB;
static_assert((size_t)MI * LDT * 2 <= 65 * MiB && WS_MLS + 4 * MiB <= SCR + 656 * MiB, "mLSTM scratch");
constexpr size_t WS_NUM = WS_XM, WS_Y = WS_XC;
constexpr size_t WS_GI = WS_MLS, WS_GF = WS_MLS + 256 * 1024, WS_GS = WS_MLS + 512 * 1024, WS_RMT = WS_MLS + 768 * 1024, WS_EF = WS_MLS + 1024 * 1024, WS_MC = WS_MLS + 1280 * 1024,
                 WS_DENP = WS_MLS + 2 * MiB, WS_NS = WS_MLS + 3 * MiB;
constexpr size_t WS_UP = SCR + 32 * MiB, WS_EB = SCR + 80 * MiB, WS_YA = SCR + 112 * MiB;
constexpr size_t WS_WFFN = SCR + 200 * MiB, WS_AG = SCR + 332 * MiB, WS_H = SCR + 400 * MiB, WS_OUT = SCR + 587 * MiB, WS_META = SCR + 655 * MiB, WS_END = SCR + 656 * MiB;
constexpr size_t WS_TOPI = WS_META, WS_TOPW = WS_META + 128 * 1024, WS_LISTE = WS_META + 384 * 1024;
constexpr size_t W13_BYTES = (size_t)2 * FF * D * 2, W2_BYTES = (size_t)D * FF * 2;
constexpr size_t WS_W13 = WS_WFFN, WS_W2T = WS_WFFN + NE * W13_BYTES;
constexpr size_t WS_WD1_13 = SCR + 144 * MiB, WS_WD1_2 = SCR + 155 * MiB;
constexpr size_t WS_W2T8 = WS_WFFN + NE * (W13_BYTES / 2);
constexpr size_t WS_AGX = WS_WFFN + NE * (W13_BYTES / 2) + NE * (W2_BYTES / 2);
static_assert(WS_AGX + (size_t)NE * T * D <= WS_H, "fp8 MoE rows");
static_assert(WS_WD1_13 + W13_BYTES <= WS_WD1_2 && WS_WD1_2 + W2_BYTES <= SCR + 161 * MiB, "dense-1 weights");
static_assert(WS_W2T + NE * W2_BYTES <= WS_AG, "ffn weights");
static_assert(WS_CIN + (size_t)RNC * RW * 4 <= WS_WFFN, "rg scratch vs dense weights");
static_assert(WS_H + (size_t)MOE_ROWS * FF * 2 <= WS_OUT && WS_OUT + (size_t)MOE_ROWS * D * 2 <= WS_META, "moe buffers");
constexpr int CW_BAR = 4096, CW_MOE = 204800, CW_DQ = 208896;

constexpr int RING_BYTES = 131072, EXTRA_OFF = RING_BYTES, EXTRA_BYTES = 24576, LDS_BYTES = RING_BYTES + EXTRA_BYTES;
constexpr int MISC_OFF = LDS_BYTES - 64;

struct Args { const float* in[N_IN]; float* out; unsigned char* ws; int ph_lo, ph_hi, li, pad; };

__device__ __forceinline__ float wave_sum(float v) {
#pragma unroll
    for (int o = 1; o < 64; o <<= 1) v += __shfl_xor(v, o);
    return v;
}
__device__ __forceinline__ float wave_max(float v) {
#pragma unroll
    for (int o = 1; o < 64; o <<= 1) v = fmaxf(v, __shfl_xor(v, o));
    return v;
}
__device__ __forceinline__ u32x4 ldg16(const void* p) { return *(const GAS u32x4*)p; }
__device__ __forceinline__ u32x2 ldg8(const void* p) { return *(const GAS u32x2*)p; }
__device__ __forceinline__ f32x4 ldgf4(const void* p) { return *(const GAS f32x4*)p; }
__device__ __forceinline__ float ldgf(const void* p) { return *(const GAS float*)p; }
__device__ __forceinline__ int ldgi(const void* p) { return *(const GAS int*)p; }
#ifndef STORE_SC1
#define STORE_SC1 0
#endif
#if STORE_SC1
__device__ __forceinline__ void stg16(void* p, u32x4 v) { asm volatile("global_store_dwordx4 %0, %1, off sc1\n\ts_nop 1" :: "v"((GAS u32x4*)p), "v"(v) : "memory"); }
__device__ __forceinline__ void stg8(void* p, u32x2 v) { asm volatile("global_store_dwordx2 %0, %1, off sc1\n\ts_nop 1" :: "v"((GAS u32x2*)p), "v"(v) : "memory"); }
__device__ __forceinline__ void stgf4(void* p, f32x4 v) { asm volatile("global_store_dwordx4 %0, %1, off sc1\n\ts_nop 1" :: "v"((GAS f32x4*)p), "v"(v) : "memory"); }
__device__ __forceinline__ void stgf(void* p, float v) { asm volatile("global_store_dword %0, %1, off sc1\n\ts_nop 1" :: "v"((GAS float*)p), "v"(v) : "memory"); }
__device__ __forceinline__ void stgi(void* p, int v) { asm volatile("global_store_dword %0, %1, off sc1\n\ts_nop 1" :: "v"((GAS int*)p), "v"(v) : "memory"); }
__device__ __forceinline__ void stgh(void* p, bf16 v) { asm volatile("global_store_short %0, %1, off sc1\n\ts_nop 1" :: "v"((GAS bf16*)p), "v"((unsigned)v) : "memory"); }
#else
__device__ __forceinline__ void stg16(void* p, u32x4 v) { *(GAS u32x4*)p = v; }
__device__ __forceinline__ void stg8(void* p, u32x2 v) { *(GAS u32x2*)p = v; }
__device__ __forceinline__ void stgf4(void* p, f32x4 v) { *(GAS f32x4*)p = v; }
__device__ __forceinline__ void stgf(void* p, float v) { *(GAS float*)p = v; }
__device__ __forceinline__ void stgi(void* p, int v) { *(GAS int*)p = v; }
__device__ __forceinline__ void stgh(void* p, bf16 v) { *(GAS bf16*)p = v; }
#endif
#define LDS_WAIT() asm volatile("s_waitcnt lgkmcnt(0)" ::: "memory")

#ifndef WGM_
#define WGM_ 8
#endif
__device__ __forceinline__ void tile_of(int L, int nM, int nN, int& pm, int& pn) {
    const int nwg = nM * nN; int wgid = L;
    { const int q = nwg / 8, r = nwg % 8, xcd = wgid % 8, off = wgid / 8; wgid = (xcd < r ? xcd * (q + 1) : r * (q + 1) + (xcd - r) * q) + off; }
    const int nig = WGM_ * nN, gid = wgid / nig, fm = gid * WGM_, gsz = (nM - fm) < WGM_ ? (nM - fm) : WGM_;
    pm = fm + ((wgid % nig) % gsz); pn = (wgid % nig) / gsz;
}
using pg8::Unit;
__device__ __forceinline__ const char* uptr(const char* p) { const unsigned long long v = (unsigned long long)p; unsigned lo = __builtin_amdgcn_readfirstlane((unsigned)v), hi = __builtin_amdgcn_readfirstlane((unsigned)(v >> 32));
    asm volatile("s_nop 4" : "+s"(lo), "+s"(hi)); return (const char*)(((unsigned long long)hi << 32) | lo); }
struct Sched2D {
    const char* A; const char* B; unsigned lda, ldb; int nM, nN, G, c;
    __device__ __forceinline__ bool next(int i, Unit& u) const {
        const int L = i * G + c; if (L >= nM * nN) return false;
        tile_of(L, nM, nN, u.pm, u.pn); u.aux = 0;
        u.A1 = uptr(A + (size_t)u.pm * 512 * lda); u.B1 = uptr(B + (size_t)u.pn * 512 * ldb); u.A2 = u.A1; u.B2 = u.B1; return true;
    }
};
struct SchedMoe {
    LAS const int* gt; int gather;
    const char* A; const char* B; unsigned lda, ldb; size_t bstride; int P, nN, G, c; int ps[NE];
    int erows = 0;
    int ksplit; unsigned khbytes;
    __device__ __forceinline__ bool next(int i, Unit& u) const {
        const int L = i * G + c, nu = P * nN; if (L >= nu * ksplit) return false;
        const int kh = L / nu;
        tile_of(L - kh * nu, P, nN, u.pm, u.pn);
        int e = 0;
#pragma unroll
        for (int j = 1; j < NE; ++j) e += (u.pm >= ps[j]) ? 1 : 0;
        u.aux = (ksplit > 1) ? kh : e;
        int arow = u.pm * 256;
        if (erows) { int pse = 0;
#pragma unroll
            for (int j = 1; j < NE; ++j) pse = (u.pm >= ps[j]) ? ps[j] : pse;
            arow = e * erows + (u.pm - pse) * 256; }
        u.A1 = gather ? A : uptr(A + (size_t)arow * 2 * lda + (size_t)kh * khbytes); u.B1 = uptr(B + (size_t)e * bstride + (size_t)u.pn * 512 * ldb + (size_t)kh * khbytes); u.A2 = u.A1; u.B2 = u.B1; return true;
    }
};
struct SchedBatch {
    const char* A; const char* B; unsigned lda, ldb; size_t astride, bstride; int nMb, nB, G, c;
    __device__ __forceinline__ bool next(int i, Unit& u) const {
        const int L = i * G + c; if (L >= nMb * nB) return false;
        u.aux = L / nMb; u.pm = L % nMb; u.pn = 0;
        u.A1 = uptr(A + (size_t)u.aux * astride + (size_t)u.pm * 512 * lda); u.B1 = uptr(B + (size_t)u.aux * bstride); u.A2 = u.A1; u.B2 = u.B1; return true;
    }
};
struct SchedSbuild {
    const char* Q; const char* K; int G, c;
    __device__ __forceinline__ bool next(int i, Unit& u) const {
        const int L = i * G + c; if (L >= MNC * MH) return false;
        const int ch = L / MH, h = L % MH; u.aux = L; u.pm = ch; u.pn = h;
        u.A1 = uptr(Q + ((size_t)ch * MCH * MI + (size_t)h * HD) * 2); u.B1 = uptr(K + ((size_t)ch * MCH * MI + (size_t)h * HD) * 2); u.A2 = u.A1; u.B2 = u.B1; return true;
    }
};
struct SchedPass2 {
    const char* SMp; const char* Q; const char* VT; const char* CT; int G, c;
    __device__ __forceinline__ bool next(int i, Unit& u) const {
        const int pr_ = (i >> 1) * G + c; if (pr_ >= MNC * MH) return false;
        const int L = pr_ * 2 + (i & 1);
        const int eh = L & 1, ch_h = L >> 1, ch = ch_h / MH, h = ch_h % MH; u.aux = ch_h; u.pm = ch; u.pn = h * 2 + eh;
        u.A1 = uptr(SMp + (size_t)ch_h * MCH * MCH * 2); u.A2 = uptr(Q + ((size_t)ch * MCH * MI + (size_t)h * HD) * 2);
        u.B1 = uptr(VT + (((size_t)ch_h * HD + eh * 256) * MCH) * 2);     u.B2 = uptr(CT + ((size_t)ch_h * HD * HD + (size_t)eh * 256 * HD) * 2); return true;
    }
};

struct SchedState {
    const char* VT; const char* KT; int G, c;
    __device__ __forceinline__ bool next(int i, Unit& u) const {
        const int pq_ = (i >> 2) * G + c; if (pq_ >= MNC * MH) return false;
        const int L = pq_ * 4 + (i & 3);
        const int ch_h = L >> 2, ch = ch_h / MH, h = ch_h % MH; u.aux = ch_h; u.pm = (L >> 1) & 1; u.pn = L & 1;
        u.A1 = uptr(VT + (((size_t)ch_h * HD + u.pm * 256) * MCH) * 2); u.B1 = uptr(KT + (((size_t)ch_h * HD + u.pn * 256) * MCH) * 2); u.A2 = u.A1; u.B2 = u.B1; return true;
    }
};

__device__ __forceinline__ float rss_rstd(const float* rss, int row) { const f32x4 p = ldgf4(rss + (size_t)row * 4); return __builtin_amdgcn_rsqf(((p[0] + p[1]) + (p[2] + p[3])) * (1.0f / D) + EPS); }
template <int EMIT> __device__ __forceinline__ float emit_x(unsigned char* hn, size_t eoff, const f32x4& x) {
    if (EMIT == 1) { u32x2 w; w.x = cvt_pk_bf16(x[0], x[1]); w.y = cvt_pk_bf16(x[2], x[3]); stg8(hn + eoff * 2, w); }
    else stgi(hn + eoff, (int)cvt4_fp8(__builtin_amdgcn_fmed3f(x[0], -448.0f, 448.0f), __builtin_amdgcn_fmed3f(x[1], -448.0f, 448.0f), __builtin_amdgcn_fmed3f(x[2], -448.0f, 448.0f), __builtin_amdgcn_fmed3f(x[3], -448.0f, 448.0f)));
    return (x[0] * x[0] + x[1] * x[1]) + (x[2] * x[2] + x[3] * x[3]);
}
__device__ __forceinline__ void emit_rss(LAS float* P, float* rss, const pg8::Unit& u) {
    LDS_WAIT(); __builtin_amdgcn_s_barrier(); asm volatile("" ::: "memory");
    const int t = otid(); if (t < 256) { const f32x4 p = *(const LAS f32x4*)(P + t * 4); stgf(rss + ((size_t)u.pm * 256 + t) * 4 + u.pn, (p[0] + p[1]) + (p[2] + p[3])); }
}

template <bool RS> struct EpiBf16T {
    static constexpr bool PERM = true;
    bf16* O; int ldc; int split_cols; size_t split_stride; size_t aux_stride;
    float scale = 1.0f; const float* rss = nullptr;
    __device__ __forceinline__ void operator()(const f32x4 (&acc)[2][2][4][2], const Unit& u, int wr, int wc, int fr, int fq) const {
        const int row0 = u.pm * 256 + wr * 64 + fr; int colt = u.pn * 256; bf16* base = O + (size_t)u.aux * aux_stride;
        if (split_cols) { const int t = colt / split_cols; base += (size_t)t * split_stride; colt -= t * split_cols; }
        const int col0 = colt + wc * 32 + 8 * fq;
#pragma unroll
        for (int ai = 0; ai < 2; ++ai)
#pragma unroll
            for (int m = 0; m < 4; ++m) { bf16* rowp = base + (size_t)(row0 + ai * 128 + m * 16) * ldc + col0; const float sc_ = RS ? scale * rss_rstd(rss, row0 + ai * 128 + m * 16) : scale;
#pragma unroll
                for (int bj = 0; bj < 2; ++bj) { const f32x4 v0 = acc[ai][bj][m][0] * sc_, v1 = acc[ai][bj][m][1] * sc_;
                    u32x4 w; w.x = cvt_pk_bf16(v0[0], v0[1]); w.y = cvt_pk_bf16(v0[2], v0[3]); w.z = cvt_pk_bf16(v1[0], v1[1]); w.w = cvt_pk_bf16(v1[2], v1[3]);
                    stg16(rowp + bj * 128, w); }
                asm volatile("" ::: "memory"); }
    }
};
using EpiBf16 = EpiBf16T<false>;
template <int EMIT> struct EpiResidT {
    static constexpr bool PERM = false;
    const float* base; float* out; unsigned char* hn; float* rss; LAS float* P; float scale;
    __device__ __forceinline__ void operator()(const f32x4 (&acc)[2][2][4][2], const Unit& u, int wr, int wc, int fr, int fq) const {
        const int row0 = u.pm * 256 + wr * 64 + fr, col0 = u.pn * 256 + wc * 32 + 4 * fq;
#pragma unroll
        for (int ai = 0; ai < 2; ++ai) { f32x4 bs[4][2][2];
#pragma unroll
            for (int m = 0; m < 4; ++m) { const size_t off = (size_t)(row0 + ai * 128 + m * 16) * D + col0;
#pragma unroll
                for (int bj = 0; bj < 2; ++bj)
#pragma unroll
                    for (int n = 0; n < 2; ++n) bs[m][bj][n] = ldgf4(base + off + bj * 128 + n * 16); }
#pragma unroll
            for (int m = 0; m < 4; ++m) { const size_t off = (size_t)(row0 + ai * 128 + m * 16) * D + col0; float ss = 0.f;
#pragma unroll
                for (int bj = 0; bj < 2; ++bj)
#pragma unroll
                    for (int n = 0; n < 2; ++n) { const f32x4 x = bs[m][bj][n] + acc[ai][bj][m][n] * scale; stgf4(out + off + bj * 128 + n * 16, x);
                        if (EMIT) ss += emit_x<EMIT>(hn, off + bj * 128 + n * 16, x); }
                if (EMIT) { ss += __shfl_xor(ss, 16); ss += __shfl_xor(ss, 32); if (fq == 0) P[(ai * 128 + wr * 64 + m * 16 + fr) * 4 + wc] = ss; } }
            asm volatile("" ::: "memory"); }
        if (EMIT) emit_rss(P, rss, u);
    }
};
using EpiResid = EpiResidT<0>;
template <bool RS> struct EpiSwigluT {
    static constexpr bool PERM = true;
    bf16* Hh; const float* rss = nullptr;
    __device__ __forceinline__ void operator()(const f32x4 (&acc)[2][2][4][2], const Unit& u, int wr, int wc, int fr, int fq) const {
        const int row0 = u.pm * 256 + wr * 64 + fr, col0 = u.pn * 128 + wc * 32 + 8 * fq;
#pragma unroll
        for (int ai = 0; ai < 2; ++ai)
#pragma unroll
            for (int m = 0; m < 4; ++m) { bf16* rowp = Hh + (size_t)(row0 + ai * 128 + m * 16) * FF + col0; const float rs_ = RS ? rss_rstd(rss, row0 + ai * 128 + m * 16) : 1.0f;
                f32x2 o[4];
#pragma unroll
                for (int n = 0; n < 2; ++n)
#pragma unroll
                    for (int hh = 0; hh < 2; ++hh) { const f32x4 a4 = acc[ai][0][m][n], b4 = acc[ai][1][m][n];
                        f32x2 a = hh ? (f32x2){a4[2], a4[3]} : (f32x2){a4[0], a4[1]}, b = hh ? (f32x2){b4[2], b4[3]} : (f32x2){b4[0], b4[1]}; if (RS) { a = a * rs_; b = b * rs_; }
                        f32x2 e; e[0] = __builtin_amdgcn_exp2f(-a[0]); e[1] = __builtin_amdgcn_exp2f(-a[1]);
                        const f32x2 d = e + 1.0f; f32x2 r; r[0] = __builtin_amdgcn_rcpf(d[0]); r[1] = __builtin_amdgcn_rcpf(d[1]);
                        o[n * 2 + hh] = (a * b) * r; }
                u32x4 w; w.x = cvt_pk_bf16(o[0][0], o[0][1]); w.y = cvt_pk_bf16(o[1][0], o[1][1]); w.z = cvt_pk_bf16(o[2][0], o[2][1]); w.w = cvt_pk_bf16(o[3][0], o[3][1]);
                stg16(rowp, w); asm volatile("" ::: "memory"); }
    }
};
using EpiSwiglu = EpiSwigluT<false>;
template <bool RS> struct EpiSwiglu8T {
    static constexpr bool PERM = true;
    unsigned char* H8; const float* rss = nullptr;
    __device__ __forceinline__ void operator()(const f32x4 (&acc)[2][2][4][2], const Unit& u, int wr, int wc, int fr, int fq) const {
        const int row0 = u.pm * 256 + wr * 64 + fr, col0 = u.pn * 128 + wc * 32 + 8 * fq;
#pragma unroll
        for (int ai = 0; ai < 2; ++ai)
#pragma unroll
            for (int m = 0; m < 4; ++m) { unsigned char* rowp = H8 + (size_t)(row0 + ai * 128 + m * 16) * FF + col0; const float rs_ = RS ? 0.03125f * rss_rstd(rss, row0 + ai * 128 + m * 16) : 0.03125f;
                f32x2 o[4];
#pragma unroll
                for (int n = 0; n < 2; ++n)
#pragma unroll
                    for (int hh = 0; hh < 2; ++hh) { const f32x4 a4 = acc[ai][0][m][n], b4 = acc[ai][1][m][n];
                        const f32x2 a = (hh ? (f32x2){a4[2], a4[3]} : (f32x2){a4[0], a4[1]}) * rs_, b = hh ? (f32x2){b4[2], b4[3]} : (f32x2){b4[0], b4[1]};
                        f32x2 e; e[0] = __builtin_amdgcn_exp2f(-a[0]); e[1] = __builtin_amdgcn_exp2f(-a[1]);
                        const f32x2 d = e + 1.0f; f32x2 r; r[0] = __builtin_amdgcn_rcpf(d[0]); r[1] = __builtin_amdgcn_rcpf(d[1]);
                        o[n * 2 + hh] = (a * (b * rs_)) * r; }
                u32x2 w; w.x = cvt4_fp8(o[0][0], o[0][1], o[1][0], o[1][1]); w.y = cvt4_fp8(o[2][0], o[2][1], o[3][0], o[3][1]);
                stg8(rowp, w); asm volatile("" ::: "memory"); }
    }
};
using EpiSwiglu8 = EpiSwiglu8T<false>;
template <int EMIT> struct EpiGluT {
    static constexpr bool PERM = false;
    const bf16* YA; const float* bglu; float* xf; unsigned char* hn = nullptr; float* rss = nullptr; LAS float* P = nullptr;
    __device__ __forceinline__ void operator()(const f32x4 (&acc)[2][2][4][2], const Unit& u, int wr, int wc, int fr, int fq) const {
        const int row0 = u.pm * 256 + wr * 64 + fr, col0 = u.pn * 256 + wc * 32 + 4 * fq;
        f32x4 bv[2][2];
#pragma unroll
        for (int bj = 0; bj < 2; ++bj)
#pragma unroll
            for (int n = 0; n < 2; ++n) bv[bj][n] = ldgf4(bglu + col0 + bj * 128 + n * 16);
#pragma unroll
        for (int ai = 0; ai < 2; ++ai)
#pragma unroll
            for (int mp = 0; mp < 2; ++mp) { f32x4 xs[2][2][2]; u32x2 yv[2][2][2];
#pragma unroll
                for (int mm = 0; mm < 2; ++mm) { const size_t off = (size_t)(row0 + ai * 128 + (2 * mp + mm) * 16) * D + col0;
#pragma unroll
                    for (int bj = 0; bj < 2; ++bj)
#pragma unroll
                        for (int n = 0; n < 2; ++n) { const size_t o2 = off + bj * 128 + n * 16; xs[mm][bj][n] = ldgf4(xf + o2); const int col_ = col0 + bj * 128 + n * 16, row_ = row0 + ai * 128 + (2 * mp + mm) * 16; yv[mm][bj][n] = ldg8(YA + ((size_t)(col_ >> 4) * T + row_) * 16 + (col_ & 15)); } }
#pragma unroll
                for (int mm = 0; mm < 2; ++mm) { const int m = 2 * mp + mm; const size_t off = (size_t)(row0 + ai * 128 + m * 16) * D + col0; float ss = 0.f;
#pragma unroll
                    for (int bj = 0; bj < 2; ++bj)
#pragma unroll
                        for (int n = 0; n < 2; ++n) { const size_t o2 = off + bj * 128 + n * 16; const f32x4 x_ = xs[mm][bj][n]; const u32x2 y_ = yv[mm][bj][n];
                            const f32x4 z = acc[ai][bj][m][n] + bv[bj][n]; f32x4 r;
                            r[0] = x_[0] + bflo(y_.x) * sigm(z[0]); r[1] = x_[1] + bfhi(y_.x) * sigm(z[1]); r[2] = x_[2] + bflo(y_.y) * sigm(z[2]); r[3] = x_[3] + bfhi(y_.y) * sigm(z[3]);
                            stgf4(xf + o2, r); if (EMIT) ss += emit_x<EMIT>(hn, o2, r); }
                    if (EMIT) { ss += __shfl_xor(ss, 16); ss += __shfl_xor(ss, 32); if (fq == 0) P[(ai * 128 + wr * 64 + m * 16 + fr) * 4 + wc] = ss; } }
                asm volatile("" ::: "memory"); }
        if (EMIT) emit_rss(P, rss, u);
    }
};
using EpiGlu = EpiGluT<0>;
struct EpiS5e {
    static constexpr bool PERM = false;
    float* EB;
    __device__ __forceinline__ void operator()(const f32x4 (&acc)[2][2][4][2], const Unit& u, int wr, int wc, int fr, int fq) const {
        const int row0 = u.aux * SNC + u.pm * 256 + wr * 64 + fr, col0 = wc * 32 + 4 * fq;
#pragma unroll
        for (int ai = 0; ai < 2; ++ai)
#pragma unroll
            for (int m = 0; m < 4; ++m) { float* rowp = EB + (size_t)(row0 + ai * 128 + m * 16) * 128 + col0;
#pragma unroll
                for (int n = 0; n < 2; ++n) stgf4(rowp + n * 16, acc[ai][0][m][n]); }
    }
};
struct EpiS5y {
    static constexpr bool PERM = true;
    const bf16* UP; const float* dsk; bf16* YA;
    __device__ __forceinline__ void operator()(const f32x4 (&acc)[2][2][4][2], const Unit& u, int wr, int wc, int fr, int fq) const {
        const int g = u.aux, row0 = u.pm * 256 + wr * 64 + fr;
#pragma unroll
        for (int bj = 0; bj < 2; ++bj) { const int cc = bj * 128 + wc * 32 + 8 * fq, tt = cc >> 4, i0 = cc & 15;
            const f32x4 d0 = ldgf4(dsk + g * 16 + i0), d1 = ldgf4(dsk + g * 16 + i0 + 4);
#pragma unroll
            for (int ai = 0; ai < 2; ++ai) { u32x4 uvv[4];
#pragma unroll
                for (int m = 0; m < 4; ++m) uvv[m] = ldg16(UP + ((size_t)g * SNC + (row0 + ai * 128 + m * 16)) * SK + cc);
#pragma unroll
                for (int m = 0; m < 4; ++m) { const int chunk = row0 + ai * 128 + m * 16;
                    const u32x4 uv = uvv[m];
                    const f32x4 v0 = acc[ai][bj][m][0], v1 = acc[ai][bj][m][1]; float o[8];
                    o[0] = gelu_tanh(v0[0] + d0[0] * bflo(uv.x)); o[1] = gelu_tanh(v0[1] + d0[1] * bfhi(uv.x)); o[2] = gelu_tanh(v0[2] + d0[2] * bflo(uv.y)); o[3] = gelu_tanh(v0[3] + d0[3] * bfhi(uv.y));
                    o[4] = gelu_tanh(v1[0] + d1[0] * bflo(uv.z)); o[5] = gelu_tanh(v1[1] + d1[1] * bfhi(uv.z)); o[6] = gelu_tanh(v1[2] + d1[2] * bflo(uv.w)); o[7] = gelu_tanh(v1[3] + d1[3] * bfhi(uv.w));
                    u32x4 w; w.x = cvt_pk_bf16(o[0], o[1]); w.y = cvt_pk_bf16(o[2], o[3]); w.z = cvt_pk_bf16(o[4], o[5]); w.w = cvt_pk_bf16(o[6], o[7]);
                    stg16(YA + ((size_t)g * T + (size_t)(chunk * SL + tt)) * 16 + i0, w); }
                asm volatile("" ::: "memory"); } }
    }
};
struct EpiSbuild {
    static constexpr bool PERM = true;
    bf16* SMp; float* DENP; const float* GS; const float* MC;
    __device__ __forceinline__ void operator()(const f32x4 (&acc)[2][2][4][2], const Unit& u, int wr, int wc, int fr, int fq) const {
        const int ch = u.pm, h = u.pn, ch_h = u.aux; const float mc = ldgf(MC + h * 80 + ch);
        float rs[2][4];
#pragma unroll
        for (int ai = 0; ai < 2; ++ai)
#pragma unroll
            for (int m = 0; m < 4; ++m) rs[ai][m] = 0.f;
#pragma unroll
        for (int bj = 0; bj < 2; ++bj) { const int s0 = bj * 128 + wc * 32 + 8 * fq; float w[8];
            { const f32x4 g0 = ldgf4(GS + (size_t)h * T + ch * MCH + s0), g1 = ldgf4(GS + (size_t)h * T + ch * MCH + s0 + 4);
#pragma unroll
              for (int j = 0; j < 4; ++j) { w[j] = __expf(g0[j] - mc); w[4 + j] = __expf(g1[j] - mc); } }
#pragma unroll
            for (int ai = 0; ai < 2; ++ai)
#pragma unroll
                for (int m = 0; m < 4; ++m) { const int r = ai * 128 + wr * 64 + m * 16 + fr; float o[8];
#pragma unroll
                    for (int n = 0; n < 2; ++n)
#pragma unroll
                        for (int j = 0; j < 4; ++j) { const int s = s0 + n * 4 + j; o[n * 4 + j] = (s <= r) ? acc[ai][bj][m][n][j] * w[n * 4 + j] : 0.f; }
                    u32x4 pk; pk.x = cvt_pk_bf16(o[0], o[1]); pk.y = cvt_pk_bf16(o[2], o[3]); pk.z = cvt_pk_bf16(o[4], o[5]); pk.w = cvt_pk_bf16(o[6], o[7]);
                    rs[ai][m] += (bflo(pk.x) + bfhi(pk.x)) + (bflo(pk.y) + bfhi(pk.y)) + (bflo(pk.z) + bfhi(pk.z)) + (bflo(pk.w) + bfhi(pk.w));
                    stg16(SMp + ((size_t)ch_h * MCH + r) * MCH + s0, pk); asm volatile("" ::: "memory"); } }
#pragma unroll
        for (int ai = 0; ai < 2; ++ai)
#pragma unroll
            for (int m = 0; m < 4; ++m) { const int r = ai * 128 + wr * 64 + m * 16 + fr; float v = rs[ai][m]; v += __shfl_xor(v, 16); v += __shfl_xor(v, 32);
                if (fq == 0) stgf(DENP + ((size_t)ch_h * MCH + r) * 4 + wc, v); }
    }
};
struct EpiNum {
    static constexpr bool PERM = true;
    bf16* NUM; const float* RMT; const float* MC;
    __device__ __forceinline__ void operator()(const f32x4 (&acc)[2][2][4][2], const Unit& u, int wr, int wc, int fr, int fq) const {
        const int ch = u.pm, h = u.pn >> 1, eh = u.pn & 1; const float mc = ldgf(MC + h * 80 + ch);
        const int col0 = h * HD + eh * 256 + wc * 32 + 8 * fq;
        float rmv[2][4];
#pragma unroll
        for (int ai = 0; ai < 2; ++ai)
#pragma unroll
            for (int m = 0; m < 4; ++m) rmv[ai][m] = ldgf(RMT + (size_t)h * T + ch * MCH + ai * 128 + wr * 64 + m * 16 + fr);
#pragma unroll
        for (int ai = 0; ai < 2; ++ai)
#pragma unroll
            for (int m = 0; m < 4; ++m) { const int t = ch * MCH + ai * 128 + wr * 64 + m * 16 + fr; const float sc = __expf(mc - rmv[ai][m]);
                bf16* rowp = NUM + (size_t)t * MI + col0;
#pragma unroll
                for (int bj = 0; bj < 2; ++bj) { const f32x4 v0 = acc[ai][bj][m][0] * sc, v1 = acc[ai][bj][m][1] * sc;
                    u32x4 w; w.x = cvt_pk_bf16(v0[0], v0[1]); w.y = cvt_pk_bf16(v0[2], v0[3]); w.z = cvt_pk_bf16(v1[0], v1[1]); w.w = cvt_pk_bf16(v1[2], v1[3]);
                    stg16(rowp + bj * 128, w); }
                asm volatile("" ::: "memory"); }
    }
};
struct ConvItem { const float* W; bf16* WT; int ldw, ldt, k0, n0, drow0; float scale; int f8; const float* kg; };
__device__ __forceinline__ void tr_load(const ConvItem& d, f32x2 (&v)[33], int lane) {
    const int hrow = lane >> 5, cl = lane & 31; const unsigned voff = (unsigned)(hrow * d.ldw + 2 * cl) * 4u;
    const char* rb = (const char*)(d.W + (size_t)d.k0 * d.ldw + d.n0); const size_t rstep = (size_t)d.ldw * 8;
#pragma unroll
    for (int i = 0; i < 32; ++i) v[i] = *(const GAS f32x2*)(rb + (size_t)i * rstep + voff);
    v[32][0] = d.kg ? ldgf(d.kg + d.k0 + lane) : 1.0f; v[32][1] = 0.f;
}
__device__ __forceinline__ float tr_scale(const ConvItem& d, const f32x2 (&v)[33], int i, int hrow) {
    const int gi = __float_as_int(v[32][0]); const float g0 = __int_as_float(__builtin_amdgcn_readlane(gi, 2 * i)), g1 = __int_as_float(__builtin_amdgcn_readlane(gi, 2 * i + 1)); return d.scale * (hrow ? g1 : g0);
}
__device__ __forceinline__ void tr_store8(const ConvItem& d, const f32x2 (&v)[33], LAS float* scr, int lane) {
    LAS unsigned char* tile = (LAS unsigned char*)scr; constexpr int TS8 = 68;
    const int hrow = lane >> 5, cl = lane & 31;
#pragma unroll
    for (int i = 0; i < 32; ++i) { const float s_ = tr_scale(d, v, i, hrow); *(LAS unsigned short*)(tile + (2 * i + hrow) * TS8 + cl * 2) = (unsigned short)__builtin_amdgcn_cvt_pk_fp8_f32(v[i][0] * s_, v[i][1] * s_, 0, false); }
    LDS_WAIT(); asm volatile("" ::: "memory");
    const int c = lane & 7;
#pragma unroll
    for (int j = 0; j < 8; ++j) { const int n = (lane >> 3) + 8 * j; const LAS unsigned char* sp = tile + (8 * c) * TS8 + n;
        u32x2 o; o.x = (unsigned)sp[0 * TS8] | ((unsigned)sp[1 * TS8] << 8) | ((unsigned)sp[2 * TS8] << 16) | ((unsigned)sp[3 * TS8] << 24);
        o.y = (unsigned)sp[4 * TS8] | ((unsigned)sp[5 * TS8] << 8) | ((unsigned)sp[6 * TS8] << 16) | ((unsigned)sp[7 * TS8] << 24);
        stg8((unsigned char*)d.WT + (size_t)(d.drow0 + n) * d.ldt + d.k0 + 8 * c, o); }
    LDS_WAIT(); asm volatile("" ::: "memory");
}
__device__ __forceinline__ void tr_store(const ConvItem& d, const f32x2 (&v)[33], LAS float* scr, int lane) {
    if (d.f8) { tr_store8(d, v, scr, lane); return; }
    LAS unsigned char* tile = (LAS unsigned char*)scr; constexpr int TS = 132;
    const int hrow = lane >> 5, cl = lane & 31;
#pragma unroll
    for (int i = 0; i < 32; ++i) { const float s_ = tr_scale(d, v, i, hrow); *(LAS unsigned*)(tile + (2 * i + hrow) * TS + cl * 4) = cvt_pk_bf16(v[i][0] * s_, v[i][1] * s_); }
    LDS_WAIT(); asm volatile("" ::: "memory");
    const int c = lane & 7;
#pragma unroll
    for (int j = 0; j < 8; ++j) { const int n = (lane >> 3) + 8 * j; const LAS bf16* sp = (const LAS bf16*)(tile + (8 * c) * TS) + n;
        u32x4 o; o.x = (unsigned)sp[0 * (TS / 2)] | ((unsigned)sp[1 * (TS / 2)] << 16); o.y = (unsigned)sp[2 * (TS / 2)] | ((unsigned)sp[3 * (TS / 2)] << 16);
        o.z = (unsigned)sp[4 * (TS / 2)] | ((unsigned)sp[5 * (TS / 2)] << 16); o.w = (unsigned)sp[6 * (TS / 2)] | ((unsigned)sp[7 * (TS / 2)] << 16);
        stg16(d.WT + (size_t)(d.drow0 + n) * d.ldt + d.k0 + 8 * c, o); }
    LDS_WAIT(); asm volatile("" ::: "memory");
}
__device__ __forceinline__ ConvItem conv_desc(const float* W, int K, int N, bf16* WT, int ldt, int mode, int it) {
    const int nblk = N / 64, kb = it / nblk, nb_ = it % nblk, n0 = nb_ * 64;
    ConvItem d; d.W = W; d.WT = WT; d.ldw = N; d.ldt = ldt; d.k0 = kb * 64; d.n0 = n0; d.drow0 = (mode == 0 || mode == 3) ? n0 : ((n0 >> 7) * 256 + (n0 & 127) + (mode == 2 ? 128 : 0));
    d.scale = (mode == 1 || mode == 3) ? 1.4426950408889634f : (mode == 2) ? 0.6931471805599453f : 1.0f;
    d.f8 = 0; d.kg = nullptr; return d;
}
__device__ __forceinline__ ConvItem conv_desc8(const float* W, int K, int N, unsigned char* WT, int mode, int it) {
    ConvItem d = conv_desc(W, K, N, (bf16*)WT, K, mode, it); d.f8 = 1;
    d.scale = (mode == 1) ? 32.0f * 1.4426950408889634f : (mode == 2) ? 32.0f * 0.6931471805599453f : 64.0f; return d;
}
__device__ __forceinline__ void conv_item(const float* W, int K, int N, bf16* WT, int ldt, int mode, int it, LAS float* scr, int lane) {
    const ConvItem d = conv_desc(W, K, N, WT, ldt, mode, it); f32x2 v[33]; tr_load(d, v, lane); tr_store(d, v, scr, lane);
}
__device__ __forceinline__ void conv_mat(const float* W, int K, int N, bf16* WT, int ldt, int mode, int gw, int NGW, LAS float* scr, int lane) {
    const int items = (K / 64) * (N / 64);
    int it = gw; if (it >= items) return;
    f32x2 va[33], vb[33]; ConvItem da = conv_desc(W, K, N, WT, ldt, mode, it), db = da; tr_load(da, va, lane);
    for (;;) {
        const int i1 = it + NGW; if (i1 < items) { db = conv_desc(W, K, N, WT, ldt, mode, i1); tr_load(db, vb, lane); }
        tr_store(da, va, scr, lane); if (i1 >= items) break;
        const int i2 = i1 + NGW; if (i2 < items) { da = conv_desc(W, K, N, WT, ldt, mode, i2); tr_load(da, va, lane); }
        tr_store(db, vb, scr, lane); if (i2 >= items) break;
        it = i2;
    }
}
__device__ __forceinline__ void conv_dense(const Args& a, int f, int gw, int NGW, LAS float* scr, int lane) {
    bf16* W13 = (bf16*)(a.ws + (f ? WS_WD1_13 : WS_W13)); bf16* W2T = (bf16*)(a.ws + (f ? WS_WD1_2 : WS_W2T));
    conv_mat(a.in[I_F_W1] + (size_t)f * D * FF, D, FF, W13, D, 1, gw, NGW, scr, lane);
    conv_mat(a.in[I_F_W3] + (size_t)f * D * FF, D, FF, W13, D, 2, gw, NGW, scr, lane);
    conv_mat(a.in[I_F_W2] + (size_t)f * D * FF, FF, D, W2T, FF, 0, gw, NGW, scr, lane);
}
__device__ __forceinline__ ConvItem moe_desc(const Args& a, int f, int idx) {
    constexpr int I1 = (D / 64) * (FF / 64), I2 = (FF / 64) * (D / 64), PER = 2 * I1 + I2;
    const int e = idx / PER, r = idx % PER; const size_t wo = ((size_t)f * NE + e) * D * FF;
    if (MOE_F8(f)) {
        unsigned char* W13 = a.ws + WS_W13 + (size_t)e * (W13_BYTES / 2); unsigned char* W2T = a.ws + WS_W2T8 + (size_t)e * (W2_BYTES / 2);
        if (r < I1) return conv_desc8(a.in[I_E_W1] + wo, D, FF, W13, 1, r);
        if (r < 2 * I1) return conv_desc8(a.in[I_E_W3] + wo, D, FF, W13, 2, r - I1);
        return conv_desc8(a.in[I_E_W2] + wo, FF, D, W2T, 0, r - 2 * I1); }
    bf16* W13 = (bf16*)(a.ws + WS_W13 + (size_t)e * W13_BYTES); bf16* W2T = (bf16*)(a.ws + WS_W2T + (size_t)e * W2_BYTES);
    if (r < I1) return conv_desc(a.in[I_E_W1] + wo, D, FF, W13, D, 1, r);
    if (r < 2 * I1) return conv_desc(a.in[I_E_W3] + wo, D, FF, W13, D, 2, r - I1);
    return conv_desc(a.in[I_E_W2] + wo, FF, D, W2T, FF, 0, r - 2 * I1);
}
__device__ __forceinline__ void conv_moe(const Args& a, int f, int gw, int NGW, LAS float* scr, int lane) {
    constexpr int I1 = (D / 64) * (FF / 64), I2 = (FF / 64) * (D / 64), PER = 2 * I1 + I2, items = NE * PER;
    int it = gw; if (it >= items) return;
    f32x2 va[33], vb[33]; ConvItem da = moe_desc(a, f, it), db = da; tr_load(da, va, lane);
    for (;;) {
        const int i1 = it + NGW; if (i1 < items) { db = moe_desc(a, f, i1); tr_load(db, vb, lane); }
        tr_store(da, va, scr, lane); if (i1 >= items) break;
        const int i2 = i1 + NGW; if (i2 < items) { da = moe_desc(a, f, i2); tr_load(da, va, lane); }
        tr_store(db, vb, scr, lane); if (i2 >= items) break;
        it = i2;
    }
}
enum { DQ_DENSE0 = 0, DQ_B, DQ_C, DQ_DENSE1, DQ_A1, DQ_MOE1, DQ_NG };
constexpr int DQ_I = (D / 64) * (FF / 64);
__device__ __forceinline__ int dq_size(int g) { return g == DQ_DENSE0 || g == DQ_DENSE1 ? 3 * DQ_I : g == DQ_B ? 1024 + 512 : g == DQ_C ? 256 : g == DQ_A1 ? 640 + 320 + 80 : NE * 3 * DQ_I; }
__device__ __forceinline__ ConvItem dq_desc0(const Args& a, int g, int idx) {
    if (g == DQ_DENSE0 || g == DQ_DENSE1) { const int f = (g == DQ_DENSE1) ? 1 : 0, m = idx / DQ_I, it = idx % DQ_I;
        if (DENSE_F8(f)) { unsigned char* W13 = a.ws + (f ? WS_WD1_13 : WS_W13); unsigned char* W2T = a.ws + (f ? WS_WD1_2 : WS_W2T);
            if (m == 0) return conv_desc8(a.in[I_F_W1] + (size_t)f * D * FF, D, FF, W13, 1, it);
            if (m == 1) return conv_desc8(a.in[I_F_W3] + (size_t)f * D * FF, D, FF, W13, 2, it);
            return conv_desc8(a.in[I_F_W2] + (size_t)f * D * FF, FF, D, W2T, 0, it); }
        bf16* W13 = (bf16*)(a.ws + (f ? WS_WD1_13 : WS_W13)); bf16* W2T = (bf16*)(a.ws + (f ? WS_WD1_2 : WS_W2T));
        if (m == 0) return conv_desc(a.in[I_F_W1] + (size_t)f * D * FF, D, FF, W13, D, 1, it);
        if (m == 1) return conv_desc(a.in[I_F_W3] + (size_t)f * D * FF, D, FF, W13, D, 2, it);
        return conv_desc(a.in[I_F_W2] + (size_t)f * D * FF, FF, D, W2T, FF, 0, it); }
    if (g == DQ_B) { if (idx < 1024) return conv_desc(a.in[I_B_W_IN], D, 2 * MI, (bf16*)(a.ws + WS_WB_IN), D, 0, idx);
        return conv_desc(a.in[I_B_W_OUT], MI, D, (bf16*)(a.ws + WS_WB_OUT), MI, 0, idx - 1024); }
    if (g == DQ_C) return conv_desc(a.in[I_C_W_GLU], D, D, (bf16*)(a.ws + WS_WC_GLU), D, 0, idx);
    if (g == DQ_A1) { if (idx < 640) { if (RG_F8(1)) return conv_desc8(a.in[I_A_W_IN] + (size_t)D * 2 * RW, D, 2 * RW, a.ws + WS_WA_IN + (size_t)2 * RW * D * 2, 0, idx);
            return conv_desc(a.in[I_A_W_IN] + (size_t)D * 2 * RW, D, 2 * RW, (bf16*)(a.ws + WS_WA_IN) + (size_t)2 * RW * D, D, 0, idx); }
        if (idx < 960) return conv_desc(a.in[I_A_W_OUT] + (size_t)RW * D, RW, D, (bf16*)(a.ws + WS_WA_OUT) + (size_t)D * RW, RW, 0, idx - 640);
        const int it = idx - 960, n = it / 8, r = it % 8, which = r / 4, q = r % 4;
        return conv_desc(a.in[which ? I_A_W_I : I_A_W_R] + ((size_t)RNB + n) * RBD * RBD, RBD, RBD, (bf16*)(a.ws + WS_WA_G) + ((size_t)RNB + n) * 256 * RBD + (size_t)which * 128 * RBD, RBD, 3, q); }
    return moe_desc(a, 1, idx);
}
__device__ __forceinline__ ConvItem dq_desc(const Args& a, int g, int idx) {
    ConvItem d = dq_desc0(a, g, idx);
#if DEFER_NORM
    if ((g == DQ_DENSE0 || g == DQ_DENSE1) && idx < 2 * DQ_I) d.kg = a.in[I_NORM_FFN] + (g == DQ_DENSE1 ? 2 : 0) * D;
    if (g == DQ_B && idx < 1024) d.kg = a.in[I_NORM_MIX] + 1 * D;
    if (g == DQ_A1 && idx < 640) d.kg = a.in[I_NORM_MIX] + 3 * D;
#endif
    return d;
}
__device__ __forceinline__ unsigned* dq_cursor(const Args& a, int g) { return (unsigned*)(a.ws + WS_CTL) + CW_DQ + 64 * g; }
__device__ __forceinline__ int dq_left(const Args& a, int g) { const int c = (int)__hip_atomic_load(dq_cursor(a, g), __ATOMIC_RELAXED, __HIP_MEMORY_SCOPE_AGENT), s = dq_size(g); return c >= s ? 0 : s - c; }
__device__ __forceinline__ void dq_work(const Args& a, int g_lo, int g_hi, int quota, LAS unsigned char* lds, LAS float* scr) {
    const int tid = otid(), lane = tid & 63, wave = tid >> 6; volatile LAS int* slot = (volatile LAS int*)(lds + MISC_OFF + 16);
    int done = 0;
    if (quota == -2) {
        __syncthreads(); if (tid == 0) *slot = (dq_left(a, g_lo) + 16 * (int)gridDim.x - 1) / (16 * (int)gridDim.x); __syncthreads(); quota = *slot; }
    for (int g = g_lo; g <= g_hi; ++g) {
        const int size = dq_size(g);
        for (;;) {
            if (quota >= 0 && done >= quota) return;
            __syncthreads();
            if (tid == 0) { int base = size; if (dq_left(a, g) > 0) base = (int)__hip_atomic_fetch_add(dq_cursor(a, g), 16u, __ATOMIC_RELAXED, __HIP_MEMORY_SCOPE_AGENT); *slot = base; }
            __syncthreads();
            const int base = *slot; if (base >= size) break;
            const int i0 = base + wave * 2, i1 = i0 + 1; ++done;
            if (i0 < size) { f32x2 va[33], vb[33]; const ConvItem da = dq_desc(a, g, i0); tr_load(da, va, lane);
                if (i1 < size) { const ConvItem db = dq_desc(a, g, i1); tr_load(db, vb, lane); tr_store(da, va, scr, lane); tr_store(db, vb, scr, lane); }
                else tr_store(da, va, scr, lane); }
        }
    }
}
__device__ __forceinline__ void conv_a(const Args& a, int j, int gw, int NGW, LAS float* scr, int lane) {
    conv_mat(a.in[I_A_W_IN] + (size_t)j * D * 2 * RW, D, 2 * RW, (bf16*)(a.ws + WS_WA_IN) + (size_t)j * 2 * RW * D, D, 0, gw, NGW, scr, lane);
    conv_mat(a.in[I_A_W_OUT] + (size_t)j * RW * D, RW, D, (bf16*)(a.ws + WS_WA_OUT) + (size_t)j * D * RW, RW, 0, gw, NGW, scr, lane);
    for (int it = gw; it < RNB * 2 * 4; it += NGW) { const int n = it / 8, r = it % 8, which = r / 4, q = r % 4;
        const float* W = a.in[which ? I_A_W_I : I_A_W_R] + ((size_t)j * RNB + n) * RBD * RBD;
        bf16* WT = (bf16*)(a.ws + WS_WA_G) + ((size_t)j * RNB + n) * 256 * RBD + (size_t)which * 128 * RBD;
        conv_item(W, RBD, RBD, WT, RBD, 3, q, scr, lane); }
}
__device__ __forceinline__ void conv_perm(const Args& a, int gw, int NGW, LAS float* scr, int lane) {
    for (int j = 0; j < 2; ++j) {
        conv_mat(a.in[I_A_W_IN] + (size_t)j * D * 2 * RW, D, 2 * RW, (bf16*)(a.ws + WS_WA_IN) + (size_t)j * 2 * RW * D, D, 0, gw, NGW, scr, lane);
        conv_mat(a.in[I_A_W_OUT] + (size_t)j * RW * D, RW, D, (bf16*)(a.ws + WS_WA_OUT) + (size_t)j * D * RW, RW, 0, gw, NGW, scr, lane);
        for (int it = gw; it < RNB * 2 * 4; it += NGW) { const int n = it / 8, r = it % 8, which = r / 4, q = r % 4;
            const float* W = a.in[which ? I_A_W_I : I_A_W_R] + ((size_t)j * RNB + n) * RBD * RBD;
            bf16* WT = (bf16*)(a.ws + WS_WA_G) + ((size_t)j * RNB + n) * 256 * RBD + (size_t)which * 128 * RBD;
            conv_item(W, RBD, RBD, WT, RBD, 3, q, scr, lane); }
    }
    conv_mat(a.in[I_B_W_IN], D, 2 * MI, (bf16*)(a.ws + WS_WB_IN), D, 0, gw, NGW, scr, lane);
    conv_mat(a.in[I_B_W_OUT], MI, D, (bf16*)(a.ws + WS_WB_OUT), MI, 0, gw, NGW, scr, lane);
    conv_mat(a.in[I_C_W_GLU], D, D, (bf16*)(a.ws + WS_WC_GLU), D, 0, gw, NGW, scr, lane);
}
__device__ __forceinline__ void s5_mats(const Args& a, LAS unsigned char* lds, int bid, int nb) {
    LAS float* lre = (LAS float*)lds; LAS float* lim = lre + 17 * 64; LAS float* bre = lim + 17 * 64; LAS float* bim = bre + 1024; LAS float* cre = bim + 1024; LAS float* cim = cre + 1024; LAS float* Kt = cim + 1024;
    const int tid = otid();
    for (int gq = bid; gq < NG * 4; gq += nb) {
        const int g = gq >> 2, q4 = gq & 3;
        __syncthreads();
        if (tid < 64) { const int p = tid; const float are = ldgf(a.in[I_C_A_RE] + g * 64 + p), aim = ldgf(a.in[I_C_A_IM] + g * 64 + p), dl = __expf(ldgf(a.in[I_C_LOG_STEP] + g));
            for (int tau = 0; tau <= 16; ++tau) { const float mag = __expf((float)tau * dl * are); float sn, cs; sincosf((float)tau * dl * aim, &sn, &cs); lre[tau * 64 + p] = mag * cs; lim[tau * 64 + p] = mag * sn; }
            const float mag = __expf(dl * are); float sn, cs; sincosf(dl * aim, &sn, &cs);
            const float nr = mag * cs - 1.0f, ni = mag * sn, den = are * are + aim * aim, fr_ = (nr * are + ni * aim) / den, fi_ = (ni * are - nr * aim) / den;
            for (int j = 0; j < 16; ++j) { const float br = ldgf(a.in[I_C_B_RE] + ((size_t)g * 64 + p) * 16 + j), bi = ldgf(a.in[I_C_B_IM] + ((size_t)g * 64 + p) * 16 + j);
                bre[p * 16 + j] = fr_ * br - fi_ * bi; bim[p * 16 + j] = fr_ * bi + fi_ * br; } }
        for (int i = tid; i < 1024; i += NTHR) { cre[i] = ldgf(a.in[I_C_C_RE] + (size_t)g * 1024 + i); cim[i] = ldgf(a.in[I_C_C_IM] + (size_t)g * 1024 + i); }
        __syncthreads();
        for (int o = tid; o < 4096; o += NTHR) { const int tau = o >> 8, i = (o >> 4) & 15, j = o & 15; float s = 0.f;
            for (int p = 0; p < 64; ++p) { const float cr = cre[i * 64 + p], ci = cim[i * 64 + p], lr = lre[tau * 64 + p], li = lim[tau * 64 + p], xr = cr * lr - ci * li, xi = cr * li + ci * lr;
                s += xr * bre[p * 16 + j] - xi * bim[p * 16 + j]; }
            Kt[o] = s; }
        __syncthreads();
        bf16* KC = (bf16*)(a.ws + WS_S5_KC) + (size_t)g * 256 * SK; bf16* BE = (bf16*)(a.ws + WS_S5_BE) + (size_t)g * 256 * 256;
        for (int o = tid; o < 64 * (SK / 8); o += NTHR) { const int n = q4 * 64 + o / (SK / 8), k0 = (o % (SK / 8)) * 8, tt = n >> 4, i = n & 15; float v[8];
#pragma unroll
            for (int q = 0; q < 8; ++q) { const int k = k0 + q;
                if (k < 256) { const int s = k >> 4, j = k & 15; v[q] = (s <= tt) ? Kt[((tt - s) << 8) + (i << 4) + j] : 0.f; }
                else { const int p = (k - 256) & 63, im = (k - 256) >> 6; const float cr = cre[i * 64 + p], ci = cim[i * 64 + p], lr = lre[(tt + 1) * 64 + p], li = lim[(tt + 1) * 64 + p];
                    v[q] = im ? -(cr * li + ci * lr) : (cr * lr - ci * li); } }
            u32x4 w; w.x = cvt_pk_bf16(v[0], v[1]); w.y = cvt_pk_bf16(v[2], v[3]); w.z = cvt_pk_bf16(v[4], v[5]); w.w = cvt_pk_bf16(v[6], v[7]);
            stg16(KC + (size_t)n * SK + k0, w); }
        for (int o = tid; o < 64 * 32; o += NTHR) { const int n = q4 * 64 + (o >> 5), k0 = (o & 31) * 8; float v[8];
#pragma unroll
            for (int q = 0; q < 8; ++q) { const int k = k0 + q, s = k >> 4, j = k & 15;
                if (n < 128) { const int p = n & 63, im = n >> 6; const float lr = lre[(15 - s) * 64 + p], li = lim[(15 - s) * 64 + p], br = bre[p * 16 + j], bi = bim[p * 16 + j];
                    v[q] = im ? (lr * bi + li * br) : (lr * br - li * bi); } else v[q] = 0.f; }
            u32x4 w; w.x = cvt_pk_bf16(v[0], v[1]); w.y = cvt_pk_bf16(v[2], v[3]); w.z = cvt_pk_bf16(v[4], v[5]); w.w = cvt_pk_bf16(v[6], v[7]);
            stg16(BE + (size_t)n * 256 + k0, w); }
    }
    __syncthreads();
}

__device__ __forceinline__ void moe_prefix(const Args& a, int f, int (&ps)[NE], int& P, int (&cnt)[NE]) {
    const unsigned* gc = (const unsigned*)(a.ws + WS_CTL) + CW_MOE + f * 1024; int acc = 0;
#pragma unroll
    for (int e = 0; e < NE; ++e) { ps[e] = acc; const int c = __builtin_amdgcn_readfirstlane((int)__hip_atomic_load(gc + e * 64, __ATOMIC_RELAXED, __HIP_MEMORY_SCOPE_AGENT)); cnt[e] = c; acc += (c + 255) >> 8; }
    P = acc;
}
template <bool COMBINE, bool ROUTER, int OUTMODE>
__device__ __forceinline__ void ph_norm(const Args& a, LAS unsigned char* lds, int bid, int nb, const float* xsrc, float* xf, const float* gain, int f) {
    const int tid = otid(), lane = tid & 63, wave = tid >> 6;
    const int RPB = T / nb;
    LAS float* rt = (LAS float*)lds; LAS int* sel = (LAS int*)(lds + 32768); LAS int* rnk = (LAS int*)(lds + 32768 + 1024); LAS int* bases = (LAS int*)(lds + 32768 + 2048); LAS int* dstl = (LAS int*)(lds + 32768 + 3072); LAS unsigned char* rows8 = lds + 36864;
    if (ROUTER) {
        const float* router = a.in[I_E_ROUTER] + (size_t)f * D * NE;
        for (int i = tid; i < D * NE; i += NTHR) rt[(i & 7) * D + (i >> 3)] = ldgf(router + i);
        __syncthreads();
    }
    f32x4 gv[4];
#pragma unroll
    for (int j = 0; j < 4; ++j) gv[j] = ldgf4(gain + 4 * lane + 256 * j);
    bf16* HN = (bf16*)(a.ws + WS_HN); bf16* UP = (bf16*)(a.ws + WS_UP);
    const bf16* OUTB = (const bf16*)(a.ws + WS_OUT); const bf16* OUTA = (const bf16*)(a.ws + WS_AG); float* TOPW = (float*)(a.ws + WS_TOPW); int* TOPI = (int*)(a.ws + WS_TOPI);
    int cps[NE], cP = 0, ccnt[NE];
    if (COMBINE) moe_prefix(a, f, cps, cP, ccnt);
#pragma unroll 1
    for (int lr0 = wave; lr0 < RPB; lr0 += NWAVES * 4) {
      f32x4 vv[4][4];
#pragma unroll
      for (int k_ = 0; k_ < 4; ++k_) { const int lrk = (lr0 + k_ * NWAVES < RPB) ? lr0 + k_ * NWAVES : lr0;
#pragma unroll
        for (int j = 0; j < 4; ++j) vv[k_][j] = ldgf4(xsrc + (size_t)(bid * RPB + lrk) * D + 4 * lane + 256 * j); }
#pragma unroll
      for (int k_ = 0; k_ < 4; ++k_) { const int lr = lr0 + k_ * NWAVES; if (lr < RPB) {
        const int row = bid * RPB + lr;
        f32x4 (&v)[4] = vv[k_];
        if (COMBINE) {
            const int t1 = ldgi(TOPI + row * 2), t2 = ldgi(TOPI + row * 2 + 1); const int e1 = t1 >> 16, e2 = t2 >> 16; int s1 = 0, s2 = 0;
#pragma unroll
            for (int e = 0; e < NE; ++e) { s1 = (e1 == e) ? cps[e] : s1; s2 = (e2 == e) ? cps[e] : s2; }
            const int r1 = s1 * 256 + (t1 & 0xffff), r2 = s2 * 256 + (t2 & 0xffff); const float p1 = ldgf(TOPW + row * 2), p2 = ldgf(TOPW + row * 2 + 1);
#pragma unroll
            for (int j = 0; j < 4; ++j) { const bool one_buf = MOE_F8(f) != 0;
                const u32x2 o1 = ldg8(OUTA + (size_t)r1 * D + 4 * lane + 256 * j), o2 = ldg8(OUTA + (size_t)r2 * D + 4 * lane + 256 * j);
                u32x2 q1 = (u32x2){0u, 0u}, q2 = (u32x2){0u, 0u};
                if (!one_buf) { q1 = ldg8(OUTB + (size_t)r1 * D + 4 * lane + 256 * j); q2 = ldg8(OUTB + (size_t)r2 * D + 4 * lane + 256 * j); }
                v[j][0] += p1 * (bflo(o1.x) + bflo(q1.x)) + p2 * (bflo(o2.x) + bflo(q2.x)); v[j][1] += p1 * (bfhi(o1.x) + bfhi(q1.x)) + p2 * (bfhi(o2.x) + bfhi(q2.x));
                v[j][2] += p1 * (bflo(o1.y) + bflo(q1.y)) + p2 * (bflo(o2.y) + bflo(q2.y)); v[j][3] += p1 * (bfhi(o1.y) + bfhi(q1.y)) + p2 * (bfhi(o2.y) + bfhi(q2.y));
                if (OUTMODE != 2) stgf4(xf + (size_t)row * D + 4 * lane + 256 * j, v[j]); }
        }
        float s2 = 0.f;
#pragma unroll
        for (int j = 0; j < 4; ++j) s2 += (v[j][0] * v[j][0] + v[j][1] * v[j][1]) + (v[j][2] * v[j][2] + v[j][3] * v[j][3]);
        const float rstd = __builtin_amdgcn_rsqf(wave_sum(s2) * (1.0f / D) + EPS);
#pragma unroll
        for (int j = 0; j < 4; ++j) v[j] = v[j] * rstd * gv[j];
        if (OUTMODE == 0) {
#pragma unroll
            for (int j = 0; j < 4; ++j) { u32x2 w; w.x = cvt_pk_bf16(v[j][0], v[j][1]); w.y = cvt_pk_bf16(v[j][2], v[j][3]); stg8(HN + (size_t)row * D + 4 * lane + 256 * j, w); }
        } else if (OUTMODE == 3) {
            if (ROUTER) {
#pragma unroll
                for (int j = 0; j < 4; ++j) *(LAS int*)(rows8 + lr * D + 4 * lane + 256 * j) = (int)cvt4_fp8(v[j][0], v[j][1], v[j][2], v[j][3]);
            } else {
#pragma unroll
                for (int j = 0; j < 4; ++j) stgi((unsigned char*)HN + (size_t)row * D + 4 * lane + 256 * j, (int)cvt4_fp8(v[j][0], v[j][1], v[j][2], v[j][3]));
            }
        } else if (OUTMODE == 1) {
            const int chunk = row >> 4, s = row & 15;
#pragma unroll
            for (int j = 0; j < 4; ++j) { const int g = (lane >> 2) + 16 * j, i0 = 4 * (lane & 3); u32x2 w; w.x = cvt_pk_bf16(v[j][0], v[j][1]); w.y = cvt_pk_bf16(v[j][2], v[j][3]);
                stg8(UP + ((size_t)g * SNC + chunk) * SK + s * 16 + i0, w); }
        } else {
#pragma unroll
            for (int j = 0; j < 4; ++j) stgf4(a.out + (size_t)row * D + 4 * lane + 256 * j, v[j]);
        }
      } }
      if (ROUTER) {
          float x[32];
#pragma unroll
          for (int i = 0; i < 32; ++i) x[i] = 0.f;
#pragma unroll
          for (int e = 0; e < NE; ++e)
#pragma unroll
              for (int j = 0; j < 4; ++j) { const f32x4 r = *(const LAS f32x4*)(rt + e * D + 4 * lane + 256 * j);
#pragma unroll
                  for (int k_ = 0; k_ < 4; ++k_) x[k_ * 8 + e] += (vv[k_][j][0] * r[0] + vv[k_][j][1] * r[1]) + (vv[k_][j][2] * r[2] + vv[k_][j][3] * r[3]);
                  if (j & 1) asm volatile("" ::: "memory"); }
#define RS_STEP(HB) { const bool up_ = (lane & (2 * (HB))) != 0; _Pragma("unroll") for (int i = 0; i < (HB); ++i) { const float send = up_ ? x[i] : x[i + (HB)], keep = up_ ? x[i + (HB)] : x[i]; x[i] = keep + __shfl_xor(send, 2 * (HB)); } }
          RS_STEP(16) RS_STEP(8) RS_STEP(4) RS_STEP(2) RS_STEP(1)
#undef RS_STEP
          const float z = x[0] + __shfl_xor(x[0], 1);
          float rb[NE];
#pragma unroll
          for (int e = 0; e < NE; ++e) rb[e] = ldgf(a.in[I_E_ROUTER_B] + f * NE + e);
#pragma unroll
          for (int k_ = 0; k_ < 4; ++k_) { const int lr = lr0 + k_ * NWAVES; if (lr < RPB) { const int row = bid * RPB + lr;
              float lg[NE];
#pragma unroll
              for (int e = 0; e < NE; ++e) lg[e] = __int_as_float(__builtin_amdgcn_readlane(__float_as_int(z), 2 * (k_ * 8 + e))) + rb[e];
              int e1 = 0; float v1 = lg[0];
#pragma unroll
              for (int e = 1; e < NE; ++e) if (lg[e] > v1) { v1 = lg[e]; e1 = e; }
              int e2 = -1; float v2 = -3.0e38f;
#pragma unroll
              for (int e = 0; e < NE; ++e) if (e != e1 && lg[e] > v2) { v2 = lg[e]; e2 = e; }
              const float p1 = 1.0f / (1.0f + __expf(v2 - v1)), p2 = 1.0f - p1;
              if (lane == 0) { sel[lr * 2] = e1; sel[lr * 2 + 1] = e2; stgf(TOPW + row * 2, p1); stgf(TOPW + row * 2 + 1, p2); } } }
      }
    }
    if (ROUTER) {
        __syncthreads();
        LAS int* wc = (LAS int*)(lds + 32768 + 3584);
        int mye = 0, myrank = 0;
        if (tid < RPB * 2) { mye = sel[tid];
#pragma unroll
            for (int q = 0; q < NE; ++q) { const unsigned long long m = __ballot(mye == q); if (mye == q) myrank = __popcll(m & ((1ull << lane) - 1ull)); if (lane == 0) wc[wave * NE + q] = __popcll(m); } }
        __syncthreads();
        if (tid < NE) { const int cnt = wc[tid] + wc[NE + tid];
            unsigned* gc = (unsigned*)(a.ws + WS_CTL) + CW_MOE + f * 1024 + tid * 64;
            bases[tid] = (int)__hip_atomic_fetch_add(gc, (unsigned)cnt, __ATOMIC_RELAXED, __HIP_MEMORY_SCOPE_AGENT); }
        __syncthreads();
        if (tid < RPB * 2) { const int e = mye, pos = bases[e] + myrank + (wave == 1 ? wc[e] : 0); stgi(TOPI + (size_t)bid * RPB * 2 + tid, (e << 16) | pos);
            stgi((int*)(a.ws + WS_LISTE) + e * T + pos, bid * RPB + (tid >> 1));
            if (OUTMODE == 3) dstl[tid] = e * T + pos; }
        __syncthreads();
        if (OUTMODE == 3) {
            unsigned char* AGX = a.ws + WS_AGX;
            for (int p = wave; p < RPB * 2; p += NWAVES) { const u32x4 x = *(const LAS u32x4*)(rows8 + (p >> 1) * D + lane * 16); stg16(AGX + (size_t)dstl[p] * D + lane * 16, x); }
            __syncthreads(); }
    }
}
__device__ __forceinline__ void ph_rg_gates(const Args& a, LAS unsigned char* lds, int bid, int nb, int jl) {
    const int tid = otid(), lane = tid & 63, wave = tid >> 6, fr = lane & 15, fq = lane >> 4;
    constexpr int AS_OFF = 0, BS_OFF = 17408, LA_OFF = 87040, BB_OFF = 87040 + 16384, XS_OFF = 87040 + 32768, RS = 272;
    const bf16* XR = (const bf16*)(a.ws + WS_XR); bf16* HL = (bf16*)(a.ws + WS_HL); bf16* AC = (bf16*)(a.ws + WS_AC);
    float* CSA = (float*)(a.ws + WS_CSA); float* CSH = (float*)(a.ws + WS_CSH);
    const int n = bid % RNB, rnk = bid / RNB, cnt = (nb - 1 - n) / RNB + 1;
    { const bf16* WG = (const bf16*)(a.ws + WS_WA_G) + ((size_t)jl * RNB + n) * 256 * RBD;
#pragma unroll
        for (int i = 0; i < 8; ++i) { const int idx = tid + NTHR * i, row = idx >> 4, c16 = idx & 15; *(LAS u32x4*)(lds + BS_OFF + row * RS + c16 * 16) = ldg16(WG + row * RBD + c16 * 8); } }
    const int r2 = tid >> 4, cg = tid & 15, ch0 = n * RBD + cg * 8;
    f32x2 cwv[4][4], cbv[4];
    { const float* cw = a.in[I_A_CONV_W] + (size_t)jl * 4 * RW; const float* cb = a.in[I_A_CONV_B] + (size_t)jl * RW;
#pragma unroll
      for (int k = 0; k < 4; ++k) { const f32x4 w0 = ldgf4(cw + (size_t)k * RW + ch0), w1 = ldgf4(cw + (size_t)k * RW + ch0 + 4); cwv[k][0] = (f32x2){w0[0], w0[1]}; cwv[k][1] = (f32x2){w0[2], w0[3]}; cwv[k][2] = (f32x2){w1[0], w1[1]}; cwv[k][3] = (f32x2){w1[2], w1[3]}; }
      const f32x4 b0 = ldgf4(cb + ch0), b1 = ldgf4(cb + ch0 + 4); cbv[0] = (f32x2){b0[0], b0[1]}; cbv[1] = (f32x2){b0[2], b0[3]}; cbv[2] = (f32x2){b1[0], b1[1]}; cbv[3] = (f32x2){b1[2], b1[3]}; }
    const int tg = wave & 3, half = wave >> 2;
    float brq[4], biq[4], spq[4];
#pragma unroll
    for (int q = 0; q < 4; ++q) { const int ch = n * RBD + 64 * half + 16 * q + fr; const float L2E = 1.4426950408889634f;
        brq[q] = L2E * ldgf(a.in[I_A_B_R] + (size_t)jl * RW + ch); biq[q] = L2E * ldgf(a.in[I_A_B_I] + (size_t)jl * RW + ch); spq[q] = 8.0f * L2E * softplus_f(-ldgf(a.in[I_A_LAM] + (size_t)jl * RW + ch)); }
    u32x4 xr_[5];
    int c = rnk;
#define RG_LOADX(cc) do { _Pragma("unroll") for (int k = 0; k < 5; ++k) { const int tk = (cc) * RCH + 2 * r2 - 3 + k; xr_[k] = (tk >= 0) ? ldg16(XR + (size_t)tk * RW + ch0) : (u32x4){0u, 0u, 0u, 0u}; } } while (0)
    if (c < RNC) RG_LOADX(c);
    for (; c < RNC; c += cnt) {
        __syncthreads();
        {
#pragma unroll
            for (int rr = 0; rr < 2; ++rr) { f32x2 acc[4];
#pragma unroll
                for (int j = 0; j < 4; ++j) acc[j] = cbv[j];
#pragma unroll
                for (int k = 0; k < 4; ++k) { const u32x4 x = xr_[rr + k];
                    acc[0] += cwv[k][0] * (f32x2){bflo(x.x), bfhi(x.x)}; acc[1] += cwv[k][1] * (f32x2){bflo(x.y), bfhi(x.y)};
                    acc[2] += cwv[k][2] * (f32x2){bflo(x.z), bfhi(x.z)}; acc[3] += cwv[k][3] * (f32x2){bflo(x.w), bfhi(x.w)}; }
                u32x4 w0; w0.x = cvt_pk_bf16(acc[0][0], acc[0][1]); w0.y = cvt_pk_bf16(acc[1][0], acc[1][1]); w0.z = cvt_pk_bf16(acc[2][0], acc[2][1]); w0.w = cvt_pk_bf16(acc[3][0], acc[3][1]);
                *(LAS u32x4*)(lds + AS_OFF + (2 * r2 + rr) * RS + cg * 16) = w0; }
        }
        { const int cn = c + cnt; if (cn < RNC) RG_LOADX(cn); }
        __syncthreads();
        f32x4 accr[4], acci[4];
#pragma unroll
        for (int q = 0; q < 4; ++q) { accr[q] = (f32x4){0.f, 0.f, 0.f, 0.f}; acci[q] = (f32x4){0.f, 0.f, 0.f, 0.f}; }
#pragma unroll
        for (int kk = 0; kk < 4; ++kk) { const bf16x8 af = *(const LAS bf16x8*)(lds + AS_OFF + (16 * tg + fr) * RS + (kk * 32 + 8 * fq) * 2);
#pragma unroll
            for (int q = 0; q < 4; ++q) { const bf16x8 br = *(const LAS bf16x8*)(lds + BS_OFF + (64 * half + 16 * q + fr) * RS + (kk * 32 + 8 * fq) * 2);
                const bf16x8 bi = *(const LAS bf16x8*)(lds + BS_OFF + (128 + 64 * half + 16 * q + fr) * RS + (kk * 32 + 8 * fq) * 2);
                accr[q] = __builtin_amdgcn_mfma_f32_16x16x32_bf16(af, br, accr[q], 0, 0, 0); acci[q] = __builtin_amdgcn_mfma_f32_16x16x32_bf16(af, bi, acci[q], 0, 0, 0); } }
#pragma unroll
        for (int q = 0; q < 4; ++q) { const int chl = 64 * half + 16 * q + fr;
#pragma unroll
            for (int pr_ = 0; pr_ < 2; ++pr_) { const int row = 16 * tg + 4 * fq + 2 * pr_;
                const f32x2 R2 = (f32x2){accr[q][2 * pr_], accr[q][2 * pr_ + 1]} + brq[q], I2 = (f32x2){acci[q][2 * pr_], acci[q][2 * pr_ + 1]} + biq[q];
                f32x2 eR, eI; eR[0] = __builtin_amdgcn_exp2f(-R2[0]); eR[1] = __builtin_amdgcn_exp2f(-R2[1]); eI[0] = __builtin_amdgcn_exp2f(-I2[0]); eI[1] = __builtin_amdgcn_exp2f(-I2[1]);
                const f32x2 dR = eR + 1.0f, dI = eI + 1.0f; f32x2 rr, ii; rr[0] = __builtin_amdgcn_rcpf(dR[0]); rr[1] = __builtin_amdgcn_rcpf(dR[1]); ii[0] = __builtin_amdgcn_rcpf(dI[0]); ii[1] = __builtin_amdgcn_rcpf(dI[1]);
                const f32x2 la = rr * spq[q]; f32x2 a_; a_[0] = __builtin_amdgcn_exp2f(-la[0]); a_[1] = __builtin_amdgcn_exp2f(-la[1]);
                f32x2 om = 1.0f - a_; om[0] = fmaxf(om[0], 0.f); om[1] = fmaxf(om[1], 0.f);
                const f32x2 t2 = om * (a_ + 1.0f); f32x2 sq; sq[0] = __builtin_amdgcn_sqrtf(t2[0]); sq[1] = __builtin_amdgcn_sqrtf(t2[1]);
                const f32x2 xr = (f32x2){bf2f(*(const LAS bf16*)(lds + AS_OFF + row * RS + chl * 2)), bf2f(*(const LAS bf16*)(lds + AS_OFF + (row + 1) * RS + chl * 2))};
                const f32x2 bb = (sq * ii) * xr;
                *(LAS bf16*)(lds + LA_OFF + (row * 128 + chl) * 2) = f2bf(om[0]); *(LAS bf16*)(lds + LA_OFF + ((row + 1) * 128 + chl) * 2) = f2bf(om[1]);
                *(LAS bf16*)(lds + BB_OFF + (row * 128 + chl) * 2) = f2bf(bb[0]); *(LAS bf16*)(lds + BB_OFF + ((row + 1) * 128 + chl) * 2) = f2bf(bb[1]); } }
        __syncthreads();
        { const int j = tid & 127, seg = tid >> 7, ch = n * RBD + j; float hl[16], pa[16]; float h = 0.f, pr = 1.f;
#pragma unroll
            for (int i = 0; i < 16; ++i) { const float om = bf2f(*(const LAS bf16*)(lds + LA_OFF + ((16 * seg + i) * 128 + j) * 2)), bb = bf2f(*(const LAS bf16*)(lds + BB_OFF + ((16 * seg + i) * 128 + j) * 2));
                const float ai = 1.0f - om; h = ai * h + bb; pr *= ai; hl[i] = h; pa[i] = pr; }
            LAS float* xs = (LAS float*)(lds + XS_OFF); xs[(seg * 128 + j) * 2] = pr; xs[(seg * 128 + j) * 2 + 1] = h;
            __syncthreads();
            float cin_h = 0.f, cin_a = 1.f;
#pragma unroll
            for (int s = 0; s < 3; ++s) if (s < seg) { const float sa = xs[(s * 128 + j) * 2], sh = xs[(s * 128 + j) * 2 + 1]; cin_h = sa * cin_h + sh; cin_a *= sa; }
#pragma unroll
            for (int i = 0; i < 16; ++i) { const float hf = hl[i] + pa[i] * cin_h, af = pa[i] * cin_a;
                *(LAS bf16*)(lds + LA_OFF + ((16 * seg + i) * 128 + j) * 2) = f2bf(hf); *(LAS bf16*)(lds + BB_OFF + ((16 * seg + i) * 128 + j) * 2) = f2bf(af);
                if (i == 15 && seg == 3) { stgf(CSA + (size_t)c * RW + ch, af); stgf(CSH + (size_t)c * RW + ch, hf); } } }
        __syncthreads();
#pragma unroll
        for (int i = 0; i < 2; ++i) { const int idx = tid + NTHR * i, row = idx >> 4, c16 = idx & 15; const size_t o = (size_t)(c * RCH + row) * RW + n * RBD + c16 * 8;
            stg16(HL + o, *(const LAS u32x4*)(lds + LA_OFF + row * 256 + c16 * 16)); stg16(AC + o, *(const LAS u32x4*)(lds + BB_OFF + row * 256 + c16 * 16)); }
    }
#undef RG_LOADX
    __syncthreads();
}
__device__ __forceinline__ void ph_rg_carry(const Args& a, int bid, int nb) {
    const int tid = otid(), lane = tid & 63, gw = bid * NWAVES + (tid >> 6), NGW = nb * NWAVES;
    const float* CSA = (const float*)(a.ws + WS_CSA); const float* CSH = (const float*)(a.ws + WS_CSH); float* CIN = (float*)(a.ws + WS_CIN);
    for (int ch = gw; ch < RW; ch += NGW) {
        float Ak[4], Hk[4]; float A = 1.f, H = 0.f;
#pragma unroll
        for (int k = 0; k < 4; ++k) { Ak[k] = ldgf(CSA + (size_t)(4 * lane + k) * RW + ch); Hk[k] = ldgf(CSH + (size_t)(4 * lane + k) * RW + ch); H = Ak[k] * H + Hk[k]; A = Ak[k] * A; }
#pragma unroll
        for (int off = 1; off < 64; off <<= 1) { const float Ay = __shfl_up(A, off), Hy = __shfl_up(H, off); if (lane >= off) { H = A * Hy + H; A = A * Ay; } }
        float h = __shfl_up(H, 1); if (lane == 0) h = 0.f;
#pragma unroll
        for (int k = 0; k < 4; ++k) { stgf(CIN + (size_t)(4 * lane + k) * RW + ch, h); h = Ak[k] * h + Hk[k]; }
    }
}
__device__ __forceinline__ void ph_rg_fix(const Args& a, int bid, int nb) {
    const int tid = otid(); bf16* GX = (bf16*)(a.ws + WS_GX); const bf16* HL = (const bf16*)(a.ws + WS_HL); const bf16* AC = (const bf16*)(a.ws + WS_AC); const float* CIN = (const float*)(a.ws + WS_CIN);
    const int total = T * (RW / 8);
    for (int it = bid * NTHR + tid; it < total; it += nb * NTHR) {
        const int t = it / (RW / 8), ch = (it % (RW / 8)) * 8, c = t / RCH; const size_t o = (size_t)t * RW + ch;
        const u32x4 g = ldg16(GX + o), hl = ldg16(HL + o), ac = ldg16(AC + o); const f32x4 c0 = ldgf4(CIN + (size_t)c * RW + ch), c1 = ldgf4(CIN + (size_t)c * RW + ch + 4);
        float y[8];
        y[0] = gelu_tanh(bflo(g.x)) * (bflo(hl.x) + bflo(ac.x) * c0[0]); y[1] = gelu_tanh(bfhi(g.x)) * (bfhi(hl.x) + bfhi(ac.x) * c0[1]);
        y[2] = gelu_tanh(bflo(g.y)) * (bflo(hl.y) + bflo(ac.y) * c0[2]); y[3] = gelu_tanh(bfhi(g.y)) * (bfhi(hl.y) + bfhi(ac.y) * c0[3]);
        y[4] = gelu_tanh(bflo(g.z)) * (bflo(hl.z) + bflo(ac.z) * c1[0]); y[5] = gelu_tanh(bfhi(g.z)) * (bfhi(hl.z) + bfhi(ac.z) * c1[1]);
        y[6] = gelu_tanh(bflo(g.w)) * (bflo(hl.w) + bflo(ac.w) * c1[2]); y[7] = gelu_tanh(bfhi(g.w)) * (bfhi(hl.w) + bfhi(ac.w) * c1[3]);
        u32x4 w; w.x = cvt_pk_bf16(y[0], y[1]); w.y = cvt_pk_bf16(y[2], y[3]); w.z = cvt_pk_bf16(y[4], y[5]); w.w = cvt_pk_bf16(y[6], y[7]);
        stg16(GX + o, w);
    }
}

__device__ __forceinline__ void ph_ml_prep(const Args& a, LAS unsigned char* lds, int bid, int nb) {
    const bf16* XM = (const bf16*)(a.ws + WS_XM); bf16* Q = (bf16*)(a.ws + WS_Q); bf16* Kb = (bf16*)(a.ws + WS_K); bf16* XC = (bf16*)(a.ws + WS_XC);
    float* GI = (float*)(a.ws + WS_GI); float* GF = (float*)(a.ws + WS_GF);
    LAS float* red = (LAS float*)(lds + EXTRA_OFF);
    const float kscale = 0.044194173824159216f;
    for (int tb = bid; tb < T / 64; tb += nb) {
        const int t0 = tb * 64;
        {
            const int tid = otid(), lane = tid & 63, wave = tid >> 6, n4 = tid * 4;
            f32x2 cw[4][2], cb[2], wq[4][2], wk[4][2], wv[4][2], gqk[4][4], gv[4][4];
#pragma unroll
            for (int k = 0; k < 4; ++k) { const f32x4 v = ldgf4(a.in[I_B_CONV_W] + k * MI + n4); cw[k][0] = (f32x2){v[0], v[1]}; cw[k][1] = (f32x2){v[2], v[3]}; }
            { const f32x4 v = ldgf4(a.in[I_B_CONV_B] + n4); cb[0] = (f32x2){v[0], v[1]}; cb[1] = (f32x2){v[2], v[3]}; }
#pragma unroll
            for (int i = 0; i < 4; ++i) { const f32x4 q_ = ldgf4(a.in[I_B_W_Q] + tid * 16 + i * 4), k_ = ldgf4(a.in[I_B_W_K] + tid * 16 + i * 4), v_ = ldgf4(a.in[I_B_W_V] + tid * 16 + i * 4);
                wq[i][0] = (f32x2){q_[0], q_[1]}; wq[i][1] = (f32x2){q_[2], q_[3]}; wk[i][0] = (f32x2){k_[0], k_[1]}; wk[i][1] = (f32x2){k_[2], k_[3]}; wv[i][0] = (f32x2){v_[0], v_[1]}; wv[i][1] = (f32x2){v_[2], v_[3]}; }
#pragma unroll
            for (int i = 0; i < 4; ++i)
#pragma unroll
                for (int e = 0; e < 4; ++e) { gqk[i][e] = (f32x2){0.f, 0.f}; gv[i][e] = (f32x2){0.f, 0.f}; }
#pragma unroll
            for (int j = 0; j < 4; ++j) { const float* pwg = a.in[I_B_W_GATE];
                const f32x4 a0 = ldgf4(pwg + (size_t)(0 * MI + n4 + j) * 8), a1 = ldgf4(pwg + (size_t)(0 * MI + n4 + j) * 8 + 4);
                const f32x4 b0 = ldgf4(pwg + (size_t)(1 * MI + n4 + j) * 8), b1 = ldgf4(pwg + (size_t)(1 * MI + n4 + j) * 8 + 4);
                const f32x4 c0 = ldgf4(pwg + (size_t)(2 * MI + n4 + j) * 8), c1 = ldgf4(pwg + (size_t)(2 * MI + n4 + j) * 8 + 4);
                const f32x2 ga[4] = {(f32x2){a0[0], a0[1]}, (f32x2){a0[2], a0[3]}, (f32x2){a1[0], a1[1]}, (f32x2){a1[2], a1[3]}};
                const f32x2 gb[4] = {(f32x2){b0[0], b0[1]}, (f32x2){b0[2], b0[3]}, (f32x2){b1[0], b1[1]}, (f32x2){b1[2], b1[3]}};
                const f32x2 gc[4] = {(f32x2){c0[0], c0[1]}, (f32x2){c0[2], c0[3]}, (f32x2){c1[0], c1[1]}, (f32x2){c1[2], c1[3]}};
#pragma unroll
                for (int i = 0; i < 4; ++i) { const float wq_ = wq[i][j >> 1][j & 1], wk_ = wk[i][j >> 1][j & 1], wv_ = wv[i][j >> 1][j & 1];
#pragma unroll
                    for (int e = 0; e < 4; ++e) { gqk[i][e] += ga[e] * wq_ + gb[e] * wk_; gv[i][e] += gc[e] * wv_; } } }
            f32x2 x0[2], x1[2], x2[2], x3[2];
#pragma unroll
            for (int p = 0; p < 2; ++p) { x0[p] = (f32x2){0.f, 0.f}; x1[p] = x0[p]; x2[p] = x0[p]; }
            if (t0 > 0) { const u32x2 p0 = ldg8(XM + (size_t)(t0 - 3) * MI + n4), p1 = ldg8(XM + (size_t)(t0 - 2) * MI + n4), p2 = ldg8(XM + (size_t)(t0 - 1) * MI + n4);
                x0[0] = (f32x2){bflo(p0.x), bfhi(p0.x)}; x0[1] = (f32x2){bflo(p0.y), bfhi(p0.y)}; x1[0] = (f32x2){bflo(p1.x), bfhi(p1.x)}; x1[1] = (f32x2){bflo(p1.y), bfhi(p1.y)};
                x2[0] = (f32x2){bflo(p2.x), bfhi(p2.x)}; x2[1] = (f32x2){bflo(p2.y), bfhi(p2.y)}; }
            u32x2 xs[8], xn[8];
#pragma unroll
            for (int b = 0; b < 8; ++b) xs[b] = ldg8(XM + (size_t)(t0 + b) * MI + n4);
#pragma unroll 1
            for (int tl0 = 0; tl0 < 64; tl0 += 8) {
              { const int tn = (tl0 + 8 < 64) ? tl0 + 8 : tl0;
#pragma unroll
                for (int b = 0; b < 8; ++b) xn[b] = ldg8(XM + (size_t)(t0 + tn + b) * MI + n4); }
#pragma unroll 1
              for (int b = 0; b < 8; ++b) {
                const int tl = tl0 + b, t = t0 + tl;
                { const u32x2 p3 = xs[0];
#pragma unroll
                  for (int q = 0; q < 7; ++q) xs[q] = xs[q + 1];
                  x3[0] = (f32x2){bflo(p3.x), bfhi(p3.x)}; x3[1] = (f32x2){bflo(p3.y), bfhi(p3.y)}; }
                float xc[4]; f32x2 q2[2], k2[2], v2[2];
#pragma unroll
                for (int p = 0; p < 2; ++p) { const f32x2 cv = cb[p] + cw[0][p] * x0[p] + cw[1][p] * x1[p] + cw[2][p] * x2[p] + cw[3][p] * x3[p]; xc[2 * p] = silu_f(cv[0]); xc[2 * p + 1] = silu_f(cv[1]); }
                const float xm[4] = {x3[0][0], x3[0][1], x3[1][0], x3[1][1]};
#pragma unroll
                for (int p = 0; p < 2; ++p) { q2[p] = wq[0][p] * xc[0] + wq[1][p] * xc[1] + wq[2][p] * xc[2] + wq[3][p] * xc[3]; k2[p] = wk[0][p] * xc[0] + wk[1][p] * xc[1] + wk[2][p] * xc[2] + wk[3][p] * xc[3];
                    v2[p] = wv[0][p] * xm[0] + wv[1][p] * xm[1] + wv[2][p] * xm[2] + wv[3][p] * xm[3]; }
                { u32x2 w; w.x = cvt_pk_bf16(q2[0][0], q2[0][1]); w.y = cvt_pk_bf16(q2[1][0], q2[1][1]); stg8(Q + (size_t)t * MI + n4, w);
                  w.x = cvt_pk_bf16(k2[0][0] * kscale, k2[0][1] * kscale); w.y = cvt_pk_bf16(k2[1][0] * kscale, k2[1][1] * kscale); stg8(Kb + (size_t)t * MI + n4, w);
                  w.x = cvt_pk_bf16(xc[0], xc[1]); w.y = cvt_pk_bf16(xc[2], xc[3]); stg8(XC + (size_t)t * MI + n4, w);
                  (void)v2; }
                f32x2 g2[4];
#pragma unroll
                for (int e = 0; e < 4; ++e) g2[e] = gqk[0][e] * xc[0] + gqk[1][e] * xc[1] + gqk[2][e] * xc[2] + gqk[3][e] * xc[3] + gv[0][e] * xm[0] + gv[1][e] * xm[1] + gv[2][e] * xm[2] + gv[3][e] * xm[3];
                const float g[8] = {g2[0][0], g2[0][1], g2[1][0], g2[1][1], g2[2][0], g2[2][1], g2[3][0], g2[3][1]};
                { const bool h5 = (lane & 32) != 0; float k4[4];
#pragma unroll
                  for (int e = 0; e < 4; ++e) { const float snd = h5 ? g[e] : g[4 + e], kp = h5 ? g[4 + e] : g[e]; k4[e] = kp + __shfl_xor(snd, 32); }
                  const bool h4 = (lane & 16) != 0; float k2_[2];
#pragma unroll
                  for (int e = 0; e < 2; ++e) { const float snd = h4 ? k4[e] : k4[2 + e], kp = h4 ? k4[2 + e] : k4[e]; k2_[e] = kp + __shfl_xor(snd, 16); }
                  const bool h3 = (lane & 8) != 0; const float snd = h3 ? k2_[0] : k2_[1], kp = h3 ? k2_[1] : k2_[0]; float k1 = kp + __shfl_xor(snd, 8);
                  k1 += __shfl_xor(k1, 4); k1 += __shfl_xor(k1, 2); k1 += __shfl_xor(k1, 1);
                  if ((lane & 7) == 0) red[(tl * 8 + wave) * 8 + (lane >> 3)] = k1; }
#pragma unroll
                for (int p = 0; p < 2; ++p) { x0[p] = x1[p]; x1[p] = x2[p]; x2[p] = x3[p]; }
              }
#pragma unroll
              for (int b = 0; b < 8; ++b) xs[b] = xn[b];
            }
        }
        __syncthreads();
        { const int tid = otid(), tok = tid >> 3, e = tid & 7; float s = ldgf(a.in[I_B_B_GATE] + e);
#pragma unroll
            for (int w = 0; w < 8; ++w) s += red[(tok * 8 + w) * 8 + e];
            if (e < 4) stgf(GI + (size_t)e * T + t0 + tok, s); else stgf(GF + (size_t)(e - 4) * T + t0 + tok, -softplus_f(-s)); }
        __syncthreads();
    }
}
__device__ __forceinline__ void ph_ml_gscan(const Args& a, LAS unsigned char* lds, int bid, int nb) {
    const int tid = otid(), lane = tid & 63, wave = tid >> 6;
    const float* GI = (const float*)(a.ws + WS_GI); const float* GF = (const float*)(a.ws + WS_GF);
    float* GS = (float*)(a.ws + WS_GS); float* RMT = (float*)(a.ws + WS_RMT); float* EF = (float*)(a.ws + WS_EF); float* MC = (float*)(a.ws + WS_MC);
    LAS float* wt = (LAS float*)lds;
    for (int h = bid; h < MH; h += nb) {
        __syncthreads();
        float lf[32], ig[32]; float s = 0.f;
#pragma unroll
        for (int q = 0; q < 8; ++q) { const f32x4 v = ldgf4(GF + (size_t)h * T + tid * 32 + 4 * q), w = ldgf4(GI + (size_t)h * T + tid * 32 + 4 * q);
            lf[4 * q] = v[0]; lf[4 * q + 1] = v[1]; lf[4 * q + 2] = v[2]; lf[4 * q + 3] = v[3]; ig[4 * q] = w[0]; ig[4 * q + 1] = w[1]; ig[4 * q + 2] = w[2]; ig[4 * q + 3] = w[3]; }
#pragma unroll
        for (int i = 0; i < 32; ++i) s += lf[i];
        float inc = s;
#pragma unroll
        for (int off = 1; off < 64; off <<= 1) { const float y = __shfl_up(inc, off); if (lane >= off) inc += y; }
        if (lane == 63) wt[wave] = inc;
        __syncthreads();
        float base = inc - s;
#pragma unroll
        for (int w = 0; w < 8; ++w) if (w < wave) base += wt[w];
        float F = base, lmax = -3.0e38f;
#pragma unroll
        for (int i = 0; i < 32; ++i) { F += lf[i]; lf[i] = F; ig[i] = ig[i] - F; lmax = fmaxf(lmax, ig[i]); }
        float minc = lmax;
#pragma unroll
        for (int off = 1; off < 64; off <<= 1) { const float y = __shfl_up(minc, off); if (lane >= off) minc = fmaxf(minc, y); }
        __syncthreads();
        if (lane == 63) wt[8 + wave] = minc;
        __syncthreads();
        float pm = __shfl_up(minc, 1); if (lane == 0) pm = -3.0e38f;
#pragma unroll
        for (int w = 0; w < 8; ++w) if (w < wave) pm = fmaxf(pm, wt[8 + w]);
        float rm = fmaxf(pm, 0.f);
#pragma unroll
        for (int i = 0; i < 32; ++i) { rm = fmaxf(rm, ig[i]); const size_t o = (size_t)h * T + tid * 32 + i; stgf(GS + o, ig[i]); stgf(RMT + o, rm); stgf(EF + o, __expf(-lf[i] - rm)); }
        if ((tid & 7) == 7) stgf(MC + h * 80 + (tid + 1) / 8, rm);
        if (tid == 0) stgf(MC + h * 80, 0.f);
    }
    __syncthreads();
}
__device__ __forceinline__ void ph_ml_ktw(const Args& a, LAS unsigned char* lds, int bid, int nb) {
    const bf16* Kn = (const bf16*)(a.ws + WS_K); const bf16* Xm = (const bf16*)(a.ws + WS_XM); bf16* KT = (bf16*)(a.ws + WS_KT); bf16* VT = (bf16*)(a.ws + WS_VT);
    const float* GS = (const float*)(a.ws + WS_GS); const float* MC = (const float*)(a.ws + WS_MC); float* NS = (float*)(a.ws + WS_NS);
    LAS float* w = (LAS float*)(lds + EXTRA_OFF); constexpr int TS = 144;
    for (int u = bid; u < MNC * MH; u += nb) { const int c = u / MH, h = u % MH; const int tid = otid(), lane = tid & 63, wave = tid >> 6;
        LAS unsigned char* tile = lds + wave * 16384;
        __syncthreads();
        if (tid < MCH) w[tid] = __expf(ldgf(GS + (size_t)h * T + c * MCH + tid) - ldgf(MC + h * 80 + c + 1));
        __syncthreads();
        const int ch0 = h * HD + wave * 64, rr = lane >> 3, c8 = lane & 7;
        f32x2 wvv[2][4][2];
#pragma unroll
        for (int bk = 0; bk < 2; ++bk)
#pragma unroll
            for (int i = 0; i < 4; ++i) { const f32x4 wr = ldgf4(a.in[I_B_W_V] + (size_t)((ch0 + c8 * 8) / 4 + bk) * 16 + i * 4); wvv[bk][i][0] = (f32x2){wr[0], wr[1]}; wvv[bk][i][1] = (f32x2){wr[2], wr[3]}; }
        float psum[8];
#pragma unroll
        for (int i = 0; i < 8; ++i) psum[i] = 0.f;
#pragma unroll 1
        for (int pass = 0; pass < 8; ++pass) { const int isv = pass >> 2, tg = pass & 3; const bf16* src = (isv ? Xm : Kn) + (size_t)(c * MCH + tg * 64) * MI + ch0; bf16* dst = (isv ? VT : KT) + ((size_t)u * HD + wave * 64) * MCH + tg * 64;
            u32x4 x[8];
#pragma unroll
            for (int i = 0; i < 8; ++i) x[i] = ldg16(src + (size_t)(rr + 8 * i) * MI + c8 * 8);
            if (isv) {
#pragma unroll
                for (int i = 0; i < 8; ++i) { const u32x4 xx = x[i]; const float xa[4] = {bflo(xx.x), bfhi(xx.x), bflo(xx.y), bfhi(xx.y)}, xb[4] = {bflo(xx.z), bfhi(xx.z), bflo(xx.w), bfhi(xx.w)};
                    const f32x2 va0 = wvv[0][0][0] * xa[0] + wvv[0][1][0] * xa[1] + wvv[0][2][0] * xa[2] + wvv[0][3][0] * xa[3], va1 = wvv[0][0][1] * xa[0] + wvv[0][1][1] * xa[1] + wvv[0][2][1] * xa[2] + wvv[0][3][1] * xa[3];
                    const f32x2 vb0 = wvv[1][0][0] * xb[0] + wvv[1][1][0] * xb[1] + wvv[1][2][0] * xb[2] + wvv[1][3][0] * xb[3], vb1 = wvv[1][0][1] * xb[0] + wvv[1][1][1] * xb[1] + wvv[1][2][1] * xb[2] + wvv[1][3][1] * xb[3];
                    u32x4 o; o.x = cvt_pk_bf16(va0[0], va0[1]); o.y = cvt_pk_bf16(va1[0], va1[1]); o.z = cvt_pk_bf16(vb0[0], vb0[1]); o.w = cvt_pk_bf16(vb1[0], vb1[1]); x[i] = o; } }
#pragma unroll
            for (int i = 0; i < 8; ++i) *(LAS u32x4*)(tile + (rr + 8 * i) * TS + c8 * 16) = x[i];
            LDS_WAIT(); asm volatile("" ::: "memory");
#pragma unroll
            for (int i = 0; i < 8; ++i) { const int d = rr + 8 * i; const LAS bf16* tp = (const LAS bf16*)(tile + (c8 * 8) * TS) + d; float v[8];
#pragma unroll
                for (int q = 0; q < 8; ++q) v[q] = bf2f(tp[q * (TS / 2)]);
                if (!isv) { const LAS float* wp = w + tg * 64 + c8 * 8;
#pragma unroll
                    for (int q = 0; q < 8; ++q) v[q] *= wp[q]; }
                u32x4 o; o.x = cvt_pk_bf16(v[0], v[1]); o.y = cvt_pk_bf16(v[2], v[3]); o.z = cvt_pk_bf16(v[4], v[5]); o.w = cvt_pk_bf16(v[6], v[7]);
                if (!isv) psum[i] += (bflo(o.x) + bfhi(o.x)) + (bflo(o.y) + bfhi(o.y)) + (bflo(o.z) + bfhi(o.z)) + (bflo(o.w) + bfhi(o.w));
                stg16(dst + (size_t)d * MCH + c8 * 8, o); }
            LDS_WAIT(); asm volatile("" ::: "memory");
        }
#pragma unroll
        for (int i = 0; i < 8; ++i) { float ps = psum[i]; ps += __shfl_xor(ps, 1); ps += __shfl_xor(ps, 2); ps += __shfl_xor(ps, 4); if (c8 == 0) stgf(NS + (size_t)u * HD + wave * 64 + rr + 8 * i, ps); }
    }
    asm volatile("s_waitcnt vmcnt(0)" ::: "memory");
    __syncthreads();
}
__device__ __forceinline__ void ph_ml_sscan(const Args& a, int bid, int nb) {
    bf16* CT = (bf16*)(a.ws + WS_CT); float* NS = (float*)(a.ws + WS_NS); const float* MC = (const float*)(a.ws + WS_MC);
    { const int tid = otid(), lane = tid & 63, gw = bid * NWAVES + (tid >> 6), NGW = nb * NWAVES;
      static_assert(MNC == 64, "one lane per chunk");
      for (int it = gw; it < MH * HD; it += NGW) { const int h = it / HD, d = it % HD; float* q = NS + ((size_t)lane * MH + h) * HD + d;
          float H = ldgf(q), A = __expf(ldgf(MC + h * 80 + lane) - ldgf(MC + h * 80 + lane + 1));
#pragma unroll
          for (int off = 1; off < 64; off <<= 1) { const float Ay = __shfl_up(A, off), Hy = __shfl_up(H, off); if (lane >= off) { H = A * Hy + H; A = A * Ay; } }
          float o = __shfl_up(H, 1); if (lane == 0) o = 0.f; stgf(q, o); } }
    for (int it = bid * NTHR + otid(); it < MH * HD * (HD / 8); it += nb * NTHR) {
        const int h = it / (HD * (HD / 8)), rem = it % (HD * (HD / 8)); bf16* p = CT + (size_t)h * HD * HD + (size_t)rem * 8; const size_t cs = (size_t)MH * HD * HD;
        float run[8];
#pragma unroll
        for (int j = 0; j < 8; ++j) run[j] = 0.f;
        u32x4 sv[8], sn[8];
#pragma unroll
        for (int q = 0; q < 8; ++q) sv[q] = ldg16(p + (size_t)q * cs);
        for (int c0 = 0; c0 < MNC; c0 += 8) {
            float dec[8]; const int cn = (c0 + 8 < MNC) ? c0 + 8 : c0;
#pragma unroll
            for (int q = 0; q < 8; ++q) { sn[q] = ldg16(p + (size_t)(cn + q) * cs); dec[q] = __expf(ldgf(MC + h * 80 + c0 + q) - ldgf(MC + h * 80 + c0 + q + 1)); }
#pragma unroll
            for (int q = 0; q < 8; ++q) { u32x4 o; o.x = cvt_pk_bf16(run[0], run[1]); o.y = cvt_pk_bf16(run[2], run[3]); o.z = cvt_pk_bf16(run[4], run[5]); o.w = cvt_pk_bf16(run[6], run[7]);
                stg16(p + (size_t)(c0 + q) * cs, o);
                run[0] = dec[q] * run[0] + bflo(sv[q].x); run[1] = dec[q] * run[1] + bfhi(sv[q].x); run[2] = dec[q] * run[2] + bflo(sv[q].y); run[3] = dec[q] * run[3] + bfhi(sv[q].y);
                run[4] = dec[q] * run[4] + bflo(sv[q].z); run[5] = dec[q] * run[5] + bfhi(sv[q].z); run[6] = dec[q] * run[6] + bflo(sv[q].w); run[7] = dec[q] * run[7] + bfhi(sv[q].w); }
#pragma unroll
            for (int q = 0; q < 8; ++q) sv[q] = sn[q];
        }
    }
}
struct FinIn { u32x4 nu, qv, zv, xv; f32x4 n0, n1, dp, g0, g1, k0, k1; float mc, rmt, ef; };
__device__ __forceinline__ FinIn fin_load(const Args& a, int it, int e0) {
    const bf16* NUM = (const bf16*)(a.ws + WS_NUM); const bf16* Q = (const bf16*)(a.ws + WS_Q); const bf16* Z = (const bf16*)(a.ws + WS_Z); const bf16* XC = (const bf16*)(a.ws + WS_XC);
    const float* NS = (const float*)(a.ws + WS_NS); const float* DENP = (const float*)(a.ws + WS_DENP); const float* MC = (const float*)(a.ws + WS_MC); const float* RMT = (const float*)(a.ws + WS_RMT); const float* EF = (const float*)(a.ws + WS_EF);
    const int t = it >> 2, h = it & 3, c = t >> 8, r = t & 255; const size_t o = (size_t)t * MI + h * HD + e0, cth = (size_t)(c * MH + h);
    FinIn f; f.nu = ldg16(NUM + o); f.qv = ldg16(Q + o); f.zv = ldg16(Z + o); f.xv = ldg16(XC + o);
    f.n0 = ldgf4(NS + cth * HD + e0); f.n1 = ldgf4(NS + cth * HD + e0 + 4); f.dp = ldgf4(DENP + (cth * MCH + r) * 4);
    f.g0 = ldgf4(a.in[I_B_NORM] + h * HD + e0); f.g1 = ldgf4(a.in[I_B_NORM] + h * HD + e0 + 4); f.k0 = ldgf4(a.in[I_B_SKIP] + h * HD + e0); f.k1 = ldgf4(a.in[I_B_SKIP] + h * HD + e0 + 4);
    f.mc = ldgf(MC + h * 80 + c); f.rmt = ldgf(RMT + (size_t)h * T + t); f.ef = ldgf(EF + (size_t)h * T + t); return f;
}
__device__ __forceinline__ void fin_compute(const Args& a, int it, int e0, const FinIn& f) {
    bf16* Y = (bf16*)(a.ws + WS_Y); const int t = it >> 2, h = it & 3; const size_t o = (size_t)t * MI + h * HD + e0;
    const u32x4 nu = f.nu, qv = f.qv, zv = f.zv, xv = f.xv;
    const f32x2 num[4] = {(f32x2){bflo(nu.x), bfhi(nu.x)}, (f32x2){bflo(nu.y), bfhi(nu.y)}, (f32x2){bflo(nu.z), bfhi(nu.z)}, (f32x2){bflo(nu.w), bfhi(nu.w)}};
    const f32x2 qq[4] = {(f32x2){bflo(qv.x), bfhi(qv.x)}, (f32x2){bflo(qv.y), bfhi(qv.y)}, (f32x2){bflo(qv.z), bfhi(qv.z)}, (f32x2){bflo(qv.w), bfhi(qv.w)}};
    const f32x2 nn[4] = {(f32x2){f.n0[0], f.n0[1]}, (f32x2){f.n0[2], f.n0[3]}, (f32x2){f.n1[0], f.n1[1]}, (f32x2){f.n1[2], f.n1[3]}};
    const f32x2 qn2 = (qq[0] * nn[0] + qq[1] * nn[1]) + (qq[2] * nn[2] + qq[3] * nn[3]);
    const float qn = wave_sum(qn2[0] + qn2[1]);
    const float rs = __expf(f.mc - f.rmt), den = rs * ((f.dp[0] + f.dp[1]) + (f.dp[2] + f.dp[3]) + qn);
    const float inv = __builtin_amdgcn_rcpf(fmaxf(fabsf(den), f.ef));
    f32x2 hc[4], s2 = (f32x2){0.f, 0.f};
#pragma unroll
    for (int i = 0; i < 4; ++i) { hc[i] = num[i] * inv; s2 += hc[i] * hc[i]; }
    const float rstd = __builtin_amdgcn_rsqf(wave_sum(s2[0] + s2[1]) * (1.0f / HD) + EPS);
    const f32x2 gg[4] = {(f32x2){f.g0[0], f.g0[1]}, (f32x2){f.g0[2], f.g0[3]}, (f32x2){f.g1[0], f.g1[1]}, (f32x2){f.g1[2], f.g1[3]}};
    const f32x2 sk[4] = {(f32x2){f.k0[0], f.k0[1]}, (f32x2){f.k0[2], f.k0[3]}, (f32x2){f.k1[0], f.k1[1]}, (f32x2){f.k1[2], f.k1[3]}};
    const f32x2 zz[4] = {(f32x2){bflo(zv.x), bfhi(zv.x)}, (f32x2){bflo(zv.y), bfhi(zv.y)}, (f32x2){bflo(zv.z), bfhi(zv.z)}, (f32x2){bflo(zv.w), bfhi(zv.w)}};
    const f32x2 xx[4] = {(f32x2){bflo(xv.x), bfhi(xv.x)}, (f32x2){bflo(xv.y), bfhi(xv.y)}, (f32x2){bflo(xv.z), bfhi(xv.z)}, (f32x2){bflo(xv.w), bfhi(xv.w)}};
    f32x2 y[4];
#pragma unroll
    for (int i = 0; i < 4; ++i) { const f32x2 zl = zz[i] * -1.4426950408889634f; f32x2 e; e[0] = __builtin_amdgcn_exp2f(zl[0]); e[1] = __builtin_amdgcn_exp2f(zl[1]);
        const f32x2 d = e + 1.0f; f32x2 sg; sg[0] = __builtin_amdgcn_rcpf(d[0]); sg[1] = __builtin_amdgcn_rcpf(d[1]);
        y[i] = sg * ((hc[i] * rstd) * gg[i] + sk[i] * xx[i]); }
    u32x4 w; w.x = cvt_pk_bf16(y[0][0], y[0][1]); w.y = cvt_pk_bf16(y[1][0], y[1][1]); w.z = cvt_pk_bf16(y[2][0], y[2][1]); w.w = cvt_pk_bf16(y[3][0], y[3][1]);
    stg16(Y + o, w);
}
__device__ __forceinline__ void ph_ml_fin(const Args& a, int bid, int nb) {
    const int tid = otid(), lane = tid & 63, wave = tid >> 6, e0 = 8 * lane;
    asm volatile("s_waitcnt vmcnt(0)" ::: "memory"); __syncthreads();
    for (int p = bid; p < MNC * MH; p += nb) { const int ch = p / MH, h = p % MH;
        for (int r = wave; r < MCH; r += 4 * NWAVES) { const int i0 = ((ch * MCH + r) << 2) + h, st = NWAVES << 2;
            const FinIn f0 = fin_load(a, i0, e0), f1 = fin_load(a, i0 + st, e0), f2 = fin_load(a, i0 + 2 * st, e0), f3 = fin_load(a, i0 + 3 * st, e0);
            fin_compute(a, i0, e0, f0); fin_compute(a, i0 + st, e0, f1); fin_compute(a, i0 + 2 * st, e0, f2); fin_compute(a, i0 + 3 * st, e0, f3); } }
}

__device__ __forceinline__ void ph_s5_scan(const Args& a, LAS unsigned char* lds, int bid, int nb) {
    const int tid = otid(), pl4 = tid & 3, seg = tid >> 2;
    const float* EB = (const float*)(a.ws + WS_EB); bf16* UP = (bf16*)(a.ws + WS_UP); LAS float* tot = (LAS float*)lds;
    for (int u = bid; u < NG * 4; u += nb) {
        const int g = u >> 2, p0 = 16 * (u & 3) + 4 * pl4;
        f32x4 lr, li;
        { const f32x4 are = ldgf4(a.in[I_C_A_RE] + g * 64 + p0), aim = ldgf4(a.in[I_C_A_IM] + g * 64 + p0); const float dl = __expf(ldgf(a.in[I_C_LOG_STEP] + g));
#pragma unroll
          for (int q = 0; q < 4; ++q) { const float mag = __expf(dl * are[q]); float sn, cs; sincosf(dl * aim[q], &sn, &cs); lr[q] = mag * cs; li[q] = mag * sn; }
#pragma unroll
          for (int q = 0; q < 4; ++q) { const f32x4 nr = lr * lr - li * li, ni = 2.f * lr * li; lr = nr; li = ni; } }
        f32x4 sr = lr, si = li;
#pragma unroll
        for (int q = 0; q < 3; ++q) { const f32x4 nr = sr * sr - si * si, ni = 2.f * sr * si; sr = nr; si = ni; }
        const float* eb = EB + ((size_t)g * SNC + seg * 8) * 128 + p0;
        f32x4 er[8], ei[8];
#pragma unroll
        for (int c = 0; c < 8; ++c) { er[c] = ldgf4(eb + (size_t)c * 128); ei[c] = ldgf4(eb + (size_t)c * 128 + 64); }
        f32x4 str = (f32x4){0.f, 0.f, 0.f, 0.f}, sti = str;
#pragma unroll
        for (int c = 0; c < 8; ++c) { const f32x4 tr = er[c], ti = ei[c]; er[c] = str; ei[c] = sti;
            const f32x4 nr = lr * str - li * sti + tr, ni = lr * sti + li * str + ti; str = nr; sti = ni; }
        __syncthreads();
        *(LAS f32x4*)(tot + (seg * 16 + 4 * pl4) * 2) = (f32x4){str[0], sti[0], str[1], sti[1]}; *(LAS f32x4*)(tot + (seg * 16 + 4 * pl4) * 2 + 4) = (f32x4){str[2], sti[2], str[3], sti[3]};
        __syncthreads();
        f32x4 cr = (f32x4){0.f, 0.f, 0.f, 0.f}, ci = cr;
        for (int s = 0; s < seg; ++s) { const f32x4 t0 = *(const LAS f32x4*)(tot + (s * 16 + 4 * pl4) * 2), t1 = *(const LAS f32x4*)(tot + (s * 16 + 4 * pl4) * 2 + 4);
            const f32x4 tr = (f32x4){t0[0], t0[2], t1[0], t1[2]}, ti = (f32x4){t0[1], t0[3], t1[1], t1[3]};
            const f32x4 nr = sr * cr - si * ci + tr, ni = sr * ci + si * cr + ti; cr = nr; ci = ni; }
        bf16* up = UP + ((size_t)g * SNC + seg * 8) * SK + 256 + p0;
#pragma unroll
        for (int c = 0; c < 8; ++c) { const f32x4 vr = er[c] + cr, vi = ei[c] + ci;
            u32x2 wr_, wi_; wr_.x = cvt_pk_bf16(vr[0], vr[1]); wr_.y = cvt_pk_bf16(vr[2], vr[3]); wi_.x = cvt_pk_bf16(vi[0], vi[1]); wi_.y = cvt_pk_bf16(vi[2], vi[3]);
            stg8(up + (size_t)c * SK, wr_); stg8(up + (size_t)c * SK + 64, wi_);
            const f32x4 nr = lr * cr - li * ci, ni = lr * ci + li * cr; cr = nr; ci = ni; }
    }
    __syncthreads();
}
#ifndef MK_PER_PHASE
#define MK_PER_PHASE 0
#endif
constexpr int NPHASES = 38 - 4 * DEFER_NORM;
__global__ void __launch_bounds__(NTHR, 2) mega_fwd(Args args0) {
    extern __shared__ __attribute__((aligned(16))) unsigned char lds_raw[];
    LAS unsigned char* lds = (LAS unsigned char*)lds_raw;
    const int tid = threadIdx.x, bid0 = blockIdx.x, nb0 = gridDim.x;
    if (tid < 16) ((LAS unsigned*)(lds + MISC_OFF))[tid] = 0u;
    __syncthreads();
    XcdBarrier bar = xcd_barrier_post((unsigned*)(args0.ws + WS_CTL) + CW_BAR + args0.li * 4096, (volatile LAS unsigned*)(lds + MISC_OFF));
    int pc = 0; const int lo = args0.ph_lo, hi = args0.ph_hi;
#ifndef PH_REP
#define PH_REP 0ull
#endif
#ifndef PH_REPN
#define PH_REPN 1
#endif
#ifndef XBAR_EXTRA
#define XBAR_EXTRA 0
#endif
#ifndef PH_MASK
#define PH_MASK 0xFFFFFFFFull
#endif
#ifdef PROBE_LO
    long long tacc_ = 0;
#define PROBE_T0 if (pc >= PROBE_LO && pc < PROBE_HI) tacc_ -= (long long)__builtin_amdgcn_s_memrealtime();
#define PROBE_T1 if (pc >= PROBE_LO && pc < PROBE_HI) tacc_ += (long long)__builtin_amdgcn_s_memrealtime();
#else
#define PROBE_T0
#define PROBE_T1
#endif
#define PHASE(id, ...) do { if (((PH_MASK >> (id)) & 1ull) && pc >= lo && pc < hi) { PROBE_T0 { int bid = bid0, nb = nb0; unsigned char* ws = args0.ws; asm volatile("" : "+s"(bid), "+s"(nb), "+s"(ws)); Args args = args0; args.ws = ws; const int tidl = otid(), lane = tidl & 63, wave = tidl >> 6; const int gw = bid * NWAVES + wave, NGW = nb * NWAVES; bf16* HN = (bf16*)(ws + WS_HN); LAS float* scr = (LAS float*)(lds + wave * 16384); for (int rep_ = 0; rep_ < 1 + (int)((PH_REP >> (id)) & 1ull) * PH_REPN; ++rep_) { __VA_ARGS__; __syncthreads(); } } if (pc + 1 < hi) xcd_barrier(bar); PROBE_T1 } ++pc; } while (0)


#define XSRC(l) ((l) == 0 ? args.in[I_X] : (const float*)args.out)
#define GMIX(l) (args.in[I_NORM_MIX] + (l) * D)
#define GFFN(l) (args.in[I_NORM_FFN] + (l) * D)
#define DQ_TAIL(nun_, TL, TH, q_) do { if ((TL) >= 0) { const int nu__ = (nun_); const int mine_ = bid < nu__ ? (nu__ - 1 - bid) / nb + 1 : 0, mx_ = (nu__ - 1) / nb + 1; \
        if (mine_ < mx_) dq_work(args, (TL), (TH), (q_) * (mx_ - mine_), lds, scr); } } while (0)
#define DQ_DRAIN(G) do { if ((G) >= 0) { dq_work(args, (G), (G), -1, lds, scr); __syncthreads(); } } while (0)
#define RG_MIXER(l, jl, CONVF, TL, TH, RSI, EM, DR)   \
    PHASE(3, { if (RG_F8(jl)) { Sched2D S{(const char*)HN, (const char*)(ws + WS_WA_IN) + (size_t)(jl) * 2 * RW * D * 2, (unsigned)D / 2, (unsigned)D / 2, T / 256, 2 * RW / 256, nb, bid}; \
               pg8::Shape sh{D / 128, 0, (unsigned)D / 2, (unsigned)D / 2, 0u, 0u}; EpiBf16T<(RSI) != 0> E{(bf16*)(ws + WS_GX), RW, RW, (WS_XR - WS_GX) / 2, 0, 1.0f / 64.0f, (const float*)(ws + WS_RSS)}; \
               pg8::gemm_phase<EpiBf16T<(RSI) != 0>, Sched2D, false, false, true>(lds, sh, S, E); } \
               else { Sched2D S{(const char*)HN, (const char*)(ws + WS_WA_IN) + (size_t)(jl) * 2 * RW * D * 2, (unsigned)D, (unsigned)D, T / 256, 2 * RW / 256, nb, bid}; \
               pg8::Shape sh{D / 64, 0, (unsigned)D, (unsigned)D, 0u, 0u}; EpiBf16T<(RSI) != 0> E{(bf16*)(ws + WS_GX), RW, RW, (WS_XR - WS_GX) / 2, 0, 1.0f, (const float*)(ws + WS_RSS)}; \
               pg8::gemm_phase<EpiBf16T<(RSI) != 0>, Sched2D, false>(lds, sh, S, E); } DQ_TAIL((T / 256) * (2 * RW / 256), TL, TH, 2); } ); \
    PHASE(4, ph_rg_gates(args, lds, bid, nb, (jl)); ); \
    PHASE(5, ph_rg_carry(args, bid, nb); ); \
    PHASE(6, ph_rg_fix(args, bid, nb); ); \
    PHASE(7, { const bool early_ = ((bid >> 3) & 1) != 0;        \
               DQ_DRAIN(DR); \
               if ((CONVF) >= 0 && early_) { dq_work(args, DQ_MOE1, DQ_MOE1, -2, lds, scr); __syncthreads(); }     \
               { Sched2D S{(const char*)(ws + WS_GX), (const char*)(ws + WS_WA_OUT) + (size_t)(jl) * D * RW * 2, (unsigned)RW, (unsigned)RW, T / 256, D / 256, nb, bid}; \
               pg8::Shape sh{RW / 64, 0, (unsigned)RW, (unsigned)RW, 0u, 0u}; \
               if (EM) { EpiResidT<(EM) ? (EM) : 1> E{XSRC(l), args.out, ws + WS_HN, (float*)(ws + WS_RSS), (LAS float*)(lds + EXTRA_OFF), 1.0f}; pg8::gemm_phase<EpiResidT<(EM) ? (EM) : 1>, Sched2D, false>(lds, sh, S, E); } \
               else { EpiResid E{XSRC(l), args.out, nullptr, nullptr, nullptr, 1.0f}; pg8::gemm_phase<EpiResid, Sched2D, false>(lds, sh, S, E); } } \
               if ((CONVF) >= 0) { dq_work(args, DQ_MOE1, DQ_MOE1, -1, lds, scr); __syncthreads(); } } );
#define DENSE_FFN(l, W13O, W2O, GDR, TL, TH, F8, EM, DR)   \
    if (!DEFER_NORM) { PHASE(20, DQ_DRAIN(GDR); ph_norm<false, false, (F8) ? 3 : 0>(args, lds, bid, nb, args.out, args.out, GFFN(l), 0); ); } \
    PHASE(21, { if (F8) { Sched2D S{(const char*)HN, (const char*)(ws + (W13O)), (unsigned)D / 2, (unsigned)D / 2, T / 256, 2 * FF / 256, nb, bid}; \
                          pg8::Shape sh{D / 128, 0, (unsigned)D / 2, (unsigned)D / 2, 0u, 0u}; EpiSwiglu8T<DEFER_NORM != 0> E{ws + WS_H, (const float*)(ws + WS_RSS)}; \
                          pg8::gemm_phase<EpiSwiglu8T<DEFER_NORM != 0>, Sched2D, false, false, true>(lds, sh, S, E); } \
                else { Sched2D S{(const char*)HN, (const char*)(ws + (W13O)), (unsigned)D, (unsigned)D, T / 256, 2 * FF / 256, nb, bid}; \
                       pg8::Shape sh{D / 64, 0, (unsigned)D, (unsigned)D, 0u, 0u}; EpiSwigluT<DEFER_NORM != 0> E{(bf16*)(ws + WS_H), (const float*)(ws + WS_RSS)}; \
                       pg8::gemm_phase<EpiSwigluT<DEFER_NORM != 0>, Sched2D, false>(lds, sh, S, E); } \
                DQ_TAIL((T / 256) * (2 * FF / 256), TL, TH, 2); \
                if ((l) == 0 && bid >= nb / 2) s5_mats(args, lds, bid - nb / 2, nb / 2); } );     \
    PHASE(22, { if (DEFER_NORM) DQ_DRAIN(DR); \
                if (F8) { Sched2D S{(const char*)(ws + WS_H), (const char*)(ws + (W2O)), (unsigned)FF / 2, (unsigned)FF / 2, T / 256, D / 256, nb, bid}; \
                          pg8::Shape sh{FF / 128, 0, (unsigned)FF / 2, (unsigned)FF / 2, 0u, 0u}; EpiResidT<DEFER_NORM ? (EM) : 0> E{args.out, args.out, ws + WS_HN, (float*)(ws + WS_RSS), (LAS float*)(lds + EXTRA_OFF), 1.0f / 64.0f}; \
                          pg8::gemm_phase<EpiResidT<DEFER_NORM ? (EM) : 0>, Sched2D, false, false, true>(lds, sh, S, E); } \
                else { Sched2D S{(const char*)(ws + WS_H), (const char*)(ws + (W2O)), (unsigned)FF, (unsigned)FF, T / 256, D / 256, nb, bid}; \
                       pg8::Shape sh{FF / 64, 0, (unsigned)FF, (unsigned)FF, 0u, 0u}; EpiResidT<DEFER_NORM ? (EM) : 0> E{args.out, args.out, ws + WS_HN, (float*)(ws + WS_RSS), (LAS float*)(lds + EXTRA_OFF), 1.0f}; \
                       pg8::gemm_phase<EpiResidT<DEFER_NORM ? (EM) : 0>, Sched2D, false>(lds, sh, S, E); } } );
#define MOE_FFN(l, f, CONV, TL, TH, F8) \
    PHASE(23, if (CONV) { conv_moe(args, (f), gw, NGW, scr, lane); __syncthreads(); } ph_norm<false, true, (F8) ? 3 : 0>(args, lds, bid, nb, args.out, args.out, GFFN(l), (f)); ); \
    PHASE(25, { SchedMoe S; S.A = (const char*)HN; S.B = (const char*)(ws + WS_W13); S.lda = (F8) ? D / 2 : D; S.ldb = S.lda; S.bstride = (F8) ? W13_BYTES / 2 : W13_BYTES; S.nN = 2 * FF / 256; S.G = nb; S.c = bid; S.ksplit = 1; S.khbytes = 0; S.gather = 1; \
                int cnt_[NE]; moe_prefix(args, (f), S.ps, S.P, cnt_); LAS int* gt_ = (LAS int*)(lds + EXTRA_OFF); S.gt = gt_; \
                if (!(F8)) { const int* LISTE = (const int*)(ws + WS_LISTE); pg8::Unit u_; const int tid_ = otid(); \
                  _Pragma("unroll 1") for (int i_ = 0; S.next(i_, u_) && i_ < 23; ++i_) { const int e_ = u_.aux; int c_ = 0, p0_ = 0; \
                      _Pragma("unroll") for (int q_ = 0; q_ < NE; ++q_) { c_ = (e_ == q_) ? cnt_[q_] : c_; p0_ = (e_ == q_) ? S.ps[q_] : p0_; } \
                      const int r_ = (u_.pm - p0_) * 256 + tid_; if (tid_ < 256) gt_[i_ * 256 + tid_] = (r_ < c_) ? ldgi(LISTE + e_ * T + r_) : 0; } \
                  __syncthreads(); } \
                if (F8) { S.A = (const char*)(ws + WS_AGX); S.gather = 0; S.erows = T; pg8::Shape sh{D / 128, 0, (unsigned)D / 2, (unsigned)D / 2, 0u, 0u}; EpiSwiglu8 E{ws + WS_H};     \
                          pg8::gemm_phase<EpiSwiglu8, SchedMoe, false, false, true>(lds, sh, S, E); } \
                else { pg8::Shape sh{D / 64, 0, (unsigned)D, (unsigned)D, 0u, 0u}; EpiSwiglu E{(bf16*)(ws + WS_H)}; \
                       pg8::gemm_phase<EpiSwiglu, SchedMoe, false, true>(lds, sh, S, E); } \
                DQ_TAIL(S.P * S.nN, TL, TH, 2); } ); \
    PHASE(26, { SchedMoe S; S.A = (const char*)(ws + WS_H); S.B = (const char*)(ws + ((F8) ? WS_W2T8 : WS_W2T)); S.lda = (F8) ? FF / 2 : FF; S.ldb = S.lda; S.bstride = (F8) ? W2_BYTES / 2 : W2_BYTES; S.nN = D / 256; S.G = nb; S.c = bid; \
                S.ksplit = (F8) ? 1 : 2; S.khbytes = FF; S.gather = 0; S.gt = nullptr; int cnt_[NE]; moe_prefix(args, (f), S.ps, S.P, cnt_); \
                if (F8) { pg8::Shape sh{FF / 128, 0, (unsigned)FF / 2, (unsigned)FF / 2, 0u, 0u}; EpiBf16 E{(bf16*)(ws + WS_AG), D, 0, 0, 0, 1.0f / 64.0f}; \
                          pg8::gemm_phase<EpiBf16, SchedMoe, false, false, true>(lds, sh, S, E); } \
                else { pg8::Shape sh{FF / 128, 0, (unsigned)FF, (unsigned)FF, 0u, 0u}; EpiBf16 E{(bf16*)(ws + WS_AG), D, 0, 0, (WS_OUT - WS_AG) / 2}; \
                       pg8::gemm_phase<EpiBf16, SchedMoe, false>(lds, sh, S, E); } \
                DQ_TAIL(S.P * S.nN * S.ksplit, TL, TH, 3); } );

        PHASE(0, conv_a(args, 0, gw, NGW, scr, lane); __syncthreads(); ph_norm<false, false, 0>(args, lds, bid, nb, XSRC(0), args.out, GMIX(0), 0); );
    RG_MIXER(0, 0, -1, DQ_DENSE0, DQ_C, 0, DEFER_NORM ? (DENSE_F8(0) ? 2 : 1) : 0, DEFER_NORM ? DQ_DENSE0 : -1)
    DENSE_FFN(0, WS_W13, WS_W2T, DQ_DENSE0, DQ_B, DQ_C, DENSE_F8(0), 1, DQ_B)
    if (!DEFER_NORM) { PHASE(1, DQ_DRAIN(DQ_B); ph_norm<false, false, 0>(args, lds, bid, nb, XSRC(1), args.out, GMIX(1), 0); ); }
    PHASE(8, { Sched2D S{(const char*)HN, (const char*)(ws + WS_WB_IN), (unsigned)D, (unsigned)D, T / 256, 2 * MI / 256, nb, bid};
               pg8::Shape sh{D / 64, 0, (unsigned)D, (unsigned)D, 0u, 0u}; EpiBf16T<DEFER_NORM != 0> E{(bf16*)(ws + WS_XM), MI, MI, (WS_Z - WS_XM) / 2, 0, 1.0f, (const float*)(ws + WS_RSS)};
               pg8::gemm_phase<EpiBf16T<DEFER_NORM != 0>, Sched2D, false>(lds, sh, S, E); } );
    PHASE(9, ph_ml_prep(args, lds, bid, nb); );
    PHASE(10, ph_ml_gscan(args, lds, bid, nb); );
    PHASE(11, { SchedSbuild S{(const char*)(ws + WS_Q), (const char*)(ws + WS_K), nb, bid};
                pg8::Shape sh{HD / 64, 0, (unsigned)MI, (unsigned)MI, 0u, 0u}; EpiSbuild E{(bf16*)(ws + WS_SM), (float*)(ws + WS_DENP), (const float*)(ws + WS_GS), (const float*)(ws + WS_MC)};
                pg8::gemm_phase<EpiSbuild, SchedSbuild, false>(lds, sh, S, E); }
#ifdef PROBE_KTW
              tacc_ -= (long long)__builtin_amdgcn_s_memrealtime();
#endif
              ph_ml_ktw(args, lds, bid, nb);
#ifdef PROBE_KTW
              tacc_ += (long long)__builtin_amdgcn_s_memrealtime();
#endif
#ifdef PROBE_STATE
              tacc_ -= (long long)__builtin_amdgcn_s_memrealtime();
#endif
              { SchedState S{(const char*)(ws + WS_VT), (const char*)(ws + WS_KT), nb, bid};
                pg8::Shape sh{MCH / 64, 0, (unsigned)MCH, (unsigned)MCH, 0u, 0u}; EpiBf16 E{(bf16*)(ws + WS_CT), HD, 0, 0, (size_t)HD * HD};
                pg8::gemm_phase<EpiBf16, SchedState, false>(lds, sh, S, E); }
#ifdef PROBE_STATE
              tacc_ += (long long)__builtin_amdgcn_s_memrealtime();
#endif
              );
    PHASE(28, ph_ml_sscan(args, bid, nb); );
    PHASE(13, { SchedPass2 S{(const char*)(ws + WS_SM), (const char*)(ws + WS_Q), (const char*)(ws + WS_VT), (const char*)(ws + WS_CT), nb, bid};
                pg8::Shape sh{MCH / 64, HD / 64, (unsigned)MCH, (unsigned)MCH, (unsigned)MI, (unsigned)HD}; EpiNum E{(bf16*)(ws + WS_NUM), (const float*)(ws + WS_RMT), (const float*)(ws + WS_MC)};
                pg8::gemm_phase<EpiNum, SchedPass2, true>(lds, sh, S, E); }
              ph_ml_fin(args, bid, nb); );
#ifndef ML_OUT_STAGGER
#define ML_OUT_STAGGER 1
#endif
    PHASE(15, { const bool early_ = !ML_OUT_STAGGER || ((bid >> 3) & 1) != 0;
                if (early_) { conv_moe(args, 0, gw, NGW, scr, lane); __syncthreads(); }
                { Sched2D S{(const char*)(ws + WS_Y), (const char*)(ws + WS_WB_OUT), (unsigned)MI, (unsigned)MI, T / 256, D / 256, nb, bid};
                pg8::Shape sh{MI / 64, 0, (unsigned)MI, (unsigned)MI, 0u, 0u}; EpiResid E{args.out, args.out, nullptr, nullptr, nullptr, 1.0f};
                pg8::gemm_phase<EpiResid, Sched2D, false>(lds, sh, S, E); }
                if (!early_) { conv_moe(args, 0, gw, NGW, scr, lane); __syncthreads(); } } );
    MOE_FFN(1, 0, false, DQ_DENSE1, DQ_A1, MOE_F8(0))
    PHASE(2, DQ_DRAIN(DQ_C); ph_norm<true, false, 1>(args, lds, bid, nb, XSRC(2), args.out, GMIX(2), 0); );
    PHASE(16, { SchedBatch S{(const char*)(ws + WS_UP), (const char*)(ws + WS_S5_BE), (unsigned)SK, 256u, (size_t)SNC * SK * 2, (size_t)256 * 256 * 2, SNC / 256, NG, nb, bid};
                pg8::Shape sh{4, 0, (unsigned)SK, 256u, 0u, 0u}; EpiS5e E{(float*)(ws + WS_EB)};
                pg8::gemm_phase<EpiS5e, SchedBatch, false>(lds, sh, S, E); } );
    PHASE(17, ph_s5_scan(args, lds, bid, nb); );
    PHASE(18, { SchedBatch S{(const char*)(ws + WS_UP), (const char*)(ws + WS_S5_KC), (unsigned)SK, (unsigned)SK, (size_t)SNC * SK * 2, (size_t)256 * SK * 2, SNC / 256, NG, nb, bid};
                pg8::Shape sh{SK / 64, 0, (unsigned)SK, (unsigned)SK, 0u, 0u}; EpiS5y E{(const bf16*)(ws + WS_UP), args.in[I_C_D], (bf16*)(ws + WS_YA)};
                pg8::gemm_phase<EpiS5y, SchedBatch, false>(lds, sh, S, E); } );
    PHASE(19, { if (DEFER_NORM) DQ_DRAIN(DQ_DENSE1);
                Sched2D S{(const char*)(ws + WS_YA), (const char*)(ws + WS_WC_GLU), 16u, (unsigned)D, T / 256, D / 256, nb, bid};
                pg8::Shape sh{D / 64, 0, 16u, (unsigned)D, 0u, 0u, 4u * T * 32u, T * 32u}; constexpr int EM_ = DEFER_NORM ? (DENSE_F8(1) ? 2 : 1) : 0;
                EpiGluT<EM_> E{(const bf16*)(ws + WS_YA), args.in[I_C_B_GLU], args.out, ws + WS_HN, (float*)(ws + WS_RSS), (LAS float*)(lds + EXTRA_OFF)};
                pg8::gemm_phase<EpiGluT<EM_>, Sched2D, false>(lds, sh, S, E); } );
    DENSE_FFN(2, WS_WD1_13, WS_WD1_2, DQ_DENSE1, DQ_MOE1, DQ_MOE1, DENSE_F8(1), (RG_F8(1) ? 2 : 1), DQ_A1)
    if (!DEFER_NORM) PHASE(1, DQ_DRAIN(DQ_A1); if (RG_F8(1)) ph_norm<false, false, 3>(args, lds, bid, nb, XSRC(3), args.out, GMIX(3), 0); else ph_norm<false, false, 0>(args, lds, bid, nb, XSRC(3), args.out, GMIX(3), 0); );
    RG_MIXER(3, 1, 1, DQ_MOE1, DQ_MOE1, DEFER_NORM, 0, -1)
    MOE_FFN(3, 1, false, -1, -1, MOE_F8(1))
    PHASE(27, ph_norm<true, false, 2>(args, lds, bid, nb, args.out, args.out, args.in[I_NORM_FINAL], 1); );
    for (int xb_ = 0; xb_ < XBAR_EXTRA; ++xb_) xcd_barrier(bar);
#ifdef PROBE_LO
    if (bid0 == 0 && tid == 0) { const long long te_ = (long long)__builtin_amdgcn_s_memrealtime() + (long long)(PROBE_N) * tacc_; while ((long long)__builtin_amdgcn_s_memrealtime() < te_) __builtin_amdgcn_s_sleep(16); }
#endif
#undef PHASE
}

extern "C" void kernel_launch(void* const* d_in, const int* in_sizes, int n_in, void* d_out, int out_size, void* d_ws, size_t ws_size, hipStream_t stream) {
    static int grid = 0;
    if (grid == 0) {
        if (n_in != N_IN || in_sizes[0] != T * D || out_size != T * D || ws_size < WS_END) {
            fprintf(stderr, "kernel_launch: unexpected problem (n_in %d, in0 %d, out %d, ws %zu, need %zu)\n", n_in, n_in > 0 ? in_sizes[0] : -1, out_size, ws_size, (size_t)WS_END); grid = -1; return; }
        int dev = 0, cus = 0, per_cu = 0;
        if (hipGetDevice(&dev) != hipSuccess || hipDeviceGetAttribute(&cus, hipDeviceAttributeMultiprocessorCount, dev) != hipSuccess) { fprintf(stderr, "kernel_launch: device query failed\n"); grid = -1; return; }
        if (hipFuncSetAttribute((const void*)mega_fwd, hipFuncAttributeMaxDynamicSharedMemorySize, LDS_BYTES) != hipSuccess) { fprintf(stderr, "kernel_launch: hipFuncSetAttribute failed\n"); grid = -1; return; }
        if (hipOccupancyMaxActiveBlocksPerMultiprocessor(&per_cu, (const void*)mega_fwd, NTHR, LDS_BYTES) != hipSuccess || per_cu < 1) fprintf(stderr, "kernel_launch: occupancy query reports %d blocks per CU\n", per_cu);
        (void)hipGetLastError();
        if (cus < 256) { fprintf(stderr, "kernel_launch: %d CUs < 256: the 256-workgroup grid would not be resident\n", cus); grid = -1; return; }
        grid = 256;
    }
    if (grid < 0) return;
    if (hipMemsetAsync((char*)d_ws + WS_CTL, 0, CTL_ZERO_BYTES, stream) != hipSuccess) { fprintf(stderr, "kernel_launch: memset failed\n"); return; }
    Args a{};
    for (int i = 0; i < N_IN; ++i) a.in[i] = (const float*)d_in[i];
    a.out = (float*)d_out; a.ws = (unsigned char*)d_ws; a.pad = 0;
#if MK_PER_PHASE
    for (int k = 0; k < NPHASES; ++k) { a.ph_lo = k; a.ph_hi = k + 1; a.li = k; hipLaunchKernelGGL(mega_fwd, dim3(grid), dim3(NTHR), LDS_BYTES, stream, a); }
#else
    a.ph_lo = 0; a.ph_hi = NPHASES; a.li = 0;
    hipLaunchKernelGGL(mega_fwd, dim3(grid), dim3(NTHR), LDS_BYTES, stream, a);
#endif
    const hipError_t le = hipPeekAtLastError();
    if (le != hipSuccess) fprintf(stderr, "kernel_launch: launch failed: %s\n", hipGetErrorName(le));
}
```

```cpp
#include <hip/hip_runtime.h>
#include <cstdio>
#include <cstdint>

#define LAS __attribute__((address_space(3)))
#define GAS __attribute__((address_space(1)))
typedef unsigned short bf16;
typedef short bf16x8 __attribute__((ext_vector_type(8)));
typedef float f32x4 __attribute__((ext_vector_type(4)));
typedef float f32x2 __attribute__((ext_vector_type(2)));
typedef unsigned u32x4 __attribute__((ext_vector_type(4)));
typedef unsigned u32x2 __attribute__((ext_vector_type(2)));

__device__ __forceinline__ unsigned cvt_pk_bf16(float lo, float hi) { unsigned r; asm volatile("v_cvt_pk_bf16_f32 %0, %1, %2" : "=v"(r) : "v"(lo), "v"(hi)); return r; }
__device__ __forceinline__ float bflo(unsigned u) { return __uint_as_float(u << 16); }
__device__ __forceinline__ float bfhi(unsigned u) { return __uint_as_float(u & 0xffff0000u); }
__device__ __forceinline__ float bf2f(bf16 b) { return __uint_as_float(((unsigned)b) << 16); }
__device__ __forceinline__ bf16 f2bf(float f) { return (bf16)(cvt_pk_bf16(f, 0.f) & 0xffffu); }
__device__ __forceinline__ unsigned cvt4_fp8(float a, float b, float c, float d) { int p = 0; p = __builtin_amdgcn_cvt_pk_fp8_f32(a, b, p, false); p = __builtin_amdgcn_cvt_pk_fp8_f32(c, d, p, true); return (unsigned)p; }
__device__ __forceinline__ float sigm(float x) { return __builtin_amdgcn_rcpf(1.0f + __expf(-x)); }
__device__ __forceinline__ float silu_f(float x) { return x * sigm(x); }
__device__ __forceinline__ float gelu_tanh(float x) { return x * sigm(1.5957691216057308f * (x + 0.044715f * x * x * x)); }
__device__ __forceinline__ float softplus_f(float x) { return x > 20.f ? x : log1pf(__expf(x)); }

__device__ __forceinline__ int otid() { int t = threadIdx.x; asm volatile("" : "+v"(t)); return t; }
__device__ __forceinline__ void glds16(const char* sbase, unsigned voff, unsigned lds_dst) {
    unsigned keep;
    asm volatile("s_mov_b32 %0, m0\n\ts_mov_b32 m0, %3\n\ts_nop 0\n\tglobal_load_lds_dwordx4 %1, %2\n\ts_mov_b32 m0, %0" : "=&s"(keep) : "v"(voff), "s"(sbase), "s"(lds_dst) : "memory");
}
namespace pg8 {
constexpr int BM = 256, BK = 64, HALF = 128, HTB = HALF * BK * 2, STAGE_BYTES = 8 * HTB;
__host__ __device__ __forceinline__ int lds_byte(int r, int c) { const int st = (r >> 4) * 2 + (c >> 5), rr = r & 15, cc = c & 31, ob = rr * 64 + cc * 2; return st * 1024 + (ob ^ (((ob >> 9) & 1) << 5)); }
__host__ __device__ __forceinline__ void stage_rc(int b, int& R, int& C) { const int st = b / 1024, sb = b % 1024, swz = sb ^ (((sb >> 9) & 1) << 5); R = (st >> 1) * 16 + swz / 64; C = (st & 1) * 32 + (swz % 64) / 2; }
__host__ __device__ __forceinline__ int perm32(int rho) { const int n = rho >> 4, i = rho & 15; return 8 * (i >> 2) + 4 * n + (i & 3); }

struct Unit { int pm, pn, aux; const char *A1, *B1, *A2, *B2; };
struct Shape { int nt1, nt2; unsigned lda1, ldb1, lda2, ldb2; unsigned kstepA = 128u, agstride = 0u; };

typedef int pg8_v8i __attribute__((ext_vector_type(8))); typedef int pg8_v4i __attribute__((ext_vector_type(4)));
__device__ __forceinline__ pg8_v8i pg8_cat(bf16x8 lo, bf16x8 hi) { const pg8_v4i a = __builtin_bit_cast(pg8_v4i, lo), b = __builtin_bit_cast(pg8_v4i, hi); return __builtin_shufflevector(a, b, 0, 1, 2, 3, 4, 5, 6, 7); }
template <class Epi, class Sched, bool TWO, bool GATHER = false, bool FP8 = false>
__device__ __forceinline__ void gemm_phase(LAS unsigned char* lds, const Shape sh, const Sched& S, const Epi& E) {
    const int tid = otid(), wid = __builtin_amdgcn_readfirstlane(tid >> 6), lane = tid & 63, wr = wid >> 2, wc = wid & 3, fr = lane & 15, fq = lane >> 4;
    const int nt1 = sh.nt1, nt = sh.nt1 + (TWO ? sh.nt2 : 0);
    unsigned vA1[2], vB1[2], vA2[2], vB2[2]; unsigned vGc[2][2], vGn[2][2];
#pragma unroll
    for (int i = 0; i < 2; ++i) { int R, C; stage_rc(tid * 16 + i * 8192, R, C); const int Rb = Epi::PERM ? ((R & ~31) + perm32(R & 31)) : R;
        vA1[i] = sh.agstride ? (unsigned)(C >> 4) * sh.agstride + (unsigned)(R * 32 + (C & 15) * 2) : (unsigned)(R * sh.lda1 + C) * 2u; vB1[i] = (unsigned)(Rb * sh.ldb1 + C) * 2u;
        vA2[i] = TWO ? (unsigned)(R * sh.lda2 + C) * 2u : 0u; vB2[i] = TWO ? (unsigned)(Rb * sh.ldb2 + C) * 2u : 0u; }
    const unsigned hA1 = 256u * sh.lda1, hB1 = 256u * sh.ldb1, hA2 = TWO ? 256u * sh.lda2 : 0u, hB2 = TWO ? 256u * sh.ldb2 : 0u;
    const unsigned kstepA = sh.kstepA;
    const unsigned ldsw = (unsigned)wid * 1024u, ldsbase = (unsigned)(unsigned long long)lds;
    const int aoff = lds_byte(wr * 64 + fr, fq * 8), boff = lds_byte(wc * 32 + fr, fq * 8);
#define PG8_SA(b, h) (((b) * 2 + (h)) * HTB)
#define PG8_SB(b, h) ((4 + (b) * 2 + (h)) * HTB)
#define PG8_LOADG(ui_, dst) do { if constexpr (GATHER) { const int tg_ = otid(); _Pragma("unroll") for (int i_ = 0; i_ < 2; ++i_) { int R_, C_; stage_rc(tg_ * 16 + i_ * 8192, R_, C_);     \
        _Pragma("unroll") for (int h_ = 0; h_ < 2; ++h_) dst[h_][i_] = (unsigned)S.gt[(ui_) * 256 + h_ * 128 + R_] * (sh.lda1 * 2u) + (unsigned)C_ * 2u; } } } while (0)
#define PG8_STG_AG(bufoff, U, tt, h, usen) do { if constexpr (GATHER) { const char* gp_ = (U).A1 + (size_t)(tt) * 128; \
        const unsigned v0_ = (usen) ? vGn[h][0] : vGc[h][0], v1_ = (usen) ? vGn[h][1] : vGc[h][1]; \
        glds16(gp_, v0_, ldsbase + (unsigned)(bufoff) + ldsw); glds16(gp_, v1_, ldsbase + (unsigned)(bufoff) + ldsw + 8192u); } else { PG8_STG_A(bufoff, U, tt, h); } } while (0)
#define PG8_STG_A(bufoff, U, tt, h) do { const bool s2_ = TWO && ((tt) >= nt1); \
        const char* gp_ = (s2_ ? (U).A2 + (size_t)((tt) - nt1) * 128 + (size_t)(h) * hA2 : (U).A1 + (size_t)(tt) * kstepA + (size_t)(h) * hA1); \
        const unsigned v0_ = s2_ ? vA2[0] : vA1[0], v1_ = s2_ ? vA2[1] : vA1[1]; \
        glds16(gp_, v0_, ldsbase + (unsigned)(bufoff) + ldsw); glds16(gp_, v1_, ldsbase + (unsigned)(bufoff) + ldsw + 8192u); } while (0)
#define PG8_STG_B(bufoff, U, tt, h) do { const bool s2_ = TWO && ((tt) >= nt1); \
        const char* gp_ = (s2_ ? (U).B2 + (size_t)((tt) - nt1) * 128 + (size_t)(h) * hB2 : (U).B1 + (size_t)(tt) * 128 + (size_t)(h) * hB1); \
        const unsigned v0_ = s2_ ? vB2[0] : vB1[0], v1_ = s2_ ? vB2[1] : vB1[1]; \
        glds16(gp_, v0_, ldsbase + (unsigned)(bufoff) + ldsw); glds16(gp_, v1_, ldsbase + (unsigned)(bufoff) + ldsw + 8192u); } while (0)
#define PG8_LDA(dst, b, h) do { if constexpr (FP8) { _Pragma("unroll") for (int m = 0; m < 4; ++m) dst##8[m] = pg8_cat(*(const LAS bf16x8*)(lds + PG8_SA(b, h) + aoff + m * 2048), *(const LAS bf16x8*)(lds + PG8_SA(b, h) + aoff + m * 2048 + 1024)); } \
        else { _Pragma("unroll") for (int m = 0; m < 4; ++m) _Pragma("unroll") for (int k = 0; k < 2; ++k) dst[m][k] = *(const LAS bf16x8*)(lds + PG8_SA(b, h) + aoff + m * 2048 + k * 1024); } } while (0)
#define PG8_LDB(dst, b, h) do { if constexpr (FP8) { _Pragma("unroll") for (int n = 0; n < 2; ++n) dst##8[n] = pg8_cat(*(const LAS bf16x8*)(lds + PG8_SB(b, h) + boff + n * 2048), *(const LAS bf16x8*)(lds + PG8_SB(b, h) + boff + n * 2048 + 1024)); } \
        else { _Pragma("unroll") for (int n = 0; n < 2; ++n) _Pragma("unroll") for (int k = 0; k < 2; ++k) dst[n][k] = *(const LAS bf16x8*)(lds + PG8_SB(b, h) + boff + n * 2048 + k * 1024); } } while (0)
#define PG8_MMA(ai, bj, At, Bt) do { __builtin_amdgcn_s_setprio(1); if constexpr (FP8) { _Pragma("unroll") for (int m = 0; m < 4; ++m) _Pragma("unroll") for (int n = 0; n < 2; ++n) \
        acc[ai][bj][m][n] = __builtin_amdgcn_mfma_scale_f32_16x16x128_f8f6f4(Bt##8[n], At##8[m], acc[ai][bj][m][n], 0, 0, 0, 0x7f7f7f7f, 0, 0x7f7f7f7f); } \
        else { _Pragma("unroll") for (int m = 0; m < 4; ++m) _Pragma("unroll") for (int n = 0; n < 2; ++n) _Pragma("unroll") for (int k = 0; k < 2; ++k) \
        acc[ai][bj][m][n] = __builtin_amdgcn_mfma_f32_16x16x32_bf16(Bt[n][k], At[m][k], acc[ai][bj][m][n], 0, 0, 0); } __builtin_amdgcn_s_setprio(0); } while (0)
#define PG8_WAIT_V(n) asm volatile("s_waitcnt vmcnt(" #n ")" ::: "memory")
#define PG8_WAIT_L(n) asm volatile("s_waitcnt lgkmcnt(" #n ")" ::: "memory")
#define PG8_BAR __builtin_amdgcn_s_barrier()
#define PG8_SCHED __builtin_amdgcn_sched_barrier(0)
    Unit cur, nxt;
    if (!S.next(0, cur)) return;
    f32x4 acc[2][2][4][2];
#pragma unroll
    for (int a = 0; a < 2; ++a)
#pragma unroll
        for (int b = 0; b < 2; ++b)
#pragma unroll
            for (int m = 0; m < 4; ++m)
#pragma unroll
                for (int n = 0; n < 2; ++n) acc[a][b][m][n] = (f32x4){0.f, 0.f, 0.f, 0.f};
    bf16x8 At[4][2], B0[2][2], B1[2][2]; pg8_v8i At8[4], B08[2], B18[2];
    PG8_LOADG(0, vGc);
    PG8_STG_B(PG8_SB(0, 0), cur, 0, 0); PG8_STG_B(PG8_SB(0, 1), cur, 0, 1); PG8_STG_AG(PG8_SA(0, 0), cur, 0, 0, false); PG8_STG_AG(PG8_SA(0, 1), cur, 0, 1, false);
    if (wr == 1) PG8_BAR;
    PG8_WAIT_V(2); PG8_BAR;
    PG8_STG_B(PG8_SB(1, 0), cur, 1, 0); PG8_STG_AG(PG8_SA(1, 0), cur, 1, 0, false); PG8_STG_B(PG8_SB(1, 1), cur, 1, 1);
    PG8_WAIT_V(6); PG8_BAR;
    for (int ui = 0;; ++ui) {
        const bool has_next = S.next(ui + 1, nxt);
        if (!has_next) nxt = cur;
        if constexpr (GATHER) { if (has_next) PG8_LOADG(ui + 1, vGn); else {
#pragma unroll
            for (int h_ = 0; h_ < 2; ++h_) { vGn[h_][0] = vGc[h_][0]; vGn[h_][1] = vGc[h_][1]; } } }
#pragma unroll 1
        for (int t = 0; t < nt; t += 2) {
            const bool last = (t == nt - 2);
            const char* uA1 = last ? nxt.A1 : cur.A1; const char* uB1 = last ? nxt.B1 : cur.B1; const char* uA2 = last ? nxt.A2 : cur.A2; const char* uB2 = last ? nxt.B2 : cur.B2;
            Unit U2; U2.A1 = uA1; U2.B1 = uB1; U2.A2 = uA2; U2.B2 = uB2;
            const int t2 = last ? 0 : t + 2, t3 = t2 + 1;
            PG8_LDB(B0, 0, 0); PG8_LDB(B1, 0, 1); PG8_SCHED; PG8_LDA(At, 0, 0); PG8_STG_AG(PG8_SA(1, 1), cur, t + 1, 1, false);
            PG8_WAIT_V(8); PG8_WAIT_L(0); PG8_BAR; PG8_MMA(0, 0, At, B0); PG8_MMA(0, 1, At, B1); PG8_BAR; PG8_SCHED;
            PG8_LDA(At, 0, 1); PG8_STG_B(PG8_SB(0, 0), U2, t2, 0); PG8_STG_B(PG8_SB(0, 1), U2, t2, 1); PG8_STG_AG(PG8_SA(0, 0), U2, t2, 0, last);
            PG8_WAIT_V(8); PG8_WAIT_L(0); PG8_BAR; PG8_MMA(1, 0, At, B0); PG8_MMA(1, 1, At, B1); PG8_BAR; PG8_SCHED;
            PG8_LDB(B0, 1, 0); PG8_LDB(B1, 1, 1); PG8_SCHED; PG8_LDA(At, 1, 0); PG8_STG_AG(PG8_SA(0, 1), U2, t2, 1, last);
            PG8_WAIT_V(8); PG8_WAIT_L(0); PG8_BAR; PG8_MMA(0, 0, At, B0); PG8_MMA(0, 1, At, B1); PG8_BAR; PG8_SCHED;
            PG8_LDA(At, 1, 1); PG8_STG_B(PG8_SB(1, 0), U2, t3, 0); PG8_STG_B(PG8_SB(1, 1), U2, t3, 1); PG8_STG_AG(PG8_SA(1, 0), U2, t3, 0, last);
            PG8_WAIT_V(8); PG8_WAIT_L(0); PG8_BAR; PG8_MMA(1, 0, At, B0); PG8_MMA(1, 1, At, B1); PG8_BAR; PG8_SCHED;
        }
        if (wr == 0) PG8_BAR;
        { const int l2_ = otid() & 63; E(acc, cur, wr, wc, l2_ & 15, l2_ >> 4); }
        if (!has_next) break;
#pragma unroll
        for (int a = 0; a < 2; ++a)
#pragma unroll
            for (int b = 0; b < 2; ++b)
#pragma unroll
                for (int m = 0; m < 4; ++m)
#pragma unroll
                    for (int n = 0; n < 2; ++n) acc[a][b][m][n] = (f32x4){0.f, 0.f, 0.f, 0.f};
        cur = nxt;
        if constexpr (GATHER) {
#pragma unroll
            for (int h_ = 0; h_ < 2; ++h_) { vGc[h_][0] = vGn[h_][0]; vGc[h_][1] = vGn[h_][1]; } }
        if (wr == 1) PG8_BAR;
    }
    PG8_WAIT_V(0);
    PG8_BAR;
#undef PG8_SA
#undef PG8_SB
#undef PG8_STG_A
#undef PG8_STG_AG
#undef PG8_LOADG
#undef PG8_STG_B
#undef PG8_LDA
#undef PG8_LDB
#undef PG8_MMA
#undef PG8_WAIT_V
#undef PG8_WAIT_L
#undef PG8_BAR
#undef PG8_SCHED
}
}

#define XB_TMO      128
#define XB_XCNT(j)  (256  + 64 * (j))
#define XB_XSUB(j)  (1280 + 64 * (j))
#define XB_XGEN(j)  (2304 + 64 * (j))
#define XB_TOP      3328
#define XB_TOPGEN   3392
#define XCD_BAR_WORDS 3456
#define XB_SPIN_CAP (1u << 18)

__device__ __forceinline__ unsigned xb_ld(unsigned* p)              { return __hip_atomic_load(p, __ATOMIC_RELAXED, __HIP_MEMORY_SCOPE_AGENT); }
__device__ __forceinline__ unsigned xb_add(unsigned* p, unsigned v) { return __hip_atomic_fetch_add(p, v, __ATOMIC_RELAXED, __HIP_MEMORY_SCOPE_AGENT); }
__device__ __forceinline__ unsigned xb_xcc_id() { return (unsigned)__builtin_amdgcn_s_getreg((3 << 11) | 20) & 0xFu; }
#define XB_SPIN(cond, bar) do { unsigned _sp = 0; while (cond) { __builtin_amdgcn_s_sleep(1); \
    if ((++_sp & 255u) == 0u) { if (xb_ld(&(bar)[XB_TMO])) break; if (_sp > XB_SPIN_CAP) { atomicAdd(&(bar)[XB_TMO], 1u); break; } } } } while (0)

struct XcdBarrier {
    unsigned* bar; unsigned x;
    volatile LAS unsigned* st;
};

__device__ __forceinline__ XcdBarrier xcd_barrier_post(unsigned* bar, volatile LAS unsigned* st) {
    XcdBarrier b; b.bar = bar; b.x = xb_xcc_id(); b.st = st;
    if (threadIdx.x == 0) (void)xb_add(&bar[XB_XCNT(b.x)], 1u);
    return b;
}
__device__ __forceinline__ void xcd_barrier_complete(unsigned* bar, unsigned x, unsigned& nloc, unsigned& nx) {
    const unsigned G = gridDim.x * gridDim.y * gridDim.z;
    unsigned sum, cnt, mine, sp = 0u;
    for (;;) {
        sum = 0u; cnt = 0u; mine = 0u;
#pragma unroll
        for (unsigned j = 0; j < 16; ++j) { const unsigned c = xb_ld(&bar[XB_XCNT(j)]); sum += c; cnt += (c > 0u) ? 1u : 0u; mine = (j == x) ? c : mine; }
        if (sum == G) break;
        __builtin_amdgcn_s_sleep(1);
        if ((++sp & 255u) == 0u) { if (xb_ld(&bar[XB_TMO])) break; if (sp > XB_SPIN_CAP) { atomicAdd(&bar[XB_TMO], 1u); break; } }
    }
    nloc = mine > 0u ? mine : 1u; nx = cnt > 0u ? cnt : 1u;
}

__device__ __forceinline__ void xcd_barrier(const XcdBarrier& b) {
    asm volatile("s_waitcnt vmcnt(0)" ::: "memory");
    __syncthreads();
    if (threadIdx.x == 0) {
        unsigned* bar = b.bar;
        __builtin_amdgcn_s_waitcnt(0);
        unsigned nloc = b.st[0], nx = b.st[1];
        if (nloc == 0u) { xcd_barrier_complete(bar, b.x, nloc, nx); b.st[0] = nloc; b.st[1] = nx; }
        const unsigned old = xb_add(&bar[XB_XSUB(b.x)], 1u);
        const unsigned gen = old / nloc;
        if (old + 1u == (gen + 1u) * nloc) {
            __builtin_amdgcn_fence(__ATOMIC_RELEASE, "agent");
            asm volatile("s_waitcnt vmcnt(0)" ::: "memory");
            const unsigned og = xb_add(&bar[XB_TOP], 1u);
            const unsigned tg = og / nx;
            if (og + 1u == (tg + 1u) * nx) xb_add(&bar[XB_TOPGEN], 1u);
            else XB_SPIN(xb_ld(&bar[XB_TOPGEN]) == tg, bar);
            __builtin_amdgcn_fence(__ATOMIC_ACQUIRE, "agent");
            xb_add(&bar[XB_XGEN(b.x)], 1u);
            asm volatile("s_waitcnt vmcnt(0)" ::: "memory");
        } else {
            XB_SPIN(xb_ld(&bar[XB_XGEN(b.x)]) == gen, bar);
            __builtin_amdgcn_fence(__ATOMIC_ACQUIRE, "agent");
            asm volatile("s_waitcnt vmcnt(0)" ::: "memory");
        }
    }
    __syncthreads();
}

constexpr int T = 16384, D = 1024;
constexpr int RW = 1280, RNB = 10, RBD = 128, RCH = 64, RNC = T / RCH;
constexpr int MI = 2048, MH = 4, HD = 512, MCH = 256, MNC = T / MCH;
constexpr int LDT = T + 64;
constexpr int NG = 64, SL = 16, SNC = T / SL, SK = 384;
constexpr int FF = 2816, NE = 8, MOE_ROWS = 2 * T + NE * 256;
#ifndef MOE_F8_MASK
#define MOE_F8_MASK 3
#endif
#define MOE_F8(f) (((MOE_F8_MASK) >> (f)) & 1)
#ifndef DENSE_F8_MASK
#define DENSE_F8_MASK 2
#endif
#define DENSE_F8(f) (((DENSE_F8_MASK) >> (f)) & 1)
#ifndef RG_F8_MASK
#define RG_F8_MASK 2
#endif
#define RG_F8(j) (((RG_F8_MASK) >> (j)) & 1)
#ifndef DEFER_NORM
#define DEFER_NORM 1
#endif
constexpr float EPS = 1e-6f;
constexpr int NTHR = 512, NWAVES = 8;

enum { I_X = 0, I_NORM_MIX, I_NORM_FFN, I_NORM_FINAL, I_A_W_IN, I_A_CONV_W, I_A_CONV_B, I_A_W_R, I_A_B_R, I_A_W_I, I_A_B_I, I_A_LAM, I_A_W_OUT,
       I_B_W_IN, I_B_CONV_W, I_B_CONV_B, I_B_W_Q, I_B_W_K, I_B_W_V, I_B_W_GATE, I_B_B_GATE, I_B_NORM, I_B_SKIP, I_B_W_OUT,
       I_C_A_RE, I_C_A_IM, I_C_LOG_STEP, I_C_B_RE, I_C_B_IM, I_C_C_RE, I_C_C_IM, I_C_D, I_C_W_GLU, I_C_B_GLU,
       I_F_W1, I_F_W3, I_F_W2, I_E_ROUTER, I_E_ROUTER_B, I_E_W1, I_E_W3, I_E_W2, N_IN };

constexpr size_t MiB = 1u << 20;
constexpr size_t WS_CTL = 0, CTL_ZERO_BYTES = 1 * MiB;
constexpr size_t WS_WA_IN = 2 * MiB, WS_WA_OUT = 12 * MiB, WS_WA_G = 17 * MiB, WS_WB_IN = 19 * MiB, WS_WB_OUT = 27 * MiB, WS_WC_GLU = 31 * MiB, WS_S5_BE = 33 * MiB, WS_S5_KC = 41 * MiB;
constexpr size_t WS_RSS = 53 * MiB;
constexpr size_t SCR = 56 * MiB;
constexpr size_t WS_HN = SCR + 0 * MiB;
constexpr size_t WS_XB = WS_HN;
constexpr size_t WS_HN8 = SCR + 161 * MiB;
static_assert(DEFER_NORM == 1, "the bf16 residual stream needs the deferred norms");
constexpr size_t WS_GX = SCR + 32 * MiB, WS_XR = SCR + 72 * MiB, WS_HL = SCR + 112 * MiB, WS_AC = SCR + 152 * MiB, WS_CSA = SCR + 192 * MiB, WS_CSH = SCR + 194 * MiB, WS_CIN = SCR + 196 * MiB;
constexpr size_t WS_XM = SCR + 32 * MiB, WS_Z = SCR + 96 * MiB, WS_Q = SCR + 160 * MiB, WS_K = SCR + 224 * MiB, WS_KT = SCR + 288 * MiB, WS_VT = SCR + 353 * MiB, WS_XC = SCR + 418 * MiB,
                 WS_SM = SCR + 482 * MiB, WS_CT = SCR + 514 * MiB, WS_MLS = SCR + 642 * MiB;
static_assert((size_t)MI * LDT * 2 <= 65 * MiB && WS_MLS + 4 * MiB <= SCR + 656 * MiB, "mLSTM scratch");
constexpr size_t WS_NUM = WS_XM, WS_Y = WS_XC;
constexpr size_t WS_GI = WS_MLS, WS_GF = WS_MLS + 256 * 1024, WS_GS = WS_MLS + 512 * 1024, WS_RMT = WS_MLS + 768 * 1024, WS_EF = WS_MLS + 1024 * 1024, WS_MC = WS_MLS + 1280 * 1024,
                 WS_DENP = WS_MLS + 2 * MiB, WS_NS = WS_MLS + 3 * MiB;
constexpr size_t WS_UP = SCR + 32 * MiB, WS_EB = SCR + 80 * MiB, WS_YA = SCR + 112 * MiB;
constexpr size_t WS_WFFN = SCR + 200 * MiB, WS_AG = SCR + 332 * MiB, WS_H = SCR + 400 * MiB, WS_OUT = SCR + 587 * MiB, WS_META = SCR + 655 * MiB, WS_END = SCR + 656 * MiB;
constexpr size_t WS_TOPI = WS_META, WS_TOPW = WS_META + 128 * 1024, WS_LISTE = WS_META + 384 * 1024;
constexpr size_t W13_BYTES = (size_t)2 * FF * D * 2, W2_BYTES = (size_t)D * FF * 2;
constexpr size_t WS_W13 = WS_WFFN, WS_W2T = WS_WFFN + NE * W13_BYTES;
constexpr size_t WS_WD1_13 = SCR + 144 * MiB, WS_WD1_2 = SCR + 155 * MiB;
constexpr size_t WS_W2T8 = WS_WFFN + NE * (W13_BYTES / 2);
constexpr size_t WS_AGX = WS_WFFN + NE * (W13_BYTES / 2) + NE * (W2_BYTES / 2);
static_assert(WS_AGX + (size_t)NE * T * D <= WS_H, "fp8 MoE rows");
static_assert(WS_WD1_13 + W13_BYTES <= WS_WD1_2 && WS_WD1_2 + W2_BYTES <= SCR + 161 * MiB && WS_HN8 + (size_t)T * D <= SCR + 200 * MiB, "dense-1 weights / fp8 stream copy");
static_assert(WS_W2T + NE * W2_BYTES <= WS_AG, "ffn weights");
static_assert(WS_CIN + (size_t)RNC * RW * 4 <= WS_WFFN, "rg scratch vs dense weights");
static_assert(WS_H + (size_t)MOE_ROWS * FF * 2 <= WS_OUT && WS_OUT + (size_t)MOE_ROWS * D * 2 <= WS_META, "moe buffers");
constexpr int CW_BAR = 4096, CW_MOE = 204800, CW_DQ = 208896;

constexpr int RING_BYTES = 131072, EXTRA_OFF = RING_BYTES, EXTRA_BYTES = 24576, LDS_BYTES = RING_BYTES + EXTRA_BYTES;
constexpr int MISC_OFF = LDS_BYTES - 64;

struct Args { const float* in[N_IN]; float* out; unsigned char* ws; int ph_lo, ph_hi, li, pad; };

__device__ __forceinline__ float wave_sum(float v) {
#pragma unroll
    for (int o = 1; o < 64; o <<= 1) v += __shfl_xor(v, o);
    return v;
}
__device__ __forceinline__ float wave_max(float v) {
#pragma unroll
    for (int o = 1; o < 64; o <<= 1) v = fmaxf(v, __shfl_xor(v, o));
    return v;
}
__device__ __forceinline__ u32x4 ldg16(const void* p) { return *(const GAS u32x4*)p; }
__device__ __forceinline__ u32x2 ldg8(const void* p) { return *(const GAS u32x2*)p; }
__device__ __forceinline__ f32x4 ldgf4(const void* p) { return *(const GAS f32x4*)p; }
__device__ __forceinline__ float ldgf(const void* p) { return *(const GAS float*)p; }
__device__ __forceinline__ int ldgi(const void* p) { return *(const GAS int*)p; }
#ifndef STORE_SC1
#define STORE_SC1 0
#endif
#if STORE_SC1
__device__ __forceinline__ void stg16(void* p, u32x4 v) { asm volatile("global_store_dwordx4 %0, %1, off sc1\n\ts_nop 1" :: "v"((GAS u32x4*)p), "v"(v) : "memory"); }
__device__ __forceinline__ void stg8(void* p, u32x2 v) { asm volatile("global_store_dwordx2 %0, %1, off sc1\n\ts_nop 1" :: "v"((GAS u32x2*)p), "v"(v) : "memory"); }
__device__ __forceinline__ void stgf4(void* p, f32x4 v) { asm volatile("global_store_dwordx4 %0, %1, off sc1\n\ts_nop 1" :: "v"((GAS f32x4*)p), "v"(v) : "memory"); }
__device__ __forceinline__ void stgf(void* p, float v) { asm volatile("global_store_dword %0, %1, off sc1\n\ts_nop 1" :: "v"((GAS float*)p), "v"(v) : "memory"); }
__device__ __forceinline__ void stgi(void* p, int v) { asm volatile("global_store_dword %0, %1, off sc1\n\ts_nop 1" :: "v"((GAS int*)p), "v"(v) : "memory"); }
__device__ __forceinline__ void stgh(void* p, bf16 v) { asm volatile("global_store_short %0, %1, off sc1\n\ts_nop 1" :: "v"((GAS bf16*)p), "v"((unsigned)v) : "memory"); }
#else
__device__ __forceinline__ void stg16(void* p, u32x4 v) { *(GAS u32x4*)p = v; }
__device__ __forceinline__ void stg8(void* p, u32x2 v) { *(GAS u32x2*)p = v; }
__device__ __forceinline__ void stgf4(void* p, f32x4 v) { *(GAS f32x4*)p = v; }
__device__ __forceinline__ void stgf(void* p, float v) { *(GAS float*)p = v; }
__device__ __forceinline__ void stgi(void* p, int v) { *(GAS int*)p = v; }
__device__ __forceinline__ void stgh(void* p, bf16 v) { *(GAS bf16*)p = v; }
#endif
#define LDS_WAIT() asm volatile("s_waitcnt lgkmcnt(0)" ::: "memory")

#ifndef WGM_
#define WGM_ 8
#endif
__device__ __forceinline__ void tile_of(int L, int nM, int nN, int& pm, int& pn) {
    const int nwg = nM * nN; int wgid = L;
    { const int q = nwg / 8, r = nwg % 8, xcd = wgid % 8, off = wgid / 8; wgid = (xcd < r ? xcd * (q + 1) : r * (q + 1) + (xcd - r) * q) + off; }
    const int nig = WGM_ * nN, gid = wgid / nig, fm = gid * WGM_, gsz = (nM - fm) < WGM_ ? (nM - fm) : WGM_;
    pm = fm + ((wgid % nig) % gsz); pn = (wgid % nig) / gsz;
}
using pg8::Unit;
__device__ __forceinline__ const char* uptr(const char* p) { const unsigned long long v = (unsigned long long)p; unsigned lo = __builtin_amdgcn_readfirstlane((unsigned)v), hi = __builtin_amdgcn_readfirstlane((unsigned)(v >> 32));
    asm volatile("s_nop 4" : "+s"(lo), "+s"(hi)); return (const char*)(((unsigned long long)hi << 32) | lo); }
struct Sched2D {
    const char* A; const char* B; unsigned lda, ldb; int nM, nN, G, c;
    __device__ __forceinline__ bool next(int i, Unit& u) const {
        const int L = i * G + c; if (L >= nM * nN) return false;
        tile_of(L, nM, nN, u.pm, u.pn); u.aux = 0;
        u.A1 = uptr(A + (size_t)u.pm * 512 * lda); u.B1 = uptr(B + (size_t)u.pn * 512 * ldb); u.A2 = u.A1; u.B2 = u.B1; return true;
    }
};
struct SchedMoe {
    LAS const int* gt; int gather;
    const char* A; const char* B; unsigned lda, ldb; size_t bstride; int P, nN, G, c; int ps[NE];
    int erows = 0;
    int ksplit; unsigned khbytes;
    __device__ __forceinline__ bool next(int i, Unit& u) const {
        const int L = i * G + c, nu = P * nN; if (L >= nu * ksplit) return false;
        const int kh = L / nu;
        tile_of(L - kh * nu, P, nN, u.pm, u.pn);
        int e = 0;
#pragma unroll
        for (int j = 1; j < NE; ++j) e += (u.pm >= ps[j]) ? 1 : 0;
        u.aux = (ksplit > 1) ? kh : e;
        int arow = u.pm * 256;
        if (erows) { int pse = 0;
#pragma unroll
            for (int j = 1; j < NE; ++j) pse = (u.pm >= ps[j]) ? ps[j] : pse;
            arow = e * erows + (u.pm - pse) * 256; }
        u.A1 = gather ? A : uptr(A + (size_t)arow * 2 * lda + (size_t)kh * khbytes); u.B1 = uptr(B + (size_t)e * bstride + (size_t)u.pn * 512 * ldb + (size_t)kh * khbytes); u.A2 = u.A1; u.B2 = u.B1; return true;
    }
};
struct SchedBatch {
    const char* A; const char* B; unsigned lda, ldb; size_t astride, bstride; int nMb, nB, G, c;
    __device__ __forceinline__ bool next(int i, Unit& u) const {
        const int L = i * G + c; if (L >= nMb * nB) return false;
        u.aux = L / nMb; u.pm = L % nMb; u.pn = 0;
        u.A1 = uptr(A + (size_t)u.aux * astride + (size_t)u.pm * 512 * lda); u.B1 = uptr(B + (size_t)u.aux * bstride); u.A2 = u.A1; u.B2 = u.B1; return true;
    }
};
struct SchedSbuild {
    const char* Q; const char* K; int G, c;
    __device__ __forceinline__ bool next(int i, Unit& u) const {
        const int L = i * G + c; if (L >= MNC * MH) return false;
        const int ch = L / MH, h = L % MH; u.aux = L; u.pm = ch; u.pn = h;
        u.A1 = uptr(Q + ((size_t)ch * MCH * MI + (size_t)h * HD) * 2); u.B1 = uptr(K + ((size_t)ch * MCH * MI + (size_t)h * HD) * 2); u.A2 = u.A1; u.B2 = u.B1; return true;
    }
};
struct SchedPass2 {
    const char* SMp; const char* Q; const char* VT; const char* CT; int G, c;
    __device__ __forceinline__ bool next(int i, Unit& u) const {
        const int pr_ = (i >> 1) * G + c; if (pr_ >= MNC * MH) return false;
        const int L = pr_ * 2 + (i & 1);
        const int eh = L & 1, ch_h = L >> 1, ch = ch_h / MH, h = ch_h % MH; u.aux = ch_h; u.pm = ch; u.pn = h * 2 + eh;
        u.A1 = uptr(SMp + (size_t)ch_h * MCH * MCH * 2); u.A2 = uptr(Q + ((size_t)ch * MCH * MI + (size_t)h * HD) * 2);
        u.B1 = uptr(VT + (((size_t)ch_h * HD + eh * 256) * MCH) * 2);     u.B2 = uptr(CT + ((size_t)ch_h * HD * HD + (size_t)eh * 256 * HD) * 2); return true;
    }
};

struct SchedState {
    const char* VT; const char* KT; int G, c;
    __device__ __forceinline__ bool next(int i, Unit& u) const {
        const int pq_ = (i >> 2) * G + c; if (pq_ >= MNC * MH) return false;
        const int L = pq_ * 4 + (i & 3);
        const int ch_h = L >> 2, ch = ch_h / MH, h = ch_h % MH; u.aux = ch_h; u.pm = (L >> 1) & 1; u.pn = L & 1;
        u.A1 = uptr(VT + (((size_t)ch_h * HD + u.pm * 256) * MCH) * 2); u.B1 = uptr(KT + (((size_t)ch_h * HD + u.pn * 256) * MCH) * 2); u.A2 = u.A1; u.B2 = u.B1; return true;
    }
};

__device__ __forceinline__ float rss_rstd(const float* rss, int row) { const f32x4 p = ldgf4(rss + (size_t)row * 4); return __builtin_amdgcn_rsqf(((p[0] + p[1]) + (p[2] + p[3])) * (1.0f / D) + EPS); }
__device__ __forceinline__ void emit_fp8x8(unsigned char* hn8, size_t eoff, const f32x4& a, const f32x4& b) {
    u32x2 w; w.x = cvt4_fp8(__builtin_amdgcn_fmed3f(a[0], -448.0f, 448.0f), __builtin_amdgcn_fmed3f(a[1], -448.0f, 448.0f), __builtin_amdgcn_fmed3f(a[2], -448.0f, 448.0f), __builtin_amdgcn_fmed3f(a[3], -448.0f, 448.0f));
    w.y = cvt4_fp8(__builtin_amdgcn_fmed3f(b[0], -448.0f, 448.0f), __builtin_amdgcn_fmed3f(b[1], -448.0f, 448.0f), __builtin_amdgcn_fmed3f(b[2], -448.0f, 448.0f), __builtin_amdgcn_fmed3f(b[3], -448.0f, 448.0f));
    stg8(hn8 + eoff, w);
}
__device__ __forceinline__ float sumsq4(const f32x4& x) { return (x[0] * x[0] + x[1] * x[1]) + (x[2] * x[2] + x[3] * x[3]); }
__device__ __forceinline__ void emit_rss(LAS float* P, float* rss, const pg8::Unit& u) {
    LDS_WAIT(); __builtin_amdgcn_s_barrier(); asm volatile("" ::: "memory");
    const int t = otid(); if (t < 256) { const f32x4 p = *(const LAS f32x4*)(P + t * 4); stgf(rss + ((size_t)u.pm * 256 + t) * 4 + u.pn, (p[0] + p[1]) + (p[2] + p[3])); }
}

template <bool RS> struct EpiBf16T {
    static constexpr bool PERM = true;
    bf16* O; int ldc; int split_cols; size_t split_stride; size_t aux_stride;
    float scale = 1.0f; const float* rss = nullptr;
    __device__ __forceinline__ void operator()(const f32x4 (&acc)[2][2][4][2], const Unit& u, int wr, int wc, int fr, int fq) const {
        const int row0 = u.pm * 256 + wr * 64 + fr; int colt = u.pn * 256; bf16* base = O + (size_t)u.aux * aux_stride;
        if (split_cols) { const int t = colt / split_cols; base += (size_t)t * split_stride; colt -= t * split_cols; }
        const int col0 = colt + wc * 32 + 8 * fq;
#pragma unroll
        for (int ai = 0; ai < 2; ++ai)
#pragma unroll
            for (int m = 0; m < 4; ++m) { bf16* rowp = base + (size_t)(row0 + ai * 128 + m * 16) * ldc + col0; const float sc_ = RS ? scale * rss_rstd(rss, row0 + ai * 128 + m * 16) : scale;
#pragma unroll
                for (int bj = 0; bj < 2; ++bj) { const f32x4 v0 = acc[ai][bj][m][0] * sc_, v1 = acc[ai][bj][m][1] * sc_;
                    u32x4 w; w.x = cvt_pk_bf16(v0[0], v0[1]); w.y = cvt_pk_bf16(v0[2], v0[3]); w.z = cvt_pk_bf16(v1[0], v1[1]); w.w = cvt_pk_bf16(v1[2], v1[3]);
                    stg16(rowp + bj * 128, w); }
                asm volatile("" ::: "memory"); }
    }
};
using EpiBf16 = EpiBf16T<false>;
template <int EMIT> struct EpiResidT {
    static constexpr bool PERM = true;
    bf16* xb; unsigned char* hn8; float* rss; LAS float* P; float scale;
    __device__ __forceinline__ void operator()(const f32x4 (&acc)[2][2][4][2], const Unit& u, int wr, int wc, int fr, int fq) const {
        const int row0 = u.pm * 256 + wr * 64 + fr, col0 = u.pn * 256 + wc * 32 + 8 * fq;
#pragma unroll
        for (int ai = 0; ai < 2; ++ai) { u32x4 bs[4][2];
#pragma unroll
            for (int m = 0; m < 4; ++m)
#pragma unroll
                for (int bj = 0; bj < 2; ++bj) bs[m][bj] = ldg16(xb + (size_t)(row0 + ai * 128 + m * 16) * D + col0 + bj * 128);
#pragma unroll
            for (int m = 0; m < 4; ++m) { float ss = 0.f;
#pragma unroll
                for (int bj = 0; bj < 2; ++bj) { const size_t off = (size_t)(row0 + ai * 128 + m * 16) * D + col0 + bj * 128; const u32x4 x = bs[m][bj];
                    const f32x4 v0 = acc[ai][bj][m][0] * scale + (f32x4){bflo(x.x), bfhi(x.x), bflo(x.y), bfhi(x.y)}, v1 = acc[ai][bj][m][1] * scale + (f32x4){bflo(x.z), bfhi(x.z), bflo(x.w), bfhi(x.w)};
                    u32x4 w; w.x = cvt_pk_bf16(v0[0], v0[1]); w.y = cvt_pk_bf16(v0[2], v0[3]); w.z = cvt_pk_bf16(v1[0], v1[1]); w.w = cvt_pk_bf16(v1[2], v1[3]);
                    stg16(xb + off, w);
                    if (EMIT) ss += sumsq4(v0) + sumsq4(v1);
                    if (EMIT == 2) emit_fp8x8(hn8, off, v0, v1); }
                if (EMIT) { ss += __shfl_xor(ss, 16); ss += __shfl_xor(ss, 32); if (fq == 0) P[(ai * 128 + wr * 64 + m * 16 + fr) * 4 + wc] = ss; } }
            asm volatile("" ::: "memory"); }
        if (EMIT) emit_rss(P, rss, u);
    }
};
using EpiResid = EpiResidT<0>;
template <bool RS> struct EpiSwigluT {
    static constexpr bool PERM = true;
    bf16* Hh; const float* rss = nullptr;
    __device__ __forceinline__ void operator()(const f32x4 (&acc)[2][2][4][2], const Unit& u, int wr, int wc, int fr, int fq) const {
        const int row0 = u.pm * 256 + wr * 64 + fr, col0 = u.pn * 128 + wc * 32 + 8 * fq;
#pragma unroll
        for (int ai = 0; ai < 2; ++ai)
#pragma unroll
            for (int m = 0; m < 4; ++m) { bf16* rowp = Hh + (size_t)(row0 + ai * 128 + m * 16) * FF + col0; const float rs_ = RS ? rss_rstd(rss, row0 + ai * 128 + m * 16) : 1.0f;
                f32x2 o[4];
#pragma unroll
                for (int n = 0; n < 2; ++n)
#pragma unroll
                    for (int hh = 0; hh < 2; ++hh) { const f32x4 a4 = acc[ai][0][m][n], b4 = acc[ai][1][m][n];
                        f32x2 a = hh ? (f32x2){a4[2], a4[3]} : (f32x2){a4[0], a4[1]}, b = hh ? (f32x2){b4[2], b4[3]} : (f32x2){b4[0], b4[1]}; if (RS) { a = a * rs_; b = b * rs_; }
                        f32x2 e; e[0] = __builtin_amdgcn_exp2f(-a[0]); e[1] = __builtin_amdgcn_exp2f(-a[1]);
                        const f32x2 d = e + 1.0f; f32x2 r; r[0] = __builtin_amdgcn_rcpf(d[0]); r[1] = __builtin_amdgcn_rcpf(d[1]);
                        o[n * 2 + hh] = (a * b) * r; }
                u32x4 w; w.x = cvt_pk_bf16(o[0][0], o[0][1]); w.y = cvt_pk_bf16(o[1][0], o[1][1]); w.z = cvt_pk_bf16(o[2][0], o[2][1]); w.w = cvt_pk_bf16(o[3][0], o[3][1]);
                stg16(rowp, w); asm volatile("" ::: "memory"); }
    }
};
using EpiSwiglu = EpiSwigluT<false>;
template <bool RS> struct EpiSwiglu8T {
    static constexpr bool PERM = true;
    unsigned char* H8; const float* rss = nullptr;
    __device__ __forceinline__ void operator()(const f32x4 (&acc)[2][2][4][2], const Unit& u, int wr, int wc, int fr, int fq) const {
        const int row0 = u.pm * 256 + wr * 64 + fr, col0 = u.pn * 128 + wc * 32 + 8 * fq;
#pragma unroll
        for (int ai = 0; ai < 2; ++ai)
#pragma unroll
            for (int m = 0; m < 4; ++m) { unsigned char* rowp = H8 + (size_t)(row0 + ai * 128 + m * 16) * FF + col0; const float rs_ = RS ? 0.03125f * rss_rstd(rss, row0 + ai * 128 + m * 16) : 0.03125f;
                f32x2 o[4];
#pragma unroll
                for (int n = 0; n < 2; ++n)
#pragma unroll
                    for (int hh = 0; hh < 2; ++hh) { const f32x4 a4 = acc[ai][0][m][n], b4 = acc[ai][1][m][n];
                        const f32x2 a = (hh ? (f32x2){a4[2], a4[3]} : (f32x2){a4[0], a4[1]}) * rs_, b = hh ? (f32x2){b4[2], b4[3]} : (f32x2){b4[0], b4[1]};
                        f32x2 e; e[0] = __builtin_amdgcn_exp2f(-a[0]); e[1] = __builtin_amdgcn_exp2f(-a[1]);
                        const f32x2 d = e + 1.0f; f32x2 r; r[0] = __builtin_amdgcn_rcpf(d[0]); r[1] = __builtin_amdgcn_rcpf(d[1]);
                        o[n * 2 + hh] = (a * (b * rs_)) * r; }
                u32x2 w; w.x = cvt4_fp8(o[0][0], o[0][1], o[1][0], o[1][1]); w.y = cvt4_fp8(o[2][0], o[2][1], o[3][0], o[3][1]);
                stg8(rowp, w); asm volatile("" ::: "memory"); }
    }
};
using EpiSwiglu8 = EpiSwiglu8T<false>;
template <int EMIT> struct EpiGluT {
    static constexpr bool PERM = true;
    const bf16* YA; const float* bglu; bf16* xb; unsigned char* hn8; float* rss; LAS float* P;
    __device__ __forceinline__ void operator()(const f32x4 (&acc)[2][2][4][2], const Unit& u, int wr, int wc, int fr, int fq) const {
        const int row0 = u.pm * 256 + wr * 64 + fr, col0 = u.pn * 256 + wc * 32 + 8 * fq;
        f32x4 bv[2][2];
#pragma unroll
        for (int bj = 0; bj < 2; ++bj) { bv[bj][0] = ldgf4(bglu + col0 + bj * 128); bv[bj][1] = ldgf4(bglu + col0 + bj * 128 + 4); }
#pragma unroll
        for (int ai = 0; ai < 2; ++ai) { u32x4 xs[4][2], ys[4][2];
#pragma unroll
            for (int m = 0; m < 4; ++m)
#pragma unroll
                for (int bj = 0; bj < 2; ++bj) { const int row = row0 + ai * 128 + m * 16, col = col0 + bj * 128;
                    xs[m][bj] = ldg16(xb + (size_t)row * D + col); ys[m][bj] = ldg16(YA + ((size_t)(col >> 4) * T + row) * 16 + (col & 15)); }
#pragma unroll
            for (int m = 0; m < 4; ++m) { float ss = 0.f;
#pragma unroll
                for (int bj = 0; bj < 2; ++bj) { const size_t off = (size_t)(row0 + ai * 128 + m * 16) * D + col0 + bj * 128; const u32x4 x = xs[m][bj], y = ys[m][bj];
                    const f32x4 z0 = acc[ai][bj][m][0] + bv[bj][0], z1 = acc[ai][bj][m][1] + bv[bj][1]; f32x4 v0, v1;
                    v0[0] = bflo(x.x) + bflo(y.x) * sigm(z0[0]); v0[1] = bfhi(x.x) + bfhi(y.x) * sigm(z0[1]); v0[2] = bflo(x.y) + bflo(y.y) * sigm(z0[2]); v0[3] = bfhi(x.y) + bfhi(y.y) * sigm(z0[3]);
                    v1[0] = bflo(x.z) + bflo(y.z) * sigm(z1[0]); v1[1] = bfhi(x.z) + bfhi(y.z) * sigm(z1[1]); v1[2] = bflo(x.w) + bflo(y.w) * sigm(z1[2]); v1[3] = bfhi(x.w) + bfhi(y.w) * sigm(z1[3]);
                    u32x4 w; w.x = cvt_pk_bf16(v0[0], v0[1]); w.y = cvt_pk_bf16(v0[2], v0[3]); w.z = cvt_pk_bf16(v1[0], v1[1]); w.w = cvt_pk_bf16(v1[2], v1[3]);
                    stg16(xb + off, w);
                    if (EMIT) ss += sumsq4(v0) + sumsq4(v1);
                    if (EMIT == 2) emit_fp8x8(hn8, off, v0, v1); }
                if (EMIT) { ss += __shfl_xor(ss, 16); ss += __shfl_xor(ss, 32); if (fq == 0) P[(ai * 128 + wr * 64 + m * 16 + fr) * 4 + wc] = ss; } }
            asm volatile("" ::: "memory"); }
        if (EMIT) emit_rss(P, rss, u);
    }
};
using EpiGlu = EpiGluT<0>;
struct EpiS5e {
    static constexpr bool PERM = false;
    float* EB;
    __device__ __forceinline__ void operator()(const f32x4 (&acc)[2][2][4][2], const Unit& u, int wr, int wc, int fr, int fq) const {
        const int row0 = u.aux * SNC + u.pm * 256 + wr * 64 + fr, col0 = wc * 32 + 4 * fq;
#pragma unroll
        for (int ai = 0; ai < 2; ++ai)
#pragma unroll
            for (int m = 0; m < 4; ++m) { float* rowp = EB + (size_t)(row0 + ai * 128 + m * 16) * 128 + col0;
#pragma unroll
                for (int n = 0; n < 2; ++n) stgf4(rowp + n * 16, acc[ai][0][m][n]); }
    }
};
struct EpiS5y {
    static constexpr bool PERM = true;
    const bf16* UP; const float* dsk; bf16* YA;
    __device__ __forceinline__ void operator()(const f32x4 (&acc)[2][2][4][2], const Unit& u, int wr, int wc, int fr, int fq) const {
        const int g = u.aux, row0 = u.pm * 256 + wr * 64 + fr;
#pragma unroll
        for (int bj = 0; bj < 2; ++bj) { const int cc = bj * 128 + wc * 32 + 8 * fq, tt = cc >> 4, i0 = cc & 15;
            const f32x4 d0 = ldgf4(dsk + g * 16 + i0), d1 = ldgf4(dsk + g * 16 + i0 + 4);
#pragma unroll
            for (int ai = 0; ai < 2; ++ai) { u32x4 uvv[4];
#pragma unroll
                for (int m = 0; m < 4; ++m) uvv[m] = ldg16(UP + ((size_t)g * SNC + (row0 + ai * 128 + m * 16)) * SK + cc);
#pragma unroll
                for (int m = 0; m < 4; ++m) { const int chunk = row0 + ai * 128 + m * 16;
                    const u32x4 uv = uvv[m];
                    const f32x4 v0 = acc[ai][bj][m][0], v1 = acc[ai][bj][m][1]; float o[8];
                    o[0] = gelu_tanh(v0[0] + d0[0] * bflo(uv.x)); o[1] = gelu_tanh(v0[1] + d0[1] * bfhi(uv.x)); o[2] = gelu_tanh(v0[2] + d0[2] * bflo(uv.y)); o[3] = gelu_tanh(v0[3] + d0[3] * bfhi(uv.y));
                    o[4] = gelu_tanh(v1[0] + d1[0] * bflo(uv.z)); o[5] = gelu_tanh(v1[1] + d1[1] * bfhi(uv.z)); o[6] = gelu_tanh(v1[2] + d1[2] * bflo(uv.w)); o[7] = gelu_tanh(v1[3] + d1[3] * bfhi(uv.w));
                    u32x4 w; w.x = cvt_pk_bf16(o[0], o[1]); w.y = cvt_pk_bf16(o[2], o[3]); w.z = cvt_pk_bf16(o[4], o[5]); w.w = cvt_pk_bf16(o[6], o[7]);
                    stg16(YA + ((size_t)g * T + (size_t)(chunk * SL + tt)) * 16 + i0, w); }
                asm volatile("" ::: "memory"); } }
    }
};
struct EpiSbuild {
    static constexpr bool PERM = true;
    bf16* SMp; float* DENP; const float* GS; const float* MC;
    __device__ __forceinline__ void operator()(const f32x4 (&acc)[2][2][4][2], const Unit& u, int wr, int wc, int fr, int fq) const {
        const int ch = u.pm, h = u.pn, ch_h = u.aux; const float mc = ldgf(MC + h * 80 + ch);
        float rs[2][4];
#pragma unroll
        for (int ai = 0; ai < 2; ++ai)
#pragma unroll
            for (int m = 0; m < 4; ++m) rs[ai][m] = 0.f;
#pragma unroll
        for (int bj = 0; bj < 2; ++bj) { const int s0 = bj * 128 + wc * 32 + 8 * fq; float w[8];
            { const f32x4 g0 = ldgf4(GS + (size_t)h * T + ch * MCH + s0), g1 = ldgf4(GS + (size_t)h * T + ch * MCH + s0 + 4);
#pragma unroll
              for (int j = 0; j < 4; ++j) { w[j] = __expf(g0[j] - mc); w[4 + j] = __expf(g1[j] - mc); } }
#pragma unroll
            for (int ai = 0; ai < 2; ++ai)
#pragma unroll
                for (int m = 0; m < 4; ++m) { const int r = ai * 128 + wr * 64 + m * 16 + fr; float o[8];
#pragma unroll
                    for (int n = 0; n < 2; ++n)
#pragma unroll
                        for (int j = 0; j < 4; ++j) { const int s = s0 + n * 4 + j; o[n * 4 + j] = (s <= r) ? acc[ai][bj][m][n][j] * w[n * 4 + j] : 0.f; }
                    u32x4 pk; pk.x = cvt_pk_bf16(o[0], o[1]); pk.y = cvt_pk_bf16(o[2], o[3]); pk.z = cvt_pk_bf16(o[4], o[5]); pk.w = cvt_pk_bf16(o[6], o[7]);
                    rs[ai][m] += (bflo(pk.x) + bfhi(pk.x)) + (bflo(pk.y) + bfhi(pk.y)) + (bflo(pk.z) + bfhi(pk.z)) + (bflo(pk.w) + bfhi(pk.w));
                    stg16(SMp + ((size_t)ch_h * MCH + r) * MCH + s0, pk); asm volatile("" ::: "memory"); } }
#pragma unroll
        for (int ai = 0; ai < 2; ++ai)
#pragma unroll
            for (int m = 0; m < 4; ++m) { const int r = ai * 128 + wr * 64 + m * 16 + fr; float v = rs[ai][m]; v += __shfl_xor(v, 16); v += __shfl_xor(v, 32);
                if (fq == 0) stgf(DENP + ((size_t)ch_h * MCH + r) * 4 + wc, v); }
    }
};
struct EpiNum {
    static constexpr bool PERM = true;
    bf16* NUM; const float* RMT; const float* MC;
    __device__ __forceinline__ void operator()(const f32x4 (&acc)[2][2][4][2], const Unit& u, int wr, int wc, int fr, int fq) const {
        const int ch = u.pm, h = u.pn >> 1, eh = u.pn & 1; const float mc = ldgf(MC + h * 80 + ch);
        const int col0 = h * HD + eh * 256 + wc * 32 + 8 * fq;
        float rmv[2][4];
#pragma unroll
        for (int ai = 0; ai < 2; ++ai)
#pragma unroll
            for (int m = 0; m < 4; ++m) rmv[ai][m] = ldgf(RMT + (size_t)h * T + ch * MCH + ai * 128 + wr * 64 + m * 16 + fr);
#pragma unroll
        for (int ai = 0; ai < 2; ++ai)
#pragma unroll
            for (int m = 0; m < 4; ++m) { const int t = ch * MCH + ai * 128 + wr * 64 + m * 16 + fr; const float sc = __expf(mc - rmv[ai][m]);
                bf16* rowp = NUM + (size_t)t * MI + col0;
#pragma unroll
                for (int bj = 0; bj < 2; ++bj) { const f32x4 v0 = acc[ai][bj][m][0] * sc, v1 = acc[ai][bj][m][1] * sc;
                    u32x4 w; w.x = cvt_pk_bf16(v0[0], v0[1]); w.y = cvt_pk_bf16(v0[2], v0[3]); w.z = cvt_pk_bf16(v1[0], v1[1]); w.w = cvt_pk_bf16(v1[2], v1[3]);
                    stg16(rowp + bj * 128, w); }
                asm volatile("" ::: "memory"); }
    }
};
struct ConvItem { const float* W; bf16* WT; int ldw, ldt, k0, n0, drow0; float scale; int f8; const float* kg; };
__device__ __forceinline__ void tr_load(const ConvItem& d, f32x2 (&v)[33], int lane) {
    const int hrow = lane >> 5, cl = lane & 31; const unsigned voff = (unsigned)(hrow * d.ldw + 2 * cl) * 4u;
    const char* rb = (const char*)(d.W + (size_t)d.k0 * d.ldw + d.n0); const size_t rstep = (size_t)d.ldw * 8;
#pragma unroll
    for (int i = 0; i < 32; ++i) v[i] = *(const GAS f32x2*)(rb + (size_t)i * rstep + voff);
    v[32][0] = d.kg ? ldgf(d.kg + d.k0 + lane) : 1.0f; v[32][1] = 0.f;
}
__device__ __forceinline__ float tr_scale(const ConvItem& d, const f32x2 (&v)[33], int i, int hrow) {
    const int gi = __float_as_int(v[32][0]); const float g0 = __int_as_float(__builtin_amdgcn_readlane(gi, 2 * i)), g1 = __int_as_float(__builtin_amdgcn_readlane(gi, 2 * i + 1)); return d.scale * (hrow ? g1 : g0);
}
__device__ __forceinline__ void tr_store8(const ConvItem& d, const f32x2 (&v)[33], LAS float* scr, int lane) {
    LAS unsigned char* tile = (LAS unsigned char*)scr; constexpr int TS8 = 68;
    const int hrow = lane >> 5, cl = lane & 31;
#pragma unroll
    for (int i = 0; i < 32; ++i) { const float s_ = tr_scale(d, v, i, hrow); *(LAS unsigned short*)(tile + (2 * i + hrow) * TS8 + cl * 2) = (unsigned short)__builtin_amdgcn_cvt_pk_fp8_f32(v[i][0] * s_, v[i][1] * s_, 0, false); }
    LDS_WAIT(); asm volatile("" ::: "memory");
    const int c = lane & 7;
#pragma unroll
    for (int j = 0; j < 8; ++j) { const int n = (lane >> 3) + 8 * j; const LAS unsigned char* sp = tile + (8 * c) * TS8 + n;
        u32x2 o; o.x = (unsigned)sp[0 * TS8] | ((unsigned)sp[1 * TS8] << 8) | ((unsigned)sp[2 * TS8] << 16) | ((unsigned)sp[3 * TS8] << 24);
        o.y = (unsigned)sp[4 * TS8] | ((unsigned)sp[5 * TS8] << 8) | ((unsigned)sp[6 * TS8] << 16) | ((unsigned)sp[7 * TS8] << 24);
        stg8((unsigned char*)d.WT + (size_t)(d.drow0 + n) * d.ldt + d.k0 + 8 * c, o); }
    LDS_WAIT(); asm volatile("" ::: "memory");
}
__device__ __forceinline__ void tr_store(const ConvItem& d, const f32x2 (&v)[33], LAS float* scr, int lane) {
    if (d.f8) { tr_store8(d, v, scr, lane); return; }
    LAS unsigned char* tile = (LAS unsigned char*)scr; constexpr int TS = 132;
    const int hrow = lane >> 5, cl = lane & 31;
#pragma unroll
    for (int i = 0; i < 32; ++i) { const float s_ = tr_scale(d, v, i, hrow); *(LAS unsigned*)(tile + (2 * i + hrow) * TS + cl * 4) = cvt_pk_bf16(v[i][0] * s_, v[i][1] * s_); }
    LDS_WAIT(); asm volatile("" ::: "memory");
    const int c = lane & 7;
#pragma unroll
    for (int j = 0; j < 8; ++j) { const int n = (lane >> 3) + 8 * j; const LAS bf16* sp = (const LAS bf16*)(tile + (8 * c) * TS) + n;
        u32x4 o; o.x = (unsigned)sp[0 * (TS / 2)] | ((unsigned)sp[1 * (TS / 2)] << 16); o.y = (unsigned)sp[2 * (TS / 2)] | ((unsigned)sp[3 * (TS / 2)] << 16);
        o.z = (unsigned)sp[4 * (TS / 2)] | ((unsigned)sp[5 * (TS / 2)] << 16); o.w = (unsigned)sp[6 * (TS / 2)] | ((unsigned)sp[7 * (TS / 2)] << 16);
        stg16(d.WT + (size_t)(d.drow0 + n) * d.ldt + d.k0 + 8 * c, o); }
    LDS_WAIT(); asm volatile("" ::: "memory");
}
__device__ __forceinline__ ConvItem conv_desc(const float* W, int K, int N, bf16* WT, int ldt, int mode, int it) {
    const int nblk = N / 64, kb = it / nblk, nb_ = it % nblk, n0 = nb_ * 64;
    ConvItem d; d.W = W; d.WT = WT; d.ldw = N; d.ldt = ldt; d.k0 = kb * 64; d.n0 = n0; d.drow0 = (mode == 0 || mode == 3) ? n0 : ((n0 >> 7) * 256 + (n0 & 127) + (mode == 2 ? 128 : 0));
    d.scale = (mode == 1 || mode == 3) ? 1.4426950408889634f : (mode == 2) ? 0.6931471805599453f : 1.0f;
    d.f8 = 0; d.kg = nullptr; return d;
}
__device__ __forceinline__ ConvItem conv_desc8(const float* W, int K, int N, unsigned char* WT, int mode, int it) {
    ConvItem d = conv_desc(W, K, N, (bf16*)WT, K, mode, it); d.f8 = 1;
    d.scale = (mode == 1) ? 32.0f * 1.4426950408889634f : (mode == 2) ? 32.0f * 0.6931471805599453f : 64.0f; return d;
}
__device__ __forceinline__ void conv_item(const float* W, int K, int N, bf16* WT, int ldt, int mode, int it, LAS float* scr, int lane) {
    const ConvItem d = conv_desc(W, K, N, WT, ldt, mode, it); f32x2 v[33]; tr_load(d, v, lane); tr_store(d, v, scr, lane);
}
__device__ __forceinline__ void conv_mat(const float* W, int K, int N, bf16* WT, int ldt, int mode, int gw, int NGW, LAS float* scr, int lane, const float* kg = nullptr) {
    const int items = (K / 64) * (N / 64);
    int it = gw; if (it >= items) return;
    f32x2 va[33], vb[33]; ConvItem da = conv_desc(W, K, N, WT, ldt, mode, it), db = da; da.kg = kg; tr_load(da, va, lane);
    for (;;) {
        const int i1 = it + NGW; if (i1 < items) { db = conv_desc(W, K, N, WT, ldt, mode, i1); db.kg = kg; tr_load(db, vb, lane); }
        tr_store(da, va, scr, lane); if (i1 >= items) break;
        const int i2 = i1 + NGW; if (i2 < items) { da = conv_desc(W, K, N, WT, ldt, mode, i2); da.kg = kg; tr_load(da, va, lane); }
        tr_store(db, vb, scr, lane); if (i2 >= items) break;
        it = i2;
    }
}
__device__ __forceinline__ void conv_dense(const Args& a, int f, int gw, int NGW, LAS float* scr, int lane) {
    bf16* W13 = (bf16*)(a.ws + (f ? WS_WD1_13 : WS_W13)); bf16* W2T = (bf16*)(a.ws + (f ? WS_WD1_2 : WS_W2T));
    conv_mat(a.in[I_F_W1] + (size_t)f * D * FF, D, FF, W13, D, 1, gw, NGW, scr, lane);
    conv_mat(a.in[I_F_W3] + (size_t)f * D * FF, D, FF, W13, D, 2, gw, NGW, scr, lane);
    conv_mat(a.in[I_F_W2] + (size_t)f * D * FF, FF, D, W2T, FF, 0, gw, NGW, scr, lane);
}
__device__ __forceinline__ ConvItem moe_desc(const Args& a, int f, int idx) {
    constexpr int I1 = (D / 64) * (FF / 64), I2 = (FF / 64) * (D / 64), PER = 2 * I1 + I2;
    const int e = idx / PER, r = idx % PER; const size_t wo = ((size_t)f * NE + e) * D * FF;
    if (MOE_F8(f)) {
        unsigned char* W13 = a.ws + WS_W13 + (size_t)e * (W13_BYTES / 2); unsigned char* W2T = a.ws + WS_W2T8 + (size_t)e * (W2_BYTES / 2);
        if (r < I1) return conv_desc8(a.in[I_E_W1] + wo, D, FF, W13, 1, r);
        if (r < 2 * I1) return conv_desc8(a.in[I_E_W3] + wo, D, FF, W13, 2, r - I1);
        return conv_desc8(a.in[I_E_W2] + wo, FF, D, W2T, 0, r - 2 * I1); }
    bf16* W13 = (bf16*)(a.ws + WS_W13 + (size_t)e * W13_BYTES); bf16* W2T = (bf16*)(a.ws + WS_W2T + (size_t)e * W2_BYTES);
    if (r < I1) return conv_desc(a.in[I_E_W1] + wo, D, FF, W13, D, 1, r);
    if (r < 2 * I1) return conv_desc(a.in[I_E_W3] + wo, D, FF, W13, D, 2, r - I1);
    return conv_desc(a.in[I_E_W2] + wo, FF, D, W2T, FF, 0, r - 2 * I1);
}
__device__ __forceinline__ void conv_moe(const Args& a, int f, int gw, int NGW, LAS float* scr, int lane) {
    constexpr int I1 = (D / 64) * (FF / 64), I2 = (FF / 64) * (D / 64), PER = 2 * I1 + I2, items = NE * PER;
    int it = gw; if (it >= items) return;
    f32x2 va[33], vb[33]; ConvItem da = moe_desc(a, f, it), db = da; tr_load(da, va, lane);
    for (;;) {
        const int i1 = it + NGW; if (i1 < items) { db = moe_desc(a, f, i1); tr_load(db, vb, lane); }
        tr_store(da, va, scr, lane); if (i1 >= items) break;
        const int i2 = i1 + NGW; if (i2 < items) { da = moe_desc(a, f, i2); tr_load(da, va, lane); }
        tr_store(db, vb, scr, lane); if (i2 >= items) break;
        it = i2;
    }
}
enum { DQ_DENSE0 = 0, DQ_B, DQ_C, DQ_DENSE1, DQ_A1, DQ_MOE1, DQ_NG };
constexpr int DQ_I = (D / 64) * (FF / 64);
__device__ __forceinline__ int dq_size(int g) { return g == DQ_DENSE0 || g == DQ_DENSE1 ? 3 * DQ_I : g == DQ_B ? 1024 + 512 : g == DQ_C ? 256 : g == DQ_A1 ? 640 + 320 + 80 : NE * 3 * DQ_I; }
__device__ __forceinline__ ConvItem dq_desc0(const Args& a, int g, int idx) {
    if (g == DQ_DENSE0 || g == DQ_DENSE1) { const int f = (g == DQ_DENSE1) ? 1 : 0, m = idx / DQ_I, it = idx % DQ_I;
        if (DENSE_F8(f)) { unsigned char* W13 = a.ws + (f ? WS_WD1_13 : WS_W13); unsigned char* W2T = a.ws + (f ? WS_WD1_2 : WS_W2T);
            if (m == 0) return conv_desc8(a.in[I_F_W1] + (size_t)f * D * FF, D, FF, W13, 1, it);
            if (m == 1) return conv_desc8(a.in[I_F_W3] + (size_t)f * D * FF, D, FF, W13, 2, it);
            return conv_desc8(a.in[I_F_W2] + (size_t)f * D * FF, FF, D, W2T, 0, it); }
        bf16* W13 = (bf16*)(a.ws + (f ? WS_WD1_13 : WS_W13)); bf16* W2T = (bf16*)(a.ws + (f ? WS_WD1_2 : WS_W2T));
        if (m == 0) return conv_desc(a.in[I_F_W1] + (size_t)f * D * FF, D, FF, W13, D, 1, it);
        if (m == 1) return conv_desc(a.in[I_F_W3] + (size_t)f * D * FF, D, FF, W13, D, 2, it);
        return conv_desc(a.in[I_F_W2] + (size_t)f * D * FF, FF, D, W2T, FF, 0, it); }
    if (g == DQ_B) { if (idx < 1024) return conv_desc(a.in[I_B_W_IN], D, 2 * MI, (bf16*)(a.ws + WS_WB_IN), D, 0, idx);
        return conv_desc(a.in[I_B_W_OUT], MI, D, (bf16*)(a.ws + WS_WB_OUT), MI, 0, idx - 1024); }
    if (g == DQ_C) return conv_desc(a.in[I_C_W_GLU], D, D, (bf16*)(a.ws + WS_WC_GLU), D, 0, idx);
    if (g == DQ_A1) { if (idx < 640) { if (RG_F8(1)) return conv_desc8(a.in[I_A_W_IN] + (size_t)D * 2 * RW, D, 2 * RW, a.ws + WS_WA_IN + (size_t)2 * RW * D * 2, 0, idx);
            return conv_desc(a.in[I_A_W_IN] + (size_t)D * 2 * RW, D, 2 * RW, (bf16*)(a.ws + WS_WA_IN) + (size_t)2 * RW * D, D, 0, idx); }
        if (idx < 960) return conv_desc(a.in[I_A_W_OUT] + (size_t)RW * D, RW, D, (bf16*)(a.ws + WS_WA_OUT) + (size_t)D * RW, RW, 0, idx - 640);
        const int it = idx - 960, n = it / 8, r = it % 8, which = r / 4, q = r % 4;
        return conv_desc(a.in[which ? I_A_W_I : I_A_W_R] + ((size_t)RNB + n) * RBD * RBD, RBD, RBD, (bf16*)(a.ws + WS_WA_G) + ((size_t)RNB + n) * 256 * RBD + (size_t)which * 128 * RBD, RBD, 3, q); }
    return moe_desc(a, 1, idx);
}
__device__ __forceinline__ ConvItem dq_desc(const Args& a, int g, int idx) {
    ConvItem d = dq_desc0(a, g, idx);
#if DEFER_NORM
    if ((g == DQ_DENSE0 || g == DQ_DENSE1) && idx < 2 * DQ_I) d.kg = a.in[I_NORM_FFN] + (g == DQ_DENSE1 ? 2 : 0) * D;
    if (g == DQ_B && idx < 1024) d.kg = a.in[I_NORM_MIX] + 1 * D;
    if (g == DQ_A1 && idx < 640) d.kg = a.in[I_NORM_MIX] + 3 * D;
#endif
    return d;
}
__device__ __forceinline__ unsigned* dq_cursor(const Args& a, int g) { return (unsigned*)(a.ws + WS_CTL) + CW_DQ + 64 * g; }
__device__ __forceinline__ int dq_left(const Args& a, int g) { const int c = (int)__hip_atomic_load(dq_cursor(a, g), __ATOMIC_RELAXED, __HIP_MEMORY_SCOPE_AGENT), s = dq_size(g); return c >= s ? 0 : s - c; }
__device__ __forceinline__ void dq_work(const Args& a, int g_lo, int g_hi, int quota, LAS unsigned char* lds, LAS float* scr) {
    const int tid = otid(), lane = tid & 63, wave = tid >> 6; volatile LAS int* slot = (volatile LAS int*)(lds + MISC_OFF + 16);
    int done = 0;
    if (quota == -2) {
        __syncthreads(); if (tid == 0) *slot = (dq_left(a, g_lo) + 16 * (int)gridDim.x - 1) / (16 * (int)gridDim.x); __syncthreads(); quota = *slot; }
    for (int g = g_lo; g <= g_hi; ++g) {
        const int size = dq_size(g);
        for (;;) {
            if (quota >= 0 && done >= quota) return;
            __syncthreads();
            if (tid == 0) { int base = size; if (dq_left(a, g) > 0) base = (int)__hip_atomic_fetch_add(dq_cursor(a, g), 16u, __ATOMIC_RELAXED, __HIP_MEMORY_SCOPE_AGENT); *slot = base; }
            __syncthreads();
            const int base = *slot; if (base >= size) break;
            const int i0 = base + wave * 2, i1 = i0 + 1; ++done;
            if (i0 < size) { f32x2 va[33], vb[33]; const ConvItem da = dq_desc(a, g, i0); tr_load(da, va, lane);
                if (i1 < size) { const ConvItem db = dq_desc(a, g, i1); tr_load(db, vb, lane); tr_store(da, va, scr, lane); tr_store(db, vb, scr, lane); }
                else tr_store(da, va, scr, lane); }
        }
    }
}
__device__ __forceinline__ void conv_a(const Args& a, int j, int gw, int NGW, LAS float* scr, int lane) {
    conv_mat(a.in[I_A_W_IN] + (size_t)j * D * 2 * RW, D, 2 * RW, (bf16*)(a.ws + WS_WA_IN) + (size_t)j * 2 * RW * D, D, 0, gw, NGW, scr, lane, a.in[I_NORM_MIX] + (size_t)(3 * j) * D);
    conv_mat(a.in[I_A_W_OUT] + (size_t)j * RW * D, RW, D, (bf16*)(a.ws + WS_WA_OUT) + (size_t)j * D * RW, RW, 0, gw, NGW, scr, lane);
    for (int it = gw; it < RNB * 2 * 4; it += NGW) { const int n = it / 8, r = it % 8, which = r / 4, q = r % 4;
        const float* W = a.in[which ? I_A_W_I : I_A_W_R] + ((size_t)j * RNB + n) * RBD * RBD;
        bf16* WT = (bf16*)(a.ws + WS_WA_G) + ((size_t)j * RNB + n) * 256 * RBD + (size_t)which * 128 * RBD;
        conv_item(W, RBD, RBD, WT, RBD, 3, q, scr, lane); }
}
__device__ __forceinline__ void conv_perm(const Args& a, int gw, int NGW, LAS float* scr, int lane) {
    for (int j = 0; j < 2; ++j) {
        conv_mat(a.in[I_A_W_IN] + (size_t)j * D * 2 * RW, D, 2 * RW, (bf16*)(a.ws + WS_WA_IN) + (size_t)j * 2 * RW * D, D, 0, gw, NGW, scr, lane);
        conv_mat(a.in[I_A_W_OUT] + (size_t)j * RW * D, RW, D, (bf16*)(a.ws + WS_WA_OUT) + (size_t)j * D * RW, RW, 0, gw, NGW, scr, lane);
        for (int it = gw; it < RNB * 2 * 4; it += NGW) { const int n = it / 8, r = it % 8, which = r / 4, q = r % 4;
            const float* W = a.in[which ? I_A_W_I : I_A_W_R] + ((size_t)j * RNB + n) * RBD * RBD;
            bf16* WT = (bf16*)(a.ws + WS_WA_G) + ((size_t)j * RNB + n) * 256 * RBD + (size_t)which * 128 * RBD;
            conv_item(W, RBD, RBD, WT, RBD, 3, q, scr, lane); }
    }
    conv_mat(a.in[I_B_W_IN], D, 2 * MI, (bf16*)(a.ws + WS_WB_IN), D, 0, gw, NGW, scr, lane);
    conv_mat(a.in[I_B_W_OUT], MI, D, (bf16*)(a.ws + WS_WB_OUT), MI, 0, gw, NGW, scr, lane);
    conv_mat(a.in[I_C_W_GLU], D, D, (bf16*)(a.ws + WS_WC_GLU), D, 0, gw, NGW, scr, lane);
}
__device__ __forceinline__ void s5_mats(const Args& a, LAS unsigned char* lds, int bid, int nb) {
    LAS float* lre = (LAS float*)lds; LAS float* lim = lre + 17 * 64; LAS float* bre = lim + 17 * 64; LAS float* bim = bre + 1024; LAS float* cre = bim + 1024; LAS float* cim = cre + 1024; LAS float* Kt = cim + 1024;
    const int tid = otid();
    for (int gq = bid; gq < NG * 4; gq += nb) {
        const int g = gq >> 2, q4 = gq & 3;
        __syncthreads();
        if (tid < 64) { const int p = tid; const float are = ldgf(a.in[I_C_A_RE] + g * 64 + p), aim = ldgf(a.in[I_C_A_IM] + g * 64 + p), dl = __expf(ldgf(a.in[I_C_LOG_STEP] + g));
            for (int tau = 0; tau <= 16; ++tau) { const float mag = __expf((float)tau * dl * are); float sn, cs; sincosf((float)tau * dl * aim, &sn, &cs); lre[tau * 64 + p] = mag * cs; lim[tau * 64 + p] = mag * sn; }
            const float mag = __expf(dl * are); float sn, cs; sincosf(dl * aim, &sn, &cs);
            const float nr = mag * cs - 1.0f, ni = mag * sn, den = are * are + aim * aim, fr_ = (nr * are + ni * aim) / den, fi_ = (ni * are - nr * aim) / den;
            for (int j = 0; j < 16; ++j) { const float br = ldgf(a.in[I_C_B_RE] + ((size_t)g * 64 + p) * 16 + j), bi = ldgf(a.in[I_C_B_IM] + ((size_t)g * 64 + p) * 16 + j);
                bre[p * 16 + j] = fr_ * br - fi_ * bi; bim[p * 16 + j] = fr_ * bi + fi_ * br; } }
        for (int i = tid; i < 1024; i += NTHR) { cre[i] = ldgf(a.in[I_C_C_RE] + (size_t)g * 1024 + i); cim[i] = ldgf(a.in[I_C_C_IM] + (size_t)g * 1024 + i); }
        __syncthreads();
        for (int o = tid; o < 4096; o += NTHR) { const int tau = o >> 8, i = (o >> 4) & 15, j = o & 15; float s = 0.f;
            for (int p = 0; p < 64; ++p) { const float cr = cre[i * 64 + p], ci = cim[i * 64 + p], lr = lre[tau * 64 + p], li = lim[tau * 64 + p], xr = cr * lr - ci * li, xi = cr * li + ci * lr;
                s += xr * bre[p * 16 + j] - xi * bim[p * 16 + j]; }
            Kt[o] = s; }
        __syncthreads();
        bf16* KC = (bf16*)(a.ws + WS_S5_KC) + (size_t)g * 256 * SK; bf16* BE = (bf16*)(a.ws + WS_S5_BE) + (size_t)g * 256 * 256;
        for (int o = tid; o < 64 * (SK / 8); o += NTHR) { const int n = q4 * 64 + o / (SK / 8), k0 = (o % (SK / 8)) * 8, tt = n >> 4, i = n & 15; float v[8];
#pragma unroll
            for (int q = 0; q < 8; ++q) { const int k = k0 + q;
                if (k < 256) { const int s = k >> 4, j = k & 15; v[q] = (s <= tt) ? Kt[((tt - s) << 8) + (i << 4) + j] : 0.f; }
                else { const int p = (k - 256) & 63, im = (k - 256) >> 6; const float cr = cre[i * 64 + p], ci = cim[i * 64 + p], lr = lre[(tt + 1) * 64 + p], li = lim[(tt + 1) * 64 + p];
                    v[q] = im ? -(cr * li + ci * lr) : (cr * lr - ci * li); } }
            u32x4 w; w.x = cvt_pk_bf16(v[0], v[1]); w.y = cvt_pk_bf16(v[2], v[3]); w.z = cvt_pk_bf16(v[4], v[5]); w.w = cvt_pk_bf16(v[6], v[7]);
            stg16(KC + (size_t)n * SK + k0, w); }
        for (int o = tid; o < 64 * 32; o += NTHR) { const int n = q4 * 64 + (o >> 5), k0 = (o & 31) * 8; float v[8];
#pragma unroll
            for (int q = 0; q < 8; ++q) { const int k = k0 + q, s = k >> 4, j = k & 15;
                if (n < 128) { const int p = n & 63, im = n >> 6; const float lr = lre[(15 - s) * 64 + p], li = lim[(15 - s) * 64 + p], br = bre[p * 16 + j], bi = bim[p * 16 + j];
                    v[q] = im ? (lr * bi + li * br) : (lr * br - li * bi); } else v[q] = 0.f; }
            u32x4 w; w.x = cvt_pk_bf16(v[0], v[1]); w.y = cvt_pk_bf16(v[2], v[3]); w.z = cvt_pk_bf16(v[4], v[5]); w.w = cvt_pk_bf16(v[6], v[7]);
            stg16(BE + (size_t)n * 256 + k0, w); }
    }
    __syncthreads();
}

__device__ __forceinline__ void moe_prefix(const Args& a, int f, int (&ps)[NE], int& P, int (&cnt)[NE]) {
    const unsigned* gc = (const unsigned*)(a.ws + WS_CTL) + CW_MOE + f * 1024; int acc = 0;
#pragma unroll
    for (int e = 0; e < NE; ++e) { ps[e] = acc; const int c = __builtin_amdgcn_readfirstlane((int)__hip_atomic_load(gc + e * 64, __ATOMIC_RELAXED, __HIP_MEMORY_SCOPE_AGENT)); cnt[e] = c; acc += (c + 255) >> 8; }
    P = acc;
}
template <bool COMBINE, bool ROUTER, int OUTMODE, bool XIN = false>
__device__ __forceinline__ void ph_norm(const Args& a, LAS unsigned char* lds, int bid, int nb, const float* xin, const float* gain, int f) {
    bf16* XB = (bf16*)(a.ws + WS_XB);
    const int tid = otid(), lane = tid & 63, wave = tid >> 6;
    const int RPB = T / nb;
    LAS float* rt = (LAS float*)lds; LAS int* sel = (LAS int*)(lds + 32768); LAS int* rnk = (LAS int*)(lds + 32768 + 1024); LAS int* bases = (LAS int*)(lds + 32768 + 2048); LAS int* dstl = (LAS int*)(lds + 32768 + 3072); LAS unsigned char* rows8 = lds + 36864;
    if (ROUTER) {
        const float* router = a.in[I_E_ROUTER] + (size_t)f * D * NE;
        for (int i = tid; i < D * NE; i += NTHR) rt[(i & 7) * D + (i >> 3)] = ldgf(router + i);
        __syncthreads();
    }
    f32x4 gv[4];
#pragma unroll
    for (int j = 0; j < 4; ++j) gv[j] = ldgf4(gain + 4 * lane + 256 * j);
    bf16* HN = (bf16*)(a.ws + WS_HN); bf16* UP = (bf16*)(a.ws + WS_UP);
    const bf16* OUTB = (const bf16*)(a.ws + WS_OUT); const bf16* OUTA = (const bf16*)(a.ws + WS_AG); float* TOPW = (float*)(a.ws + WS_TOPW); int* TOPI = (int*)(a.ws + WS_TOPI);
    int cps[NE], cP = 0, ccnt[NE];
    if (COMBINE) moe_prefix(a, f, cps, cP, ccnt);
#pragma unroll 1
    for (int lr0 = wave; lr0 < RPB; lr0 += NWAVES * 4) {
      f32x4 vv[4][4];
#pragma unroll
      for (int k_ = 0; k_ < 4; ++k_) { const int lrk = (lr0 + k_ * NWAVES < RPB) ? lr0 + k_ * NWAVES : lr0;
#pragma unroll
        for (int j = 0; j < 4; ++j) { const size_t o_ = (size_t)(bid * RPB + lrk) * D + 4 * lane + 256 * j;
            if (XIN) vv[k_][j] = ldgf4(xin + o_); else { const u32x2 q_ = ldg8(XB + o_); vv[k_][j] = (f32x4){bflo(q_.x), bfhi(q_.x), bflo(q_.y), bfhi(q_.y)}; } } }
#pragma unroll
      for (int k_ = 0; k_ < 4; ++k_) { const int lr = lr0 + k_ * NWAVES; if (lr < RPB) {
        const int row = bid * RPB + lr;
        f32x4 (&v)[4] = vv[k_];
        if (COMBINE) {
            const int t1 = ldgi(TOPI + row * 2), t2 = ldgi(TOPI + row * 2 + 1); const int e1 = t1 >> 16, e2 = t2 >> 16; int s1 = 0, s2 = 0;
#pragma unroll
            for (int e = 0; e < NE; ++e) { s1 = (e1 == e) ? cps[e] : s1; s2 = (e2 == e) ? cps[e] : s2; }
            const int r1 = s1 * 256 + (t1 & 0xffff), r2 = s2 * 256 + (t2 & 0xffff); const float p1 = ldgf(TOPW + row * 2), p2 = ldgf(TOPW + row * 2 + 1);
#pragma unroll
            for (int j = 0; j < 4; ++j) { const bool one_buf = MOE_F8(f) != 0;
                const u32x2 o1 = ldg8(OUTA + (size_t)r1 * D + 4 * lane + 256 * j), o2 = ldg8(OUTA + (size_t)r2 * D + 4 * lane + 256 * j);
                u32x2 q1 = (u32x2){0u, 0u}, q2 = (u32x2){0u, 0u};
                if (!one_buf) { q1 = ldg8(OUTB + (size_t)r1 * D + 4 * lane + 256 * j); q2 = ldg8(OUTB + (size_t)r2 * D + 4 * lane + 256 * j); }
                v[j][0] += p1 * (bflo(o1.x) + bflo(q1.x)) + p2 * (bflo(o2.x) + bflo(q2.x)); v[j][1] += p1 * (bfhi(o1.x) + bfhi(q1.x)) + p2 * (bfhi(o2.x) + bfhi(q2.x));
                v[j][2] += p1 * (bflo(o1.y) + bflo(q1.y)) + p2 * (bflo(o2.y) + bflo(q2.y)); v[j][3] += p1 * (bfhi(o1.y) + bfhi(q1.y)) + p2 * (bfhi(o2.y) + bfhi(q2.y));
                if (OUTMODE != 2) { u32x2 w_; w_.x = cvt_pk_bf16(v[j][0], v[j][1]); w_.y = cvt_pk_bf16(v[j][2], v[j][3]); stg8(XB + (size_t)row * D + 4 * lane + 256 * j, w_); } }
        }
        float s2 = 0.f;
#pragma unroll
        for (int j = 0; j < 4; ++j) s2 += (v[j][0] * v[j][0] + v[j][1] * v[j][1]) + (v[j][2] * v[j][2] + v[j][3] * v[j][3]);
        const float ssq_ = wave_sum(s2);
        if (OUTMODE == 4) {
#pragma unroll
            for (int j = 0; j < 4; ++j) { u32x2 w_; w_.x = cvt_pk_bf16(v[j][0], v[j][1]); w_.y = cvt_pk_bf16(v[j][2], v[j][3]); stg8(XB + (size_t)row * D + 4 * lane + 256 * j, w_); }
            if (lane == 0) stgf4((float*)(a.ws + WS_RSS) + (size_t)row * 4, (f32x4){ssq_, 0.f, 0.f, 0.f});
        }
        const float rstd = __builtin_amdgcn_rsqf(ssq_ * (1.0f / D) + EPS);
#pragma unroll
        for (int j = 0; j < 4; ++j) v[j] = v[j] * rstd * gv[j];
        if (OUTMODE == 4) {
        } else if (OUTMODE == 0) {
#pragma unroll
            for (int j = 0; j < 4; ++j) { u32x2 w; w.x = cvt_pk_bf16(v[j][0], v[j][1]); w.y = cvt_pk_bf16(v[j][2], v[j][3]); stg8(HN + (size_t)row * D + 4 * lane + 256 * j, w); }
        } else if (OUTMODE == 3) {
            if (ROUTER) {
#pragma unroll
                for (int j = 0; j < 4; ++j) *(LAS int*)(rows8 + lr * D + 4 * lane + 256 * j) = (int)cvt4_fp8(v[j][0], v[j][1], v[j][2], v[j][3]);
            } else {
#pragma unroll
                for (int j = 0; j < 4; ++j) stgi((unsigned char*)HN + (size_t)row * D + 4 * lane + 256 * j, (int)cvt4_fp8(v[j][0], v[j][1], v[j][2], v[j][3]));
            }
        } else if (OUTMODE == 1) {
            const int chunk = row >> 4, s = row & 15;
#pragma unroll
            for (int j = 0; j < 4; ++j) { const int g = (lane >> 2) + 16 * j, i0 = 4 * (lane & 3); u32x2 w; w.x = cvt_pk_bf16(v[j][0], v[j][1]); w.y = cvt_pk_bf16(v[j][2], v[j][3]);
                stg8(UP + ((size_t)g * SNC + chunk) * SK + s * 16 + i0, w); }
        } else {
#pragma unroll
            for (int j = 0; j < 4; ++j) stgf4(a.out + (size_t)row * D + 4 * lane + 256 * j, v[j]);
        }
      } }
      if (ROUTER) {
          float x[32];
#pragma unroll
          for (int i = 0; i < 32; ++i) x[i] = 0.f;
#pragma unroll
          for (int e = 0; e < NE; ++e)
#pragma unroll
              for (int j = 0; j < 4; ++j) { const f32x4 r = *(const LAS f32x4*)(rt + e * D + 4 * lane + 256 * j);
#pragma unroll
                  for (int k_ = 0; k_ < 4; ++k_) x[k_ * 8 + e] += (vv[k_][j][0] * r[0] + vv[k_][j][1] * r[1]) + (vv[k_][j][2] * r[2] + vv[k_][j][3] * r[3]);
                  if (j & 1) asm volatile("" ::: "memory"); }
#define RS_STEP(HB) { const bool up_ = (lane & (2 * (HB))) != 0; _Pragma("unroll") for (int i = 0; i < (HB); ++i) { const float send = up_ ? x[i] : x[i + (HB)], keep = up_ ? x[i + (HB)] : x[i]; x[i] = keep + __shfl_xor(send, 2 * (HB)); } }
          RS_STEP(16) RS_STEP(8) RS_STEP(4) RS_STEP(2) RS_STEP(1)
#undef RS_STEP
          const float z = x[0] + __shfl_xor(x[0], 1);
          float rb[NE];
#pragma unroll
          for (int e = 0; e < NE; ++e) rb[e] = ldgf(a.in[I_E_ROUTER_B] + f * NE + e);
#pragma unroll
          for (int k_ = 0; k_ < 4; ++k_) { const int lr = lr0 + k_ * NWAVES; if (lr < RPB) { const int row = bid * RPB + lr;
              float lg[NE];
#pragma unroll
              for (int e = 0; e < NE; ++e) lg[e] = __int_as_float(__builtin_amdgcn_readlane(__float_as_int(z), 2 * (k_ * 8 + e))) + rb[e];
              int e1 = 0; float v1 = lg[0];
#pragma unroll
              for (int e = 1; e < NE; ++e) if (lg[e] > v1) { v1 = lg[e]; e1 = e; }
              int e2 = -1; float v2 = -3.0e38f;
#pragma unroll
              for (int e = 0; e < NE; ++e) if (e != e1 && lg[e] > v2) { v2 = lg[e]; e2 = e; }
              const float p1 = 1.0f / (1.0f + __expf(v2 - v1)), p2 = 1.0f - p1;
              if (lane == 0) { sel[lr * 2] = e1; sel[lr * 2 + 1] = e2; stgf(TOPW + row * 2, p1); stgf(TOPW + row * 2 + 1, p2); } } }
      }
    }
    if (ROUTER) {
        __syncthreads();
        LAS int* wc = (LAS int*)(lds + 32768 + 3584);
        int mye = 0, myrank = 0;
        if (tid < RPB * 2) { mye = sel[tid];
#pragma unroll
            for (int q = 0; q < NE; ++q) { const unsigned long long m = __ballot(mye == q); if (mye == q) myrank = __popcll(m & ((1ull << lane) - 1ull)); if (lane == 0) wc[wave * NE + q] = __popcll(m); } }
        __syncthreads();
        if (tid < NE) { const int cnt = wc[tid] + wc[NE + tid];
            unsigned* gc = (unsigned*)(a.ws + WS_CTL) + CW_MOE + f * 1024 + tid * 64;
            bases[tid] = (int)__hip_atomic_fetch_add(gc, (unsigned)cnt, __ATOMIC_RELAXED, __HIP_MEMORY_SCOPE_AGENT); }
        __syncthreads();
        if (tid < RPB * 2) { const int e = mye, pos = bases[e] + myrank + (wave == 1 ? wc[e] : 0); stgi(TOPI + (size_t)bid * RPB * 2 + tid, (e << 16) | pos);
            stgi((int*)(a.ws + WS_LISTE) + e * T + pos, bid * RPB + (tid >> 1));
            if (OUTMODE == 3) dstl[tid] = e * T + pos; }
        __syncthreads();
        if (OUTMODE == 3) {
            unsigned char* AGX = a.ws + WS_AGX;
            for (int p = wave; p < RPB * 2; p += NWAVES) { const u32x4 x = *(const LAS u32x4*)(rows8 + (p >> 1) * D + lane * 16); stg16(AGX + (size_t)dstl[p] * D + lane * 16, x); }
            __syncthreads(); }
    }
}
__device__ __forceinline__ void ph_rg_gates(const Args& a, LAS unsigned char* lds, int bid, int nb, int jl) {
    const int tid = otid(), lane = tid & 63, wave = tid >> 6, fr = lane & 15, fq = lane >> 4;
    constexpr int AS_OFF = 0, BS_OFF = 17408, LA_OFF = 87040, BB_OFF = 87040 + 16384, XS_OFF = 87040 + 32768, RS = 272;
    const bf16* XR = (const bf16*)(a.ws + WS_XR); bf16* HL = (bf16*)(a.ws + WS_HL); bf16* AC = (bf16*)(a.ws + WS_AC);
    float* CSA = (float*)(a.ws + WS_CSA); float* CSH = (float*)(a.ws + WS_CSH);
    const int n = bid % RNB, rnk = bid / RNB, cnt = (nb - 1 - n) / RNB + 1;
    { const bf16* WG = (const bf16*)(a.ws + WS_WA_G) + ((size_t)jl * RNB + n) * 256 * RBD;
#pragma unroll
        for (int i = 0; i < 8; ++i) { const int idx = tid + NTHR * i, row = idx >> 4, c16 = idx & 15; *(LAS u32x4*)(lds + BS_OFF + row * RS + c16 * 16) = ldg16(WG + row * RBD + c16 * 8); } }
    const int r2 = tid >> 4, cg = tid & 15, ch0 = n * RBD + cg * 8;
    f32x2 cwv[4][4], cbv[4];
    { const float* cw = a.in[I_A_CONV_W] + (size_t)jl * 4 * RW; const float* cb = a.in[I_A_CONV_B] + (size_t)jl * RW;
#pragma unroll
      for (int k = 0; k < 4; ++k) { const f32x4 w0 = ldgf4(cw + (size_t)k * RW + ch0), w1 = ldgf4(cw + (size_t)k * RW + ch0 + 4); cwv[k][0] = (f32x2){w0[0], w0[1]}; cwv[k][1] = (f32x2){w0[2], w0[3]}; cwv[k][2] = (f32x2){w1[0], w1[1]}; cwv[k][3] = (f32x2){w1[2], w1[3]}; }
      const f32x4 b0 = ldgf4(cb + ch0), b1 = ldgf4(cb + ch0 + 4); cbv[0] = (f32x2){b0[0], b0[1]}; cbv[1] = (f32x2){b0[2], b0[3]}; cbv[2] = (f32x2){b1[0], b1[1]}; cbv[3] = (f32x2){b1[2], b1[3]}; }
    const int tg = wave & 3, half = wave >> 2;
    float brq[4], biq[4], spq[4];
#pragma unroll
    for (int q = 0; q < 4; ++q) { const int ch = n * RBD + 64 * half + 16 * q + fr; const float L2E = 1.4426950408889634f;
        brq[q] = L2E * ldgf(a.in[I_A_B_R] + (size_t)jl * RW + ch); biq[q] = L2E * ldgf(a.in[I_A_B_I] + (size_t)jl * RW + ch); spq[q] = 8.0f * L2E * softplus_f(-ldgf(a.in[I_A_LAM] + (size_t)jl * RW + ch)); }
    u32x4 xr_[5];
    int c = rnk;
#define RG_LOADX(cc) do { _Pragma("unroll") for (int k = 0; k < 5; ++k) { const int tk = (cc) * RCH + 2 * r2 - 3 + k; xr_[k] = (tk >= 0) ? ldg16(XR + (size_t)tk * RW + ch0) : (u32x4){0u, 0u, 0u, 0u}; } } while (0)
    if (c < RNC) RG_LOADX(c);
    for (; c < RNC; c += cnt) {
        __syncthreads();
        {
#pragma unroll
            for (int rr = 0; rr < 2; ++rr) { f32x2 acc[4];
#pragma unroll
                for (int j = 0; j < 4; ++j) acc[j] = cbv[j];
#pragma unroll
                for (int k = 0; k < 4; ++k) { const u32x4 x = xr_[rr + k];
                    acc[0] += cwv[k][0] * (f32x2){bflo(x.x), bfhi(x.x)}; acc[1] += cwv[k][1] * (f32x2){bflo(x.y), bfhi(x.y)};
                    acc[2] += cwv[k][2] * (f32x2){bflo(x.z), bfhi(x.z)}; acc[3] += cwv[k][3] * (f32x2){bflo(x.w), bfhi(x.w)}; }
                u32x4 w0; w0.x = cvt_pk_bf16(acc[0][0], acc[0][1]); w0.y = cvt_pk_bf16(acc[1][0], acc[1][1]); w0.z = cvt_pk_bf16(acc[2][0], acc[2][1]); w0.w = cvt_pk_bf16(acc[3][0], acc[3][1]);
                *(LAS u32x4*)(lds + AS_OFF + (2 * r2 + rr) * RS + cg * 16) = w0; }
        }
        { const int cn = c + cnt; if (cn < RNC) RG_LOADX(cn); }
        __syncthreads();
        f32x4 accr[4], acci[4];
#pragma unroll
        for (int q = 0; q < 4; ++q) { accr[q] = (f32x4){0.f, 0.f, 0.f, 0.f}; acci[q] = (f32x4){0.f, 0.f, 0.f, 0.f}; }
#pragma unroll
        for (int kk = 0; kk < 4; ++kk) { const bf16x8 af = *(const LAS bf16x8*)(lds + AS_OFF + (16 * tg + fr) * RS + (kk * 32 + 8 * fq) * 2);
#pragma unroll
            for (int q = 0; q < 4; ++q) { const bf16x8 br = *(const LAS bf16x8*)(lds + BS_OFF + (64 * half + 16 * q + fr) * RS + (kk * 32 + 8 * fq) * 2);
                const bf16x8 bi = *(const LAS bf16x8*)(lds + BS_OFF + (128 + 64 * half + 16 * q + fr) * RS + (kk * 32 + 8 * fq) * 2);
                accr[q] = __builtin_amdgcn_mfma_f32_16x16x32_bf16(af, br, accr[q], 0, 0, 0); acci[q] = __builtin_amdgcn_mfma_f32_16x16x32_bf16(af, bi, acci[q], 0, 0, 0); } }
#pragma unroll
        for (int q = 0; q < 4; ++q) { const int chl = 64 * half + 16 * q + fr;
#pragma unroll
            for (int pr_ = 0; pr_ < 2; ++pr_) { const int row = 16 * tg + 4 * fq + 2 * pr_;
                const f32x2 R2 = (f32x2){accr[q][2 * pr_], accr[q][2 * pr_ + 1]} + brq[q], I2 = (f32x2){acci[q][2 * pr_], acci[q][2 * pr_ + 1]} + biq[q];
                f32x2 eR, eI; eR[0] = __builtin_amdgcn_exp2f(-R2[0]); eR[1] = __builtin_amdgcn_exp2f(-R2[1]); eI[0] = __builtin_amdgcn_exp2f(-I2[0]); eI[1] = __builtin_amdgcn_exp2f(-I2[1]);
                const f32x2 dR = eR + 1.0f, dI = eI + 1.0f; f32x2 rr, ii; rr[0] = __builtin_amdgcn_rcpf(dR[0]); rr[1] = __builtin_amdgcn_rcpf(dR[1]); ii[0] = __builtin_amdgcn_rcpf(dI[0]); ii[1] = __builtin_amdgcn_rcpf(dI[1]);
                const f32x2 la = rr * spq[q]; f32x2 a_; a_[0] = __builtin_amdgcn_exp2f(-la[0]); a_[1] = __builtin_amdgcn_exp2f(-la[1]);
                f32x2 om = 1.0f - a_; om[0] = fmaxf(om[0], 0.f); om[1] = fmaxf(om[1], 0.f);
                const f32x2 t2 = om * (a_ + 1.0f); f32x2 sq; sq[0] = __builtin_amdgcn_sqrtf(t2[0]); sq[1] = __builtin_amdgcn_sqrtf(t2[1]);
                const f32x2 xr = (f32x2){bf2f(*(const LAS bf16*)(lds + AS_OFF + row * RS + chl * 2)), bf2f(*(const LAS bf16*)(lds + AS_OFF + (row + 1) * RS + chl * 2))};
                const f32x2 bb = (sq * ii) * xr;
                *(LAS bf16*)(lds + LA_OFF + (row * 128 + chl) * 2) = f2bf(om[0]); *(LAS bf16*)(lds + LA_OFF + ((row + 1) * 128 + chl) * 2) = f2bf(om[1]);
                *(LAS bf16*)(lds + BB_OFF + (row * 128 + chl) * 2) = f2bf(bb[0]); *(LAS bf16*)(lds + BB_OFF + ((row + 1) * 128 + chl) * 2) = f2bf(bb[1]); } }
        __syncthreads();
        { const int j = tid & 127, seg = tid >> 7, ch = n * RBD + j; float hl[16], pa[16]; float h = 0.f, pr = 1.f;
#pragma unroll
            for (int i = 0; i < 16; ++i) { const float om = bf2f(*(const LAS bf16*)(lds + LA_OFF + ((16 * seg + i) * 128 + j) * 2)), bb = bf2f(*(const LAS bf16*)(lds + BB_OFF + ((16 * seg + i) * 128 + j) * 2));
                const float ai = 1.0f - om; h = ai * h + bb; pr *= ai; hl[i] = h; pa[i] = pr; }
            LAS float* xs = (LAS float*)(lds + XS_OFF); xs[(seg * 128 + j) * 2] = pr; xs[(seg * 128 + j) * 2 + 1] = h;
            __syncthreads();
            float cin_h = 0.f, cin_a = 1.f;
#pragma unroll
            for (int s = 0; s < 3; ++s) if (s < seg) { const float sa = xs[(s * 128 + j) * 2], sh = xs[(s * 128 + j) * 2 + 1]; cin_h = sa * cin_h + sh; cin_a *= sa; }
#pragma unroll
            for (int i = 0; i < 16; ++i) { const float hf = hl[i] + pa[i] * cin_h, af = pa[i] * cin_a;
                *(LAS bf16*)(lds + LA_OFF + ((16 * seg + i) * 128 + j) * 2) = f2bf(hf); *(LAS bf16*)(lds + BB_OFF + ((16 * seg + i) * 128 + j) * 2) = f2bf(af);
                if (i == 15 && seg == 3) { stgf(CSA + (size_t)c * RW + ch, af); stgf(CSH + (size_t)c * RW + ch, hf); } } }
        __syncthreads();
#pragma unroll
        for (int i = 0; i < 2; ++i) { const int idx = tid + NTHR * i, row = idx >> 4, c16 = idx & 15; const size_t o = (size_t)(c * RCH + row) * RW + n * RBD + c16 * 8;
            stg16(HL + o, *(const LAS u32x4*)(lds + LA_OFF + row * 256 + c16 * 16)); stg16(AC + o, *(const LAS u32x4*)(lds + BB_OFF + row * 256 + c16 * 16)); }
    }
#undef RG_LOADX
    __syncthreads();
}
__device__ __forceinline__ void ph_rg_carry(const Args& a, int bid, int nb) {
    const int tid = otid(), lane = tid & 63, gw = bid * NWAVES + (tid >> 6), NGW = nb * NWAVES;
    const float* CSA = (const float*)(a.ws + WS_CSA); const float* CSH = (const float*)(a.ws + WS_CSH); float* CIN = (float*)(a.ws + WS_CIN);
    for (int ch = gw; ch < RW; ch += NGW) {
        float Ak[4], Hk[4]; float A = 1.f, H = 0.f;
#pragma unroll
        for (int k = 0; k < 4; ++k) { Ak[k] = ldgf(CSA + (size_t)(4 * lane + k) * RW + ch); Hk[k] = ldgf(CSH + (size_t)(4 * lane + k) * RW + ch); H = Ak[k] * H + Hk[k]; A = Ak[k] * A; }
#pragma unroll
        for (int off = 1; off < 64; off <<= 1) { const float Ay = __shfl_up(A, off), Hy = __shfl_up(H, off); if (lane >= off) { H = A * Hy + H; A = A * Ay; } }
        float h = __shfl_up(H, 1); if (lane == 0) h = 0.f;
#pragma unroll
        for (int k = 0; k < 4; ++k) { stgf(CIN + (size_t)(4 * lane + k) * RW + ch, h); h = Ak[k] * h + Hk[k]; }
    }
}
__device__ __forceinline__ void ph_rg_fix(const Args& a, int bid, int nb) {
    const int tid = otid(); bf16* GX = (bf16*)(a.ws + WS_GX); const bf16* HL = (const bf16*)(a.ws + WS_HL); const bf16* AC = (const bf16*)(a.ws + WS_AC); const float* CIN = (const float*)(a.ws + WS_CIN);
    const int total = T * (RW / 8);
    for (int it = bid * NTHR + tid; it < total; it += nb * NTHR) {
        const int t = it / (RW / 8), ch = (it % (RW / 8)) * 8, c = t / RCH; const size_t o = (size_t)t * RW + ch;
        const u32x4 g = ldg16(GX + o), hl = ldg16(HL + o), ac = ldg16(AC + o); const f32x4 c0 = ldgf4(CIN + (size_t)c * RW + ch), c1 = ldgf4(CIN + (size_t)c * RW + ch + 4);
        float y[8];
        y[0] = gelu_tanh(bflo(g.x)) * (bflo(hl.x) + bflo(ac.x) * c0[0]); y[1] = gelu_tanh(bfhi(g.x)) * (bfhi(hl.x) + bfhi(ac.x) * c0[1]);
        y[2] = gelu_tanh(bflo(g.y)) * (bflo(hl.y) + bflo(ac.y) * c0[2]); y[3] = gelu_tanh(bfhi(g.y)) * (bfhi(hl.y) + bfhi(ac.y) * c0[3]);
        y[4] = gelu_tanh(bflo(g.z)) * (bflo(hl.z) + bflo(ac.z) * c1[0]); y[5] = gelu_tanh(bfhi(g.z)) * (bfhi(hl.z) + bfhi(ac.z) * c1[1]);
        y[6] = gelu_tanh(bflo(g.w)) * (bflo(hl.w) + bflo(ac.w) * c1[2]); y[7] = gelu_tanh(bfhi(g.w)) * (bfhi(hl.w) + bfhi(ac.w) * c1[3]);
        u32x4 w; w.x = cvt_pk_bf16(y[0], y[1]); w.y = cvt_pk_bf16(y[2], y[3]); w.z = cvt_pk_bf16(y[4], y[5]); w.w = cvt_pk_bf16(y[6], y[7]);
        stg16(GX + o, w);
    }
}

__device__ __forceinline__ void ph_ml_prep(const Args& a, LAS unsigned char* lds, int bid, int nb) {
    const bf16* XM = (const bf16*)(a.ws + WS_XM); bf16* Q = (bf16*)(a.ws + WS_Q); bf16* Kb = (bf16*)(a.ws + WS_K); bf16* XC = (bf16*)(a.ws + WS_XC);
    float* GI = (float*)(a.ws + WS_GI); float* GF = (float*)(a.ws + WS_GF);
    LAS float* red = (LAS float*)(lds + EXTRA_OFF);
    const float kscale = 0.044194173824159216f;
    for (int tb = bid; tb < T / 64; tb += nb) {
        const int t0 = tb * 64;
        {
            const int tid = otid(), lane = tid & 63, wave = tid >> 6, n4 = tid * 4;
            f32x2 cw[4][2], cb[2], wq[4][2], wk[4][2], wv[4][2], gqk[4][4], gv[4][4];
#pragma unroll
            for (int k = 0; k < 4; ++k) { const f32x4 v = ldgf4(a.in[I_B_CONV_W] + k * MI + n4); cw[k][0] = (f32x2){v[0], v[1]}; cw[k][1] = (f32x2){v[2], v[3]}; }
            { const f32x4 v = ldgf4(a.in[I_B_CONV_B] + n4); cb[0] = (f32x2){v[0], v[1]}; cb[1] = (f32x2){v[2], v[3]}; }
#pragma unroll
            for (int i = 0; i < 4; ++i) { const f32x4 q_ = ldgf4(a.in[I_B_W_Q] + tid * 16 + i * 4), k_ = ldgf4(a.in[I_B_W_K] + tid * 16 + i * 4), v_ = ldgf4(a.in[I_B_W_V] + tid * 16 + i * 4);
                wq[i][0] = (f32x2){q_[0], q_[1]}; wq[i][1] = (f32x2){q_[2], q_[3]}; wk[i][0] = (f32x2){k_[0], k_[1]}; wk[i][1] = (f32x2){k_[2], k_[3]}; wv[i][0] = (f32x2){v_[0], v_[1]}; wv[i][1] = (f32x2){v_[2], v_[3]}; }
#pragma unroll
            for (int i = 0; i < 4; ++i)
#pragma unroll
                for (int e = 0; e < 4; ++e) { gqk[i][e] = (f32x2){0.f, 0.f}; gv[i][e] = (f32x2){0.f, 0.f}; }
#pragma unroll
            for (int j = 0; j < 4; ++j) { const float* pwg = a.in[I_B_W_GATE];
                const f32x4 a0 = ldgf4(pwg + (size_t)(0 * MI + n4 + j) * 8), a1 = ldgf4(pwg + (size_t)(0 * MI + n4 + j) * 8 + 4);
                const f32x4 b0 = ldgf4(pwg + (size_t)(1 * MI + n4 + j) * 8), b1 = ldgf4(pwg + (size_t)(1 * MI + n4 + j) * 8 + 4);
                const f32x4 c0 = ldgf4(pwg + (size_t)(2 * MI + n4 + j) * 8), c1 = ldgf4(pwg + (size_t)(2 * MI + n4 + j) * 8 + 4);
                const f32x2 ga[4] = {(f32x2){a0[0], a0[1]}, (f32x2){a0[2], a0[3]}, (f32x2){a1[0], a1[1]}, (f32x2){a1[2], a1[3]}};
                const f32x2 gb[4] = {(f32x2){b0[0], b0[1]}, (f32x2){b0[2], b0[3]}, (f32x2){b1[0], b1[1]}, (f32x2){b1[2], b1[3]}};
                const f32x2 gc[4] = {(f32x2){c0[0], c0[1]}, (f32x2){c0[2], c0[3]}, (f32x2){c1[0], c1[1]}, (f32x2){c1[2], c1[3]}};
#pragma unroll
                for (int i = 0; i < 4; ++i) { const float wq_ = wq[i][j >> 1][j & 1], wk_ = wk[i][j >> 1][j & 1], wv_ = wv[i][j >> 1][j & 1];
#pragma unroll
                    for (int e = 0; e < 4; ++e) { gqk[i][e] += ga[e] * wq_ + gb[e] * wk_; gv[i][e] += gc[e] * wv_; } } }
            f32x2 x0[2], x1[2], x2[2], x3[2];
#pragma unroll
            for (int p = 0; p < 2; ++p) { x0[p] = (f32x2){0.f, 0.f}; x1[p] = x0[p]; x2[p] = x0[p]; }
            if (t0 > 0) { const u32x2 p0 = ldg8(XM + (size_t)(t0 - 3) * MI + n4), p1 = ldg8(XM + (size_t)(t0 - 2) * MI + n4), p2 = ldg8(XM + (size_t)(t0 - 1) * MI + n4);
                x0[0] = (f32x2){bflo(p0.x), bfhi(p0.x)}; x0[1] = (f32x2){bflo(p0.y), bfhi(p0.y)}; x1[0] = (f32x2){bflo(p1.x), bfhi(p1.x)}; x1[1] = (f32x2){bflo(p1.y), bfhi(p1.y)};
                x2[0] = (f32x2){bflo(p2.x), bfhi(p2.x)}; x2[1] = (f32x2){bflo(p2.y), bfhi(p2.y)}; }
            u32x2 xs[8], xn[8];
#pragma unroll
            for (int b = 0; b < 8; ++b) xs[b] = ldg8(XM + (size_t)(t0 + b) * MI + n4);
#pragma unroll 1
            for (int tl0 = 0; tl0 < 64; tl0 += 8) {
              { const int tn = (tl0 + 8 < 64) ? tl0 + 8 : tl0;
#pragma unroll
                for (int b = 0; b < 8; ++b) xn[b] = ldg8(XM + (size_t)(t0 + tn + b) * MI + n4); }
#pragma unroll 1
              for (int b = 0; b < 8; ++b) {
                const int tl = tl0 + b, t = t0 + tl;
                { const u32x2 p3 = xs[0];
#pragma unroll
                  for (int q = 0; q < 7; ++q) xs[q] = xs[q + 1];
                  x3[0] = (f32x2){bflo(p3.x), bfhi(p3.x)}; x3[1] = (f32x2){bflo(p3.y), bfhi(p3.y)}; }
                float xc[4]; f32x2 q2[2], k2[2], v2[2];
#pragma unroll
                for (int p = 0; p < 2; ++p) { const f32x2 cv = cb[p] + cw[0][p] * x0[p] + cw[1][p] * x1[p] + cw[2][p] * x2[p] + cw[3][p] * x3[p]; xc[2 * p] = silu_f(cv[0]); xc[2 * p + 1] = silu_f(cv[1]); }
                const float xm[4] = {x3[0][0], x3[0][1], x3[1][0], x3[1][1]};
#pragma unroll
                for (int p = 0; p < 2; ++p) { q2[p] = wq[0][p] * xc[0] + wq[1][p] * xc[1] + wq[2][p] * xc[2] + wq[3][p] * xc[3]; k2[p] = wk[0][p] * xc[0] + wk[1][p] * xc[1] + wk[2][p] * xc[2] + wk[3][p] * xc[3];
                    v2[p] = wv[0][p] * xm[0] + wv[1][p] * xm[1] + wv[2][p] * xm[2] + wv[3][p] * xm[3]; }
                { u32x2 w; w.x = cvt_pk_bf16(q2[0][0], q2[0][1]); w.y = cvt_pk_bf16(q2[1][0], q2[1][1]); stg8(Q + (size_t)t * MI + n4, w);
                  w.x = cvt_pk_bf16(k2[0][0] * kscale, k2[0][1] * kscale); w.y = cvt_pk_bf16(k2[1][0] * kscale, k2[1][1] * kscale); stg8(Kb + (size_t)t * MI + n4, w);
                  w.x = cvt_pk_bf16(xc[0], xc[1]); w.y = cvt_pk_bf16(xc[2], xc[3]); stg8(XC + (size_t)t * MI + n4, w);
                  (void)v2; }
                f32x2 g2[4];
#pragma unroll
                for (int e = 0; e < 4; ++e) g2[e] = gqk[0][e] * xc[0] + gqk[1][e] * xc[1] + gqk[2][e] * xc[2] + gqk[3][e] * xc[3] + gv[0][e] * xm[0] + gv[1][e] * xm[1] + gv[2][e] * xm[2] + gv[3][e] * xm[3];
                const float g[8] = {g2[0][0], g2[0][1], g2[1][0], g2[1][1], g2[2][0], g2[2][1], g2[3][0], g2[3][1]};
                { const bool h5 = (lane & 32) != 0; float k4[4];
#pragma unroll
                  for (int e = 0; e < 4; ++e) { const float snd = h5 ? g[e] : g[4 + e], kp = h5 ? g[4 + e] : g[e]; k4[e] = kp + __shfl_xor(snd, 32); }
                  const bool h4 = (lane & 16) != 0; float k2_[2];
#pragma unroll
                  for (int e = 0; e < 2; ++e) { const float snd = h4 ? k4[e] : k4[2 + e], kp = h4 ? k4[2 + e] : k4[e]; k2_[e] = kp + __shfl_xor(snd, 16); }
                  const bool h3 = (lane & 8) != 0; const float snd = h3 ? k2_[0] : k2_[1], kp = h3 ? k2_[1] : k2_[0]; float k1 = kp + __shfl_xor(snd, 8);
                  k1 += __shfl_xor(k1, 4); k1 += __shfl_xor(k1, 2); k1 += __shfl_xor(k1, 1);
                  if ((lane & 7) == 0) red[(tl * 8 + wave) * 8 + (lane >> 3)] = k1; }
#pragma unroll
                for (int p = 0; p < 2; ++p) { x0[p] = x1[p]; x1[p] = x2[p]; x2[p] = x3[p]; }
              }
#pragma unroll
              for (int b = 0; b < 8; ++b) xs[b] = xn[b];
            }
        }
        __syncthreads();
        { const int tid = otid(), tok = tid >> 3, e = tid & 7; float s = ldgf(a.in[I_B_B_GATE] + e);
#pragma unroll
            for (int w = 0; w < 8; ++w) s += red[(tok * 8 + w) * 8 + e];
            if (e < 4) stgf(GI + (size_t)e * T + t0 + tok, s); else stgf(GF + (size_t)(e - 4) * T + t0 + tok, -softplus_f(-s)); }
        __syncthreads();
    }
}
__device__ __forceinline__ void ph_ml_gscan(const Args& a, LAS unsigned char* lds, int bid, int nb) {
    const int tid = otid(), lane = tid & 63, wave = tid >> 6;
    const float* GI = (const float*)(a.ws + WS_GI); const float* GF = (const float*)(a.ws + WS_GF);
    float* GS = (float*)(a.ws + WS_GS); float* RMT = (float*)(a.ws + WS_RMT); float* EF = (float*)(a.ws + WS_EF); float* MC = (float*)(a.ws + WS_MC);
    LAS float* wt = (LAS float*)lds;
    for (int h = bid; h < MH; h += nb) {
        __syncthreads();
        float lf[32], ig[32]; float s = 0.f;
#pragma unroll
        for (int q = 0; q < 8; ++q) { const f32x4 v = ldgf4(GF + (size_t)h * T + tid * 32 + 4 * q), w = ldgf4(GI + (size_t)h * T + tid * 32 + 4 * q);
            lf[4 * q] = v[0]; lf[4 * q + 1] = v[1]; lf[4 * q + 2] = v[2]; lf[4 * q + 3] = v[3]; ig[4 * q] = w[0]; ig[4 * q + 1] = w[1]; ig[4 * q + 2] = w[2]; ig[4 * q + 3] = w[3]; }
#pragma unroll
        for (int i = 0; i < 32; ++i) s += lf[i];
        float inc = s;
#pragma unroll
        for (int off = 1; off < 64; off <<= 1) { const float y = __shfl_up(inc, off); if (lane >= off) inc += y; }
        if (lane == 63) wt[wave] = inc;
        __syncthreads();
        float base = inc - s;
#pragma unroll
        for (int w = 0; w < 8; ++w) if (w < wave) base += wt[w];
        float F = base, lmax = -3.0e38f;
#pragma unroll
        for (int i = 0; i < 32; ++i) { F += lf[i]; lf[i] = F; ig[i] = ig[i] - F; lmax = fmaxf(lmax, ig[i]); }
        float minc = lmax;
#pragma unroll
        for (int off = 1; off < 64; off <<= 1) { const float y = __shfl_up(minc, off); if (lane >= off) minc = fmaxf(minc, y); }
        __syncthreads();
        if (lane == 63) wt[8 + wave] = minc;
        __syncthreads();
        float pm = __shfl_up(minc, 1); if (lane == 0) pm = -3.0e38f;
#pragma unroll
        for (int w = 0; w < 8; ++w) if (w < wave) pm = fmaxf(pm, wt[8 + w]);
        float rm = fmaxf(pm, 0.f);
#pragma unroll
        for (int i = 0; i < 32; ++i) { rm = fmaxf(rm, ig[i]); const size_t o = (size_t)h * T + tid * 32 + i; stgf(GS + o, ig[i]); stgf(RMT + o, rm); stgf(EF + o, __expf(-lf[i] - rm)); }
        if ((tid & 7) == 7) stgf(MC + h * 80 + (tid + 1) / 8, rm);
        if (tid == 0) stgf(MC + h * 80, 0.f);
    }
    __syncthreads();
}
__device__ __forceinline__ void ph_ml_ktw(const Args& a, LAS unsigned char* lds, int bid, int nb) {
    const bf16* Kn = (const bf16*)(a.ws + WS_K); const bf16* Xm = (const bf16*)(a.ws + WS_XM); bf16* KT = (bf16*)(a.ws + WS_KT); bf16* VT = (bf16*)(a.ws + WS_VT);
    const float* GS = (const float*)(a.ws + WS_GS); const float* MC = (const float*)(a.ws + WS_MC); float* NS = (float*)(a.ws + WS_NS);
    LAS float* w = (LAS float*)(lds + EXTRA_OFF); constexpr int TS = 144;
    for (int u = bid; u < MNC * MH; u += nb) { const int c = u / MH, h = u % MH; const int tid = otid(), lane = tid & 63, wave = tid >> 6;
        LAS unsigned char* tile = lds + wave * 16384;
        __syncthreads();
        if (tid < MCH) w[tid] = __expf(ldgf(GS + (size_t)h * T + c * MCH + tid) - ldgf(MC + h * 80 + c + 1));
        __syncthreads();
        const int ch0 = h * HD + wave * 64, rr = lane >> 3, c8 = lane & 7;
        f32x2 wvv[2][4][2];
#pragma unroll
        for (int bk = 0; bk < 2; ++bk)
#pragma unroll
            for (int i = 0; i < 4; ++i) { const f32x4 wr = ldgf4(a.in[I_B_W_V] + (size_t)((ch0 + c8 * 8) / 4 + bk) * 16 + i * 4); wvv[bk][i][0] = (f32x2){wr[0], wr[1]}; wvv[bk][i][1] = (f32x2){wr[2], wr[3]}; }
        float psum[8];
#pragma unroll
        for (int i = 0; i < 8; ++i) psum[i] = 0.f;
#pragma unroll 1
        for (int pass = 0; pass < 8; ++pass) { const int isv = pass >> 2, tg = pass & 3; const bf16* src = (isv ? Xm : Kn) + (size_t)(c * MCH + tg * 64) * MI + ch0; bf16* dst = (isv ? VT : KT) + ((size_t)u * HD + wave * 64) * MCH + tg * 64;
            u32x4 x[8];
#pragma unroll
            for (int i = 0; i < 8; ++i) x[i] = ldg16(src + (size_t)(rr + 8 * i) * MI + c8 * 8);
            if (isv) {
#pragma unroll
                for (int i = 0; i < 8; ++i) { const u32x4 xx = x[i]; const float xa[4] = {bflo(xx.x), bfhi(xx.x), bflo(xx.y), bfhi(xx.y)}, xb[4] = {bflo(xx.z), bfhi(xx.z), bflo(xx.w), bfhi(xx.w)};
                    const f32x2 va0 = wvv[0][0][0] * xa[0] + wvv[0][1][0] * xa[1] + wvv[0][2][0] * xa[2] + wvv[0][3][0] * xa[3], va1 = wvv[0][0][1] * xa[0] + wvv[0][1][1] * xa[1] + wvv[0][2][1] * xa[2] + wvv[0][3][1] * xa[3];
                    const f32x2 vb0 = wvv[1][0][0] * xb[0] + wvv[1][1][0] * xb[1] + wvv[1][2][0] * xb[2] + wvv[1][3][0] * xb[3], vb1 = wvv[1][0][1] * xb[0] + wvv[1][1][1] * xb[1] + wvv[1][2][1] * xb[2] + wvv[1][3][1] * xb[3];
                    u32x4 o; o.x = cvt_pk_bf16(va0[0], va0[1]); o.y = cvt_pk_bf16(va1[0], va1[1]); o.z = cvt_pk_bf16(vb0[0], vb0[1]); o.w = cvt_pk_bf16(vb1[0], vb1[1]); x[i] = o; } }
#pragma unroll
            for (int i = 0; i < 8; ++i) *(LAS u32x4*)(tile + (rr + 8 * i) * TS + c8 * 16) = x[i];
            LDS_WAIT(); asm volatile("" ::: "memory");
#pragma unroll
            for (int i = 0; i < 8; ++i) { const int d = rr + 8 * i; const LAS bf16* tp = (const LAS bf16*)(tile + (c8 * 8) * TS) + d; float v[8];
#pragma unroll
                for (int q = 0; q < 8; ++q) v[q] = bf2f(tp[q * (TS / 2)]);
                if (!isv) { const LAS float* wp = w + tg * 64 + c8 * 8;
#pragma unroll
                    for (int q = 0; q < 8; ++q) v[q] *= wp[q]; }
                u32x4 o; o.x = cvt_pk_bf16(v[0], v[1]); o.y = cvt_pk_bf16(v[2], v[3]); o.z = cvt_pk_bf16(v[4], v[5]); o.w = cvt_pk_bf16(v[6], v[7]);
                if (!isv) psum[i] += (bflo(o.x) + bfhi(o.x)) + (bflo(o.y) + bfhi(o.y)) + (bflo(o.z) + bfhi(o.z)) + (bflo(o.w) + bfhi(o.w));
                stg16(dst + (size_t)d * MCH + c8 * 8, o); }
            LDS_WAIT(); asm volatile("" ::: "memory");
        }
#pragma unroll
        for (int i = 0; i < 8; ++i) { float ps = psum[i]; ps += __shfl_xor(ps, 1); ps += __shfl_xor(ps, 2); ps += __shfl_xor(ps, 4); if (c8 == 0) stgf(NS + (size_t)u * HD + wave * 64 + rr + 8 * i, ps); }
    }
    asm volatile("s_waitcnt vmcnt(0)" ::: "memory");
    __syncthreads();
}
__device__ __forceinline__ void ph_ml_sscan(const Args& a, int bid, int nb) {
    bf16* CT = (bf16*)(a.ws + WS_CT); float* NS = (float*)(a.ws + WS_NS); const float* MC = (const float*)(a.ws + WS_MC);
    { const int tid = otid(), lane = tid & 63, gw = bid * NWAVES + (tid >> 6), NGW = nb * NWAVES;
      static_assert(MNC == 64, "one lane per chunk");
      for (int it = gw; it < MH * HD; it += NGW) { const int h = it / HD, d = it % HD; float* q = NS + ((size_t)lane * MH + h) * HD + d;
          float H = ldgf(q), A = __expf(ldgf(MC + h * 80 + lane) - ldgf(MC + h * 80 + lane + 1));
#pragma unroll
          for (int off = 1; off < 64; off <<= 1) { const float Ay = __shfl_up(A, off), Hy = __shfl_up(H, off); if (lane >= off) { H = A * Hy + H; A = A * Ay; } }
          float o = __shfl_up(H, 1); if (lane == 0) o = 0.f; stgf(q, o); } }
    for (int it = bid * NTHR + otid(); it < MH * HD * (HD / 8); it += nb * NTHR) {
        const int h = it / (HD * (HD / 8)), rem = it % (HD * (HD / 8)); bf16* p = CT + (size_t)h * HD * HD + (size_t)rem * 8; const size_t cs = (size_t)MH * HD * HD;
        float run[8];
#pragma unroll
        for (int j = 0; j < 8; ++j) run[j] = 0.f;
        u32x4 sv[8], sn[8];
#pragma unroll
        for (int q = 0; q < 8; ++q) sv[q] = ldg16(p + (size_t)q * cs);
        for (int c0 = 0; c0 < MNC; c0 += 8) {
            float dec[8]; const int cn = (c0 + 8 < MNC) ? c0 + 8 : c0;
#pragma unroll
            for (int q = 0; q < 8; ++q) { sn[q] = ldg16(p + (size_t)(cn + q) * cs); dec[q] = __expf(ldgf(MC + h * 80 + c0 + q) - ldgf(MC + h * 80 + c0 + q + 1)); }
#pragma unroll
            for (int q = 0; q < 8; ++q) { u32x4 o; o.x = cvt_pk_bf16(run[0], run[1]); o.y = cvt_pk_bf16(run[2], run[3]); o.z = cvt_pk_bf16(run[4], run[5]); o.w = cvt_pk_bf16(run[6], run[7]);
                stg16(p + (size_t)(c0 + q) * cs, o);
                run[0] = dec[q] * run[0] + bflo(sv[q].x); run[1] = dec[q] * run[1] + bfhi(sv[q].x); run[2] = dec[q] * run[2] + bflo(sv[q].y); run[3] = dec[q] * run[3] + bfhi(sv[q].y);
                run[4] = dec[q] * run[4] + bflo(sv[q].z); run[5] = dec[q] * run[5] + bfhi(sv[q].z); run[6] = dec[q] * run[6] + bflo(sv[q].w); run[7] = dec[q] * run[7] + bfhi(sv[q].w); }
#pragma unroll
            for (int q = 0; q < 8; ++q) sv[q] = sn[q];
        }
    }
}
struct FinIn { u32x4 nu, qv, zv, xv; f32x4 n0, n1, dp, g0, g1, k0, k1; float mc, rmt, ef; };
__device__ __forceinline__ FinIn fin_load(const Args& a, int it, int e0) {
    const bf16* NUM = (const bf16*)(a.ws + WS_NUM); const bf16* Q = (const bf16*)(a.ws + WS_Q); const bf16* Z = (const bf16*)(a.ws + WS_Z); const bf16* XC = (const bf16*)(a.ws + WS_XC);
    const float* NS = (const float*)(a.ws + WS_NS); const float* DENP = (const float*)(a.ws + WS_DENP); const float* MC = (const float*)(a.ws + WS_MC); const float* RMT = (const float*)(a.ws + WS_RMT); const float* EF = (const float*)(a.ws + WS_EF);
    const int t = it >> 2, h = it & 3, c = t >> 8, r = t & 255; const size_t o = (size_t)t * MI + h * HD + e0, cth = (size_t)(c * MH + h);
    FinIn f; f.nu = ldg16(NUM + o); f.qv = ldg16(Q + o); f.zv = ldg16(Z + o); f.xv = ldg16(XC + o);
    f.n0 = ldgf4(NS + cth * HD + e0); f.n1 = ldgf4(NS + cth * HD + e0 + 4); f.dp = ldgf4(DENP + (cth * MCH + r) * 4);
    f.g0 = ldgf4(a.in[I_B_NORM] + h * HD + e0); f.g1 = ldgf4(a.in[I_B_NORM] + h * HD + e0 + 4); f.k0 = ldgf4(a.in[I_B_SKIP] + h * HD + e0); f.k1 = ldgf4(a.in[I_B_SKIP] + h * HD + e0 + 4);
    f.mc = ldgf(MC + h * 80 + c); f.rmt = ldgf(RMT + (size_t)h * T + t); f.ef = ldgf(EF + (size_t)h * T + t); return f;
}
__device__ __forceinline__ void fin_compute(const Args& a, int it, int e0, const FinIn& f) {
    bf16* Y = (bf16*)(a.ws + WS_Y); const int t = it >> 2, h = it & 3; const size_t o = (size_t)t * MI + h * HD + e0;
    const u32x4 nu = f.nu, qv = f.qv, zv = f.zv, xv = f.xv;
    const f32x2 num[4] = {(f32x2){bflo(nu.x), bfhi(nu.x)}, (f32x2){bflo(nu.y), bfhi(nu.y)}, (f32x2){bflo(nu.z), bfhi(nu.z)}, (f32x2){bflo(nu.w), bfhi(nu.w)}};
    const f32x2 qq[4] = {(f32x2){bflo(qv.x), bfhi(qv.x)}, (f32x2){bflo(qv.y), bfhi(qv.y)}, (f32x2){bflo(qv.z), bfhi(qv.z)}, (f32x2){bflo(qv.w), bfhi(qv.w)}};
    const f32x2 nn[4] = {(f32x2){f.n0[0], f.n0[1]}, (f32x2){f.n0[2], f.n0[3]}, (f32x2){f.n1[0], f.n1[1]}, (f32x2){f.n1[2], f.n1[3]}};
    const f32x2 qn2 = (qq[0] * nn[0] + qq[1] * nn[1]) + (qq[2] * nn[2] + qq[3] * nn[3]);
    const float qn = wave_sum(qn2[0] + qn2[1]);
    const float rs = __expf(f.mc - f.rmt), den = rs * ((f.dp[0] + f.dp[1]) + (f.dp[2] + f.dp[3]) + qn);
    const float inv = __builtin_amdgcn_rcpf(fmaxf(fabsf(den), f.ef));
    f32x2 hc[4], s2 = (f32x2){0.f, 0.f};
#pragma unroll
    for (int i = 0; i < 4; ++i) { hc[i] = num[i] * inv; s2 += hc[i] * hc[i]; }
    const float rstd = __builtin_amdgcn_rsqf(wave_sum(s2[0] + s2[1]) * (1.0f / HD) + EPS);
    const f32x2 gg[4] = {(f32x2){f.g0[0], f.g0[1]}, (f32x2){f.g0[2], f.g0[3]}, (f32x2){f.g1[0], f.g1[1]}, (f32x2){f.g1[2], f.g1[3]}};
    const f32x2 sk[4] = {(f32x2){f.k0[0], f.k0[1]}, (f32x2){f.k0[2], f.k0[3]}, (f32x2){f.k1[0], f.k1[1]}, (f32x2){f.k1[2], f.k1[3]}};
    const f32x2 zz[4] = {(f32x2){bflo(zv.x), bfhi(zv.x)}, (f32x2){bflo(zv.y), bfhi(zv.y)}, (f32x2){bflo(zv.z), bfhi(zv.z)}, (f32x2){bflo(zv.w), bfhi(zv.w)}};
    const f32x2 xx[4] = {(f32x2){bflo(xv.x), bfhi(xv.x)}, (f32x2){bflo(xv.y), bfhi(xv.y)}, (f32x2){bflo(xv.z), bfhi(xv.z)}, (f32x2){bflo(xv.w), bfhi(xv.w)}};
    f32x2 y[4];
#pragma unroll
    for (int i = 0; i < 4; ++i) { const f32x2 zl = zz[i] * -1.4426950408889634f; f32x2 e; e[0] = __builtin_amdgcn_exp2f(zl[0]); e[1] = __builtin_amdgcn_exp2f(zl[1]);
        const f32x2 d = e + 1.0f; f32x2 sg; sg[0] = __builtin_amdgcn_rcpf(d[0]); sg[1] = __builtin_amdgcn_rcpf(d[1]);
        y[i] = sg * ((hc[i] * rstd) * gg[i] + sk[i] * xx[i]); }
    u32x4 w; w.x = cvt_pk_bf16(y[0][0], y[0][1]); w.y = cvt_pk_bf16(y[1][0], y[1][1]); w.z = cvt_pk_bf16(y[2][0], y[2][1]); w.w = cvt_pk_bf16(y[3][0], y[3][1]);
    stg16(Y + o, w);
}
__device__ __forceinline__ void ph_ml_fin(const Args& a, int bid, int nb) {
    const int tid = otid(), lane = tid & 63, wave = tid >> 6, e0 = 8 * lane;
    asm volatile("s_waitcnt vmcnt(0)" ::: "memory"); __syncthreads();
    for (int p = bid; p < MNC * MH; p += nb) { const int ch = p / MH, h = p % MH;
        for (int r = wave; r < MCH; r += 4 * NWAVES) { const int i0 = ((ch * MCH + r) << 2) + h, st = NWAVES << 2;
            const FinIn f0 = fin_load(a, i0, e0), f1 = fin_load(a, i0 + st, e0), f2 = fin_load(a, i0 + 2 * st, e0), f3 = fin_load(a, i0 + 3 * st, e0);
            fin_compute(a, i0, e0, f0); fin_compute(a, i0 + st, e0, f1); fin_compute(a, i0 + 2 * st, e0, f2); fin_compute(a, i0 + 3 * st, e0, f3); } }
}

__device__ __forceinline__ void ph_s5_scan(const Args& a, LAS unsigned char* lds, int bid, int nb) {
    const int tid = otid(), pl4 = tid & 3, seg = tid >> 2;
    const float* EB = (const float*)(a.ws + WS_EB); bf16* UP = (bf16*)(a.ws + WS_UP); LAS float* tot = (LAS float*)lds;
    for (int u = bid; u < NG * 4; u += nb) {
        const int g = u >> 2, p0 = 16 * (u & 3) + 4 * pl4;
        f32x4 lr, li;
        { const f32x4 are = ldgf4(a.in[I_C_A_RE] + g * 64 + p0), aim = ldgf4(a.in[I_C_A_IM] + g * 64 + p0); const float dl = __expf(ldgf(a.in[I_C_LOG_STEP] + g));
#pragma unroll
          for (int q = 0; q < 4; ++q) { const float mag = __expf(dl * are[q]); float sn, cs; sincosf(dl * aim[q], &sn, &cs); lr[q] = mag * cs; li[q] = mag * sn; }
#pragma unroll
          for (int q = 0; q < 4; ++q) { const f32x4 nr = lr * lr - li * li, ni = 2.f * lr * li; lr = nr; li = ni; } }
        f32x4 sr = lr, si = li;
#pragma unroll
        for (int q = 0; q < 3; ++q) { const f32x4 nr = sr * sr - si * si, ni = 2.f * sr * si; sr = nr; si = ni; }
        const float* eb = EB + ((size_t)g * SNC + seg * 8) * 128 + p0;
        f32x4 er[8], ei[8];
#pragma unroll
        for (int c = 0; c < 8; ++c) { er[c] = ldgf4(eb + (size_t)c * 128); ei[c] = ldgf4(eb + (size_t)c * 128 + 64); }
        f32x4 str = (f32x4){0.f, 0.f, 0.f, 0.f}, sti = str;
#pragma unroll
        for (int c = 0; c < 8; ++c) { const f32x4 tr = er[c], ti = ei[c]; er[c] = str; ei[c] = sti;
            const f32x4 nr = lr * str - li * sti + tr, ni = lr * sti + li * str + ti; str = nr; sti = ni; }
        __syncthreads();
        *(LAS f32x4*)(tot + (seg * 16 + 4 * pl4) * 2) = (f32x4){str[0], sti[0], str[1], sti[1]}; *(LAS f32x4*)(tot + (seg * 16 + 4 * pl4) * 2 + 4) = (f32x4){str[2], sti[2], str[3], sti[3]};
        __syncthreads();
        f32x4 cr = (f32x4){0.f, 0.f, 0.f, 0.f}, ci = cr;
        for (int s = 0; s < seg; ++s) { const f32x4 t0 = *(const LAS f32x4*)(tot + (s * 16 + 4 * pl4) * 2), t1 = *(const LAS f32x4*)(tot + (s * 16 + 4 * pl4) * 2 + 4);
            const f32x4 tr = (f32x4){t0[0], t0[2], t1[0], t1[2]}, ti = (f32x4){t0[1], t0[3], t1[1], t1[3]};
            const f32x4 nr = sr * cr - si * ci + tr, ni = sr * ci + si * cr + ti; cr = nr; ci = ni; }
        bf16* up = UP + ((size_t)g * SNC + seg * 8) * SK + 256 + p0;
#pragma unroll
        for (int c = 0; c < 8; ++c) { const f32x4 vr = er[c] + cr, vi = ei[c] + ci;
            u32x2 wr_, wi_; wr_.x = cvt_pk_bf16(vr[0], vr[1]); wr_.y = cvt_pk_bf16(vr[2], vr[3]); wi_.x = cvt_pk_bf16(vi[0], vi[1]); wi_.y = cvt_pk_bf16(vi[2], vi[3]);
            stg8(up + (size_t)c * SK, wr_); stg8(up + (size_t)c * SK + 64, wi_);
            const f32x4 nr = lr * cr - li * ci, ni = lr * ci + li * cr; cr = nr; ci = ni; }
    }
    __syncthreads();
}
#ifndef MK_PER_PHASE
#define MK_PER_PHASE 0
#endif
constexpr int NPHASES = 38 - 4 * DEFER_NORM;
__global__ void __launch_bounds__(NTHR, 2) mega_fwd(Args args0) {
    extern __shared__ __attribute__((aligned(16))) unsigned char lds_raw[];
    LAS unsigned char* lds = (LAS unsigned char*)lds_raw;
    const int tid = threadIdx.x, bid0 = blockIdx.x, nb0 = gridDim.x;
    if (tid < 16) ((LAS unsigned*)(lds + MISC_OFF))[tid] = 0u;
    __syncthreads();
    XcdBarrier bar = xcd_barrier_post((unsigned*)(args0.ws + WS_CTL) + CW_BAR + args0.li * 4096, (volatile LAS unsigned*)(lds + MISC_OFF));
    int pc = 0; const int lo = args0.ph_lo, hi = args0.ph_hi;
#ifndef PH_REP
#define PH_REP 0ull
#endif
#ifndef PH_REPN
#define PH_REPN 1
#endif
#ifndef XBAR_EXTRA
#define XBAR_EXTRA 0
#endif
#ifndef PH_MASK
#define PH_MASK 0xFFFFFFFFull
#endif
#ifdef PROBE_LO
    long long tacc_ = 0;
#define PROBE_T0 if (pc >= PROBE_LO && pc < PROBE_HI) tacc_ -= (long long)__builtin_amdgcn_s_memrealtime();
#define PROBE_T1 if (pc >= PROBE_LO && pc < PROBE_HI) tacc_ += (long long)__builtin_amdgcn_s_memrealtime();
#else
#define PROBE_T0
#define PROBE_T1
#endif
#define PHASE(id, ...) do { if (((PH_MASK >> (id)) & 1ull) && pc >= lo && pc < hi) { PROBE_T0 { int bid = bid0, nb = nb0; unsigned char* ws = args0.ws; asm volatile("" : "+s"(bid), "+s"(nb), "+s"(ws)); Args args = args0; args.ws = ws; const int tidl = otid(), lane = tidl & 63, wave = tidl >> 6; const int gw = bid * NWAVES + wave, NGW = nb * NWAVES; bf16* HN = (bf16*)(ws + WS_HN); LAS float* scr = (LAS float*)(lds + wave * 16384); for (int rep_ = 0; rep_ < 1 + (int)((PH_REP >> (id)) & 1ull) * PH_REPN; ++rep_) { __VA_ARGS__; __syncthreads(); } } if (pc + 1 < hi) xcd_barrier(bar); PROBE_T1 } ++pc; } while (0)


#define GMIX(l) (args.in[I_NORM_MIX] + (l) * D)
#define GFFN(l) (args.in[I_NORM_FFN] + (l) * D)
#define DQ_TAIL(nun_, TL, TH, q_) do { if ((TL) >= 0) { const int nu__ = (nun_); const int mine_ = bid < nu__ ? (nu__ - 1 - bid) / nb + 1 : 0, mx_ = (nu__ - 1) / nb + 1; \
        if (mine_ < mx_) dq_work(args, (TL), (TH), (q_) * (mx_ - mine_), lds, scr); } } while (0)
#define DQ_DRAIN(G) do { if ((G) >= 0) { dq_work(args, (G), (G), -1, lds, scr); __syncthreads(); } } while (0)
#define RG_MIXER(l, jl, CONVF, TL, TH, RSI, EM, DR)   \
    PHASE(3, { if (RG_F8(jl)) { Sched2D S{(const char*)(ws + WS_HN8), (const char*)(ws + WS_WA_IN) + (size_t)(jl) * 2 * RW * D * 2, (unsigned)D / 2, (unsigned)D / 2, T / 256, 2 * RW / 256, nb, bid}; \
               pg8::Shape sh{D / 128, 0, (unsigned)D / 2, (unsigned)D / 2, 0u, 0u}; EpiBf16T<(RSI) != 0> E{(bf16*)(ws + WS_GX), RW, RW, (WS_XR - WS_GX) / 2, 0, 1.0f / 64.0f, (const float*)(ws + WS_RSS)}; \
               pg8::gemm_phase<EpiBf16T<(RSI) != 0>, Sched2D, false, false, true>(lds, sh, S, E); } \
               else { Sched2D S{(const char*)HN, (const char*)(ws + WS_WA_IN) + (size_t)(jl) * 2 * RW * D * 2, (unsigned)D, (unsigned)D, T / 256, 2 * RW / 256, nb, bid}; \
               pg8::Shape sh{D / 64, 0, (unsigned)D, (unsigned)D, 0u, 0u}; EpiBf16T<(RSI) != 0> E{(bf16*)(ws + WS_GX), RW, RW, (WS_XR - WS_GX) / 2, 0, 1.0f, (const float*)(ws + WS_RSS)}; \
               pg8::gemm_phase<EpiBf16T<(RSI) != 0>, Sched2D, false>(lds, sh, S, E); } DQ_TAIL((T / 256) * (2 * RW / 256), TL, TH, 2); } ); \
    PHASE(4, ph_rg_gates(args, lds, bid, nb, (jl)); ); \
    PHASE(5, ph_rg_carry(args, bid, nb); ); \
    PHASE(6, ph_rg_fix(args, bid, nb); ); \
    PHASE(7, { const bool early_ = ((bid >> 3) & 1) != 0;        \
               DQ_DRAIN(DR); \
               if ((CONVF) >= 0 && early_) { dq_work(args, DQ_MOE1, DQ_MOE1, -2, lds, scr); __syncthreads(); }     \
               { Sched2D S{(const char*)(ws + WS_GX), (const char*)(ws + WS_WA_OUT) + (size_t)(jl) * D * RW * 2, (unsigned)RW, (unsigned)RW, T / 256, D / 256, nb, bid}; \
               pg8::Shape sh{RW / 64, 0, (unsigned)RW, (unsigned)RW, 0u, 0u}; \
               { EpiResidT<(EM)> E{(bf16*)(ws + WS_XB), ws + WS_HN8, (float*)(ws + WS_RSS), (LAS float*)(lds + EXTRA_OFF), 1.0f}; pg8::gemm_phase<EpiResidT<(EM)>, Sched2D, false>(lds, sh, S, E); } } \
               if ((CONVF) >= 0) { dq_work(args, DQ_MOE1, DQ_MOE1, -1, lds, scr); __syncthreads(); } } );
#define DENSE_FFN(l, W13O, W2O, GDR, TL, TH, F8, EM, DR)   \
    PHASE(21, { if (F8) { Sched2D S{(const char*)(ws + WS_HN8), (const char*)(ws + (W13O)), (unsigned)D / 2, (unsigned)D / 2, T / 256, 2 * FF / 256, nb, bid}; \
                          pg8::Shape sh{D / 128, 0, (unsigned)D / 2, (unsigned)D / 2, 0u, 0u}; EpiSwiglu8T<DEFER_NORM != 0> E{ws + WS_H, (const float*)(ws + WS_RSS)}; \
                          pg8::gemm_phase<EpiSwiglu8T<DEFER_NORM != 0>, Sched2D, false, false, true>(lds, sh, S, E); } \
                else { Sched2D S{(const char*)HN, (const char*)(ws + (W13O)), (unsigned)D, (unsigned)D, T / 256, 2 * FF / 256, nb, bid}; \
                       pg8::Shape sh{D / 64, 0, (unsigned)D, (unsigned)D, 0u, 0u}; EpiSwigluT<DEFER_NORM != 0> E{(bf16*)(ws + WS_H), (const float*)(ws + WS_RSS)}; \
                       pg8::gemm_phase<EpiSwigluT<DEFER_NORM != 0>, Sched2D, false>(lds, sh, S, E); } \
                DQ_TAIL((T / 256) * (2 * FF / 256), TL, TH, 2); \
                if ((l) == 0 && bid >= nb / 2) s5_mats(args, lds, bid - nb / 2, nb / 2); } );     \
    PHASE(22, { if (DEFER_NORM) DQ_DRAIN(DR); \
                if (F8) { Sched2D S{(const char*)(ws + WS_H), (const char*)(ws + (W2O)), (unsigned)FF / 2, (unsigned)FF / 2, T / 256, D / 256, nb, bid}; \
                          pg8::Shape sh{FF / 128, 0, (unsigned)FF / 2, (unsigned)FF / 2, 0u, 0u}; EpiResidT<(EM)> E{(bf16*)(ws + WS_XB), ws + WS_HN8, (float*)(ws + WS_RSS), (LAS float*)(lds + EXTRA_OFF), 1.0f / 64.0f}; \
                          pg8::gemm_phase<EpiResidT<(EM)>, Sched2D, false, false, true>(lds, sh, S, E); } \
                else { Sched2D S{(const char*)(ws + WS_H), (const char*)(ws + (W2O)), (unsigned)FF, (unsigned)FF, T / 256, D / 256, nb, bid}; \
                       pg8::Shape sh{FF / 64, 0, (unsigned)FF, (unsigned)FF, 0u, 0u}; EpiResidT<(EM)> E{(bf16*)(ws + WS_XB), ws + WS_HN8, (float*)(ws + WS_RSS), (LAS float*)(lds + EXTRA_OFF), 1.0f}; \
                       pg8::gemm_phase<EpiResidT<(EM)>, Sched2D, false>(lds, sh, S, E); } } );
#define MOE_FFN(l, f, CONV, TL, TH, F8) \
    PHASE(23, if (CONV) { conv_moe(args, (f), gw, NGW, scr, lane); __syncthreads(); } ph_norm<false, true, (F8) ? 3 : 0>(args, lds, bid, nb, nullptr, GFFN(l), (f)); ); \
    PHASE(25, { SchedMoe S; S.A = (const char*)HN; S.B = (const char*)(ws + WS_W13); S.lda = (F8) ? D / 2 : D; S.ldb = S.lda; S.bstride = (F8) ? W13_BYTES / 2 : W13_BYTES; S.nN = 2 * FF / 256; S.G = nb; S.c = bid; S.ksplit = 1; S.khbytes = 0; S.gather = 1; \
                int cnt_[NE]; moe_prefix(args, (f), S.ps, S.P, cnt_); LAS int* gt_ = (LAS int*)(lds + EXTRA_OFF); S.gt = gt_; \
                if (!(F8)) { const int* LISTE = (const int*)(ws + WS_LISTE); pg8::Unit u_; const int tid_ = otid(); \
                  _Pragma("unroll 1") for (int i_ = 0; S.next(i_, u_) && i_ < 23; ++i_) { const int e_ = u_.aux; int c_ = 0, p0_ = 0; \
                      _Pragma("unroll") for (int q_ = 0; q_ < NE; ++q_) { c_ = (e_ == q_) ? cnt_[q_] : c_; p0_ = (e_ == q_) ? S.ps[q_] : p0_; } \
                      const int r_ = (u_.pm - p0_) * 256 + tid_; if (tid_ < 256) gt_[i_ * 256 + tid_] = (r_ < c_) ? ldgi(LISTE + e_ * T + r_) : 0; } \
                  __syncthreads(); } \
                if (F8) { S.A = (const char*)(ws + WS_AGX); S.gather = 0; S.erows = T; pg8::Shape sh{D / 128, 0, (unsigned)D / 2, (unsigned)D / 2, 0u, 0u}; EpiSwiglu8 E{ws + WS_H};     \
                          pg8::gemm_phase<EpiSwiglu8, SchedMoe, false, false, true>(lds, sh, S, E); } \
                else { pg8::Shape sh{D / 64, 0, (unsigned)D, (unsigned)D, 0u, 0u}; EpiSwiglu E{(bf16*)(ws + WS_H)}; \
                       pg8::gemm_phase<EpiSwiglu, SchedMoe, false, true>(lds, sh, S, E); } \
                DQ_TAIL(S.P * S.nN, TL, TH, 2); } ); \
    PHASE(26, { SchedMoe S; S.A = (const char*)(ws + WS_H); S.B = (const char*)(ws + ((F8) ? WS_W2T8 : WS_W2T)); S.lda = (F8) ? FF / 2 : FF; S.ldb = S.lda; S.bstride = (F8) ? W2_BYTES / 2 : W2_BYTES; S.nN = D / 256; S.G = nb; S.c = bid; \
                S.ksplit = (F8) ? 1 : 2; S.khbytes = FF; S.gather = 0; S.gt = nullptr; int cnt_[NE]; moe_prefix(args, (f), S.ps, S.P, cnt_); \
                if (F8) { pg8::Shape sh{FF / 128, 0, (unsigned)FF / 2, (unsigned)FF / 2, 0u, 0u}; EpiBf16 E{(bf16*)(ws + WS_AG), D, 0, 0, 0, 1.0f / 64.0f}; \
                          pg8::gemm_phase<EpiBf16, SchedMoe, false, false, true>(lds, sh, S, E); } \
                else { pg8::Shape sh{FF / 128, 0, (unsigned)FF, (unsigned)FF, 0u, 0u}; EpiBf16 E{(bf16*)(ws + WS_AG), D, 0, 0, (WS_OUT - WS_AG) / 2}; \
                       pg8::gemm_phase<EpiBf16, SchedMoe, false>(lds, sh, S, E); } \
                DQ_TAIL(S.P * S.nN * S.ksplit, TL, TH, 3); } );

        PHASE(0, conv_a(args, 0, gw, NGW, scr, lane); __syncthreads(); ph_norm<false, false, 4, true>(args, lds, bid, nb, args.in[I_X], GMIX(0), 0); );
    RG_MIXER(0, 0, -1, DQ_DENSE0, DQ_C, 1, (DENSE_F8(0) ? 2 : 1), DQ_DENSE0)
    DENSE_FFN(0, WS_W13, WS_W2T, DQ_DENSE0, DQ_B, DQ_C, DENSE_F8(0), 1, DQ_B)
    PHASE(8, { Sched2D S{(const char*)HN, (const char*)(ws + WS_WB_IN), (unsigned)D, (unsigned)D, T / 256, 2 * MI / 256, nb, bid};
               pg8::Shape sh{D / 64, 0, (unsigned)D, (unsigned)D, 0u, 0u}; EpiBf16T<DEFER_NORM != 0> E{(bf16*)(ws + WS_XM), MI, MI, (WS_Z - WS_XM) / 2, 0, 1.0f, (const float*)(ws + WS_RSS)};
               pg8::gemm_phase<EpiBf16T<DEFER_NORM != 0>, Sched2D, false>(lds, sh, S, E); } );
    PHASE(9, ph_ml_prep(args, lds, bid, nb); );
    PHASE(10, ph_ml_gscan(args, lds, bid, nb); );
    PHASE(11, { SchedSbuild S{(const char*)(ws + WS_Q), (const char*)(ws + WS_K), nb, bid};
                pg8::Shape sh{HD / 64, 0, (unsigned)MI, (unsigned)MI, 0u, 0u}; EpiSbuild E{(bf16*)(ws + WS_SM), (float*)(ws + WS_DENP), (const float*)(ws + WS_GS), (const float*)(ws + WS_MC)};
                pg8::gemm_phase<EpiSbuild, SchedSbuild, false>(lds, sh, S, E); }
#ifdef PROBE_KTW
              tacc_ -= (long long)__builtin_amdgcn_s_memrealtime();
#endif
              ph_ml_ktw(args, lds, bid, nb);
#ifdef PROBE_KTW
              tacc_ += (long long)__builtin_amdgcn_s_memrealtime();
#endif
#ifdef PROBE_STATE
              tacc_ -= (long long)__builtin_amdgcn_s_memrealtime();
#endif
              { SchedState S{(const char*)(ws + WS_VT), (const char*)(ws + WS_KT), nb, bid};
                pg8::Shape sh{MCH / 64, 0, (unsigned)MCH, (unsigned)MCH, 0u, 0u}; EpiBf16 E{(bf16*)(ws + WS_CT), HD, 0, 0, (size_t)HD * HD};
                pg8::gemm_phase<EpiBf16, SchedState, false>(lds, sh, S, E); }
#ifdef PROBE_STATE
              tacc_ += (long long)__builtin_amdgcn_s_memrealtime();
#endif
              );
    PHASE(28, ph_ml_sscan(args, bid, nb); );
    PHASE(13, { SchedPass2 S{(const char*)(ws + WS_SM), (const char*)(ws + WS_Q), (const char*)(ws + WS_VT), (const char*)(ws + WS_CT), nb, bid};
                pg8::Shape sh{MCH / 64, HD / 64, (unsigned)MCH, (unsigned)MCH, (unsigned)MI, (unsigned)HD}; EpiNum E{(bf16*)(ws + WS_NUM), (const float*)(ws + WS_RMT), (const float*)(ws + WS_MC)};
                pg8::gemm_phase<EpiNum, SchedPass2, true>(lds, sh, S, E); }
              ph_ml_fin(args, bid, nb); );
#ifndef ML_OUT_STAGGER
#define ML_OUT_STAGGER 1
#endif
    PHASE(15, { const bool early_ = !ML_OUT_STAGGER || ((bid >> 3) & 1) != 0;
                if (early_) { conv_moe(args, 0, gw, NGW, scr, lane); __syncthreads(); }
                { Sched2D S{(const char*)(ws + WS_Y), (const char*)(ws + WS_WB_OUT), (unsigned)MI, (unsigned)MI, T / 256, D / 256, nb, bid};
                pg8::Shape sh{MI / 64, 0, (unsigned)MI, (unsigned)MI, 0u, 0u}; EpiResid E{(bf16*)(ws + WS_XB), nullptr, nullptr, nullptr, 1.0f};
                pg8::gemm_phase<EpiResid, Sched2D, false>(lds, sh, S, E); }
                if (!early_) { conv_moe(args, 0, gw, NGW, scr, lane); __syncthreads(); } } );
    MOE_FFN(1, 0, false, DQ_DENSE1, DQ_A1, MOE_F8(0))
    PHASE(2, DQ_DRAIN(DQ_C); ph_norm<true, false, 1>(args, lds, bid, nb, nullptr, GMIX(2), 0); );
    PHASE(16, { SchedBatch S{(const char*)(ws + WS_UP), (const char*)(ws + WS_S5_BE), (unsigned)SK, 256u, (size_t)SNC * SK * 2, (size_t)256 * 256 * 2, SNC / 256, NG, nb, bid};
                pg8::Shape sh{4, 0, (unsigned)SK, 256u, 0u, 0u}; EpiS5e E{(float*)(ws + WS_EB)};
                pg8::gemm_phase<EpiS5e, SchedBatch, false>(lds, sh, S, E); } );
    PHASE(17, ph_s5_scan(args, lds, bid, nb); );
    PHASE(18, { SchedBatch S{(const char*)(ws + WS_UP), (const char*)(ws + WS_S5_KC), (unsigned)SK, (unsigned)SK, (size_t)SNC * SK * 2, (size_t)256 * SK * 2, SNC / 256, NG, nb, bid};
                pg8::Shape sh{SK / 64, 0, (unsigned)SK, (unsigned)SK, 0u, 0u}; EpiS5y E{(const bf16*)(ws + WS_UP), args.in[I_C_D], (bf16*)(ws + WS_YA)};
                pg8::gemm_phase<EpiS5y, SchedBatch, false>(lds, sh, S, E); } );
    PHASE(19, { if (DEFER_NORM) DQ_DRAIN(DQ_DENSE1);
                Sched2D S{(const char*)(ws + WS_YA), (const char*)(ws + WS_WC_GLU), 16u, (unsigned)D, T / 256, D / 256, nb, bid};
                pg8::Shape sh{D / 64, 0, 16u, (unsigned)D, 0u, 0u, 4u * T * 32u, T * 32u}; constexpr int EM_ = DEFER_NORM ? (DENSE_F8(1) ? 2 : 1) : 0;
                EpiGluT<EM_> E{(const bf16*)(ws + WS_YA), args.in[I_C_B_GLU], (bf16*)(ws + WS_XB), ws + WS_HN8, (float*)(ws + WS_RSS), (LAS float*)(lds + EXTRA_OFF)};
                pg8::gemm_phase<EpiGluT<EM_>, Sched2D, false>(lds, sh, S, E); } );
    DENSE_FFN(2, WS_WD1_13, WS_WD1_2, DQ_DENSE1, DQ_MOE1, DQ_MOE1, DENSE_F8(1), (RG_F8(1) ? 2 : 1), DQ_A1)
    RG_MIXER(3, 1, 1, DQ_MOE1, DQ_MOE1, DEFER_NORM, 0, -1)
    MOE_FFN(3, 1, false, -1, -1, MOE_F8(1))
    PHASE(27, ph_norm<true, false, 2>(args, lds, bid, nb, nullptr, args.in[I_NORM_FINAL], 1); );
    for (int xb_ = 0; xb_ < XBAR_EXTRA; ++xb_) xcd_barrier(bar);
#ifdef PROBE_LO
    if (bid0 == 0 && tid == 0) { const long long te_ = (long long)__builtin_amdgcn_s_memrealtime() + (long long)(PROBE_N) * tacc_; while ((long long)__builtin_amdgcn_s_memrealtime() < te_) __builtin_amdgcn_s_sleep(16); }
#endif
#undef PHASE
}

extern "C" void kernel_launch(void* const* d_in, const int* in_sizes, int n_in, void* d_out, int out_size, void* d_ws, size_t ws_size, hipStream_t stream) {
    static int grid = 0;
    if (grid == 0) {
        if (n_in != N_IN || in_sizes[0] != T * D || out_size != T * D || ws_size < WS_END) {
            fprintf(stderr, "kernel_launch: unexpected problem (n_in %d, in0 %d, out %d, ws %zu, need %zu)\n", n_in, n_in > 0 ? in_sizes[0] : -1, out_size, ws_size, (size_t)WS_END); grid = -1; return; }
        int dev = 0, cus = 0, per_cu = 0;
        if (hipGetDevice(&dev) != hipSuccess || hipDeviceGetAttribute(&cus, hipDeviceAttributeMultiprocessorCount, dev) != hipSuccess) { fprintf(stderr, "kernel_launch: device query failed\n"); grid = -1; return; }
        if (hipFuncSetAttribute((const void*)mega_fwd, hipFuncAttributeMaxDynamicSharedMemorySize, LDS_BYTES) != hipSuccess) { fprintf(stderr, "kernel_launch: hipFuncSetAttribute failed\n"); grid = -1; return; }
        if (hipOccupancyMaxActiveBlocksPerMultiprocessor(&per_cu, (const void*)mega_fwd, NTHR, LDS_BYTES) != hipSuccess || per_cu < 1) fprintf(stderr, "kernel_launch: occupancy query reports %d blocks per CU\n", per_cu);
        (void)hipGetLastError();
        if (cus < 256) { fprintf(stderr, "kernel_launch: %d CUs < 256: the 256-workgroup grid would not be resident\n", cus); grid = -1; return; }
        grid = 256;
    }
    if (grid < 0) return;
    if (hipMemsetAsync((char*)d_ws + WS_CTL, 0, CTL_ZERO_BYTES, stream) != hipSuccess) { fprintf(stderr, "kernel_launch: memset failed\n"); return; }
    Args a{};
    for (int i = 0; i < N_IN; ++i) a.in[i] = (const float*)d_in[i];
    a.out = (float*)d_out; a.ws = (unsigned char*)d_ws; a.pad = 0;
#if MK_PER_PHASE
    for (int k = 0; k < NPHASES; ++k) { a.ph_lo = k; a.ph_hi = k + 1; a.li = k; hipLaunchKernelGGL(mega_fwd, dim3(grid), dim3(NTHR), LDS_BYTES, stream, a); }
#else
    a.ph_lo = 0; a.ph_hi = NPHASES; a.li = 0;
    hipLaunchKernelGGL(mega_fwd, dim3(grid), dim3(NTHR), LDS_BYTES, stream, a);
#endif
    const hipError_t le = hipPeekAtLastError();
    if (le != hipSuccess) fprintf(stderr, "kernel_launch: launch failed: %s\n", hipGetErrorName(le));
}
```
